# Optimizing an MI355X kernel written in HIP

```python
import math
import jax, jax.numpy as jnp
from jax import lax
import numpy as np

D_MODEL = 1024
BATCH = 4
SEQ = 8192
DEPTH = 1

CHUNK = 64
MEM_LEN = 256
EPS = 1e-6
NEG = -1e30

FOX_HEAD_DIM = 64
D_FOX = 3 * D_MODEL // 4
FOX_HEADS = D_FOX // FOX_HEAD_DIM
Q_BLOCK = 128

D_S5 = 3 * D_MODEL // 4
S5_GROUP = 16
S5_GROUPS = D_S5 // S5_GROUP
S5_STATE = 64

D_MEM = D_MODEL // 2
MEM_HEADS = 4
MEM_HEAD_DIM = D_MEM // MEM_HEADS

N_BRANCH = 3
IN_SIZES = (D_FOX, D_FOX, D_FOX, FOX_HEADS, D_FOX,
            D_S5, D_S5,
            D_MEM, D_MEM,
            N_BRANCH * D_MODEL)
N_IN = sum(IN_SIZES)

kernel_name = "hybrid_fox_s5_memory_gated_block"


def rms_norm(x, g):
    xf = x.astype(jnp.float32)
    y = xf * lax.rsqrt(jnp.mean(xf * xf, axis=-1, keepdims=True) + EPS)
    return (y * g.astype(jnp.float32)).astype(x.dtype)


def split_cols(z):
    offs = np.cumsum(np.array(IN_SIZES))[:-1].tolist()
    return jnp.split(z, offs, axis=-1)


def forgetting_attention(q, k, v, log_f):
    Bn, L, H, Dh = q.shape
    nb = L // Q_BLOCK
    F = jnp.cumsum(log_f, axis=1).transpose(0, 2, 1)
    kh = k.astype(jnp.float32).transpose(0, 2, 1, 3)
    vh = v.astype(jnp.float32).transpose(0, 2, 1, 3)
    qb = (q.astype(jnp.float32) * (Dh ** -0.5)).reshape(Bn, nb, Q_BLOCK, H, Dh).transpose(1, 0, 3, 2, 4)
    Fq = F.reshape(Bn, H, nb, Q_BLOCK).transpose(2, 0, 1, 3)
    starts = jnp.arange(nb, dtype=jnp.int32) * Q_BLOCK
    key_pos = jnp.arange(L, dtype=jnp.int32)

    def block(args):
        qi, Fi, s0 = args
        s = jnp.einsum('bhqd,bhkd->bhqk', qi, kh)
        s = s + Fi[..., None] - F[:, :, None, :]
        qpos = s0 + jnp.arange(Q_BLOCK, dtype=jnp.int32)
        s = jnp.where(key_pos[None, :] <= qpos[:, None], s, NEG)
        p = jax.nn.softmax(s, axis=-1)
        return jnp.einsum('bhqk,bhkd->bhqd', p, vh)

    out = lax.map(block, (qb, Fq, starts))
    return out.transpose(1, 0, 3, 2, 4).reshape(Bn, L, H * Dh).astype(q.dtype)


def s5_ssm(u, lam_re, lam_im, log_step, b_re, b_im, c_re, c_im, d_skip):
    Bn, L, _ = u.shape
    f32 = jnp.float32
    uf = u.astype(f32).reshape(Bn, L, S5_GROUPS, S5_GROUP)
    step = jnp.exp(log_step.astype(f32))[:, None]
    lr, li = lam_re.astype(f32), lam_im.astype(f32)
    mag = jnp.exp(lr * step)
    ab_re, ab_im = mag * jnp.cos(li * step), mag * jnp.sin(li * step)
    den = lr * lr + li * li
    nr, ni = ab_re - 1.0, ab_im
    f_re = (nr * lr + ni * li) / den
    f_im = (ni * lr - nr * li) / den
    br, bi = b_re.astype(f32), b_im.astype(f32)
    bb_re = f_re[..., None] * br - f_im[..., None] * bi
    bb_im = f_re[..., None] * bi + f_im[..., None] * br
    x_re = jnp.einsum('gph,blgh->blgp', bb_re, uf)
    x_im = jnp.einsum('gph,blgh->blgp', bb_im, uf)
    a_re = jnp.broadcast_to(ab_re[None, None], (1, L, S5_GROUPS, S5_STATE))
    a_im = jnp.broadcast_to(ab_im[None, None], (1, L, S5_GROUPS, S5_STATE))

    def combine(e1, e2):
        a1r, a1i, b1r, b1i = e1
        a2r, a2i, b2r, b2i = e2
        return (a2r * a1r - a2i * a1i,
                a2r * a1i + a2i * a1r,
                a2r * b1r - a2i * b1i + b2r,
                a2r * b1i + a2i * b1r + b2i)

    _, _, h_re, h_im = lax.associative_scan(combine, (a_re, a_im, x_re, x_im), axis=1)
    y = (jnp.einsum('ghp,blgp->blgh', c_re.astype(f32), h_re)
         - jnp.einsum('ghp,blgp->blgh', c_im.astype(f32), h_im))
    y = y + d_skip.astype(f32).reshape(S5_GROUPS, S5_GROUP) * uf
    return y.reshape(Bn, L, D_S5).astype(u.dtype)


def memory_attention(q, mk, mv):
    Bn, L = q.shape[:2]
    s = jnp.einsum('blhd,bmhd->bhlm', q.astype(jnp.float32), mk.astype(jnp.float32)) * (MEM_HEAD_DIM ** -0.5)
    p = jax.nn.softmax(s, axis=-1)
    o = jnp.einsum('bhlm,bmhd->blhd', p, mv.astype(jnp.float32))
    return o.reshape(Bn, L, D_MEM).astype(q.dtype)


def setup_inputs(seed: int = 0) -> dict:
    key = jax.random.key(seed)
    ks = jax.random.split(key, 24)
    f32 = jnp.float32
    nrm = lambda k, shape, scale: jax.random.normal(k, shape, f32) * scale
    x = nrm(ks[0], (BATCH, SEQ, D_MODEL), 1.0)
    mem = nrm(ks[1], (BATCH, MEM_LEN, D_MODEL), 1.0)
    g_norm = 1.0 + nrm(ks[2], (DEPTH, D_MODEL), 0.02)
    g_mem_norm = 1.0 + nrm(ks[3], (DEPTH, D_MODEL), 0.02)
    g_final = 1.0 + nrm(ks[4], (D_MODEL,), 0.02)
    w_in = nrm(ks[5], (DEPTH, D_MODEL, N_IN), D_MODEL ** -0.5)
    b_forget = jax.random.uniform(ks[6], (DEPTH, FOX_HEADS), f32, 1.0, 4.0)
    b_merge = nrm(ks[7], (DEPTH, N_BRANCH * D_MODEL), 0.01)
    w_mem_kv = nrm(ks[8], (DEPTH, D_MODEL, 2 * D_MEM), D_MODEL ** -0.5)
    lam_re = -0.5 + nrm(ks[9], (DEPTH, S5_GROUPS, S5_STATE), 0.01)
    lam_im = (math.pi * jnp.arange(S5_STATE, dtype=f32))[None, None, :] + nrm(ks[10], (DEPTH, S5_GROUPS, S5_STATE), 0.01)
    log_step = jax.random.uniform(ks[11], (DEPTH, S5_GROUPS), f32, math.log(1e-3), math.log(1e-1))
    s5_b_re = nrm(ks[12], (DEPTH, S5_GROUPS, S5_STATE, S5_GROUP), (2 * S5_GROUP) ** -0.5)
    s5_b_im = nrm(ks[13], (DEPTH, S5_GROUPS, S5_STATE, S5_GROUP), (2 * S5_GROUP) ** -0.5)
    s5_c_re = nrm(ks[14], (DEPTH, S5_GROUPS, S5_GROUP, S5_STATE), (2 * S5_STATE) ** -0.5)
    s5_c_im = nrm(ks[15], (DEPTH, S5_GROUPS, S5_GROUP, S5_STATE), (2 * S5_STATE) ** -0.5)
    s5_d = nrm(ks[16], (DEPTH, D_S5), 1.0)
    w_glu = nrm(ks[17], (DEPTH, D_S5, D_S5), D_S5 ** -0.5)
    b_glu = nrm(ks[18], (DEPTH, D_S5), 0.01)
    w_proj_fox = nrm(ks[19], (DEPTH, D_FOX, D_MODEL), D_FOX ** -0.5)
    w_proj_s5 = nrm(ks[20], (DEPTH, D_S5, D_MODEL), D_S5 ** -0.5)
    w_proj_mem = nrm(ks[21], (DEPTH, D_MEM, D_MODEL), D_MEM ** -0.5)
    w_out = nrm(ks[22], (DEPTH, D_MODEL, D_MODEL), D_MODEL ** -0.5)
    return {"x": x, "mem": mem, "g_norm": g_norm, "g_mem_norm": g_mem_norm, "g_final": g_final,
            "w_in": w_in, "b_forget": b_forget, "b_merge": b_merge, "w_mem_kv": w_mem_kv,
            "lam_re": lam_re, "lam_im": lam_im, "log_step": log_step,
            "s5_b_re": s5_b_re, "s5_b_im": s5_b_im, "s5_c_re": s5_c_re, "s5_c_im": s5_c_im,
            "s5_d": s5_d, "w_glu": w_glu, "b_glu": b_glu,
            "w_proj_fox": w_proj_fox, "w_proj_s5": w_proj_s5, "w_proj_mem": w_proj_mem, "w_out": w_out}


def reference(x, mem, g_norm, g_mem_norm, g_final, w_in, b_forget, b_merge, w_mem_kv,
              lam_re, lam_im, log_step, s5_b_re, s5_b_im, s5_c_re, s5_c_im, s5_d,
              w_glu, b_glu, w_proj_fox, w_proj_s5, w_proj_mem, w_out):
    Bn, L, _ = x.shape
    M = mem.shape[1]
    for l in range(DEPTH):
        h = rms_norm(x, g_norm[l])
        z = h @ w_in[l]
        q, k, v, fl, gf, u, gs, qm, gm, gl = split_cols(z)

        log_f = jax.nn.log_sigmoid(fl.astype(jnp.float32) + b_forget[l].astype(jnp.float32))
        y_fox = forgetting_attention(q.reshape(Bn, L, FOX_HEADS, FOX_HEAD_DIM),
                                     k.reshape(Bn, L, FOX_HEADS, FOX_HEAD_DIM),
                                     v.reshape(Bn, L, FOX_HEADS, FOX_HEAD_DIM), log_f)
        y_fox = y_fox * jax.nn.silu(gf)

        y_s5 = s5_ssm(u, lam_re[l], lam_im[l], log_step[l], s5_b_re[l], s5_b_im[l],
                      s5_c_re[l], s5_c_im[l], s5_d[l])
        y_s5 = jax.nn.gelu(y_s5)
        y_s5 = y_s5 * jax.nn.sigmoid(y_s5 @ w_glu[l] + b_glu[l])
        y_s5 = y_s5 * jax.nn.silu(gs)

        kv = rms_norm(mem, g_mem_norm[l]) @ w_mem_kv[l]
        mk, mv = jnp.split(kv, 2, axis=-1)
        y_mem = memory_attention(qm.reshape(Bn, L, MEM_HEADS, MEM_HEAD_DIM),
                                 mk.reshape(Bn, M, MEM_HEADS, MEM_HEAD_DIM),
                                 mv.reshape(Bn, M, MEM_HEADS, MEM_HEAD_DIM))
        y_mem = y_mem * jax.nn.silu(gm)

        gates = jax.nn.sigmoid(gl + b_merge[l]).reshape(Bn, L, N_BRANCH, D_MODEL)
        merged = (gates[:, :, 0] * (y_fox @ w_proj_fox[l])
                  + gates[:, :, 1] * (y_s5 @ w_proj_s5[l])
                  + gates[:, :, 2] * (y_mem @ w_proj_mem[l]))
        x = x + merged @ w_out[l]
    return rms_norm(x, g_final)
```

```cpp
#include <hip/hip_runtime.h>
#include <hip/hip_cooperative_groups.h>
#include <stdint.h>
#include <stdio.h>
namespace cg = cooperative_groups;

#ifndef COOP
#define COOP 1
#endif

#define DI __device__ __forceinline__
#ifdef ONLY_PHASE
#define PH(n) ((n) == ONLY_PHASE && p.phase_lo <= (n) && (n) <= p.phase_hi)
#else
#define PH(n) (p.phase_lo <= (n) && (n) <= p.phase_hi)
#endif
#define SYNC_BEFORE(n) if (p.phase_lo < (n) && (n) <= p.phase_hi) grid.sync();
typedef unsigned short u16;
using bf16x8 = __attribute__((ext_vector_type(8))) short;
using f32x4 = __attribute__((ext_vector_type(4))) float;
using u32x4 = __attribute__((ext_vector_type(4))) unsigned;
using u32x2 = __attribute__((ext_vector_type(2))) unsigned;

constexpr int T_ = 32768, L_ = 8192;
constexpr int LDS_BYTES = 73728;
constexpr int NPHASE = 8;

constexpr size_t MiB = 1u << 20;
constexpr size_t OFF_H = 0;
constexpr size_t OFF_Q = 64 * MiB;
constexpr size_t OFF_GF = 112 * MiB;
constexpr size_t OFF_U = 160 * MiB;
constexpr size_t OFF_GS = 208 * MiB;
constexpr size_t OFF_YS5A = 256 * MiB;
constexpr size_t OFF_QM = 304 * MiB;
constexpr size_t OFF_GM = 336 * MiB;
constexpr size_t OFF_MERGED = 368 * MiB;
constexpr size_t OFF_WINT = 432 * MiB;
constexpr size_t OFF_WGLT = 443 * MiB;
constexpr size_t OFF_WKVT = 449 * MiB;
constexpr size_t OFF_WOUTT = 451 * MiB;
constexpr size_t OFF_WPFT = 453 * MiB;
constexpr size_t OFF_WPST = 455 * MiB;
constexpr size_t OFF_WPMT = 457 * MiB;
constexpr size_t OFF_WGLUT = 458 * MiB;
constexpr size_t OFF_MEMN = 460 * MiB;
constexpr size_t OFF_MK = 462 * MiB;
constexpr size_t OFF_MVT = 463 * MiB;
constexpr size_t OFF_LOGF = 464 * MiB;
constexpr size_t OFF_F = 466 * MiB;
constexpr size_t OFF_S5AB = 468 * MiB;
constexpr size_t OFF_S5BB = 469 * MiB;
constexpr size_t OFF_S5S = 470 * MiB;
constexpr size_t OFF_PART = 482 * MiB;
constexpr size_t OFF_GATE = 484 * MiB;
constexpr size_t WS_END = 500 * MiB;

struct Params {
  const float *x, *mem, *g_norm, *g_mem_norm, *g_final, *w_in, *b_forget, *b_merge, *w_mem_kv;
  const float *lam_re, *lam_im, *log_step, *b_re, *b_im, *c_re, *c_im, *s5_d, *w_glu, *b_glu;
  const float *w_pf, *w_ps, *w_pm, *w_out;
  float* out;
  char* ws;
  int phase_lo, phase_hi;
};

DI u16 f2bf(float x) { unsigned u = __float_as_uint(x); u += 0x7fffu + ((u >> 16) & 1u); return (u16)(u >> 16); }
DI unsigned pack2(float a, float b) { return (unsigned)f2bf(a) | ((unsigned)f2bf(b) << 16); }
DI float bflo(unsigned v) { return __uint_as_float(v << 16); }
DI float bfhi(unsigned v) { return __uint_as_float(v & 0xffff0000u); }
DI float sigmoidf_(float x) { return 1.f / (1.f + __expf(-x)); }
DI float siluf_(float x) { return x / (1.f + __expf(-x)); }
DI float gelu_tanh(float x) {
  float z = 0.7978845608028654f * (x + 0.044715f * x * x * x);
  float e = __expf(2.f * z);
  float th = 1.f - 2.f / (e + 1.f);
  return 0.5f * x * (1.f + th);
}
DI float wave_sum(float v) {
#pragma unroll
  for (int o = 32; o > 0; o >>= 1) v += __shfl_xor(v, o);
  return v;
}
DI f32x4 mfma16(bf16x8 a, bf16x8 b, f32x4 c) { return __builtin_amdgcn_mfma_f32_16x16x32_bf16(a, b, c, 0, 0, 0); }

template <bool SWAP>
DI void gemm_core(f32x4 (&acc)[4][4], const u16* __restrict__ A, int lda, const u16* __restrict__ Bt, int ldb, int K, char* smem) {
  const int tid = threadIdx.x, lane = tid & 63, w = tid >> 6, wr = w >> 1, wc = w & 1, l15 = lane & 15, g = lane >> 4;
  const int lrow = tid >> 3, lch = tid & 7;
  const u16* ap = A + (size_t)lrow * lda + lch * 8;
  const u16* bp = Bt + (size_t)lrow * ldb + lch * 8;
  u32x4 ra[4], rb[4];
  const int nk = K >> 6;
#pragma unroll
  for (int c = 0; c < 4; ++c) {
    ra[c] = *(const u32x4*)(ap + (size_t)c * 32 * lda);
    rb[c] = *(const u32x4*)(bp + (size_t)c * 32 * ldb);
  }
  char* wbase = smem + lrow * 144 + lch * 16;
#pragma unroll
  for (int c = 0; c < 4; ++c) {
    *(u32x4*)(wbase + c * 32 * 144) = ra[c];
    *(u32x4*)(wbase + 18432 + c * 32 * 144) = rb[c];
  }
  __syncthreads();
  const char* ardb = smem + (wr * 64 + l15) * 144 + g * 16;
  const char* brdb = smem + 18432 + (wc * 64 + l15) * 144 + g * 16;
  for (int kt = 0; kt < nk; ++kt) {
    const int cur = (kt & 1) * 36864;
    if (kt + 1 < nk) {
#pragma unroll
      for (int c = 0; c < 4; ++c) {
        ra[c] = *(const u32x4*)(ap + (size_t)c * 32 * lda + (kt + 1) * 64);
        rb[c] = *(const u32x4*)(bp + (size_t)c * 32 * ldb + (kt + 1) * 64);
      }
    }
#pragma unroll
    for (int s = 0; s < 2; ++s) {
      bf16x8 af[4], bfr[4];
#pragma unroll
      for (int i = 0; i < 4; ++i) af[i] = *(const bf16x8*)(ardb + cur + i * 16 * 144 + s * 64);
#pragma unroll
      for (int j = 0; j < 4; ++j) bfr[j] = *(const bf16x8*)(brdb + cur + j * 16 * 144 + s * 64);
#pragma unroll
      for (int i = 0; i < 4; ++i)
#pragma unroll
        for (int j = 0; j < 4; ++j)
          acc[i][j] = SWAP ? mfma16(bfr[j], af[i], acc[i][j]) : mfma16(af[i], bfr[j], acc[i][j]);
    }
    if (kt + 1 < nk) {
      const int nxt = cur ^ 36864;
#pragma unroll
      for (int c = 0; c < 4; ++c) {
        *(u32x4*)(wbase + nxt + c * 32 * 144) = ra[c];
        *(u32x4*)(wbase + nxt + 18432 + c * 32 * 144) = rb[c];
      }
    }
    __syncthreads();
  }
}

DI void zero_acc(f32x4 (&acc)[4][4]) {
#pragma unroll
  for (int i = 0; i < 4; ++i)
#pragma unroll
    for (int j = 0; j < 4; ++j) acc[i][j] = f32x4{0.f, 0.f, 0.f, 0.f};
}

DI void swz(int v, int NT, int GN, int& mt, int& nt) {
  int xcd = v & 7, j = v >> 3;
  int per_mg = 8 * NT;
  int mg = j / per_mg, r = j - mg * per_mg;
  int ng = r / (8 * GN), wv = r - ng * (8 * GN);
  mt = xcd * 32 + mg * 8 + (wv & 7);
  nt = ng * GN + (wv >> 3);
}

DI void epi_rowmajor(const f32x4 (&acc)[4][4], u16* dst, int ld, int m0, int c0, int mode) {
  const int tid = threadIdx.x, lane = tid & 63, w = tid >> 6, wr = w >> 1, wc = w & 1, l15 = lane & 15, g = lane >> 4;
#pragma unroll
  for (int i = 0; i < 4; ++i) {
    const size_t row = (size_t)(m0 + wr * 64 + i * 16 + l15);
#pragma unroll
    for (int j = 0; j < 4; ++j) {
      f32x4 v = acc[i][j];
      if (mode == 1) { v[0] *= 0.125f; v[1] *= 0.125f; v[2] *= 0.125f; v[3] *= 0.125f; }
      else if (mode == 2) { v[0] = siluf_(v[0]); v[1] = siluf_(v[1]); v[2] = siluf_(v[2]); v[3] = siluf_(v[3]); }
      u32x2 o = {pack2(v[0], v[1]), pack2(v[2], v[3])};
      *(u32x2*)(dst + row * ld + c0 + wc * 64 + j * 16 + g * 4) = o;
    }
  }
}
DI void epi_transposed(const f32x4 (&acc)[4][4], u16* dst, int m0, int c0, int H, int lgDh, int lgLk) {
  const int tid = threadIdx.x, lane = tid & 63, w = tid >> 6, wr = w >> 1, wc = w & 1, l15 = lane & 15, g = lane >> 4;
#pragma unroll
  for (int i = 0; i < 4; ++i) {
    const int token = m0 + wr * 64 + i * 16 + g * 4;
    const int bidx = token >> lgLk, tl = token & ((1 << lgLk) - 1);
#pragma unroll
    for (int j = 0; j < 4; ++j) {
      const int col = c0 + wc * 64 + j * 16 + l15;
      const int head = col >> lgDh, d = col & ((1 << lgDh) - 1);
      f32x4 v = acc[i][j];
      u32x2 o = {pack2(v[0], v[1]), pack2(v[2], v[3])};
      *(u32x2*)(dst + ((((((size_t)bidx * H + head) << lgDh) + d) << lgLk) + tl)) = o;
    }
  }
}

template <int D, bool FOX, bool PF, int NQ>
DI void attn_item(const u16* __restrict__ qbase, int ldq, const u16* __restrict__ kbase, int ldk,
                  const u16* __restrict__ vtbase, int ldv, const float* __restrict__ Fseq, int q0, int nkv,
                  const u16* __restrict__ gate, u16* outp, float scale, char* smem) {
  const int tid = threadIdx.x, lane = tid & 63, w = tid >> 6, l15 = lane & 15, g = lane >> 4;
  constexpr int KROW = D * 2 + 16;
  constexpr int KBYTES = 64 * KROW;
  constexpr int VBYTES = D * 144;
  constexpr int BUF = KBYTES + VBYTES + 256;
  constexpr int NL = D / 32;
  constexpr int KCH = D / 8;
  static_assert(2 * BUF <= LDS_BYTES, "attn lds");

  bf16x8 qf[NQ][D / 32];
#pragma unroll
  for (int qi = 0; qi < NQ; ++qi)
#pragma unroll
    for (int s = 0; s < D / 32; ++s)
      qf[qi][s] = *(const bf16x8*)(qbase + (size_t)(w * (16 * NQ) + qi * 16 + l15) * ldq + s * 32 + g * 8);
  float fq[NQ];
#pragma unroll
  for (int qi = 0; qi < NQ; ++qi) fq[qi] = FOX ? Fseq[q0 + w * (16 * NQ) + qi * 16 + l15] : 0.f;
  f32x4 ot[D / 16][NQ];
#pragma unroll
  for (int dt = 0; dt < D / 16; ++dt)
#pragma unroll
    for (int qi = 0; qi < NQ; ++qi) ot[dt][qi] = f32x4{0, 0, 0, 0};
  float mrun[NQ], lsum[NQ];
#pragma unroll
  for (int qi = 0; qi < NQ; ++qi) { mrun[qi] = -1e30f; lsum[qi] = 0.f; }

  u32x4 kr[NL], vr[NL];
  f32x4 fr = {0, 0, 0, 0};
#define krow(c) (((c) * 256 + tid) / KCH)
#define kch(c) (((c) * 256 + tid) % KCH)
#define vrow(c) (((c) * 256 + tid) >> 3)
#define vch(c) (tid & 7)
#define ATT_LOAD(J)                                                                                   \
  {                                                                                                   \
    const int s0_ = (J) * 64;                                                                         \
    _Pragma("unroll") for (int c = 0; c < NL; ++c) {                                                  \
      kr[c] = *(const u32x4*)(kbase + (size_t)(s0_ + krow(c)) * ldk + kch(c) * 8);                    \
      vr[c] = *(const u32x4*)(vtbase + (size_t)vrow(c) * ldv + s0_ + vch(c) * 8);                     \
    }                                                                                                 \
    if (FOX && tid < 16) fr = *(const f32x4*)(Fseq + s0_ + tid * 4);                                  \
  }
#define ATT_STORE(BO)                                                                                 \
  {                                                                                                   \
    char* b_ = smem + (BO);                                                                           \
    _Pragma("unroll") for (int c = 0; c < NL; ++c) {                                                  \
      *(u32x4*)(b_ + krow(c) * KROW + kch(c) * 16) = kr[c];                                           \
      *(u32x4*)(b_ + KBYTES + vrow(c) * 144 + vch(c) * 16) = vr[c];                                   \
    }                                                                                                 \
    if (FOX && tid < 16) *(f32x4*)(b_ + KBYTES + VBYTES + tid * 16) = fr;                             \
  }
  ATT_LOAD(0);
  ATT_STORE(0);
  __syncthreads();
  const int qlo = q0 + w * (16 * NQ);
  for (int j = 0; j < nkv; ++j) {
    const int cur = (j & 1) * BUF;
    if (j + 1 < nkv) {
      ATT_LOAD(j + 1);
      if (!PF) ATT_STORE(cur ^ BUF);
    }
    const int s0 = j * 64;
    const bool active = !FOX || (s0 <= qlo + 16 * NQ - 1);
    if (active) {
      const char* Ks = smem + cur;
      const char* Vs = smem + cur + KBYTES;
      const char* Fs = smem + cur + KBYTES + VBYTES;
      f32x4 st[4][NQ];
#pragma unroll
      for (int kt = 0; kt < 4; ++kt)
#pragma unroll
        for (int qi = 0; qi < NQ; ++qi) st[kt][qi] = f32x4{0, 0, 0, 0};
#pragma unroll
      for (int s = 0; s < D / 32; ++s) {
        bf16x8 kf[4];
#pragma unroll
        for (int kt = 0; kt < 4; ++kt) kf[kt] = *(const bf16x8*)(Ks + (kt * 16 + l15) * KROW + s * 64 + g * 16);
#pragma unroll
        for (int kt = 0; kt < 4; ++kt)
#pragma unroll
          for (int qi = 0; qi < NQ; ++qi) st[kt][qi] = mfma16(kf[kt], qf[qi][s], st[kt][qi]);
      }
      if (FOX) {
        const bool need_mask = (s0 + 63 > qlo);
#pragma unroll
        for (int kt = 0; kt < 4; ++kt) {
          f32x4 fk = *(const f32x4*)(Fs + (kt * 16 + g * 4) * 4);
#pragma unroll
          for (int qi = 0; qi < NQ; ++qi) {
            const int qpos = qlo + qi * 16 + l15;
#pragma unroll
            for (int r = 0; r < 4; ++r) {
              float v = st[kt][qi][r] + fq[qi] - fk[r];
              if (need_mask && (s0 + kt * 16 + g * 4 + r > qpos)) v = -1e30f;
              st[kt][qi][r] = v;
            }
          }
        }
      } else {
#pragma unroll
        for (int kt = 0; kt < 4; ++kt)
#pragma unroll
          for (int qi = 0; qi < NQ; ++qi)
#pragma unroll
            for (int r = 0; r < 4; ++r) st[kt][qi][r] *= scale;
      }
      float alpha[NQ];
#pragma unroll
      for (int qi = 0; qi < NQ; ++qi) {
        float mx = st[0][qi][0];
#pragma unroll
        for (int kt = 0; kt < 4; ++kt)
#pragma unroll
          for (int r = 0; r < 4; ++r) mx = fmaxf(mx, st[kt][qi][r]);
        mx = fmaxf(mx, __shfl_xor(mx, 16));
        mx = fmaxf(mx, __shfl_xor(mx, 32));
        const float mnew = fmaxf(mrun[qi], mx);
        alpha[qi] = __expf(mrun[qi] - mnew);
        mrun[qi] = mnew;
        float ps = 0.f;
#pragma unroll
        for (int kt = 0; kt < 4; ++kt)
#pragma unroll
          for (int r = 0; r < 4; ++r) {
            float p = __expf(st[kt][qi][r] - mnew);
            st[kt][qi][r] = p;
            ps += p;
          }
        lsum[qi] = lsum[qi] * alpha[qi] + ps;
      }
      bf16x8 pb[2][NQ];
#pragma unroll
      for (int kp = 0; kp < 2; ++kp)
#pragma unroll
        for (int qi = 0; qi < NQ; ++qi) {
          u32x4 t = {pack2(st[2 * kp][qi][0], st[2 * kp][qi][1]), pack2(st[2 * kp][qi][2], st[2 * kp][qi][3]),
                     pack2(st[2 * kp + 1][qi][0], st[2 * kp + 1][qi][1]), pack2(st[2 * kp + 1][qi][2], st[2 * kp + 1][qi][3])};
          pb[kp][qi] = __builtin_bit_cast(bf16x8, t);
        }
#pragma unroll
      for (int dt = 0; dt < D / 16; ++dt) {
#pragma unroll
        for (int r = 0; r < 4; ++r)
#pragma unroll
          for (int qi = 0; qi < NQ; ++qi) ot[dt][qi][r] *= alpha[qi];
#pragma unroll
        for (int kp = 0; kp < 2; ++kp) {
          u32x2 lo = *(const u32x2*)(Vs + (dt * 16 + l15) * 144 + (kp * 32 + g * 4) * 2);
          u32x2 hi = *(const u32x2*)(Vs + (dt * 16 + l15) * 144 + (kp * 32 + 16 + g * 4) * 2);
          u32x4 t = {lo[0], lo[1], hi[0], hi[1]};
          bf16x8 vf = __builtin_bit_cast(bf16x8, t);
#pragma unroll
          for (int qi = 0; qi < NQ; ++qi) ot[dt][qi] = mfma16(vf, pb[kp][qi], ot[dt][qi]);
        }
      }
    }
    if (PF && j + 1 < nkv) ATT_STORE(cur ^ BUF);
    __syncthreads();
  }
#undef ATT_LOAD
#undef ATT_STORE
#undef krow
#undef kch
#undef vrow
#undef vch
#pragma unroll
  for (int qi = 0; qi < NQ; ++qi) {
    float l = lsum[qi];
    l += __shfl_xor(l, 16);
    l += __shfl_xor(l, 32);
    const float inv = 1.f / l;
    const size_t rowoff = (size_t)(w * (16 * NQ) + qi * 16 + l15) * ldq;
#pragma unroll
    for (int dt = 0; dt < D / 16; ++dt) {
      const int col = dt * 16 + g * 4;
      u32x2 gv = *(const u32x2*)(gate + rowoff + col);
      u32x2 o = {pack2(ot[dt][qi][0] * inv * bflo(gv[0]), ot[dt][qi][1] * inv * bfhi(gv[0])),
                 pack2(ot[dt][qi][2] * inv * bflo(gv[1]), ot[dt][qi][3] * inv * bfhi(gv[1]))};
      *(u32x2*)(outp + rowoff + col) = o;
    }
  }
}

DI void s5_load_u(const u16* ubuf, int b, int c, int g, char* ut, int lane) {
  const u16* src = ubuf + ((size_t)(b * L_ + c * 64 + lane)) * 768 + g * 16;
  u32x4 a = *(const u32x4*)src, bb = *(const u32x4*)(src + 8);
  *(u32x4*)(ut + lane * 32) = a;
  *(u32x4*)(ut + lane * 32 + 16) = bb;
}
DI void s5_x(const char* ut, int t, const float (&bre)[16], const float (&bim)[16], float& xr, float& xi) {
  u32x4 a = *(const u32x4*)(ut + t * 32), b = *(const u32x4*)(ut + t * 32 + 16);
  float xr0 = 0.f, xi0 = 0.f, xr1 = 0.f, xi1 = 0.f;
#pragma unroll
  for (int q = 0; q < 4; ++q) {
    float u0 = bflo(a[q]), u1 = bfhi(a[q]);
    xr0 += bre[2 * q] * u0; xi0 += bim[2 * q] * u0;
    xr1 += bre[2 * q + 1] * u1; xi1 += bim[2 * q + 1] * u1;
  }
#pragma unroll
  for (int q = 0; q < 4; ++q) {
    float u0 = bflo(b[q]), u1 = bfhi(b[q]);
    xr0 += bre[8 + 2 * q] * u0; xi0 += bim[8 + 2 * q] * u0;
    xr1 += bre[8 + 2 * q + 1] * u1; xi1 += bim[8 + 2 * q + 1] * u1;
  }
  xr = xr0 + xr1; xi = xi0 + xi1;
}

extern "C" __global__ void __launch_bounds__(256, 2) mega(Params p) {
  extern __shared__ __attribute__((aligned(16))) char smem[];
  cg::grid_group grid = cg::this_grid();
  const int tid = threadIdx.x, lane = tid & 63, w = tid >> 6, l15 = lane & 15, g4 = lane >> 4;
  const int nblk = gridDim.x, bid = blockIdx.x;
  char* ws = p.ws;
  u16* hbuf = (u16*)(ws + OFF_H);
  u16* qbuf = (u16*)(ws + OFF_Q);
  u16* gfbuf = (u16*)(ws + OFF_GF);
  u16* ubuf = (u16*)(ws + OFF_U);
  u16* gsbuf = (u16*)(ws + OFF_GS);
  u16* ys5a = (u16*)(ws + OFF_YS5A);
  u16* qmbuf = (u16*)(ws + OFF_QM);
  u16* gmbuf = (u16*)(ws + OFF_GM);
  u16* merged = (u16*)(ws + OFF_MERGED);
  u16* WinT = (u16*)(ws + OFF_WINT);
  u16* WglT = (u16*)(ws + OFF_WGLT);
  u16* WkvT = (u16*)(ws + OFF_WKVT);
  u16* WoutT = (u16*)(ws + OFF_WOUTT);
  u16* WpfT = (u16*)(ws + OFF_WPFT);
  u16* WpsT = (u16*)(ws + OFF_WPST);
  u16* WpmT = (u16*)(ws + OFF_WPMT);
  u16* WgluT = (u16*)(ws + OFF_WGLUT);
  u16* memn = (u16*)(ws + OFF_MEMN);
  u16* mkbuf = (u16*)(ws + OFF_MK);
  u16* mvT = (u16*)(ws + OFF_MVT);
  float* logf = (float*)(ws + OFF_LOGF);
  float* Fbuf = (float*)(ws + OFF_F);
  float2* abar = (float2*)(ws + OFF_S5AB);
  float* bbar = (float*)(ws + OFF_S5BB);
  float2* Sst = (float2*)(ws + OFF_S5S);
  float* part = (float*)(ws + OFF_PART);
  u16* kbuf = (u16*)p.out;
  u16* vT = (u16*)((char*)p.out + 48 * MiB);

  {
    if (PH(0)) {
      float* tile = (float*)smem;
      for (int ti = bid; ti < 3344; ti += nblk) {
        const float* src; int ld, col0, K; u16* dst; int tt;
        if (ti < 576) { src = p.w_in; ld = 8716; col0 = 0; K = 1024; dst = WinT; tt = ti; }
        else if (ti < 1408) { src = p.w_in; ld = 8716; col0 = 2316; K = 1024; dst = WinT + (size_t)2304 * 1024; tt = ti - 576; }
        else if (ti < 2176) { src = p.w_in; ld = 8716; col0 = 5644; K = 1024; dst = WglT; tt = ti - 1408; }
        else if (ti < 2432) { src = p.w_mem_kv; ld = 1024; col0 = 0; K = 1024; dst = WkvT; tt = ti - 2176; }
        else if (ti < 2688) { src = p.w_out; ld = 1024; col0 = 0; K = 1024; dst = WoutT; tt = ti - 2432; }
        else if (ti < 2880) { src = p.w_pf; ld = 1024; col0 = 0; K = 768; dst = WpfT; tt = ti - 2688; }
        else if (ti < 3072) { src = p.w_ps; ld = 1024; col0 = 0; K = 768; dst = WpsT; tt = ti - 2880; }
        else if (ti < 3200) { src = p.w_pm; ld = 1024; col0 = 0; K = 512; dst = WpmT; tt = ti - 3072; }
        else { src = p.w_glu; ld = 768; col0 = 0; K = 768; dst = WgluT; tt = ti - 3200; }
        const int nkt = K >> 6;
        const int k0 = (tt % nkt) * 64, n0 = (tt / nkt) * 64;
#pragma unroll 4
        for (int i = 0; i < 16; ++i) {
          int k = i * 4 + w, n = lane;
          tile[k * 65 + n] = src[(size_t)(k0 + k) * ld + col0 + n0 + n];
        }
        __syncthreads();
#pragma unroll 4
        for (int i = 0; i < 16; ++i) {
          int n = i * 4 + w, k = lane;
          dst[(size_t)(n0 + n) * K + k0 + k] = f2bf(tile[k * 65 + n]);
        }
        __syncthreads();
      }
      float* wfl = (float*)smem;
      for (int idx = tid; idx < 12288; idx += 256) {
        int k = idx / 12, j = idx - k * 12;
        wfl[j * 1024 + k] = p.w_in[(size_t)k * 8716 + 2304 + j];
      }
      __syncthreads();
      for (int row = bid * 4 + w; row < T_ + 1024; row += nblk * 4) {
        const bool isx = row < T_;
        const float* src = isx ? p.x + (size_t)row * 1024 : p.mem + (size_t)(row - T_) * 1024;
        const float* gsrc = isx ? p.g_norm : p.g_mem_norm;
        u16* dst = isx ? hbuf + (size_t)row * 1024 : memn + (size_t)(row - T_) * 1024;
        float4 xv[4];
        float ss = 0.f;
#pragma unroll
        for (int i = 0; i < 4; ++i) {
          xv[i] = *(const float4*)(src + i * 256 + lane * 4);
          ss += xv[i].x * xv[i].x + xv[i].y * xv[i].y + xv[i].z * xv[i].z + xv[i].w * xv[i].w;
        }
        ss = wave_sum(ss);
        const float rstd = rsqrtf(ss * (1.f / 1024.f) + 1e-6f);
#pragma unroll
        for (int i = 0; i < 4; ++i) {
          float4 gv = *(const float4*)(gsrc + i * 256 + lane * 4);
          xv[i].x *= rstd * gv.x; xv[i].y *= rstd * gv.y; xv[i].z *= rstd * gv.z; xv[i].w *= rstd * gv.w;
          u32x2 o = {pack2(xv[i].x, xv[i].y), pack2(xv[i].z, xv[i].w)};
          *(u32x2*)(dst + i * 256 + lane * 4) = o;
        }
        if (isx) {
          float myfl = 0.f;
#pragma unroll
          for (int j = 0; j < 12; ++j) {
            float a = 0.f;
#pragma unroll
            for (int i = 0; i < 4; ++i) {
              float4 wv = *(const float4*)(wfl + j * 1024 + i * 256 + lane * 4);
              a += xv[i].x * wv.x + xv[i].y * wv.y + xv[i].z * wv.z + xv[i].w * wv.w;
            }
            a = wave_sum(a);
            if (lane == j) myfl = a;
          }
          if (lane < 12) {
            float xx = myfl + p.b_forget[lane];
            float lf = fminf(xx, 0.f) - log1pf(__expf(-fabsf(xx)));
            const int b = row >> 13, t = row & (L_ - 1);
            logf[(size_t)(b * 12 + lane) * L_ + t] = lf;
          }
        }
      }
      {
        const int gid = bid * 256 + tid;
        if (gid < 3072) {
          const int g = gid >> 6;
          const float step = expf(p.log_step[g]);
          const float lr = p.lam_re[gid], li = p.lam_im[gid];
          const float mag = expf(lr * step);
          const float ar = mag * cosf(li * step), ai = mag * sinf(li * step);
          const float den = lr * lr + li * li;
          const float nr = ar - 1.f, ni = ai;
          const float fr = (nr * lr + ni * li) / den, fi = (ni * lr - nr * li) / den;
          abar[gid] = make_float2(ar, ai);
#pragma unroll
          for (int h = 0; h < 16; ++h) {
            const float br = p.b_re[(size_t)gid * 16 + h], bi = p.b_im[(size_t)gid * 16 + h];
            bbar[(size_t)gid * 32 + h] = fr * br - fi * bi;
            bbar[(size_t)gid * 32 + 16 + h] = fr * bi + fi * br;
          }
        }
      }
      __syncthreads();
    }
    SYNC_BEFORE(1);
    if (PH(1)) {
      float* sm = (float*)smem;
      for (int seq = bid; seq < 48; seq += nblk) {
        const float* src = logf + (size_t)seq * L_ + tid * 32;
        float* dst = Fbuf + (size_t)seq * L_ + tid * 32;
        float v[32];
#pragma unroll
        for (int i = 0; i < 8; ++i) {
          float4 t = *(const float4*)(src + i * 4);
          v[4 * i] = t.x; v[4 * i + 1] = t.y; v[4 * i + 2] = t.z; v[4 * i + 3] = t.w;
        }
        float run = 0.f;
#pragma unroll
        for (int i = 0; i < 32; ++i) { run += v[i]; v[i] = run; }
        float incl = run;
#pragma unroll
        for (int o = 1; o < 64; o <<= 1) {
          float t = __shfl_up(incl, o);
          if (lane >= o) incl += t;
        }
        if (lane == 63) sm[w] = incl;
        __syncthreads();
        float base = incl - run;
        for (int w2 = 0; w2 < w; ++w2) base += sm[w2];
#pragma unroll
        for (int i = 0; i < 8; ++i) {
          float4 t = make_float4(v[4 * i] + base, v[4 * i + 1] + base, v[4 * i + 2] + base, v[4 * i + 3] + base);
          *(float4*)(dst + i * 4) = t;
        }
        __syncthreads();
      }
      for (int v = bid; v < 11264 + 64; v += nblk) {
        const u16 *A, *Bt;
        int m0, n0;
        bool kvtile = v >= 11264;
        if (!kvtile) {
          int mt, nt;
          swz(v, 44, 4, mt, nt);
          m0 = mt * 128; n0 = nt * 128;
          A = hbuf + (size_t)m0 * 1024; Bt = WinT + (size_t)n0 * 1024;
        } else {
          int kv = v - 11264;
          m0 = (kv >> 3) * 128; n0 = (kv & 7) * 128;
          A = memn + (size_t)m0 * 1024; Bt = WkvT + (size_t)n0 * 1024;
        }
        const bool transp = kvtile ? (n0 >= 512) : (n0 >= 1536 && n0 < 2304);
        f32x4 acc[4][4];
        zero_acc(acc);
        if (transp) {
          gemm_core<false>(acc, A, 1024, Bt, 1024, 1024, smem);
          if (kvtile) epi_transposed(acc, mvT, m0, n0 - 512, 4, 7, 8);
          else epi_transposed(acc, vT, m0, n0 - 1536, 12, 6, 13);
        } else {
          gemm_core<true>(acc, A, 1024, Bt, 1024, 1024, smem);
          u16* dst; int ld, c0, mode;
          if (kvtile) { dst = mkbuf; ld = 512; c0 = n0; mode = 0; }
          else if (n0 < 768) { dst = qbuf; ld = 768; c0 = n0; mode = 1; }
          else if (n0 < 1536) { dst = kbuf; ld = 768; c0 = n0 - 768; mode = 0; }
          else if (n0 < 3072) { dst = gfbuf; ld = 768; c0 = n0 - 2304; mode = 2; }
          else if (n0 < 3840) { dst = ubuf; ld = 768; c0 = n0 - 3072; mode = 0; }
          else if (n0 < 4608) { dst = gsbuf; ld = 768; c0 = n0 - 3840; mode = 2; }
          else if (n0 < 5120) { dst = qmbuf; ld = 512; c0 = n0 - 4608; mode = 0; }
          else { dst = gmbuf; ld = 512; c0 = n0 - 5120; mode = 2; }
          epi_rowmajor(acc, dst, ld, m0, c0, mode);
        }
      }
    }
    SYNC_BEFORE(2);
    if (PH(2)) {
      int it = bid;
      for (; it < 3072; it += nblk) {
        {
#ifndef NO_FOX
          const int qt = 63 - it / 48, bh = it % 48, b = bh / 12, h = bh % 12;
          const int q0 = qt * 128;
          const size_t qoff = ((size_t)(b * L_ + q0)) * 768 + h * 64;
          attn_item<64, true, true, 2>(qbuf + qoff, 768, kbuf + (size_t)b * L_ * 768 + h * 64, 768,
                              vT + (size_t)(b * 12 + h) * 64 * L_, L_, Fbuf + (size_t)(b * 12 + h) * L_, q0, 2 * qt + 2,
                              gfbuf + qoff, qbuf + qoff, 1.f, smem);
#endif
        }
      }
      for (; it < 5120; it += nblk) {
        {
#ifndef NO_MEM
          const int im = it - 3072;
          const int hm = im & 3, qt = (im >> 2) & 127, b = im >> 9;
          const int q0 = qt * 64;
          const size_t qoff = ((size_t)(b * L_ + q0)) * 512 + hm * 128;
          attn_item<128, false, false, 1>(qmbuf + qoff, 512, mkbuf + (size_t)b * 256 * 512 + hm * 128, 512,
                                mvT + (size_t)(b * 4 + hm) * 128 * 256, 256, nullptr, q0, 4,
                                gmbuf + qoff, qmbuf + qoff, 0.08838834764831845f, smem);
#endif
        }
      }
      for (; it < 3072 + 2048 + 6144; it += nblk) {
        {
#ifndef NO_S5P1
          const int wi = (it - 5120) * 4 + w;
          const int g = wi % 48, c = (wi / 48) & 127, b = wi / (48 * 128);
          char* ut = smem + w * 6400;
          s5_load_u(ubuf, b, c, g, ut, lane);
          const int gp = g * 64 + lane;
          float bre[16], bim[16];
#pragma unroll
          for (int q = 0; q < 4; ++q) {
            float4 t0 = *(const float4*)(bbar + (size_t)gp * 32 + q * 4);
            float4 t1 = *(const float4*)(bbar + (size_t)gp * 32 + 16 + q * 4);
            bre[4 * q] = t0.x; bre[4 * q + 1] = t0.y; bre[4 * q + 2] = t0.z; bre[4 * q + 3] = t0.w;
            bim[4 * q] = t1.x; bim[4 * q + 1] = t1.y; bim[4 * q + 2] = t1.z; bim[4 * q + 3] = t1.w;
          }
          const float2 ab = abar[gp];
          asm volatile("s_waitcnt lgkmcnt(0)" ::: "memory");
          float hr = 0.f, hi = 0.f;
#pragma unroll 4
          for (int t = 0; t < 64; ++t) {
            float xr, xi;
            s5_x(ut, t, bre, bim, xr, xi);
            const float nhr = ab.x * hr - ab.y * hi + xr;
            const float nhi = ab.x * hi + ab.y * hr + xi;
            hr = nhr; hi = nhi;
          }
          Sst[((size_t)(b * 128 + c) * 48 + g) * 64 + lane] = make_float2(hr, hi);
          __syncthreads();
#endif
        }
      }
    }
    SYNC_BEFORE(3);
    if (PH(3)) {
      for (int it = bid; it < 6144; it += nblk) {
        const int wi = it * 4 + w;
        const int g = wi % 48, c = (wi / 48) & 127, b = wi / (48 * 128);
        char* ut = smem + w * 6400;
        char* stt = ut + 2048;
        s5_load_u(ubuf, b, c, g, ut, lane);
        const int gp = g * 64 + lane;
        float bre[16], bim[16];
#pragma unroll
        for (int q = 0; q < 4; ++q) {
          float4 t0 = *(const float4*)(bbar + (size_t)gp * 32 + q * 4);
          float4 t1 = *(const float4*)(bbar + (size_t)gp * 32 + 16 + q * 4);
          bre[4 * q] = t0.x; bre[4 * q + 1] = t0.y; bre[4 * q + 2] = t0.z; bre[4 * q + 3] = t0.w;
          bim[4 * q] = t1.x; bim[4 * q + 1] = t1.y; bim[4 * q + 2] = t1.z; bim[4 * q + 3] = t1.w;
        }
        const float2 ab = abar[gp];
        bf16x8 cf[4];
#pragma unroll
        for (int s = 0; s < 4; ++s) {
          const float* cs = (s < 2 ? p.c_re : p.c_im) + (size_t)(g * 16 + l15) * 64 + (s & 1) * 32 + g4 * 8;
          float4 t0 = *(const float4*)cs, t1 = *(const float4*)(cs + 4);
          const float sg = (s < 2) ? 1.f : -1.f;
          u32x4 t = {pack2(sg * t0.x, sg * t0.y), pack2(sg * t0.z, sg * t0.w), pack2(sg * t1.x, sg * t1.y), pack2(sg * t1.z, sg * t1.w)};
          cf[s] = __builtin_bit_cast(bf16x8, t);
        }
        const float4 dsk = *(const float4*)(p.s5_d + g * 16 + g4 * 4);
        float a64r = ab.x, a64i = ab.y;
#pragma unroll
        for (int q = 0; q < 6; ++q) {
          const float nr = a64r * a64r - a64i * a64i, ni = 2.f * a64r * a64i;
          a64r = nr; a64i = ni;
        }
        float hr = 0.f, hi = 0.f;
        {
          const float2* sp = Sst + ((size_t)(b * 128) * 48 + g) * 64 + lane;
          for (int cc = 0; cc < c; ++cc) {
            const float2 s = sp[(size_t)cc * 48 * 64];
            const float nhr = a64r * hr - a64i * hi + s.x;
            const float nhi = a64r * hi + a64i * hr + s.y;
            hr = nhr; hi = nhi;
          }
        }
        asm volatile("s_waitcnt lgkmcnt(0)" ::: "memory");
#pragma unroll 1
        for (int sub = 0; sub < 4; ++sub) {
#pragma unroll 4
          for (int tt = 0; tt < 16; ++tt) {
            float xr, xi;
            s5_x(ut, sub * 16 + tt, bre, bim, xr, xi);
            const float nhr = ab.x * hr - ab.y * hi + xr;
            const float nhi = ab.x * hi + ab.y * hr + xi;
            hr = nhr; hi = nhi;
            *(u16*)(stt + tt * 272 + lane * 2) = f2bf(hr);
            *(u16*)(stt + tt * 272 + 128 + lane * 2) = f2bf(hi);
          }
          asm volatile("s_waitcnt lgkmcnt(0)" ::: "memory");
          f32x4 y = {0, 0, 0, 0};
#pragma unroll
          for (int s = 0; s < 4; ++s) {
            bf16x8 bfr = *(const bf16x8*)(stt + l15 * 272 + s * 64 + g4 * 16);
            y = mfma16(cf[s], bfr, y);
          }
          const int t = sub * 16 + l15;
          u32x2 uv = *(const u32x2*)(ut + t * 32 + g4 * 8);
          float o0 = gelu_tanh(y[0] + dsk.x * bflo(uv[0]));
          float o1 = gelu_tanh(y[1] + dsk.y * bfhi(uv[0]));
          float o2 = gelu_tanh(y[2] + dsk.z * bflo(uv[1]));
          float o3 = gelu_tanh(y[3] + dsk.w * bfhi(uv[1]));
          u32x2 o = {pack2(o0, o1), pack2(o2, o3)};
          *(u32x2*)(ys5a + ((size_t)(b * L_ + c * 64 + t)) * 768 + g * 16 + g4 * 4) = o;
          asm volatile("s_waitcnt lgkmcnt(0)" ::: "memory");
        }
        __syncthreads();
      }
    }
    SYNC_BEFORE(4);
    if (PH(4)) {
      for (int v = bid; v < 256 * 6; v += nblk) {
        int mt, nt;
        swz(v, 6, 6, mt, nt);
        const int m0 = mt * 128, n0 = nt * 128;
        f32x4 acc[4][4];
        zero_acc(acc);
        gemm_core<true>(acc, ys5a + (size_t)m0 * 768, 768, WgluT + (size_t)n0 * 768, 768, 768, smem);
        const int wr = w >> 1, wc = w & 1;
#pragma unroll
        for (int i = 0; i < 4; ++i) {
          const size_t row = (size_t)(m0 + wr * 64 + i * 16 + l15);
#pragma unroll
          for (int j = 0; j < 4; ++j) {
            const int n = n0 + wc * 64 + j * 16 + g4 * 4;
            const float4 bg = *(const float4*)(p.b_glu + n);
            const u32x2 av = *(const u32x2*)(ys5a + row * 768 + n);
            const u32x2 sv = *(const u32x2*)(gsbuf + row * 768 + n);
            float o0 = bflo(av[0]) * sigmoidf_(acc[i][j][0] + bg.x) * bflo(sv[0]);
            float o1 = bfhi(av[0]) * sigmoidf_(acc[i][j][1] + bg.y) * bfhi(sv[0]);
            float o2 = bflo(av[1]) * sigmoidf_(acc[i][j][2] + bg.z) * bflo(sv[1]);
            float o3 = bfhi(av[1]) * sigmoidf_(acc[i][j][3] + bg.w) * bfhi(sv[1]);
            u32x2 o = {pack2(o0, o1), pack2(o2, o3)};
            *(u32x2*)(ubuf + row * 768 + n) = o;
          }
        }
      }
    }
    SYNC_BEFORE(5);
    if (PH(5)) {
      for (int v = bid; v < 256 * 8; v += nblk) {
        int mt, nt;
        swz(v, 8, 4, mt, nt);
        const int m0 = mt * 128, n0 = nt * 128;
        const int wr = w >> 1, wc = w & 1;
        f32x4 accm[4][4];
        zero_acc(accm);
        char* gstash = ws + OFF_GATE + (size_t)bid * 32768 + tid * 16;
#pragma unroll 1
        for (int stp = 0; stp < 6; ++stp) {
          const int br = stp >> 1;
          const u16* Ab; const u16* Wb; int Kb;
          if (!(stp & 1)) { Ab = hbuf + (size_t)m0 * 1024; Wb = WglT + (size_t)(br * 1024 + n0) * 1024; Kb = 1024; }
          else if (br == 0) { Ab = qbuf + (size_t)m0 * 768; Wb = WpfT + (size_t)n0 * 768; Kb = 768; }
          else if (br == 1) { Ab = ubuf + (size_t)m0 * 768; Wb = WpsT + (size_t)n0 * 768; Kb = 768; }
          else { Ab = qmbuf + (size_t)m0 * 512; Wb = WpmT + (size_t)n0 * 512; Kb = 512; }
          f32x4 acc[4][4];
          zero_acc(acc);
          gemm_core<true>(acc, Ab, Kb, Wb, Kb, Kb, smem);
          if (!(stp & 1)) {
#pragma unroll
            for (int j = 0; j < 4; ++j) {
              const float4 bm = *(const float4*)(p.b_merge + br * 1024 + n0 + wc * 64 + j * 16 + g4 * 4);
#pragma unroll
              for (int i = 0; i < 4; i += 2) {
                u32x4 gq = {pack2(sigmoidf_(acc[i][j][0] + bm.x), sigmoidf_(acc[i][j][1] + bm.y)),
                            pack2(sigmoidf_(acc[i][j][2] + bm.z), sigmoidf_(acc[i][j][3] + bm.w)),
                            pack2(sigmoidf_(acc[i + 1][j][0] + bm.x), sigmoidf_(acc[i + 1][j][1] + bm.y)),
                            pack2(sigmoidf_(acc[i + 1][j][2] + bm.z), sigmoidf_(acc[i + 1][j][3] + bm.w))};
                *(u32x4*)(gstash + (j * 2 + (i >> 1)) * 4096) = gq;
              }
            }
          } else {
#pragma unroll
            for (int j = 0; j < 4; ++j)
#pragma unroll
              for (int i = 0; i < 4; i += 2) {
                const u32x4 gq = *(const u32x4*)(gstash + (j * 2 + (i >> 1)) * 4096);
                accm[i][j][0] += bflo(gq[0]) * acc[i][j][0];
                accm[i][j][1] += bfhi(gq[0]) * acc[i][j][1];
                accm[i][j][2] += bflo(gq[1]) * acc[i][j][2];
                accm[i][j][3] += bfhi(gq[1]) * acc[i][j][3];
                accm[i + 1][j][0] += bflo(gq[2]) * acc[i + 1][j][0];
                accm[i + 1][j][1] += bfhi(gq[2]) * acc[i + 1][j][1];
                accm[i + 1][j][2] += bflo(gq[3]) * acc[i + 1][j][2];
                accm[i + 1][j][3] += bfhi(gq[3]) * acc[i + 1][j][3];
              }
          }
        }
        epi_rowmajor(accm, merged, 1024, m0, n0, 0);
      }
    }
    SYNC_BEFORE(6);
    if (PH(6)) {
      for (int v = bid; v < 256 * 8; v += nblk) {
        int mt, nt;
        swz(v, 8, 4, mt, nt);
        const int m0 = mt * 128, n0 = nt * 128;
        const int wr = w >> 1, wc = w & 1;
        f32x4 acc[4][4];
        zero_acc(acc);
        gemm_core<true>(acc, merged + (size_t)m0 * 1024, 1024, WoutT + (size_t)n0 * 1024, 1024, 1024, smem);
#pragma unroll
        for (int i = 0; i < 4; ++i) {
          const size_t row = (size_t)(m0 + wr * 64 + i * 16 + l15);
          float ss = 0.f;
#pragma unroll
          for (int j = 0; j < 4; ++j) {
            const int n = n0 + wc * 64 + j * 16 + g4 * 4;
            const float4 xv = *(const float4*)(p.x + row * 1024 + n);
            float4 o = make_float4(xv.x + acc[i][j][0], xv.y + acc[i][j][1], xv.z + acc[i][j][2], xv.w + acc[i][j][3]);
            ss += o.x * o.x + o.y * o.y + o.z * o.z + o.w * o.w;
            *(float4*)(p.out + row * 1024 + n) = o;
          }
          ss += __shfl_xor(ss, 16);
          ss += __shfl_xor(ss, 32);
          if (g4 == 0) part[row * 16 + nt * 2 + wc] = ss;
        }
      }
    }
    SYNC_BEFORE(7);
    if (PH(7)) {
      for (int row = bid * 4 + w; row < T_; row += nblk * 4) {
        float ss = (lane < 16) ? part[(size_t)row * 16 + lane] : 0.f;
        ss = wave_sum(ss);
        const float rstd = rsqrtf(ss * (1.f / 1024.f) + 1e-6f);
        float* o = p.out + (size_t)row * 1024;
#pragma unroll
        for (int i = 0; i < 4; ++i) {
          float4 v = *(const float4*)(o + i * 256 + lane * 4);
          const float4 gv = *(const float4*)(p.g_final + i * 256 + lane * 4);
          v.x *= rstd * gv.x; v.y *= rstd * gv.y; v.z *= rstd * gv.z; v.w *= rstd * gv.w;
          *(float4*)(o + i * 256 + lane * 4) = v;
        }
      }
    }
  }
}

extern "C" void kernel_launch(void* const* d_in, const int* in_sizes, int n_in, void* d_out, int out_size, void* d_ws,
                              size_t ws_size, hipStream_t stream) {
  static int grid_blocks = 0;
  if (!grid_blocks) {
    if (ws_size < WS_END || n_in != 23) {
      fprintf(stderr, "kernel_launch: unexpected ws_size %zu (need %zu) or n_in %d\n", ws_size, (size_t)WS_END, n_in);
      grid_blocks = -1;
      return;
    }
    int dev = 0, cus = 0, per_cu = 0;
    (void)hipGetDevice(&dev);
    (void)hipDeviceGetAttribute(&cus, hipDeviceAttributeMultiprocessorCount, dev);
    (void)hipFuncSetAttribute((const void*)mega, hipFuncAttributeMaxDynamicSharedMemorySize, LDS_BYTES);
    (void)hipOccupancyMaxActiveBlocksPerMultiprocessor(&per_cu, (const void*)mega, 256, LDS_BYTES);
    if (per_cu < 1) per_cu = 1;
    if (per_cu > 2) per_cu = 2;
    grid_blocks = cus * per_cu;
  }
  if (grid_blocks < 0) return;
  Params p{};
  const float** pp = (const float**)&p;
  for (int i = 0; i < 23; ++i) pp[i] = (const float*)d_in[i];
  p.out = (float*)d_out;
  p.ws = (char*)d_ws;
#if COOP
  p.phase_lo = 0;
  p.phase_hi = NPHASE - 1;
  void* args[] = {&p};
  hipError_t e = hipLaunchCooperativeKernel((const void*)mega, dim3(grid_blocks), dim3(256), args, LDS_BYTES, stream);
  if (e != hipSuccess) fprintf(stderr, "cooperative launch failed: %s (grid %d)\n", hipGetErrorString(e), grid_blocks);
#else
  for (int ph = 0; ph < NPHASE; ++ph) {
    p.phase_lo = ph;
    p.phase_hi = ph;
    hipLaunchKernelGGL(mega, dim3(grid_blocks), dim3(256), LDS_BYTES, stream, p);
  }
#endif
}
```

```cpp
#include <hip/hip_runtime.h>
#include <hip/hip_cooperative_groups.h>
#include <stdint.h>
#include <stdio.h>
namespace cg = cooperative_groups;

#ifndef COOP
#define COOP 1
#endif

#define DI __device__ __forceinline__
#ifdef ONLY_PHASE
#define PH(n) ((n) == ONLY_PHASE && p.phase_lo <= (n) && (n) <= p.phase_hi)
#else
#define PH(n) (p.phase_lo <= (n) && (n) <= p.phase_hi)
#endif
#define SYNC_BEFORE(n) if (p.phase_lo < (n) && (n) <= p.phase_hi) grid.sync();
typedef unsigned short u16;
using bf16x8 = __attribute__((ext_vector_type(8))) short;
using f32x4 = __attribute__((ext_vector_type(4))) float;
using u32x4 = __attribute__((ext_vector_type(4))) unsigned;
using u32x2 = __attribute__((ext_vector_type(2))) unsigned;

constexpr int T_ = 32768, L_ = 8192;
constexpr int LDS_BYTES = 73728;
constexpr int NPHASE = 8;

constexpr size_t MiB = 1u << 20;
constexpr size_t OFF_H = 0;
constexpr size_t OFF_Q = 64 * MiB;
constexpr size_t OFF_GF = 112 * MiB;
constexpr size_t OFF_U = 160 * MiB;
constexpr size_t OFF_GS = 208 * MiB;
constexpr size_t OFF_YS5A = 256 * MiB;
constexpr size_t OFF_QM = 304 * MiB;
constexpr size_t OFF_GM = 336 * MiB;
constexpr size_t OFF_MERGED = 368 * MiB;
constexpr size_t OFF_WINT = 432 * MiB;
constexpr size_t OFF_WGLT = 443 * MiB;
constexpr size_t OFF_WKVT = 449 * MiB;
constexpr size_t OFF_WOUTT = 451 * MiB;
constexpr size_t OFF_WPFT = 453 * MiB;
constexpr size_t OFF_WPST = 455 * MiB;
constexpr size_t OFF_WPMT = 457 * MiB;
constexpr size_t OFF_WGLUT = 458 * MiB;
constexpr size_t OFF_MEMN = 460 * MiB;
constexpr size_t OFF_MK = 462 * MiB;
constexpr size_t OFF_MVT = 463 * MiB;
constexpr size_t OFF_LOGF = 464 * MiB;
constexpr size_t OFF_F = 466 * MiB;
constexpr size_t OFF_S5AB = 468 * MiB;
constexpr size_t OFF_S5BB = 469 * MiB;
constexpr size_t OFF_S5S = 470 * MiB;
constexpr size_t OFF_PART = 482 * MiB;
constexpr size_t OFF_GATE = 484 * MiB;
constexpr size_t OFF_CTL = 500 * MiB;
constexpr size_t WS_END = 501 * MiB;

struct Params {
  const float *x, *mem, *g_norm, *g_mem_norm, *g_final, *w_in, *b_forget, *b_merge, *w_mem_kv;
  const float *lam_re, *lam_im, *log_step, *b_re, *b_im, *c_re, *c_im, *s5_d, *w_glu, *b_glu;
  const float *w_pf, *w_ps, *w_pm, *w_out;
  float* out;
  char* ws;
  int phase_lo, phase_hi;
};

DI u16 f2bf(float x) { unsigned u = __float_as_uint(x); u += 0x7fffu + ((u >> 16) & 1u); return (u16)(u >> 16); }
DI unsigned pack2(float a, float b) { return (unsigned)f2bf(a) | ((unsigned)f2bf(b) << 16); }
DI float bflo(unsigned v) { return __uint_as_float(v << 16); }
DI float bfhi(unsigned v) { return __uint_as_float(v & 0xffff0000u); }
DI float sigmoidf_(float x) { return 1.f / (1.f + __expf(-x)); }
DI float siluf_(float x) { return x / (1.f + __expf(-x)); }
DI float gelu_tanh(float x) {
  float z = 0.7978845608028654f * (x + 0.044715f * x * x * x);
  float e = __expf(2.f * z);
  float th = 1.f - 2.f / (e + 1.f);
  return 0.5f * x * (1.f + th);
}
DI float wave_sum(float v) {
#pragma unroll
  for (int o = 32; o > 0; o >>= 1) v += __shfl_xor(v, o);
  return v;
}
DI f32x4 mfma16(bf16x8 a, bf16x8 b, f32x4 c) { return __builtin_amdgcn_mfma_f32_16x16x32_bf16(a, b, c, 0, 0, 0); }

template <bool SWAP>
DI void gemm_core(f32x4 (&acc)[4][4], const u16* __restrict__ A, int lda, const u16* __restrict__ Bt, int ldb, int K, char* smem) {
  const int tid = threadIdx.x, lane = tid & 63, w = tid >> 6, wr = w >> 1, wc = w & 1, l15 = lane & 15, g = lane >> 4;
  const int lrow = tid >> 3, lch = tid & 7;
  const u16* ap = A + (size_t)lrow * lda + lch * 8;
  const u16* bp = Bt + (size_t)lrow * ldb + lch * 8;
  u32x4 ra[4], rb[4];
  const int nk = K >> 6;
#pragma unroll
  for (int c = 0; c < 4; ++c) {
    ra[c] = *(const u32x4*)(ap + (size_t)c * 32 * lda);
    rb[c] = *(const u32x4*)(bp + (size_t)c * 32 * ldb);
  }
  char* wbase = smem + lrow * 144 + lch * 16;
#pragma unroll
  for (int c = 0; c < 4; ++c) {
    *(u32x4*)(wbase + c * 32 * 144) = ra[c];
    *(u32x4*)(wbase + 18432 + c * 32 * 144) = rb[c];
  }
  __syncthreads();
  const char* ardb = smem + (wr * 64 + l15) * 144 + g * 16;
  const char* brdb = smem + 18432 + (wc * 64 + l15) * 144 + g * 16;
  for (int kt = 0; kt < nk; ++kt) {
    const int cur = (kt & 1) * 36864;
    if (kt + 1 < nk) {
#pragma unroll
      for (int c = 0; c < 4; ++c) {
        ra[c] = *(const u32x4*)(ap + (size_t)c * 32 * lda + (kt + 1) * 64);
        rb[c] = *(const u32x4*)(bp + (size_t)c * 32 * ldb + (kt + 1) * 64);
      }
    }
#pragma unroll
    for (int s = 0; s < 2; ++s) {
      bf16x8 af[4], bfr[4];
#pragma unroll
      for (int i = 0; i < 4; ++i) af[i] = *(const bf16x8*)(ardb + cur + i * 16 * 144 + s * 64);
#pragma unroll
      for (int j = 0; j < 4; ++j) bfr[j] = *(const bf16x8*)(brdb + cur + j * 16 * 144 + s * 64);
#pragma unroll
      for (int i = 0; i < 4; ++i)
#pragma unroll
        for (int j = 0; j < 4; ++j)
          acc[i][j] = SWAP ? mfma16(bfr[j], af[i], acc[i][j]) : mfma16(af[i], bfr[j], acc[i][j]);
    }
    if (kt + 1 < nk) {
      const int nxt = cur ^ 36864;
#pragma unroll
      for (int c = 0; c < 4; ++c) {
        *(u32x4*)(wbase + nxt + c * 32 * 144) = ra[c];
        *(u32x4*)(wbase + nxt + 18432 + c * 32 * 144) = rb[c];
      }
    }
    __syncthreads();
  }
}

DI void zero_acc(f32x4 (&acc)[4][4]) {
#pragma unroll
  for (int i = 0; i < 4; ++i)
#pragma unroll
    for (int j = 0; j < 4; ++j) acc[i][j] = f32x4{0.f, 0.f, 0.f, 0.f};
}

DI void swz(int v, int NT, int GN, int& mt, int& nt) {
  int xcd = v & 7, j = v >> 3;
  int per_mg = 8 * NT;
  int mg = j / per_mg, r = j - mg * per_mg;
  int ng = r / (8 * GN), wv = r - ng * (8 * GN);
  mt = xcd * 32 + mg * 8 + (wv & 7);
  nt = ng * GN + (wv >> 3);
}

DI void epi_rowmajor(const f32x4 (&acc)[4][4], u16* dst, int ld, int m0, int c0, int mode) {
  const int tid = threadIdx.x, lane = tid & 63, w = tid >> 6, wr = w >> 1, wc = w & 1, l15 = lane & 15, g = lane >> 4;
#pragma unroll
  for (int i = 0; i < 4; ++i) {
    const size_t row = (size_t)(m0 + wr * 64 + i * 16 + l15);
#pragma unroll
    for (int j = 0; j < 4; ++j) {
      f32x4 v = acc[i][j];
      if (mode == 1) { v[0] *= 0.125f; v[1] *= 0.125f; v[2] *= 0.125f; v[3] *= 0.125f; }
      else if (mode == 2) { v[0] = siluf_(v[0]); v[1] = siluf_(v[1]); v[2] = siluf_(v[2]); v[3] = siluf_(v[3]); }
      u32x2 o = {pack2(v[0], v[1]), pack2(v[2], v[3])};
      *(u32x2*)(dst + row * ld + c0 + wc * 64 + j * 16 + g * 4) = o;
    }
  }
}
DI void epi_transposed(const f32x4 (&acc)[4][4], u16* dst, int m0, int c0, int H, int lgDh, int lgLk) {
  const int tid = threadIdx.x, lane = tid & 63, w = tid >> 6, wr = w >> 1, wc = w & 1, l15 = lane & 15, g = lane >> 4;
#pragma unroll
  for (int i = 0; i < 4; ++i) {
    const int token = m0 + wr * 64 + i * 16 + g * 4;
    const int bidx = token >> lgLk, tl = token & ((1 << lgLk) - 1);
#pragma unroll
    for (int j = 0; j < 4; ++j) {
      const int col = c0 + wc * 64 + j * 16 + l15;
      const int head = col >> lgDh, d = col & ((1 << lgDh) - 1);
      f32x4 v = acc[i][j];
      u32x2 o = {pack2(v[0], v[1]), pack2(v[2], v[3])};
      *(u32x2*)(dst + ((((((size_t)bidx * H + head) << lgDh) + d) << lgLk) + tl)) = o;
    }
  }
}

template <int D, bool FOX, bool PF, int NQ>
DI void attn_item(const u16* __restrict__ qbase, int ldq, const u16* __restrict__ kbase, int ldk,
                  const u16* __restrict__ vtbase, int ldv, const float* __restrict__ Fseq, int q0, int nkv,
                  const u16* __restrict__ gate, u16* outp, float scale, float kmaxv, char* smem) {
  const int tid = threadIdx.x, lane = tid & 63, w = tid >> 6, l15 = lane & 15, g = lane >> 4;
  constexpr int KROW = D * 2 + 16;
  constexpr int KBYTES = 64 * KROW;
  constexpr int VBYTES = D * 144;
  constexpr int BUF = KBYTES + VBYTES + 256;
  constexpr int NL = D / 32;
  constexpr int KCH = D / 8;
  static_assert(2 * BUF <= LDS_BYTES, "attn lds");

  bf16x8 qf[NQ][D / 32];
#pragma unroll
  for (int qi = 0; qi < NQ; ++qi)
#pragma unroll
    for (int s = 0; s < D / 32; ++s)
      qf[qi][s] = *(const bf16x8*)(qbase + (size_t)(w * (16 * NQ) + qi * 16 + l15) * ldq + s * 32 + g * 8);
  float fq[NQ];
#pragma unroll
  for (int qi = 0; qi < NQ; ++qi) fq[qi] = FOX ? Fseq[q0 + w * (16 * NQ) + qi * 16 + l15] : 0.f;
  f32x4 ot[D / 16][NQ];
#pragma unroll
  for (int dt = 0; dt < D / 16; ++dt)
#pragma unroll
    for (int qi = 0; qi < NQ; ++qi) ot[dt][qi] = f32x4{0, 0, 0, 0};
  float mrun[NQ], lsum[NQ];
#pragma unroll
  for (int qi = 0; qi < NQ; ++qi) { mrun[qi] = -1e30f; lsum[qi] = 0.f; }
  float qk[NQ];
#pragma unroll
  for (int qi = 0; qi < NQ; ++qi) {
    float ss = 0.f;
    if (FOX) {
#pragma unroll
      for (int s = 0; s < D / 32; ++s)
#pragma unroll
        for (int e = 0; e < 8; ++e) {
          const float v = __uint_as_float(((unsigned)(unsigned short)qf[qi][s][e]) << 16);
          ss += v * v;
        }
      ss += __shfl_xor(ss, 16);
      ss += __shfl_xor(ss, 32);
    }
    qk[qi] = sqrtf(ss) * kmaxv * 1.002f + 1e-3f;
  }
  int* flags = (int*)(smem + 73664);

  u32x4 kr[NL], vr[NL];
  f32x4 fr = {0, 0, 0, 0};
#define krow(c) (((c) * 256 + tid) / KCH)
#define kch(c) (((c) * 256 + tid) % KCH)
#define vrow(c) (((c) * 256 + tid) >> 3)
#define vch(c) (tid & 7)
#define ATT_LOAD(J)                                                                                   \
  {                                                                                                   \
    const int s0_ = (J) * 64;                                                                         \
    _Pragma("unroll") for (int c = 0; c < NL; ++c) {                                                  \
      kr[c] = *(const u32x4*)(kbase + (size_t)(s0_ + krow(c)) * ldk + kch(c) * 8);                    \
      vr[c] = *(const u32x4*)(vtbase + (size_t)vrow(c) * ldv + s0_ + vch(c) * 8);                     \
    }                                                                                                 \
    if (FOX && tid < 16) fr = *(const f32x4*)(Fseq + s0_ + tid * 4);                                  \
  }
#define ATT_STORE(BO)                                                                                 \
  {                                                                                                   \
    char* b_ = smem + (BO);                                                                           \
    _Pragma("unroll") for (int c = 0; c < NL; ++c) {                                                  \
      *(u32x4*)(b_ + krow(c) * KROW + kch(c) * 16) = kr[c];                                           \
      *(u32x4*)(b_ + KBYTES + vrow(c) * 144 + vch(c) * 16) = vr[c];                                   \
    }                                                                                                 \
    if (FOX && tid < 16) *(f32x4*)(b_ + KBYTES + VBYTES + tid * 16) = fr;                             \
  }
  ATT_LOAD(nkv - 1);
  ATT_STORE(0);
  __syncthreads();
  const int qlo = q0 + w * (16 * NQ);
  for (int j = nkv - 1, itn = 0; j >= 0; --j, ++itn) {
    const int cur = (itn & 1) * BUF;
    if (j > 0) {
      ATT_LOAD(j - 1);
      if (!PF) ATT_STORE(cur ^ BUF);
    }
    bool ok = false;
    const int s0 = j * 64;
    const bool active = !FOX || (s0 <= qlo + 16 * NQ - 1);
    if (active) {
      const char* Ks = smem + cur;
      const char* Vs = smem + cur + KBYTES;
      const char* Fs = smem + cur + KBYTES + VBYTES;
      f32x4 st[4][NQ];
#pragma unroll
      for (int kt = 0; kt < 4; ++kt)
#pragma unroll
        for (int qi = 0; qi < NQ; ++qi) st[kt][qi] = f32x4{0, 0, 0, 0};
#pragma unroll
      for (int s = 0; s < D / 32; ++s) {
        bf16x8 kf[4];
#pragma unroll
        for (int kt = 0; kt < 4; ++kt) kf[kt] = *(const bf16x8*)(Ks + (kt * 16 + l15) * KROW + s * 64 + g * 16);
#pragma unroll
        for (int kt = 0; kt < 4; ++kt)
#pragma unroll
          for (int qi = 0; qi < NQ; ++qi) st[kt][qi] = mfma16(kf[kt], qf[qi][s], st[kt][qi]);
      }
      if (FOX) {
        const bool need_mask = (s0 + 63 > qlo);
#pragma unroll
        for (int kt = 0; kt < 4; ++kt) {
          f32x4 fk = *(const f32x4*)(Fs + (kt * 16 + g * 4) * 4);
#pragma unroll
          for (int qi = 0; qi < NQ; ++qi) {
            const int qpos = qlo + qi * 16 + l15;
#pragma unroll
            for (int r = 0; r < 4; ++r) {
              float v = st[kt][qi][r] + fq[qi] - fk[r];
              if (need_mask && (s0 + kt * 16 + g * 4 + r > qpos)) v = -1e30f;
              st[kt][qi][r] = v;
            }
          }
        }
      } else {
#pragma unroll
        for (int kt = 0; kt < 4; ++kt)
#pragma unroll
          for (int qi = 0; qi < NQ; ++qi)
#pragma unroll
            for (int r = 0; r < 4; ++r) st[kt][qi][r] *= scale;
      }
      float alpha[NQ];
#pragma unroll
      for (int qi = 0; qi < NQ; ++qi) {
        float mx = st[0][qi][0];
#pragma unroll
        for (int kt = 0; kt < 4; ++kt)
#pragma unroll
          for (int r = 0; r < 4; ++r) mx = fmaxf(mx, st[kt][qi][r]);
        mx = fmaxf(mx, __shfl_xor(mx, 16));
        mx = fmaxf(mx, __shfl_xor(mx, 32));
        const float mnew = fmaxf(mrun[qi], mx);
        alpha[qi] = __expf(mrun[qi] - mnew);
        mrun[qi] = mnew;
        float ps = 0.f;
#pragma unroll
        for (int kt = 0; kt < 4; ++kt)
#pragma unroll
          for (int r = 0; r < 4; ++r) {
            float p = __expf(st[kt][qi][r] - mnew);
            st[kt][qi][r] = p;
            ps += p;
          }
        lsum[qi] = lsum[qi] * alpha[qi] + ps;
      }
      bf16x8 pb[2][NQ];
#pragma unroll
      for (int kp = 0; kp < 2; ++kp)
#pragma unroll
        for (int qi = 0; qi < NQ; ++qi) {
          u32x4 t = {pack2(st[2 * kp][qi][0], st[2 * kp][qi][1]), pack2(st[2 * kp][qi][2], st[2 * kp][qi][3]),
                     pack2(st[2 * kp + 1][qi][0], st[2 * kp + 1][qi][1]), pack2(st[2 * kp + 1][qi][2], st[2 * kp + 1][qi][3])};
          pb[kp][qi] = __builtin_bit_cast(bf16x8, t);
        }
#pragma unroll
      for (int dt = 0; dt < D / 16; ++dt) {
#pragma unroll
        for (int r = 0; r < 4; ++r)
#pragma unroll
          for (int qi = 0; qi < NQ; ++qi) ot[dt][qi][r] *= alpha[qi];
#pragma unroll
        for (int kp = 0; kp < 2; ++kp) {
          u32x2 lo = *(const u32x2*)(Vs + (dt * 16 + l15) * 144 + (kp * 32 + g * 4) * 2);
          u32x2 hi = *(const u32x2*)(Vs + (dt * 16 + l15) * 144 + (kp * 32 + 16 + g * 4) * 2);
          u32x4 t = {lo[0], lo[1], hi[0], hi[1]};
          bf16x8 vf = __builtin_bit_cast(bf16x8, t);
#pragma unroll
          for (int qi = 0; qi < NQ; ++qi) ot[dt][qi] = mfma16(vf, pb[kp][qi], ot[dt][qi]);
        }
      }
      if (FOX) {
        const float f0 = *(const float*)Fs;
        ok = true;
#pragma unroll
        for (int qi = 0; qi < NQ; ++qi) ok = ok && (qk[qi] + fq[qi] - f0 - mrun[qi] <= -30.f);
      }
    }
    if (PF && j > 0) ATT_STORE(cur ^ BUF);
    if (FOX) {
      const bool wave_ok = (__ballot(ok) == ~0ull);
      if (lane == 0) flags[(itn & 1) * 4 + w] = wave_ok ? 1 : 0;
      __syncthreads();
      const int* fl = flags + (itn & 1) * 4;
      if (fl[0] & fl[1] & fl[2] & fl[3]) break;
    } else {
      __syncthreads();
    }
  }
#undef ATT_LOAD
#undef ATT_STORE
#undef krow
#undef kch
#undef vrow
#undef vch
#pragma unroll
  for (int qi = 0; qi < NQ; ++qi) {
    float l = lsum[qi];
    l += __shfl_xor(l, 16);
    l += __shfl_xor(l, 32);
    const float inv = 1.f / l;
    const size_t rowoff = (size_t)(w * (16 * NQ) + qi * 16 + l15) * ldq;
#pragma unroll
    for (int dt = 0; dt < D / 16; ++dt) {
      const int col = dt * 16 + g * 4;
      u32x2 gv = *(const u32x2*)(gate + rowoff + col);
      u32x2 o = {pack2(ot[dt][qi][0] * inv * bflo(gv[0]), ot[dt][qi][1] * inv * bfhi(gv[0])),
                 pack2(ot[dt][qi][2] * inv * bflo(gv[1]), ot[dt][qi][3] * inv * bfhi(gv[1]))};
      *(u32x2*)(outp + rowoff + col) = o;
    }
  }
}

DI void s5_load_u(const u16* ubuf, int b, int c, int g, char* ut, int lane) {
  const u16* src = ubuf + ((size_t)(b * L_ + c * 64 + lane)) * 768 + g * 16;
  u32x4 a = *(const u32x4*)src, bb = *(const u32x4*)(src + 8);
  *(u32x4*)(ut + lane * 32) = a;
  *(u32x4*)(ut + lane * 32 + 16) = bb;
}
DI void s5_x(const char* ut, int t, const float (&bre)[16], const float (&bim)[16], float& xr, float& xi) {
  u32x4 a = *(const u32x4*)(ut + t * 32), b = *(const u32x4*)(ut + t * 32 + 16);
  float xr0 = 0.f, xi0 = 0.f, xr1 = 0.f, xi1 = 0.f;
#pragma unroll
  for (int q = 0; q < 4; ++q) {
    float u0 = bflo(a[q]), u1 = bfhi(a[q]);
    xr0 += bre[2 * q] * u0; xi0 += bim[2 * q] * u0;
    xr1 += bre[2 * q + 1] * u1; xi1 += bim[2 * q + 1] * u1;
  }
#pragma unroll
  for (int q = 0; q < 4; ++q) {
    float u0 = bflo(b[q]), u1 = bfhi(b[q]);
    xr0 += bre[8 + 2 * q] * u0; xi0 += bim[8 + 2 * q] * u0;
    xr1 += bre[8 + 2 * q + 1] * u1; xi1 += bim[8 + 2 * q + 1] * u1;
  }
  xr = xr0 + xr1; xi = xi0 + xi1;
}

extern "C" __global__ void __launch_bounds__(256, 2) mega(Params p) {
  extern __shared__ __attribute__((aligned(16))) char smem[];
  cg::grid_group grid = cg::this_grid();
  const int tid = threadIdx.x, lane = tid & 63, w = tid >> 6, l15 = lane & 15, g4 = lane >> 4;
  const int nblk = gridDim.x, bid = blockIdx.x;
  char* ws = p.ws;
  u16* hbuf = (u16*)(ws + OFF_H);
  u16* qbuf = (u16*)(ws + OFF_Q);
  u16* gfbuf = (u16*)(ws + OFF_GF);
  u16* ubuf = (u16*)(ws + OFF_U);
  u16* gsbuf = (u16*)(ws + OFF_GS);
  u16* ys5a = (u16*)(ws + OFF_YS5A);
  u16* qmbuf = (u16*)(ws + OFF_QM);
  u16* gmbuf = (u16*)(ws + OFF_GM);
  u16* merged = (u16*)(ws + OFF_MERGED);
  u16* WinT = (u16*)(ws + OFF_WINT);
  u16* WglT = (u16*)(ws + OFF_WGLT);
  u16* WkvT = (u16*)(ws + OFF_WKVT);
  u16* WoutT = (u16*)(ws + OFF_WOUTT);
  u16* WpfT = (u16*)(ws + OFF_WPFT);
  u16* WpsT = (u16*)(ws + OFF_WPST);
  u16* WpmT = (u16*)(ws + OFF_WPMT);
  u16* WgluT = (u16*)(ws + OFF_WGLUT);
  u16* memn = (u16*)(ws + OFF_MEMN);
  u16* mkbuf = (u16*)(ws + OFF_MK);
  u16* mvT = (u16*)(ws + OFF_MVT);
  float* logf = (float*)(ws + OFF_LOGF);
  float* Fbuf = (float*)(ws + OFF_F);
  float2* abar = (float2*)(ws + OFF_S5AB);
  float* bbar = (float*)(ws + OFF_S5BB);
  float2* Sst = (float2*)(ws + OFF_S5S);
  float* part = (float*)(ws + OFF_PART);
  unsigned* ctl = (unsigned*)(ws + OFF_CTL);
  u16* kbuf = (u16*)p.out;
  u16* vT = (u16*)((char*)p.out + 48 * MiB);

  {
    if (PH(0)) {
      if (bid == 0 && tid < 128) ctl[tid] = 0u;
      float* tile = (float*)smem;
      for (int ti = bid; ti < 3344; ti += nblk) {
        const float* src; int ld, col0, K; u16* dst; int tt;
        if (ti < 576) { src = p.w_in; ld = 8716; col0 = 0; K = 1024; dst = WinT; tt = ti; }
        else if (ti < 1408) { src = p.w_in; ld = 8716; col0 = 2316; K = 1024; dst = WinT + (size_t)2304 * 1024; tt = ti - 576; }
        else if (ti < 2176) { src = p.w_in; ld = 8716; col0 = 5644; K = 1024; dst = WglT; tt = ti - 1408; }
        else if (ti < 2432) { src = p.w_mem_kv; ld = 1024; col0 = 0; K = 1024; dst = WkvT; tt = ti - 2176; }
        else if (ti < 2688) { src = p.w_out; ld = 1024; col0 = 0; K = 1024; dst = WoutT; tt = ti - 2432; }
        else if (ti < 2880) { src = p.w_pf; ld = 1024; col0 = 0; K = 768; dst = WpfT; tt = ti - 2688; }
        else if (ti < 3072) { src = p.w_ps; ld = 1024; col0 = 0; K = 768; dst = WpsT; tt = ti - 2880; }
        else if (ti < 3200) { src = p.w_pm; ld = 1024; col0 = 0; K = 512; dst = WpmT; tt = ti - 3072; }
        else { src = p.w_glu; ld = 768; col0 = 0; K = 768; dst = WgluT; tt = ti - 3200; }
        const int nkt = K >> 6;
        const int k0 = (tt % nkt) * 64, n0 = (tt / nkt) * 64;
#pragma unroll 4
        for (int i = 0; i < 16; ++i) {
          int k = i * 4 + w, n = lane;
          tile[k * 65 + n] = src[(size_t)(k0 + k) * ld + col0 + n0 + n];
        }
        __syncthreads();
#pragma unroll 4
        for (int i = 0; i < 16; ++i) {
          int n = i * 4 + w, k = lane;
          dst[(size_t)(n0 + n) * K + k0 + k] = f2bf(tile[k * 65 + n]);
        }
        __syncthreads();
      }
      float* wfl = (float*)smem;
      for (int idx = tid; idx < 12288; idx += 256) {
        int k = idx / 12, j = idx - k * 12;
        wfl[j * 1024 + k] = p.w_in[(size_t)k * 8716 + 2304 + j];
      }
      __syncthreads();
      for (int row = bid * 4 + w; row < T_ + 1024; row += nblk * 4) {
        const bool isx = row < T_;
        const float* src = isx ? p.x + (size_t)row * 1024 : p.mem + (size_t)(row - T_) * 1024;
        const float* gsrc = isx ? p.g_norm : p.g_mem_norm;
        u16* dst = isx ? hbuf + (size_t)row * 1024 : memn + (size_t)(row - T_) * 1024;
        float4 xv[4];
        float ss = 0.f;
#pragma unroll
        for (int i = 0; i < 4; ++i) {
          xv[i] = *(const float4*)(src + i * 256 + lane * 4);
          ss += xv[i].x * xv[i].x + xv[i].y * xv[i].y + xv[i].z * xv[i].z + xv[i].w * xv[i].w;
        }
        ss = wave_sum(ss);
        const float rstd = rsqrtf(ss * (1.f / 1024.f) + 1e-6f);
#pragma unroll
        for (int i = 0; i < 4; ++i) {
          float4 gv = *(const float4*)(gsrc + i * 256 + lane * 4);
          xv[i].x *= rstd * gv.x; xv[i].y *= rstd * gv.y; xv[i].z *= rstd * gv.z; xv[i].w *= rstd * gv.w;
          u32x2 o = {pack2(xv[i].x, xv[i].y), pack2(xv[i].z, xv[i].w)};
          *(u32x2*)(dst + i * 256 + lane * 4) = o;
        }
        if (isx) {
          float myfl = 0.f;
#pragma unroll
          for (int j = 0; j < 12; ++j) {
            float a = 0.f;
#pragma unroll
            for (int i = 0; i < 4; ++i) {
              float4 wv = *(const float4*)(wfl + j * 1024 + i * 256 + lane * 4);
              a += xv[i].x * wv.x + xv[i].y * wv.y + xv[i].z * wv.z + xv[i].w * wv.w;
            }
            a = wave_sum(a);
            if (lane == j) myfl = a;
          }
          if (lane < 12) {
            float xx = myfl + p.b_forget[lane];
            float lf = fminf(xx, 0.f) - log1pf(__expf(-fabsf(xx)));
            const int b = row >> 13, t = row & (L_ - 1);
            logf[(size_t)(b * 12 + lane) * L_ + t] = lf;
          }
        }
      }
      {
        const int gid = bid * 256 + tid;
        if (gid < 3072) {
          const int g = gid >> 6;
          const float step = expf(p.log_step[g]);
          const float lr = p.lam_re[gid], li = p.lam_im[gid];
          const float mag = expf(lr * step);
          const float ar = mag * cosf(li * step), ai = mag * sinf(li * step);
          const float den = lr * lr + li * li;
          const float nr = ar - 1.f, ni = ai;
          const float fr = (nr * lr + ni * li) / den, fi = (ni * lr - nr * li) / den;
          abar[gid] = make_float2(ar, ai);
#pragma unroll
          for (int h = 0; h < 16; ++h) {
            const float br = p.b_re[(size_t)gid * 16 + h], bi = p.b_im[(size_t)gid * 16 + h];
            bbar[(size_t)gid * 32 + h] = fr * br - fi * bi;
            bbar[(size_t)gid * 32 + 16 + h] = fr * bi + fi * br;
          }
        }
      }
      __syncthreads();
    }
    SYNC_BEFORE(1);
    if (PH(1)) {
      float* sm = (float*)smem;
      for (int seq = bid; seq < 48; seq += nblk) {
        const float* src = logf + (size_t)seq * L_ + tid * 32;
        float* dst = Fbuf + (size_t)seq * L_ + tid * 32;
        float v[32];
#pragma unroll
        for (int i = 0; i < 8; ++i) {
          float4 t = *(const float4*)(src + i * 4);
          v[4 * i] = t.x; v[4 * i + 1] = t.y; v[4 * i + 2] = t.z; v[4 * i + 3] = t.w;
        }
        float run = 0.f;
#pragma unroll
        for (int i = 0; i < 32; ++i) { run += v[i]; v[i] = run; }
        float incl = run;
#pragma unroll
        for (int o = 1; o < 64; o <<= 1) {
          float t = __shfl_up(incl, o);
          if (lane >= o) incl += t;
        }
        if (lane == 63) sm[w] = incl;
        __syncthreads();
        float base = incl - run;
        for (int w2 = 0; w2 < w; ++w2) base += sm[w2];
#pragma unroll
        for (int i = 0; i < 8; ++i) {
          float4 t = make_float4(v[4 * i] + base, v[4 * i + 1] + base, v[4 * i + 2] + base, v[4 * i + 3] + base);
          *(float4*)(dst + i * 4) = t;
        }
        __syncthreads();
      }
      for (int v = bid; v < 11264 + 64; v += nblk) {
        const u16 *A, *Bt;
        int m0, n0;
        bool kvtile = v >= 11264;
        if (!kvtile) {
          int mt, nt;
          swz(v, 44, 4, mt, nt);
          m0 = mt * 128; n0 = nt * 128;
          A = hbuf + (size_t)m0 * 1024; Bt = WinT + (size_t)n0 * 1024;
        } else {
          int kv = v - 11264;
          m0 = (kv >> 3) * 128; n0 = (kv & 7) * 128;
          A = memn + (size_t)m0 * 1024; Bt = WkvT + (size_t)n0 * 1024;
        }
        const bool transp = kvtile ? (n0 >= 512) : (n0 >= 1536 && n0 < 2304);
        f32x4 acc[4][4];
        zero_acc(acc);
        if (transp) {
          gemm_core<false>(acc, A, 1024, Bt, 1024, 1024, smem);
          if (kvtile) epi_transposed(acc, mvT, m0, n0 - 512, 4, 7, 8);
          else epi_transposed(acc, vT, m0, n0 - 1536, 12, 6, 13);
        } else {
          gemm_core<true>(acc, A, 1024, Bt, 1024, 1024, smem);
          u16* dst; int ld, c0, mode;
          if (kvtile) { dst = mkbuf; ld = 512; c0 = n0; mode = 0; }
          else if (n0 < 768) { dst = qbuf; ld = 768; c0 = n0; mode = 1; }
          else if (n0 < 1536) { dst = kbuf; ld = 768; c0 = n0 - 768; mode = 0; }
          else if (n0 < 3072) { dst = gfbuf; ld = 768; c0 = n0 - 2304; mode = 2; }
          else if (n0 < 3840) { dst = ubuf; ld = 768; c0 = n0 - 3072; mode = 0; }
          else if (n0 < 4608) { dst = gsbuf; ld = 768; c0 = n0 - 3840; mode = 2; }
          else if (n0 < 5120) { dst = qmbuf; ld = 512; c0 = n0 - 4608; mode = 0; }
          else { dst = gmbuf; ld = 512; c0 = n0 - 5120; mode = 2; }
          epi_rowmajor(acc, dst, ld, m0, c0, mode);
          if (!kvtile && n0 >= 768 && n0 < 1536) {
            float mxv = 0.f;
#pragma unroll
            for (int i = 0; i < 4; ++i) {
              float ss = 0.f;
#pragma unroll
              for (int j = 0; j < 4; ++j)
#pragma unroll
                for (int r = 0; r < 4; ++r) {
                  const float v = __uint_as_float(((unsigned)f2bf(acc[i][j][r])) << 16);
                  ss += v * v;
                }
              ss += __shfl_xor(ss, 16);
              ss += __shfl_xor(ss, 32);
              mxv = fmaxf(mxv, ss);
            }
#pragma unroll
            for (int o = 1; o < 16; o <<= 1) mxv = fmaxf(mxv, __shfl_xor(mxv, o));
            if (lane == 0) atomicMax(&ctl[(m0 >> 13) * 12 + ((n0 - 768) >> 6) + (w & 1)], __float_as_uint(mxv));
          }
        }
      }
    }
    SYNC_BEFORE(2);
    if (PH(2)) {
      int* qslot = (int*)(smem + 73696);
#define NEXT_ITEM(CTR)                                        \
      {                                                       \
        if (tid == 0) *qslot = (int)atomicAdd(&ctl[CTR], 1u); \
        __syncthreads();                                      \
        it = *qslot;                                          \
        __syncthreads();                                      \
      }
      int it;
      for (;;) {
        NEXT_ITEM(64);
        if (it >= 3072) break;
        {
#ifndef NO_FOX
          const int qt = 63 - it / 48, bh = it % 48, b = bh / 12, h = bh % 12;
          const int q0 = qt * 128;
          const size_t qoff = ((size_t)(b * L_ + q0)) * 768 + h * 64;
          attn_item<64, true, true, 2>(qbuf + qoff, 768, kbuf + (size_t)b * L_ * 768 + h * 64, 768,
                              vT + (size_t)(b * 12 + h) * 64 * L_, L_, Fbuf + (size_t)(b * 12 + h) * L_, q0, 2 * qt + 2,
                              gfbuf + qoff, qbuf + qoff, 1.f, sqrtf(__uint_as_float(ctl[b * 12 + h])), smem);
#endif
        }
      }
      for (;;) {
        NEXT_ITEM(65);
        if (it >= 2048) break;
        {
#ifndef NO_MEM
          const int im = it;
          const int hm = im & 3, qt = (im >> 2) & 127, b = im >> 9;
          const int q0 = qt * 64;
          const size_t qoff = ((size_t)(b * L_ + q0)) * 512 + hm * 128;
          attn_item<128, false, false, 1>(qmbuf + qoff, 512, mkbuf + (size_t)b * 256 * 512 + hm * 128, 512,
                                mvT + (size_t)(b * 4 + hm) * 128 * 256, 256, nullptr, q0, 4,
                                gmbuf + qoff, qmbuf + qoff, 0.08838834764831845f, 0.f, smem);
#endif
        }
      }
      for (;;) {
        NEXT_ITEM(66);
        if (it >= 6144) break;
        {
#ifndef NO_S5P1
          const int wi = it * 4 + w;
          const int g = wi % 48, c = (wi / 48) & 127, b = wi / (48 * 128);
          char* ut = smem + w * 6400;
          s5_load_u(ubuf, b, c, g, ut, lane);
          const int gp = g * 64 + lane;
          float bre[16], bim[16];
#pragma unroll
          for (int q = 0; q < 4; ++q) {
            float4 t0 = *(const float4*)(bbar + (size_t)gp * 32 + q * 4);
            float4 t1 = *(const float4*)(bbar + (size_t)gp * 32 + 16 + q * 4);
            bre[4 * q] = t0.x; bre[4 * q + 1] = t0.y; bre[4 * q + 2] = t0.z; bre[4 * q + 3] = t0.w;
            bim[4 * q] = t1.x; bim[4 * q + 1] = t1.y; bim[4 * q + 2] = t1.z; bim[4 * q + 3] = t1.w;
          }
          const float2 ab = abar[gp];
          asm volatile("s_waitcnt lgkmcnt(0)" ::: "memory");
          float hr = 0.f, hi = 0.f;
#pragma unroll 4
          for (int t = 0; t < 64; ++t) {
            float xr, xi;
            s5_x(ut, t, bre, bim, xr, xi);
            const float nhr = ab.x * hr - ab.y * hi + xr;
            const float nhi = ab.x * hi + ab.y * hr + xi;
            hr = nhr; hi = nhi;
          }
          Sst[((size_t)(b * 128 + c) * 48 + g) * 64 + lane] = make_float2(hr, hi);
          __syncthreads();
#endif
        }
      }
    }
    SYNC_BEFORE(3);
    if (PH(3)) {
      for (int it = bid; it < 6144; it += nblk) {
        const int wi = it * 4 + w;
        const int g = wi % 48, c = (wi / 48) & 127, b = wi / (48 * 128);
        char* ut = smem + w * 6400;
        char* stt = ut + 2048;
        s5_load_u(ubuf, b, c, g, ut, lane);
        const int gp = g * 64 + lane;
        float bre[16], bim[16];
#pragma unroll
        for (int q = 0; q < 4; ++q) {
          float4 t0 = *(const float4*)(bbar + (size_t)gp * 32 + q * 4);
          float4 t1 = *(const float4*)(bbar + (size_t)gp * 32 + 16 + q * 4);
          bre[4 * q] = t0.x; bre[4 * q + 1] = t0.y; bre[4 * q + 2] = t0.z; bre[4 * q + 3] = t0.w;
          bim[4 * q] = t1.x; bim[4 * q + 1] = t1.y; bim[4 * q + 2] = t1.z; bim[4 * q + 3] = t1.w;
        }
        const float2 ab = abar[gp];
        bf16x8 cf[4];
#pragma unroll
        for (int s = 0; s < 4; ++s) {
          const float* cs = (s < 2 ? p.c_re : p.c_im) + (size_t)(g * 16 + l15) * 64 + (s & 1) * 32 + g4 * 8;
          float4 t0 = *(const float4*)cs, t1 = *(const float4*)(cs + 4);
          const float sg = (s < 2) ? 1.f : -1.f;
          u32x4 t = {pack2(sg * t0.x, sg * t0.y), pack2(sg * t0.z, sg * t0.w), pack2(sg * t1.x, sg * t1.y), pack2(sg * t1.z, sg * t1.w)};
          cf[s] = __builtin_bit_cast(bf16x8, t);
        }
        const float4 dsk = *(const float4*)(p.s5_d + g * 16 + g4 * 4);
        float a64r = ab.x, a64i = ab.y;
#pragma unroll
        for (int q = 0; q < 6; ++q) {
          const float nr = a64r * a64r - a64i * a64i, ni = 2.f * a64r * a64i;
          a64r = nr; a64i = ni;
        }
        float hr = 0.f, hi = 0.f;
        {
          const float2* sp = Sst + ((size_t)(b * 128) * 48 + g) * 64 + lane;
          for (int cc = 0; cc < c; ++cc) {
            const float2 s = sp[(size_t)cc * 48 * 64];
            const float nhr = a64r * hr - a64i * hi + s.x;
            const float nhi = a64r * hi + a64i * hr + s.y;
            hr = nhr; hi = nhi;
          }
        }
        asm volatile("s_waitcnt lgkmcnt(0)" ::: "memory");
#pragma unroll 1
        for (int sub = 0; sub < 4; ++sub) {
#pragma unroll 4
          for (int tt = 0; tt < 16; ++tt) {
            float xr, xi;
            s5_x(ut, sub * 16 + tt, bre, bim, xr, xi);
            const float nhr = ab.x * hr - ab.y * hi + xr;
            const float nhi = ab.x * hi + ab.y * hr + xi;
            hr = nhr; hi = nhi;
            *(u16*)(stt + tt * 272 + lane * 2) = f2bf(hr);
            *(u16*)(stt + tt * 272 + 128 + lane * 2) = f2bf(hi);
          }
          asm volatile("s_waitcnt lgkmcnt(0)" ::: "memory");
          f32x4 y = {0, 0, 0, 0};
#pragma unroll
          for (int s = 0; s < 4; ++s) {
            bf16x8 bfr = *(const bf16x8*)(stt + l15 * 272 + s * 64 + g4 * 16);
            y = mfma16(cf[s], bfr, y);
          }
          const int t = sub * 16 + l15;
          u32x2 uv = *(const u32x2*)(ut + t * 32 + g4 * 8);
          float o0 = gelu_tanh(y[0] + dsk.x * bflo(uv[0]));
          float o1 = gelu_tanh(y[1] + dsk.y * bfhi(uv[0]));
          float o2 = gelu_tanh(y[2] + dsk.z * bflo(uv[1]));
          float o3 = gelu_tanh(y[3] + dsk.w * bfhi(uv[1]));
          u32x2 o = {pack2(o0, o1), pack2(o2, o3)};
          *(u32x2*)(ys5a + ((size_t)(b * L_ + c * 64 + t)) * 768 + g * 16 + g4 * 4) = o;
          asm volatile("s_waitcnt lgkmcnt(0)" ::: "memory");
        }
        __syncthreads();
      }
    }
    SYNC_BEFORE(4);
    if (PH(4)) {
      for (int v = bid; v < 256 * 6; v += nblk) {
        int mt, nt;
        swz(v, 6, 6, mt, nt);
        const int m0 = mt * 128, n0 = nt * 128;
        f32x4 acc[4][4];
        zero_acc(acc);
        gemm_core<true>(acc, ys5a + (size_t)m0 * 768, 768, WgluT + (size_t)n0 * 768, 768, 768, smem);
        const int wr = w >> 1, wc = w & 1;
#pragma unroll
        for (int i = 0; i < 4; ++i) {
          const size_t row = (size_t)(m0 + wr * 64 + i * 16 + l15);
#pragma unroll
          for (int j = 0; j < 4; ++j) {
            const int n = n0 + wc * 64 + j * 16 + g4 * 4;
            const float4 bg = *(const float4*)(p.b_glu + n);
            const u32x2 av = *(const u32x2*)(ys5a + row * 768 + n);
            const u32x2 sv = *(const u32x2*)(gsbuf + row * 768 + n);
            float o0 = bflo(av[0]) * sigmoidf_(acc[i][j][0] + bg.x) * bflo(sv[0]);
            float o1 = bfhi(av[0]) * sigmoidf_(acc[i][j][1] + bg.y) * bfhi(sv[0]);
            float o2 = bflo(av[1]) * sigmoidf_(acc[i][j][2] + bg.z) * bflo(sv[1]);
            float o3 = bfhi(av[1]) * sigmoidf_(acc[i][j][3] + bg.w) * bfhi(sv[1]);
            u32x2 o = {pack2(o0, o1), pack2(o2, o3)};
            *(u32x2*)(ubuf + row * 768 + n) = o;
          }
        }
      }
    }
    SYNC_BEFORE(5);
    if (PH(5)) {
      for (int v = bid; v < 256 * 8; v += nblk) {
        int mt, nt;
        swz(v, 8, 4, mt, nt);
        const int m0 = mt * 128, n0 = nt * 128;
        const int wr = w >> 1, wc = w & 1;
        f32x4 accm[4][4];
        zero_acc(accm);
        char* gstash = ws + OFF_GATE + (size_t)bid * 32768 + tid * 16;
#pragma unroll 1
        for (int stp = 0; stp < 6; ++stp) {
          const int br = stp >> 1;
          const u16* Ab; const u16* Wb; int Kb;
          if (!(stp & 1)) { Ab = hbuf + (size_t)m0 * 1024; Wb = WglT + (size_t)(br * 1024 + n0) * 1024; Kb = 1024; }
          else if (br == 0) { Ab = qbuf + (size_t)m0 * 768; Wb = WpfT + (size_t)n0 * 768; Kb = 768; }
          else if (br == 1) { Ab = ubuf + (size_t)m0 * 768; Wb = WpsT + (size_t)n0 * 768; Kb = 768; }
          else { Ab = qmbuf + (size_t)m0 * 512; Wb = WpmT + (size_t)n0 * 512; Kb = 512; }
          f32x4 acc[4][4];
          zero_acc(acc);
          gemm_core<true>(acc, Ab, Kb, Wb, Kb, Kb, smem);
          if (!(stp & 1)) {
#pragma unroll
            for (int j = 0; j < 4; ++j) {
              const float4 bm = *(const float4*)(p.b_merge + br * 1024 + n0 + wc * 64 + j * 16 + g4 * 4);
#pragma unroll
              for (int i = 0; i < 4; i += 2) {
                u32x4 gq = {pack2(sigmoidf_(acc[i][j][0] + bm.x), sigmoidf_(acc[i][j][1] + bm.y)),
                            pack2(sigmoidf_(acc[i][j][2] + bm.z), sigmoidf_(acc[i][j][3] + bm.w)),
                            pack2(sigmoidf_(acc[i + 1][j][0] + bm.x), sigmoidf_(acc[i + 1][j][1] + bm.y)),
                            pack2(sigmoidf_(acc[i + 1][j][2] + bm.z), sigmoidf_(acc[i + 1][j][3] + bm.w))};
                *(u32x4*)(gstash + (j * 2 + (i >> 1)) * 4096) = gq;
              }
            }
          } else {
#pragma unroll
            for (int j = 0; j < 4; ++j)
#pragma unroll
              for (int i = 0; i < 4; i += 2) {
                const u32x4 gq = *(const u32x4*)(gstash + (j * 2 + (i >> 1)) * 4096);
                accm[i][j][0] += bflo(gq[0]) * acc[i][j][0];
                accm[i][j][1] += bfhi(gq[0]) * acc[i][j][1];
                accm[i][j][2] += bflo(gq[1]) * acc[i][j][2];
                accm[i][j][3] += bfhi(gq[1]) * acc[i][j][3];
                accm[i + 1][j][0] += bflo(gq[2]) * acc[i + 1][j][0];
                accm[i + 1][j][1] += bfhi(gq[2]) * acc[i + 1][j][1];
                accm[i + 1][j][2] += bflo(gq[3]) * acc[i + 1][j][2];
                accm[i + 1][j][3] += bfhi(gq[3]) * acc[i + 1][j][3];
              }
          }
        }
        epi_rowmajor(accm, merged, 1024, m0, n0, 0);
      }
    }
    SYNC_BEFORE(6);
    if (PH(6)) {
      for (int v = bid; v < 256 * 8; v += nblk) {
        int mt, nt;
        swz(v, 8, 4, mt, nt);
        const int m0 = mt * 128, n0 = nt * 128;
        const int wr = w >> 1, wc = w & 1;
        f32x4 acc[4][4];
        zero_acc(acc);
        gemm_core<true>(acc, merged + (size_t)m0 * 1024, 1024, WoutT + (size_t)n0 * 1024, 1024, 1024, smem);
#pragma unroll
        for (int i = 0; i < 4; ++i) {
          const size_t row = (size_t)(m0 + wr * 64 + i * 16 + l15);
          float ss = 0.f;
#pragma unroll
          for (int j = 0; j < 4; ++j) {
            const int n = n0 + wc * 64 + j * 16 + g4 * 4;
            const float4 xv = *(const float4*)(p.x + row * 1024 + n);
            float4 o = make_float4(xv.x + acc[i][j][0], xv.y + acc[i][j][1], xv.z + acc[i][j][2], xv.w + acc[i][j][3]);
            ss += o.x * o.x + o.y * o.y + o.z * o.z + o.w * o.w;
            *(float4*)(p.out + row * 1024 + n) = o;
          }
          ss += __shfl_xor(ss, 16);
          ss += __shfl_xor(ss, 32);
          if (g4 == 0) part[row * 16 + nt * 2 + wc] = ss;
        }
      }
    }
    SYNC_BEFORE(7);
    if (PH(7)) {
      for (int row = bid * 4 + w; row < T_; row += nblk * 4) {
        float ss = (lane < 16) ? part[(size_t)row * 16 + lane] : 0.f;
        ss = wave_sum(ss);
        const float rstd = rsqrtf(ss * (1.f / 1024.f) + 1e-6f);
        float* o = p.out + (size_t)row * 1024;
#pragma unroll
        for (int i = 0; i < 4; ++i) {
          float4 v = *(const float4*)(o + i * 256 + lane * 4);
          const float4 gv = *(const float4*)(p.g_final + i * 256 + lane * 4);
          v.x *= rstd * gv.x; v.y *= rstd * gv.y; v.z *= rstd * gv.z; v.w *= rstd * gv.w;
          *(float4*)(o + i * 256 + lane * 4) = v;
        }
      }
    }
  }
}

extern "C" void kernel_launch(void* const* d_in, const int* in_sizes, int n_in, void* d_out, int out_size, void* d_ws,
                              size_t ws_size, hipStream_t stream) {
  static int grid_blocks = 0;
  if (!grid_blocks) {
    if (ws_size < WS_END || n_in != 23) {
      fprintf(stderr, "kernel_launch: unexpected ws_size %zu (need %zu) or n_in %d\n", ws_size, (size_t)WS_END, n_in);
      grid_blocks = -1;
      return;
    }
    int dev = 0, cus = 0, per_cu = 0;
    (void)hipGetDevice(&dev);
    (void)hipDeviceGetAttribute(&cus, hipDeviceAttributeMultiprocessorCount, dev);
    (void)hipFuncSetAttribute((const void*)mega, hipFuncAttributeMaxDynamicSharedMemorySize, LDS_BYTES);
    (void)hipOccupancyMaxActiveBlocksPerMultiprocessor(&per_cu, (const void*)mega, 256, LDS_BYTES);
    if (per_cu < 1) per_cu = 1;
    if (per_cu > 2) per_cu = 2;
    grid_blocks = cus * per_cu;
  }
  if (grid_blocks < 0) return;
  Params p{};
  const float** pp = (const float**)&p;
  for (int i = 0; i < 23; ++i) pp[i] = (const float*)d_in[i];
  p.out = (float*)d_out;
  p.ws = (char*)d_ws;
#if COOP
  p.phase_lo = 0;
  p.phase_hi = NPHASE - 1;
  void* args[] = {&p};
  hipError_t e = hipLaunchCooperativeKernel((const void*)mega, dim3(grid_blocks), dim3(256), args, LDS_BYTES, stream);
  if (e != hipSuccess) fprintf(stderr, "cooperative launch failed: %s (grid %d)\n", hipGetErrorString(e), grid_blocks);
#else
  for (int ph = 0; ph < NPHASE; ++ph) {
    p.phase_lo = ph;
    p.phase_hi = ph;
    hipLaunchKernelGGL(mega, dim3(grid_blocks), dim3(256), LDS_BYTES, stream, p);
#ifdef PROBE_DUP
    if (ph == PROBE_DUP) {
      for (int rep = 0; rep < 2; ++rep) {
        if (ph == 2) { p.phase_lo = p.phase_hi = 1; hipLaunchKernelGGL(mega, dim3(grid_blocks), dim3(256), LDS_BYTES, stream, p); p.phase_lo = p.phase_hi = 2; }
        hipLaunchKernelGGL(mega, dim3(grid_blocks), dim3(256), LDS_BYTES, stream, p);
      }
    }
#endif
  }
#endif
}
```

```cpp
#include <hip/hip_runtime.h>
#include <hip/hip_cooperative_groups.h>
#include <stdint.h>
#include <stdio.h>
namespace cg = cooperative_groups;

#ifndef COOP
#define COOP 1
#define XCD_MODE 0
#endif

#define DI __device__ __forceinline__
#ifdef ONLY_PHASE
#define PH(n) ((n) == ONLY_PHASE && p.phase_lo <= (n) && (n) <= p.phase_hi)
#else
#define PH(n) (p.phase_lo <= (n) && (n) <= p.phase_hi)
#endif
#define SYNC_BEFORE(n)                                        \
  if (p.phase_lo < (n) && (n) <= p.phase_hi) {                \
    if ((n) == 1) grid.sync();                                \
    else xcd_barrier(xb);                                     \
  }
typedef unsigned short u16;
using bf16x8 = __attribute__((ext_vector_type(8))) short;
using f32x4 = __attribute__((ext_vector_type(4))) float;
using u32x4 = __attribute__((ext_vector_type(4))) unsigned;
using u32x2 = __attribute__((ext_vector_type(2))) unsigned;

constexpr int T_ = 32768, L_ = 8192;
constexpr int LDS_BYTES = 73728;
constexpr int NPHASE = 8;

constexpr size_t MiB = 1u << 20;
constexpr int KLD = 1088;
constexpr size_t OFF_H = 0;
constexpr size_t OFF_Q = 68 * MiB;
constexpr size_t OFF_GF = 116 * MiB;
constexpr size_t OFF_U = 164 * MiB;
constexpr size_t OFF_GS = 212 * MiB;
constexpr size_t OFF_YS5A = 260 * MiB;
constexpr size_t OFF_QM = 308 * MiB;
constexpr size_t OFF_GM = 340 * MiB;
constexpr size_t OFF_MERGED = 372 * MiB;
constexpr size_t OFF_WINT = 440 * MiB;
constexpr size_t OFF_WGLT = 453 * MiB;
constexpr size_t OFF_WKVT = 460 * MiB;
constexpr size_t OFF_WOUTT = 463 * MiB;
constexpr size_t OFF_WPFT = 466 * MiB;
constexpr size_t OFF_WPST = 468 * MiB;
constexpr size_t OFF_WPMT = 470 * MiB;
constexpr size_t OFF_WGLUT = 471 * MiB;
constexpr size_t OFF_MEMN = 473 * MiB;
constexpr size_t OFF_MK = 476 * MiB;
constexpr size_t OFF_MVT = 477 * MiB;
constexpr size_t OFF_LOGF = 478 * MiB;
constexpr size_t OFF_F = 480 * MiB;
constexpr size_t OFF_S5AB = 482 * MiB;
constexpr size_t OFF_S5BB = 483 * MiB;
constexpr size_t OFF_S5S = 484 * MiB;
constexpr size_t OFF_PART = 496 * MiB;
constexpr size_t OFF_GATE = OFF_GS;
constexpr size_t OFF_CTL = 498 * MiB;
constexpr size_t WS_END = 499 * MiB;

struct Params {
  const float *x, *mem, *g_norm, *g_mem_norm, *g_final, *w_in, *b_forget, *b_merge, *w_mem_kv;
  const float *lam_re, *lam_im, *log_step, *b_re, *b_im, *c_re, *c_im, *s5_d, *w_glu, *b_glu;
  const float *w_pf, *w_ps, *w_pm, *w_out;
  float* out;
  char* ws;
  int phase_lo, phase_hi;
};

DI u16 f2bf(float x) { unsigned u = __float_as_uint(x); u += 0x7fffu + ((u >> 16) & 1u); return (u16)(u >> 16); }
DI unsigned pack2(float a, float b) { return (unsigned)f2bf(a) | ((unsigned)f2bf(b) << 16); }
DI float bflo(unsigned v) { return __uint_as_float(v << 16); }
DI float bfhi(unsigned v) { return __uint_as_float(v & 0xffff0000u); }
DI float sigmoidf_(float x) { return 1.f / (1.f + __expf(-x)); }
DI float siluf_(float x) { return x / (1.f + __expf(-x)); }
DI float gelu_tanh(float x) {
  float z = 0.7978845608028654f * (x + 0.044715f * x * x * x);
  float e = __expf(2.f * z);
  float th = 1.f - 2.f / (e + 1.f);
  return 0.5f * x * (1.f + th);
}
DI float wave_sum(float v) {
#pragma unroll
  for (int o = 32; o > 0; o >>= 1) v += __shfl_xor(v, o);
  return v;
}
DI f32x4 mfma16(bf16x8 a, bf16x8 b, f32x4 c) { return __builtin_amdgcn_mfma_f32_16x16x32_bf16(a, b, c, 0, 0, 0); }

template <bool SWAP, int DEPTH = 1>
DI void gemm_core(f32x4 (&acc)[4][4], const u16* __restrict__ A, int lda, const u16* __restrict__ Bt, int ldb, int K, char* smem) {
  const int tid = threadIdx.x, lane = tid & 63, w = tid >> 6, wr = w >> 1, wc = w & 1, l15 = lane & 15, g = lane >> 4;
  const int lrow = tid >> 3, lch = tid & 7;
  const char* ap = (const char*)A;
  const char* bp = (const char*)Bt;
  const unsigned aoff = (unsigned)(lrow * lda + lch * 8) * 2u;
  const unsigned boff = (unsigned)(lrow * ldb + lch * 8) * 2u;
  u32x4 ra0[4], rb0[4], ra1[4], rb1[4];
  const int nk = K >> 6;
#define G_LOAD(RA, RB, KT)                                                        \
  _Pragma("unroll") for (int c = 0; c < 4; ++c) {                                 \
    RA[c] = *(const u32x4*)(ap + ((size_t)c * 64 * lda + (KT) * 128) + aoff);     \
    RB[c] = *(const u32x4*)(bp + ((size_t)c * 64 * ldb + (KT) * 128) + boff);     \
  }
#define G_STORE(RA, RB, BO)                                                       \
  _Pragma("unroll") for (int c = 0; c < 4; ++c) {                                 \
    *(u32x4*)(wbase + (BO) + c * 32 * 128) = RA[c];                               \
    *(u32x4*)(wbase + (BO) + 16384 + c * 32 * 128) = RB[c];                       \
  }
#define G_COMPUTE(BO)                                                             \
  {                                                                               \
    bf16x8 af[2][4], bfr[2][4];                                                   \
    _Pragma("unroll") for (int i = 0; i < 4; ++i) af[0][i] = *(const bf16x8*)(ard0 + (BO) + i * 16 * 128);  \
    _Pragma("unroll") for (int j = 0; j < 4; ++j) bfr[0][j] = *(const bf16x8*)(brd0 + (BO) + j * 16 * 128); \
    _Pragma("unroll") for (int i = 0; i < 4; ++i) af[1][i] = *(const bf16x8*)(ard1 + (BO) + i * 16 * 128);  \
    _Pragma("unroll") for (int j = 0; j < 4; ++j) bfr[1][j] = *(const bf16x8*)(brd1 + (BO) + j * 16 * 128); \
    __builtin_amdgcn_sched_barrier(0);                                            \
    __builtin_amdgcn_s_setprio(1);                                                \
    _Pragma("unroll") for (int s = 0; s < 2; ++s)                                 \
      _Pragma("unroll") for (int i = 0; i < 4; ++i)                               \
        _Pragma("unroll") for (int j = 0; j < 4; ++j)                             \
          acc[i][j] = SWAP ? mfma16(bfr[s][j], af[s][i], acc[i][j]) : mfma16(af[s][i], bfr[s][j], acc[i][j]); \
    __builtin_amdgcn_s_setprio(0);                                                \
  }
  char* wbase = smem + lrow * 128 + ((lch ^ ((lrow >> 1) & 7)) << 4);
  const int hsw = l15 >> 1;
  const char* ard0 = smem + (wr * 64 + l15) * 128 + ((g ^ hsw) << 4);
  const char* ard1 = smem + (wr * 64 + l15) * 128 + (((4 + g) ^ hsw) << 4);
  const char* brd0 = smem + 16384 + (wc * 64 + l15) * 128 + ((g ^ hsw) << 4);
  const char* brd1 = smem + 16384 + (wc * 64 + l15) * 128 + (((4 + g) ^ hsw) << 4);
  if constexpr (DEPTH == 2) {
    G_LOAD(ra0, rb0, 0);
    G_LOAD(ra1, rb1, 1);
    G_STORE(ra0, rb0, 0);
    __syncthreads();
    for (int kt = 0; kt < nk; kt += 2) {
      if (kt + 2 < nk) G_LOAD(ra0, rb0, kt + 2);
      __builtin_amdgcn_sched_barrier(0);
      G_COMPUTE(0);
      __builtin_amdgcn_sched_barrier(0);
      G_STORE(ra1, rb1, 32768);
      __syncthreads();
      if (kt + 3 < nk) G_LOAD(ra1, rb1, kt + 3);
      __builtin_amdgcn_sched_barrier(0);
      G_COMPUTE(32768);
      __builtin_amdgcn_sched_barrier(0);
      if (kt + 2 < nk) G_STORE(ra0, rb0, 0);
      __syncthreads();
    }
  } else {
    G_LOAD(ra0, rb0, 0);
    G_STORE(ra0, rb0, 0);
    __syncthreads();
    for (int kt = 0; kt < nk; kt += 2) {
      G_LOAD(ra0, rb0, kt + 1);
      __builtin_amdgcn_sched_barrier(0);
      G_COMPUTE(0);
      __builtin_amdgcn_sched_barrier(0);
      G_STORE(ra0, rb0, 32768);
      __syncthreads();
      if (kt + 2 < nk) G_LOAD(ra0, rb0, kt + 2);
      __builtin_amdgcn_sched_barrier(0);
      G_COMPUTE(32768);
      __builtin_amdgcn_sched_barrier(0);
      if (kt + 2 < nk) G_STORE(ra0, rb0, 0);
      __syncthreads();
    }
  }
#undef G_LOAD
#undef G_STORE
#undef G_COMPUTE
}

DI void zero_acc(f32x4 (&acc)[4][4]) {
#pragma unroll
  for (int i = 0; i < 4; ++i)
#pragma unroll
    for (int j = 0; j < 4; ++j) acc[i][j] = f32x4{0.f, 0.f, 0.f, 0.f};
}

DI void swz(int v, int NT, int GN, int& mt, int& nt) {
#if XCD_MODE == 0
  int xcd = v & 7, j = v >> 3;
#else
  int xcd = (v & 511) >> 6, j = ((v >> 9) << 6) + (v & 63);
#endif
  int per_mg = 8 * NT;
  int mg = j / per_mg, r = j - mg * per_mg;
  int ng = r / (8 * GN), wv = r - ng * (8 * GN);
  mt = xcd * 32 + mg * 8 + (wv & 7);
  nt = ng * GN + (wv >> 3);
}

DI void epi_rowmajor(const f32x4 (&acc)[4][4], u16* dst, int ld, int m0, int c0, int mode) {
  const int tid = threadIdx.x, lane = tid & 63, w = tid >> 6, wr = w >> 1, wc = w & 1, l15 = lane & 15, g = lane >> 4;
#pragma unroll
  for (int i = 0; i < 4; ++i) {
    const size_t row = (size_t)(m0 + wr * 64 + i * 16 + l15);
#pragma unroll
    for (int j = 0; j < 4; ++j) {
      f32x4 v = acc[i][j];
      if (mode == 1) { v[0] *= 0.125f; v[1] *= 0.125f; v[2] *= 0.125f; v[3] *= 0.125f; }
      else if (mode == 2) { v[0] = siluf_(v[0]); v[1] = siluf_(v[1]); v[2] = siluf_(v[2]); v[3] = siluf_(v[3]); }
      u32x2 o = {pack2(v[0], v[1]), pack2(v[2], v[3])};
      *(u32x2*)(dst + row * ld + c0 + wc * 64 + j * 16 + g * 4) = o;
    }
  }
}
DI void epi_transposed(const f32x4 (&acc)[4][4], u16* dst, int m0, int c0, int H, int lgDh, int lgLk) {
  const int tid = threadIdx.x, lane = tid & 63, w = tid >> 6, wr = w >> 1, wc = w & 1, l15 = lane & 15, g = lane >> 4;
#pragma unroll
  for (int i = 0; i < 4; ++i) {
    const int token = m0 + wr * 64 + i * 16 + g * 4;
    const int bidx = token >> lgLk, tl = token & ((1 << lgLk) - 1);
#pragma unroll
    for (int j = 0; j < 4; ++j) {
      const int col = c0 + wc * 64 + j * 16 + l15;
      const int head = col >> lgDh, d = col & ((1 << lgDh) - 1);
      f32x4 v = acc[i][j];
      u32x2 o = {pack2(v[0], v[1]), pack2(v[2], v[3])};
      *(u32x2*)(dst + ((((((size_t)bidx * H + head) << lgDh) + d) << lgLk) + tl)) = o;
    }
  }
}

template <int D, bool FOX, bool PF, int NQ>
DI void attn_item(const u16* __restrict__ qbase, int ldq, const u16* __restrict__ kbase, int ldk,
                  const u16* __restrict__ vtbase, int ldv, const float* __restrict__ Fseq, int q0, int nkv,
                  const u16* __restrict__ gate, u16* outp, float scale, float kmaxv, char* smem) {
  const int tid = threadIdx.x, lane = tid & 63, w = tid >> 6, l15 = lane & 15, g = lane >> 4;
  constexpr int KROW = D * 2 + 16;
  constexpr int KBYTES = 64 * KROW;
  constexpr int VBYTES = D * 144;
  constexpr int BUF = KBYTES + VBYTES + 256;
  constexpr int NL = D / 32;
  constexpr int KCH = D / 8;
  static_assert(2 * BUF <= LDS_BYTES, "attn lds");

  bf16x8 qf[NQ][D / 32];
#pragma unroll
  for (int qi = 0; qi < NQ; ++qi)
#pragma unroll
    for (int s = 0; s < D / 32; ++s)
      qf[qi][s] = *(const bf16x8*)(qbase + (size_t)(w * (16 * NQ) + qi * 16 + l15) * ldq + s * 32 + g * 8);
  float fq[NQ];
#pragma unroll
  for (int qi = 0; qi < NQ; ++qi) fq[qi] = FOX ? Fseq[q0 + w * (16 * NQ) + qi * 16 + l15] : 0.f;
  f32x4 ot[D / 16][NQ];
#pragma unroll
  for (int dt = 0; dt < D / 16; ++dt)
#pragma unroll
    for (int qi = 0; qi < NQ; ++qi) ot[dt][qi] = f32x4{0, 0, 0, 0};
  float mrun[NQ], lsum[NQ];
#pragma unroll
  for (int qi = 0; qi < NQ; ++qi) { mrun[qi] = -1e30f; lsum[qi] = 0.f; }
  float qk[NQ];
#pragma unroll
  for (int qi = 0; qi < NQ; ++qi) {
    float ss = 0.f;
    if (FOX) {
#pragma unroll
      for (int s = 0; s < D / 32; ++s)
#pragma unroll
        for (int e = 0; e < 8; ++e) {
          const float v = __uint_as_float(((unsigned)(unsigned short)qf[qi][s][e]) << 16);
          ss += v * v;
        }
      ss += __shfl_xor(ss, 16);
      ss += __shfl_xor(ss, 32);
    }
    qk[qi] = sqrtf(ss) * kmaxv * 1.002f + 1e-3f;
  }
  int* flags = (int*)(smem + 73664);

  u32x4 kr[NL], vr[NL];
  f32x4 fr = {0, 0, 0, 0};
#define krow(c) (((c) * 256 + tid) / KCH)
#define kch(c) (((c) * 256 + tid) % KCH)
#define vrow(c) (((c) * 256 + tid) >> 3)
#define vch(c) (tid & 7)
#define ATT_LOAD(J)                                                                                   \
  {                                                                                                   \
    const int s0_ = (J) * 64;                                                                         \
    _Pragma("unroll") for (int c = 0; c < NL; ++c) {                                                  \
      kr[c] = *(const u32x4*)(kbase + (size_t)(s0_ + krow(c)) * ldk + kch(c) * 8);                    \
      vr[c] = *(const u32x4*)(vtbase + (size_t)vrow(c) * ldv + s0_ + vch(c) * 8);                     \
    }                                                                                                 \
    if (FOX && tid < 16) fr = *(const f32x4*)(Fseq + s0_ + tid * 4);                                  \
  }
#define ATT_STORE(BO)                                                                                 \
  {                                                                                                   \
    char* b_ = smem + (BO);                                                                           \
    _Pragma("unroll") for (int c = 0; c < NL; ++c) {                                                  \
      *(u32x4*)(b_ + krow(c) * KROW + kch(c) * 16) = kr[c];                                           \
      *(u32x4*)(b_ + KBYTES + vrow(c) * 144 + vch(c) * 16) = vr[c];                                   \
    }                                                                                                 \
    if (FOX && tid < 16) *(f32x4*)(b_ + KBYTES + VBYTES + tid * 16) = fr;                             \
  }
  ATT_LOAD(nkv - 1);
  ATT_STORE(0);
  __syncthreads();
  const int qlo = q0 + w * (16 * NQ);
  for (int j = nkv - 1, itn = 0; j >= 0; --j, ++itn) {
    const int cur = (itn & 1) * BUF;
    if (j > 0) {
      ATT_LOAD(j - 1);
      if (!PF) ATT_STORE(cur ^ BUF);
    }
    __builtin_amdgcn_sched_barrier(0);
    bool ok = false;
    const int s0 = j * 64;
    const bool active = !FOX || (s0 <= qlo + 16 * NQ - 1);
    if (active) {
      const char* Ks = smem + cur;
      const char* Vs = smem + cur + KBYTES;
      const char* Fs = smem + cur + KBYTES + VBYTES;
      f32x4 st[4][NQ];
#pragma unroll
      for (int kt = 0; kt < 4; ++kt)
#pragma unroll
        for (int qi = 0; qi < NQ; ++qi) st[kt][qi] = f32x4{0, 0, 0, 0};
#pragma unroll
      for (int s = 0; s < D / 32; ++s) {
        bf16x8 kf[4];
#pragma unroll
        for (int kt = 0; kt < 4; ++kt) kf[kt] = *(const bf16x8*)(Ks + (kt * 16 + l15) * KROW + s * 64 + g * 16);
#pragma unroll
        for (int kt = 0; kt < 4; ++kt)
#pragma unroll
          for (int qi = 0; qi < NQ; ++qi) st[kt][qi] = mfma16(kf[kt], qf[qi][s], st[kt][qi]);
      }
      if (FOX) {
        const bool need_mask = (s0 + 63 > qlo);
#pragma unroll
        for (int kt = 0; kt < 4; ++kt) {
          f32x4 fk = *(const f32x4*)(Fs + (kt * 16 + g * 4) * 4);
#pragma unroll
          for (int qi = 0; qi < NQ; ++qi) {
            const int qpos = qlo + qi * 16 + l15;
#pragma unroll
            for (int r = 0; r < 4; ++r) {
              float v = st[kt][qi][r] + fq[qi] - fk[r];
              if (need_mask && (s0 + kt * 16 + g * 4 + r > qpos)) v = -1e30f;
              st[kt][qi][r] = v;
            }
          }
        }
      } else {
#pragma unroll
        for (int kt = 0; kt < 4; ++kt)
#pragma unroll
          for (int qi = 0; qi < NQ; ++qi)
#pragma unroll
            for (int r = 0; r < 4; ++r) st[kt][qi][r] *= scale;
      }
      float alpha[NQ];
#pragma unroll
      for (int qi = 0; qi < NQ; ++qi) {
        float mx = st[0][qi][0];
#pragma unroll
        for (int kt = 0; kt < 4; ++kt)
#pragma unroll
          for (int r = 0; r < 4; ++r) mx = fmaxf(mx, st[kt][qi][r]);
        mx = fmaxf(mx, __shfl_xor(mx, 16));
        mx = fmaxf(mx, __shfl_xor(mx, 32));
        const float mnew = fmaxf(mrun[qi], mx);
        alpha[qi] = __expf(mrun[qi] - mnew);
        mrun[qi] = mnew;
        float ps = 0.f;
#pragma unroll
        for (int kt = 0; kt < 4; ++kt)
#pragma unroll
          for (int r = 0; r < 4; ++r) {
            float p = __expf(st[kt][qi][r] - mnew);
            st[kt][qi][r] = p;
            ps += p;
          }
        lsum[qi] = lsum[qi] * alpha[qi] + ps;
      }
      bf16x8 pb[2][NQ];
#pragma unroll
      for (int kp = 0; kp < 2; ++kp)
#pragma unroll
        for (int qi = 0; qi < NQ; ++qi) {
          u32x4 t = {pack2(st[2 * kp][qi][0], st[2 * kp][qi][1]), pack2(st[2 * kp][qi][2], st[2 * kp][qi][3]),
                     pack2(st[2 * kp + 1][qi][0], st[2 * kp + 1][qi][1]), pack2(st[2 * kp + 1][qi][2], st[2 * kp + 1][qi][3])};
          pb[kp][qi] = __builtin_bit_cast(bf16x8, t);
        }
#pragma unroll
      for (int dt = 0; dt < D / 16; ++dt) {
#pragma unroll
        for (int r = 0; r < 4; ++r)
#pragma unroll
          for (int qi = 0; qi < NQ; ++qi) ot[dt][qi][r] *= alpha[qi];
#pragma unroll
        for (int kp = 0; kp < 2; ++kp) {
          u32x2 lo = *(const u32x2*)(Vs + (dt * 16 + l15) * 144 + (kp * 32 + g * 4) * 2);
          u32x2 hi = *(const u32x2*)(Vs + (dt * 16 + l15) * 144 + (kp * 32 + 16 + g * 4) * 2);
          u32x4 t = {lo[0], lo[1], hi[0], hi[1]};
          bf16x8 vf = __builtin_bit_cast(bf16x8, t);
#pragma unroll
          for (int qi = 0; qi < NQ; ++qi) ot[dt][qi] = mfma16(vf, pb[kp][qi], ot[dt][qi]);
        }
      }
      if (FOX) {
        const float f0 = *(const float*)Fs;
        ok = true;
#pragma unroll
        for (int qi = 0; qi < NQ; ++qi) ok = ok && (qk[qi] + fq[qi] - f0 - mrun[qi] <= -30.f);
      }
    }
    __builtin_amdgcn_sched_barrier(0);
    if (PF && j > 0) ATT_STORE(cur ^ BUF);
    if (FOX) {
      const bool wave_ok = (__ballot(ok) == ~0ull);
      if (lane == 0) flags[(itn & 1) * 4 + w] = wave_ok ? 1 : 0;
      __syncthreads();
      const int* fl = flags + (itn & 1) * 4;
      if (fl[0] & fl[1] & fl[2] & fl[3]) break;
    } else {
      __syncthreads();
    }
  }
#undef ATT_LOAD
#undef ATT_STORE
#undef krow
#undef kch
#undef vrow
#undef vch
#pragma unroll
  for (int qi = 0; qi < NQ; ++qi) {
    float l = lsum[qi];
    l += __shfl_xor(l, 16);
    l += __shfl_xor(l, 32);
    const float inv = 1.f / l;
    const size_t rowoff = (size_t)(w * (16 * NQ) + qi * 16 + l15) * ldq;
#pragma unroll
    for (int dt = 0; dt < D / 16; ++dt) {
      const int col = dt * 16 + g * 4;
      u32x2 gv = *(const u32x2*)(gate + rowoff + col);
      u32x2 o = {pack2(ot[dt][qi][0] * inv * bflo(gv[0]), ot[dt][qi][1] * inv * bfhi(gv[0])),
                 pack2(ot[dt][qi][2] * inv * bflo(gv[1]), ot[dt][qi][3] * inv * bfhi(gv[1]))};
      *(u32x2*)(outp + rowoff + col) = o;
    }
  }
}

typedef float v2f __attribute__((ext_vector_type(2)));
DI void s5_load_u(const u16* ubuf, int b, int c, int g, char* ut, int lane) {
  const u16* src = ubuf + ((size_t)(b * L_ + c * 64 + lane)) * 768 + g * 16;
  u32x4 a = *(const u32x4*)src, bb = *(const u32x4*)(src + 8);
  f32x4 o0 = {bflo(a[0]), bfhi(a[0]), bflo(a[1]), bfhi(a[1])};
  f32x4 o1 = {bflo(a[2]), bfhi(a[2]), bflo(a[3]), bfhi(a[3])};
  f32x4 o2 = {bflo(bb[0]), bfhi(bb[0]), bflo(bb[1]), bfhi(bb[1])};
  f32x4 o3 = {bflo(bb[2]), bfhi(bb[2]), bflo(bb[3]), bfhi(bb[3])};
  *(f32x4*)(ut + lane * 64) = o0;
  *(f32x4*)(ut + lane * 64 + 16) = o1;
  *(f32x4*)(ut + lane * 64 + 32) = o2;
  *(f32x4*)(ut + lane * 64 + 48) = o3;
}
DI void s5_load_b(const float* bbar, int gp, v2f (&b2)[16]) {
#pragma unroll
  for (int q = 0; q < 4; ++q) {
    float4 t0 = *(const float4*)(bbar + (size_t)gp * 32 + q * 4);
    float4 t1 = *(const float4*)(bbar + (size_t)gp * 32 + 16 + q * 4);
    b2[4 * q] = v2f{t0.x, t1.x}; b2[4 * q + 1] = v2f{t0.y, t1.y};
    b2[4 * q + 2] = v2f{t0.z, t1.z}; b2[4 * q + 3] = v2f{t0.w, t1.w};
  }
}
DI v2f s5_x(const char* ut, int t, const v2f (&b2)[16]) {
  v2f xa = {0.f, 0.f}, xb = {0.f, 0.f};
#pragma unroll
  for (int q = 0; q < 4; ++q) {
    const f32x4 u = *(const f32x4*)(ut + t * 64 + q * 16);
    xa += b2[4 * q] * u[0];
    xb += b2[4 * q + 1] * u[1];
    xa += b2[4 * q + 2] * u[2];
    xb += b2[4 * q + 3] * u[3];
  }
  return xa + xb;
}

#define XB_TMO      128
#define XB_XCNT(j)  (256  + 64 * (j))
#define XB_XSUB(j)  (1280 + 64 * (j))
#define XB_XGEN(j)  (2304 + 64 * (j))
#define XB_TOP      3328
#define XB_TOPGEN   3392
#define XCD_BAR_WORDS 3456
#define XB_SPIN_CAP (1u << 18)
DI unsigned xb_ld(unsigned* p) { return __hip_atomic_load(p, __ATOMIC_RELAXED, __HIP_MEMORY_SCOPE_AGENT); }
DI unsigned xb_add(unsigned* p, unsigned v) { return __hip_atomic_fetch_add(p, v, __ATOMIC_RELAXED, __HIP_MEMORY_SCOPE_AGENT); }
DI unsigned xb_xcc_id() { return (unsigned)__builtin_amdgcn_s_getreg((3 << 11) | 20) & 0xFu; }
#define XB_SPIN(cond, bar) do { unsigned _sp = 0; while (cond) { __builtin_amdgcn_s_sleep(1); \
    if ((++_sp & 255u) == 0u) { if (xb_ld(&(bar)[XB_TMO])) break; if (_sp > XB_SPIN_CAP) { atomicAdd(&(bar)[XB_TMO], 1u); break; } } } } while (0)
struct XcdBarrier { unsigned* bar; unsigned x; volatile unsigned* st; };
DI XcdBarrier xcd_barrier_post(unsigned* bar, volatile unsigned* st) {
  XcdBarrier b; b.bar = bar; b.x = xb_xcc_id(); b.st = st;
  if (threadIdx.x == 0) (void)xb_add(&bar[XB_XCNT(b.x)], 1u);
  return b;
}
DI void xcd_barrier_complete(unsigned* bar, unsigned x, unsigned& nloc, unsigned& nx) {
  const unsigned G = gridDim.x * gridDim.y * gridDim.z;
  unsigned sum, cnt, mine, sp = 0u;
  for (;;) {
    sum = 0u; cnt = 0u; mine = 0u;
#pragma unroll
    for (unsigned j = 0; j < 16; ++j) { const unsigned c = xb_ld(&bar[XB_XCNT(j)]); sum += c; cnt += (c > 0u) ? 1u : 0u; mine = (j == x) ? c : mine; }
    if (sum == G) break;
    __builtin_amdgcn_s_sleep(1);
    if ((++sp & 255u) == 0u) { if (xb_ld(&bar[XB_TMO])) break; if (sp > XB_SPIN_CAP) { atomicAdd(&bar[XB_TMO], 1u); break; } }
  }
  nloc = mine > 0u ? mine : 1u; nx = cnt > 0u ? cnt : 1u;
}
DI void xcd_barrier(const XcdBarrier& b) {
  asm volatile("s_waitcnt vmcnt(0)" ::: "memory");
  __syncthreads();
  if (threadIdx.x == 0) {
    unsigned* bar = b.bar;
    __builtin_amdgcn_s_waitcnt(0);
    unsigned nloc = b.st[0], nx = b.st[1];
    if (nloc == 0u) { xcd_barrier_complete(bar, b.x, nloc, nx); b.st[0] = nloc; b.st[1] = nx; }
    const unsigned old = xb_add(&bar[XB_XSUB(b.x)], 1u);
    const unsigned gen = old / nloc;
    if (old + 1u == (gen + 1u) * nloc) {
      __builtin_amdgcn_fence(__ATOMIC_RELEASE, "agent");
      asm volatile("s_waitcnt vmcnt(0)" ::: "memory");
      const unsigned og = xb_add(&bar[XB_TOP], 1u);
      const unsigned tg = og / nx;
      if (og + 1u == (tg + 1u) * nx) xb_add(&bar[XB_TOPGEN], 1u);
      else XB_SPIN(xb_ld(&bar[XB_TOPGEN]) == tg, bar);
      __builtin_amdgcn_fence(__ATOMIC_ACQUIRE, "agent");
      xb_add(&bar[XB_XGEN(b.x)], 1u);
      asm volatile("s_waitcnt vmcnt(0)" ::: "memory");
    } else {
      XB_SPIN(xb_ld(&bar[XB_XGEN(b.x)]) == gen, bar);
      __builtin_amdgcn_fence(__ATOMIC_ACQUIRE, "agent");
      asm volatile("s_waitcnt vmcnt(0)" ::: "memory");
    }
  }
  __syncthreads();
}

extern "C" __global__ void __launch_bounds__(256, 2) mega(Params p) {
  extern __shared__ __attribute__((aligned(16))) char smem[];
  cg::grid_group grid = cg::this_grid();
#define TIDVARS                                                                  \
  int tid = threadIdx.x;                                                         \
  asm volatile("" : "+v"(tid));                                                  \
  const int lane = tid & 63, w = tid >> 6, l15 = lane & 15, g4 = lane >> 4;      \
  (void)lane; (void)w; (void)l15; (void)g4;
  const int nblk = gridDim.x, bid = blockIdx.x;
  char* ws = p.ws;
  XcdBarrier xb;
  xb.bar = (unsigned*)(ws + OFF_CTL + 4096); xb.x = 0; xb.st = (volatile unsigned*)(smem + 73712);
  if (p.phase_lo < p.phase_hi) {
    if (threadIdx.x < 2) xb.st[threadIdx.x] = 0u;
    __syncthreads();
    xb = xcd_barrier_post((unsigned*)(ws + OFF_CTL + 4096), (volatile unsigned*)(smem + 73712));
  }
  u16* hbuf = (u16*)(ws + OFF_H);
  u16* qbuf = (u16*)(ws + OFF_Q);
  u16* gfbuf = (u16*)(ws + OFF_GF);
  u16* ubuf = (u16*)(ws + OFF_U);
  u16* gsbuf = (u16*)(ws + OFF_GS);
  u16* ys5a = (u16*)(ws + OFF_YS5A);
  u16* qmbuf = (u16*)(ws + OFF_QM);
  u16* gmbuf = (u16*)(ws + OFF_GM);
  u16* merged = (u16*)(ws + OFF_MERGED);
  u16* WinT = (u16*)(ws + OFF_WINT);
  u16* WglT = (u16*)(ws + OFF_WGLT);
  u16* WkvT = (u16*)(ws + OFF_WKVT);
  u16* WoutT = (u16*)(ws + OFF_WOUTT);
  u16* WpfT = (u16*)(ws + OFF_WPFT);
  u16* WpsT = (u16*)(ws + OFF_WPST);
  u16* WpmT = (u16*)(ws + OFF_WPMT);
  u16* WgluT = (u16*)(ws + OFF_WGLUT);
  u16* memn = (u16*)(ws + OFF_MEMN);
  u16* mkbuf = (u16*)(ws + OFF_MK);
  u16* mvT = (u16*)(ws + OFF_MVT);
  float* logf = (float*)(ws + OFF_LOGF);
  float* Fbuf = (float*)(ws + OFF_F);
  float2* abar = (float2*)(ws + OFF_S5AB);
  float* bbar = (float*)(ws + OFF_S5BB);
  float2* Sst = (float2*)(ws + OFF_S5S);
  float* part = (float*)(ws + OFF_PART);
  unsigned* ctl = (unsigned*)(ws + OFF_CTL);
  u16* kbuf = (u16*)p.out;
  u16* vT = (u16*)((char*)p.out + 48 * MiB);

  {
    if (PH(0)) {
      TIDVARS
      if (bid == 0 && tid < 128) ctl[tid] = 0u;
      float* tile = (float*)smem;
      for (int ti = bid; ti < 3344; ti += nblk) {
        const float* src; int ld, col0, K; u16* dst; int tt;
        if (ti < 576) { src = p.w_in; ld = 8716; col0 = 0; K = 1024; dst = WinT; tt = ti; }
        else if (ti < 1408) { src = p.w_in; ld = 8716; col0 = 2316; K = 1024; dst = WinT + (size_t)2304 * KLD; tt = ti - 576; }
        else if (ti < 2176) { src = p.w_in; ld = 8716; col0 = 5644; K = 1024; dst = WglT; tt = ti - 1408; }
        else if (ti < 2432) { src = p.w_mem_kv; ld = 1024; col0 = 0; K = 1024; dst = WkvT; tt = ti - 2176; }
        else if (ti < 2688) { src = p.w_out; ld = 1024; col0 = 0; K = 1024; dst = WoutT; tt = ti - 2432; }
        else if (ti < 2880) { src = p.w_pf; ld = 1024; col0 = 0; K = 768; dst = WpfT; tt = ti - 2688; }
        else if (ti < 3072) { src = p.w_ps; ld = 1024; col0 = 0; K = 768; dst = WpsT; tt = ti - 2880; }
        else if (ti < 3200) { src = p.w_pm; ld = 1024; col0 = 0; K = 512; dst = WpmT; tt = ti - 3072; }
        else { src = p.w_glu; ld = 768; col0 = 0; K = 768; dst = WgluT; tt = ti - 3200; }
        const int nkt = K >> 6;
        const int dld = (K == 1024) ? KLD : K;
        const int k0 = (tt % nkt) * 64, n0 = (tt / nkt) * 64;
#pragma unroll 4
        for (int i = 0; i < 16; ++i) {
          int k = i * 4 + w, n = lane;
          tile[k * 65 + n] = src[(size_t)(k0 + k) * ld + col0 + n0 + n];
        }
        __syncthreads();
#pragma unroll 4
        for (int i = 0; i < 16; ++i) {
          int n = i * 4 + w, k = lane;
          dst[(size_t)(n0 + n) * dld + k0 + k] = f2bf(tile[k * 65 + n]);
        }
        __syncthreads();
      }
      float* wfl = (float*)smem;
      for (int idx = tid; idx < 12288; idx += 256) {
        int k = idx / 12, j = idx - k * 12;
        wfl[j * 1024 + k] = p.w_in[(size_t)k * 8716 + 2304 + j];
      }
      __syncthreads();
      for (int row = bid * 4 + w; row < T_ + 1024; row += nblk * 4) {
        const bool isx = row < T_;
        const float* src = isx ? p.x + (size_t)row * 1024 : p.mem + (size_t)(row - T_) * 1024;
        const float* gsrc = isx ? p.g_norm : p.g_mem_norm;
        u16* dst = isx ? hbuf + (size_t)row * KLD : memn + (size_t)(row - T_) * KLD;
        float4 xv[4];
        float ss = 0.f;
#pragma unroll
        for (int i = 0; i < 4; ++i) {
          xv[i] = *(const float4*)(src + i * 256 + lane * 4);
          ss += xv[i].x * xv[i].x + xv[i].y * xv[i].y + xv[i].z * xv[i].z + xv[i].w * xv[i].w;
        }
        ss = wave_sum(ss);
        const float rstd = rsqrtf(ss * (1.f / 1024.f) + 1e-6f);
#pragma unroll
        for (int i = 0; i < 4; ++i) {
          float4 gv = *(const float4*)(gsrc + i * 256 + lane * 4);
          xv[i].x *= rstd * gv.x; xv[i].y *= rstd * gv.y; xv[i].z *= rstd * gv.z; xv[i].w *= rstd * gv.w;
          u32x2 o = {pack2(xv[i].x, xv[i].y), pack2(xv[i].z, xv[i].w)};
          *(u32x2*)(dst + i * 256 + lane * 4) = o;
        }
        if (isx) {
          float myfl = 0.f;
#pragma unroll
          for (int j = 0; j < 12; ++j) {
            float a = 0.f;
#pragma unroll
            for (int i = 0; i < 4; ++i) {
              float4 wv = *(const float4*)(wfl + j * 1024 + i * 256 + lane * 4);
              a += xv[i].x * wv.x + xv[i].y * wv.y + xv[i].z * wv.z + xv[i].w * wv.w;
            }
            a = wave_sum(a);
            if (lane == j) myfl = a;
          }
          if (lane < 12) {
            float xx = myfl + p.b_forget[lane];
            float lf = fminf(xx, 0.f) - log1pf(__expf(-fabsf(xx)));
            const int b = row >> 13, t = row & (L_ - 1);
            logf[(size_t)(b * 12 + lane) * L_ + t] = lf;
          }
        }
      }
      {
        const int gid = bid * 256 + tid;
        if (gid < 3072) {
          const int g = gid >> 6;
          const float step = expf(p.log_step[g]);
          const float lr = p.lam_re[gid], li = p.lam_im[gid];
          const float mag = expf(lr * step);
          const float ar = mag * cosf(li * step), ai = mag * sinf(li * step);
          const float den = lr * lr + li * li;
          const float nr = ar - 1.f, ni = ai;
          const float fr = (nr * lr + ni * li) / den, fi = (ni * lr - nr * li) / den;
          abar[gid] = make_float2(ar, ai);
#pragma unroll
          for (int h = 0; h < 16; ++h) {
            const float br = p.b_re[(size_t)gid * 16 + h], bi = p.b_im[(size_t)gid * 16 + h];
            bbar[(size_t)gid * 32 + h] = fr * br - fi * bi;
            bbar[(size_t)gid * 32 + 16 + h] = fr * bi + fi * br;
          }
        }
      }
      __syncthreads();
    }
    SYNC_BEFORE(1);
    if (PH(1)) {
      TIDVARS
      float* sm = (float*)smem;
      for (int seq = bid; seq < 48; seq += nblk) {
        const float* src = logf + (size_t)seq * L_ + tid * 32;
        float* dst = Fbuf + (size_t)seq * L_ + tid * 32;
        float v[32];
#pragma unroll
        for (int i = 0; i < 8; ++i) {
          float4 t = *(const float4*)(src + i * 4);
          v[4 * i] = t.x; v[4 * i + 1] = t.y; v[4 * i + 2] = t.z; v[4 * i + 3] = t.w;
        }
        float run = 0.f;
#pragma unroll
        for (int i = 0; i < 32; ++i) { run += v[i]; v[i] = run; }
        float incl = run;
#pragma unroll
        for (int o = 1; o < 64; o <<= 1) {
          float t = __shfl_up(incl, o);
          if (lane >= o) incl += t;
        }
        if (lane == 63) sm[w] = incl;
        __syncthreads();
        float base = incl - run;
        for (int w2 = 0; w2 < w; ++w2) base += sm[w2];
#pragma unroll
        for (int i = 0; i < 8; ++i) {
          float4 t = make_float4(v[4 * i] + base, v[4 * i + 1] + base, v[4 * i + 2] + base, v[4 * i + 3] + base);
          *(float4*)(dst + i * 4) = t;
        }
        __syncthreads();
      }
      for (int v = bid; v < 11264 + 64; v += nblk) {
        const u16 *A, *Bt;
        int m0, n0;
        bool kvtile = v >= 11264;
        if (!kvtile) {
          int mt, nt;
          swz(v, 44, 4, mt, nt);
          m0 = mt * 128; n0 = nt * 128;
          A = hbuf + (size_t)m0 * KLD; Bt = WinT + (size_t)n0 * KLD;
        } else {
          int kv = v - 11264;
          m0 = (kv >> 3) * 128; n0 = (kv & 7) * 128;
          A = memn + (size_t)m0 * KLD; Bt = WkvT + (size_t)n0 * KLD;
        }
        const bool transp = kvtile ? (n0 >= 512) : (n0 >= 1536 && n0 < 2304);
        f32x4 acc[4][4];
        zero_acc(acc);
        if (transp) {
          gemm_core<false, 1>(acc, A, KLD, Bt, KLD, 1024, smem);
          if (kvtile) epi_transposed(acc, mvT, m0, n0 - 512, 4, 7, 8);
          else epi_transposed(acc, vT, m0, n0 - 1536, 12, 6, 13);
        } else {
          gemm_core<true>(acc, A, KLD, Bt, KLD, 1024, smem);
          u16* dst; int ld, c0, mode;
          if (kvtile) { dst = mkbuf; ld = 512; c0 = n0; mode = 0; }
          else if (n0 < 768) { dst = qbuf; ld = 768; c0 = n0; mode = 1; }
          else if (n0 < 1536) { dst = kbuf; ld = 768; c0 = n0 - 768; mode = 0; }
          else if (n0 < 3072) { dst = gfbuf; ld = 768; c0 = n0 - 2304; mode = 2; }
          else if (n0 < 3840) { dst = ubuf; ld = 768; c0 = n0 - 3072; mode = 0; }
          else if (n0 < 4608) { dst = gsbuf; ld = 768; c0 = n0 - 3840; mode = 2; }
          else if (n0 < 5120) { dst = qmbuf; ld = 512; c0 = n0 - 4608; mode = 0; }
          else { dst = gmbuf; ld = 512; c0 = n0 - 5120; mode = 2; }
          epi_rowmajor(acc, dst, ld, m0, c0, mode);
          if (!kvtile && n0 >= 768 && n0 < 1536) {
            float mxv = 0.f;
#pragma unroll
            for (int i = 0; i < 4; ++i) {
              float ss = 0.f;
#pragma unroll
              for (int j = 0; j < 4; ++j)
#pragma unroll
                for (int r = 0; r < 4; ++r) {
                  const float v = __uint_as_float(((unsigned)f2bf(acc[i][j][r])) << 16);
                  ss += v * v;
                }
              ss += __shfl_xor(ss, 16);
              ss += __shfl_xor(ss, 32);
              mxv = fmaxf(mxv, ss);
            }
#pragma unroll
            for (int o = 1; o < 16; o <<= 1) mxv = fmaxf(mxv, __shfl_xor(mxv, o));
            if (lane == 0) atomicMax(&ctl[(m0 >> 13) * 12 + ((n0 - 768) >> 6) + (w & 1)], __float_as_uint(mxv));
          }
        }
      }
    }
    SYNC_BEFORE(2);
    if (PH(2)) {
      TIDVARS
      int* qslot = (int*)(smem + 73696);
#define NEXT_ITEM(CTR)                                        \
      {                                                       \
        if (tid == 0) *qslot = (int)atomicAdd(&ctl[CTR], 1u); \
        __syncthreads();                                      \
        it = *qslot;                                          \
        __syncthreads();                                      \
      }
      int it;
      for (;;) {
        NEXT_ITEM(64);
        if (it >= 3072) break;
        {
#ifndef NO_FOX
          const int qt = 63 - it / 48, bh = it % 48, b = bh / 12, h = bh % 12;
          const int q0 = qt * 128;
          const size_t qoff = ((size_t)(b * L_ + q0)) * 768 + h * 64;
          attn_item<64, true, true, 2>(qbuf + qoff, 768, kbuf + (size_t)b * L_ * 768 + h * 64, 768,
                              vT + (size_t)(b * 12 + h) * 64 * L_, L_, Fbuf + (size_t)(b * 12 + h) * L_, q0, 2 * qt + 2,
                              gfbuf + qoff, qbuf + qoff, 1.f, sqrtf(__uint_as_float(ctl[b * 12 + h])), smem);
#endif
        }
      }
      for (;;) {
        NEXT_ITEM(65);
        if (it >= 2048) break;
        {
#ifndef NO_MEM
          const int im = it;
          const int hm = im & 3, qt = (im >> 2) & 127, b = im >> 9;
          const int q0 = qt * 64;
          const size_t qoff = ((size_t)(b * L_ + q0)) * 512 + hm * 128;
          attn_item<128, false, false, 1>(qmbuf + qoff, 512, mkbuf + (size_t)b * 256 * 512 + hm * 128, 512,
                                mvT + (size_t)(b * 4 + hm) * 128 * 256, 256, nullptr, q0, 4,
                                gmbuf + qoff, qmbuf + qoff, 0.08838834764831845f, 0.f, smem);
#endif
        }
      }
      for (;;) {
        NEXT_ITEM(66);
        if (it >= 6144) break;
        {
#ifndef NO_S5P1
          const int wi = it * 4 + w;
          const int g = wi % 48, c = (wi / 48) & 127, b = wi / (48 * 128);
          char* ut = smem + w * 8448;
          s5_load_u(ubuf, b, c, g, ut, lane);
          const int gp = g * 64 + lane;
          v2f b2[16];
          s5_load_b(bbar, gp, b2);
          const float2 ab = abar[gp];
          asm volatile("s_waitcnt lgkmcnt(0)" ::: "memory");
          float hr = 0.f, hi = 0.f;
#pragma unroll 4
          for (int t = 0; t < 64; ++t) {
            const v2f x = s5_x(ut, t, b2);
            const float nhr = ab.x * hr - ab.y * hi + x[0];
            const float nhi = ab.x * hi + ab.y * hr + x[1];
            hr = nhr; hi = nhi;
          }
          Sst[((size_t)(b * 128 + c) * 48 + g) * 64 + lane] = make_float2(hr, hi);
          __syncthreads();
#endif
        }
      }
    }
    SYNC_BEFORE(3);
    if (PH(3)) {
      TIDVARS
      for (int it = bid; it < 6144; it += nblk) {
        const int wi = it * 4 + w;
        const int g = wi % 48, c = (wi / 48) & 127, b = wi / (48 * 128);
        char* ut = smem + w * 8448;
        char* stt = ut + 4096;
        s5_load_u(ubuf, b, c, g, ut, lane);
        const int gp = g * 64 + lane;
        v2f b2[16];
        s5_load_b(bbar, gp, b2);
        const float2 ab = abar[gp];
        bf16x8 cf[4];
#pragma unroll
        for (int s = 0; s < 4; ++s) {
          const float* cs = (s < 2 ? p.c_re : p.c_im) + (size_t)(g * 16 + l15) * 64 + (s & 1) * 32 + g4 * 8;
          float4 t0 = *(const float4*)cs, t1 = *(const float4*)(cs + 4);
          const float sg = (s < 2) ? 1.f : -1.f;
          u32x4 t = {pack2(sg * t0.x, sg * t0.y), pack2(sg * t0.z, sg * t0.w), pack2(sg * t1.x, sg * t1.y), pack2(sg * t1.z, sg * t1.w)};
          cf[s] = __builtin_bit_cast(bf16x8, t);
        }
        const float4 dsk = *(const float4*)(p.s5_d + g * 16 + g4 * 4);
        float a64r = ab.x, a64i = ab.y;
#pragma unroll
        for (int q = 0; q < 6; ++q) {
          const float nr = a64r * a64r - a64i * a64i, ni = 2.f * a64r * a64i;
          a64r = nr; a64i = ni;
        }
        float hr = 0.f, hi = 0.f;
        {
          const float2* sp = Sst + ((size_t)(b * 128) * 48 + g) * 64 + lane;
          int cc = 0;
          for (; cc + 8 <= c; cc += 8) {
            float2 sv[8];
#pragma unroll
            for (int q = 0; q < 8; ++q) sv[q] = sp[(size_t)(cc + q) * 48 * 64];
#pragma unroll
            for (int q = 0; q < 8; ++q) {
              const float nhr = a64r * hr - a64i * hi + sv[q].x;
              const float nhi = a64r * hi + a64i * hr + sv[q].y;
              hr = nhr; hi = nhi;
            }
          }
          for (; cc < c; ++cc) {
            const float2 s = sp[(size_t)cc * 48 * 64];
            const float nhr = a64r * hr - a64i * hi + s.x;
            const float nhi = a64r * hi + a64i * hr + s.y;
            hr = nhr; hi = nhi;
          }
        }
        asm volatile("s_waitcnt lgkmcnt(0)" ::: "memory");
#pragma unroll 1
        for (int sub = 0; sub < 4; ++sub) {
#pragma unroll 4
          for (int tt = 0; tt < 16; ++tt) {
            const v2f x = s5_x(ut, sub * 16 + tt, b2);
            const float nhr = ab.x * hr - ab.y * hi + x[0];
            const float nhi = ab.x * hi + ab.y * hr + x[1];
            hr = nhr; hi = nhi;
            *(u16*)(stt + tt * 272 + lane * 2) = f2bf(hr);
            *(u16*)(stt + tt * 272 + 128 + lane * 2) = f2bf(hi);
          }
          asm volatile("s_waitcnt lgkmcnt(0)" ::: "memory");
          f32x4 y = {0, 0, 0, 0};
#pragma unroll
          for (int s = 0; s < 4; ++s) {
            bf16x8 bfr = *(const bf16x8*)(stt + l15 * 272 + s * 64 + g4 * 16);
            y = mfma16(cf[s], bfr, y);
          }
          const int t = sub * 16 + l15;
          const f32x4 uv = *(const f32x4*)(ut + t * 64 + g4 * 16);
          float o0 = gelu_tanh(y[0] + dsk.x * uv[0]);
          float o1 = gelu_tanh(y[1] + dsk.y * uv[1]);
          float o2 = gelu_tanh(y[2] + dsk.z * uv[2]);
          float o3 = gelu_tanh(y[3] + dsk.w * uv[3]);
          u32x2 o = {pack2(o0, o1), pack2(o2, o3)};
          *(u32x2*)(ys5a + ((size_t)(b * L_ + c * 64 + t)) * 768 + g * 16 + g4 * 4) = o;
          asm volatile("s_waitcnt lgkmcnt(0)" ::: "memory");
        }
        __syncthreads();
      }
    }
    SYNC_BEFORE(4);
    if (PH(4)) {
      TIDVARS
      for (int v = bid; v < 256 * 6; v += nblk) {
        int mt, nt;
        swz(v, 6, 6, mt, nt);
        const int m0 = mt * 128, n0 = nt * 128;
        f32x4 acc[4][4];
        zero_acc(acc);
        gemm_core<true>(acc, ys5a + (size_t)m0 * 768, 768, WgluT + (size_t)n0 * 768, 768, 768, smem);
        const int wr = w >> 1, wc = w & 1;
#pragma unroll
        for (int i = 0; i < 4; ++i) {
          const size_t row = (size_t)(m0 + wr * 64 + i * 16 + l15);
#pragma unroll
          for (int j = 0; j < 4; ++j) {
            const int n = n0 + wc * 64 + j * 16 + g4 * 4;
            const float4 bg = *(const float4*)(p.b_glu + n);
            const u32x2 av = *(const u32x2*)(ys5a + row * 768 + n);
            const u32x2 sv = *(const u32x2*)(gsbuf + row * 768 + n);
            float o0 = bflo(av[0]) * sigmoidf_(acc[i][j][0] + bg.x) * bflo(sv[0]);
            float o1 = bfhi(av[0]) * sigmoidf_(acc[i][j][1] + bg.y) * bfhi(sv[0]);
            float o2 = bflo(av[1]) * sigmoidf_(acc[i][j][2] + bg.z) * bflo(sv[1]);
            float o3 = bfhi(av[1]) * sigmoidf_(acc[i][j][3] + bg.w) * bfhi(sv[1]);
            u32x2 o = {pack2(o0, o1), pack2(o2, o3)};
            *(u32x2*)(ubuf + row * 768 + n) = o;
          }
        }
      }
    }
    SYNC_BEFORE(5);
    if (PH(5)) {
      TIDVARS
      for (int v = bid; v < 256 * 8; v += nblk) {
        int mt, nt;
        swz(v, 8, 4, mt, nt);
        const int m0 = mt * 128, n0 = nt * 128;
        const int wr = w >> 1, wc = w & 1;
        char* gstash = ws + OFF_GATE + (size_t)bid * 32768;
        char* mstash = ws + OFF_GF + (size_t)bid * 65536;
        const unsigned toff = (unsigned)tid * 16u;
#pragma unroll 1
        for (int stp = 0; stp < 6; ++stp) {
          const int br = stp >> 1;
          const u16* Ab; const u16* Wb; int Kb; int ldk;
          if (!(stp & 1)) { Ab = hbuf + (size_t)m0 * KLD; Wb = WglT + (size_t)(br * 1024 + n0) * KLD; Kb = 1024; }
          else if (br == 0) { Ab = qbuf + (size_t)m0 * 768; Wb = WpfT + (size_t)n0 * 768; Kb = 768; }
          else if (br == 1) { Ab = ubuf + (size_t)m0 * 768; Wb = WpsT + (size_t)n0 * 768; Kb = 768; }
          else { Ab = qmbuf + (size_t)m0 * 512; Wb = WpmT + (size_t)n0 * 512; Kb = 512; }
          f32x4 acc[4][4];
          zero_acc(acc);
          ldk = (Kb == 1024) ? KLD : Kb;
          gemm_core<true, 1>(acc, Ab, ldk, Wb, ldk, Kb, smem);
          if (!(stp & 1)) {
#pragma unroll
            for (int j = 0; j < 4; ++j) {
              const float4 bm = *(const float4*)(p.b_merge + br * 1024 + n0 + wc * 64 + j * 16 + g4 * 4);
#pragma unroll
              for (int i = 0; i < 4; i += 2) {
                u32x4 gq = {pack2(sigmoidf_(acc[i][j][0] + bm.x), sigmoidf_(acc[i][j][1] + bm.y)),
                            pack2(sigmoidf_(acc[i][j][2] + bm.z), sigmoidf_(acc[i][j][3] + bm.w)),
                            pack2(sigmoidf_(acc[i + 1][j][0] + bm.x), sigmoidf_(acc[i + 1][j][1] + bm.y)),
                            pack2(sigmoidf_(acc[i + 1][j][2] + bm.z), sigmoidf_(acc[i + 1][j][3] + bm.w))};
                *(u32x4*)(gstash + (j * 2 + (i >> 1)) * 4096 + toff) = gq;
              }
            }
          } else {
#pragma unroll
            for (int j = 0; j < 4; ++j)
#pragma unroll
              for (int i = 0; i < 4; i += 2) {
                const u32x4 gq = *(const u32x4*)(gstash + (j * 2 + (i >> 1)) * 4096 + toff);
                acc[i][j][0] *= bflo(gq[0]); acc[i][j][1] *= bfhi(gq[0]);
                acc[i][j][2] *= bflo(gq[1]); acc[i][j][3] *= bfhi(gq[1]);
                acc[i + 1][j][0] *= bflo(gq[2]); acc[i + 1][j][1] *= bfhi(gq[2]);
                acc[i + 1][j][2] *= bflo(gq[3]); acc[i + 1][j][3] *= bfhi(gq[3]);
              }
            if (br > 0) {
#pragma unroll
              for (int i = 0; i < 4; ++i)
#pragma unroll
                for (int j = 0; j < 4; ++j) {
                  const f32x4 pv = *(const f32x4*)(mstash + (i * 4 + j) * 4096 + toff);
                  acc[i][j] += pv;
                }
            }
            if (br < 2) {
#pragma unroll
              for (int i = 0; i < 4; ++i)
#pragma unroll
                for (int j = 0; j < 4; ++j) *(f32x4*)(mstash + (i * 4 + j) * 4096 + toff) = acc[i][j];
            } else {
              epi_rowmajor(acc, merged, KLD, m0, n0, 0);
            }
          }
        }
      }
    }
    SYNC_BEFORE(6);
    if (PH(6)) {
      TIDVARS
      for (int v = bid; v < 256 * 8; v += nblk) {
        int mt, nt;
        swz(v, 8, 4, mt, nt);
        const int m0 = mt * 128, n0 = nt * 128;
        const int wr = w >> 1, wc = w & 1;
        f32x4 acc[4][4];
        zero_acc(acc);
        gemm_core<true>(acc, merged + (size_t)m0 * KLD, KLD, WoutT + (size_t)n0 * KLD, KLD, 1024, smem);
#pragma unroll
        for (int i = 0; i < 4; ++i) {
          const size_t row = (size_t)(m0 + wr * 64 + i * 16 + l15);
          float ss = 0.f;
#pragma unroll
          for (int j = 0; j < 4; ++j) {
            const int n = n0 + wc * 64 + j * 16 + g4 * 4;
            const float4 xv = *(const float4*)(p.x + row * 1024 + n);
            float4 o = make_float4(xv.x + acc[i][j][0], xv.y + acc[i][j][1], xv.z + acc[i][j][2], xv.w + acc[i][j][3]);
            ss += o.x * o.x + o.y * o.y + o.z * o.z + o.w * o.w;
            *(float4*)(p.out + row * 1024 + n) = o;
          }
          ss += __shfl_xor(ss, 16);
          ss += __shfl_xor(ss, 32);
          if (g4 == 0) part[row * 16 + nt * 2 + wc] = ss;
        }
      }
    }
    SYNC_BEFORE(7);
    if (PH(7)) {
      TIDVARS
      for (int row = bid * 4 + w; row < T_; row += nblk * 4) {
        float ss = (lane < 16) ? part[(size_t)row * 16 + lane] : 0.f;
        ss = wave_sum(ss);
        const float rstd = rsqrtf(ss * (1.f / 1024.f) + 1e-6f);
        float* o = p.out + (size_t)row * 1024;
#pragma unroll
        for (int i = 0; i < 4; ++i) {
          float4 v = *(const float4*)(o + i * 256 + lane * 4);
          const float4 gv = *(const float4*)(p.g_final + i * 256 + lane * 4);
          v.x *= rstd * gv.x; v.y *= rstd * gv.y; v.z *= rstd * gv.z; v.w *= rstd * gv.w;
          *(float4*)(o + i * 256 + lane * 4) = v;
        }
      }
    }
  }
}

extern "C" void kernel_launch(void* const* d_in, const int* in_sizes, int n_in, void* d_out, int out_size, void* d_ws,
                              size_t ws_size, hipStream_t stream) {
  static int grid_blocks = 0;
  if (!grid_blocks) {
    if (ws_size < WS_END || n_in != 23) {
      fprintf(stderr, "kernel_launch: unexpected ws_size %zu (need %zu) or n_in %d\n", ws_size, (size_t)WS_END, n_in);
      grid_blocks = -1;
      return;
    }
    int dev = 0, cus = 0, per_cu = 0;
    (void)hipGetDevice(&dev);
    (void)hipDeviceGetAttribute(&cus, hipDeviceAttributeMultiprocessorCount, dev);
    (void)hipFuncSetAttribute((const void*)mega, hipFuncAttributeMaxDynamicSharedMemorySize, LDS_BYTES);
    (void)hipOccupancyMaxActiveBlocksPerMultiprocessor(&per_cu, (const void*)mega, 256, LDS_BYTES);
    fprintf(stderr, "occupancy query: %d blocks/CU, %d CUs\n", per_cu, cus);
    per_cu = 2;
    grid_blocks = cus * per_cu;
  }
  if (grid_blocks < 0) return;
  Params p{};
  const float** pp = (const float**)&p;
  for (int i = 0; i < 23; ++i) pp[i] = (const float*)d_in[i];
  p.out = (float*)d_out;
  p.ws = (char*)d_ws;
#if COOP
  (void)hipMemsetAsync((char*)d_ws + OFF_CTL + 4096, 0, XCD_BAR_WORDS * 4, stream);
  p.phase_lo = 0;
  p.phase_hi = NPHASE - 1;
  void* args[] = {&p};
  hipError_t e = hipLaunchCooperativeKernel((const void*)mega, dim3(grid_blocks), dim3(256), args, LDS_BYTES, stream);
  if (e != hipSuccess) fprintf(stderr, "cooperative launch failed: %s (grid %d)\n", hipGetErrorString(e), grid_blocks);
#else
  for (int ph = 0; ph < NPHASE; ++ph) {
    p.phase_lo = ph;
    p.phase_hi = ph;
    hipLaunchKernelGGL(mega, dim3(grid_blocks), dim3(256), LDS_BYTES, stream, p);
#ifdef PROBE_DUP
    if (ph == PROBE_DUP) {
      for (int rep = 0; rep < 2; ++rep) {
        if (ph == 2) { p.phase_lo = p.phase_hi = 1; hipLaunchKernelGGL(mega, dim3(grid_blocks), dim3(256), LDS_BYTES, stream, p); p.phase_lo = p.phase_hi = 2; }
        hipLaunchKernelGGL(mega, dim3(grid_blocks), dim3(256), LDS_BYTES, stream, p);
      }
    }
#endif
  }
#endif
}
```

```cpp
#include <hip/hip_runtime.h>
#include <hip/hip_cooperative_groups.h>
#include <stdint.h>
#include <stdio.h>
namespace cg = cooperative_groups;

#ifndef COOP
#define COOP 1
#define XCD_MODE 0
#endif

#define DI __device__ __forceinline__
#ifdef ONLY_PHASE
#define PH(n) ((n) == ONLY_PHASE && p.phase_lo <= (n) && (n) <= p.phase_hi)
#else
#define PH(n) (p.phase_lo <= (n) && (n) <= p.phase_hi)
#endif
#define SYNC_BEFORE(n)                                        \
  if (p.phase_lo < (n) && (n) <= p.phase_hi) {                \
    xcd_barrier(xb);                                          \
  }
typedef unsigned short u16;
using bf16x8 = __attribute__((ext_vector_type(8))) short;
using f32x4 = __attribute__((ext_vector_type(4))) float;
using u32x4 = __attribute__((ext_vector_type(4))) unsigned;
using u32x2 = __attribute__((ext_vector_type(2))) unsigned;

constexpr int T_ = 32768, L_ = 8192;
constexpr int LDS_BYTES = 73728;
constexpr int NPHASE = 8;

constexpr size_t MiB = 1u << 20;
constexpr int KLD = 1088;
constexpr size_t OFF_H = 0;
constexpr size_t OFF_Q = 68 * MiB;
constexpr size_t OFF_GF = 116 * MiB;
constexpr size_t OFF_U = 164 * MiB;
constexpr size_t OFF_GS = 212 * MiB;
constexpr size_t OFF_YS5A = 260 * MiB;
constexpr size_t OFF_QM = 308 * MiB;
constexpr size_t OFF_GM = 340 * MiB;
constexpr size_t OFF_MERGED = 372 * MiB;
constexpr size_t OFF_WINT = 440 * MiB;
constexpr size_t OFF_WGLT = 453 * MiB;
constexpr size_t OFF_WKVT = 460 * MiB;
constexpr size_t OFF_WOUTT = 463 * MiB;
constexpr size_t OFF_WPFT = 466 * MiB;
constexpr size_t OFF_WPST = 468 * MiB;
constexpr size_t OFF_WPMT = 470 * MiB;
constexpr size_t OFF_WGLUT = 471 * MiB;
constexpr size_t OFF_MEMN = 473 * MiB;
constexpr size_t OFF_MK = 476 * MiB;
constexpr size_t OFF_MVT = 477 * MiB;
constexpr size_t OFF_LOGF = 478 * MiB;
constexpr size_t OFF_F = 480 * MiB;
constexpr size_t OFF_S5AB = 482 * MiB;
constexpr size_t OFF_S5BB = 483 * MiB;
constexpr size_t OFF_S5S = 484 * MiB;
constexpr size_t OFF_PART = 496 * MiB;
constexpr size_t OFF_GATE = OFF_GS;
constexpr size_t OFF_CTL = 498 * MiB;
constexpr size_t WS_END = 499 * MiB;

struct Params {
  const float *x, *mem, *g_norm, *g_mem_norm, *g_final, *w_in, *b_forget, *b_merge, *w_mem_kv;
  const float *lam_re, *lam_im, *log_step, *b_re, *b_im, *c_re, *c_im, *s5_d, *w_glu, *b_glu;
  const float *w_pf, *w_ps, *w_pm, *w_out;
  float* out;
  char* ws;
  int phase_lo, phase_hi;
};

DI u16 f2bf(float x) { unsigned u = __float_as_uint(x); u += 0x7fffu + ((u >> 16) & 1u); return (u16)(u >> 16); }
DI unsigned pack2(float a, float b) { return (unsigned)f2bf(a) | ((unsigned)f2bf(b) << 16); }
DI float bflo(unsigned v) { return __uint_as_float(v << 16); }
DI float bfhi(unsigned v) { return __uint_as_float(v & 0xffff0000u); }
DI float sigmoidf_(float x) { return 1.f / (1.f + __expf(-x)); }
DI float siluf_(float x) { return x / (1.f + __expf(-x)); }
DI float gelu_tanh(float x) {
  float z = 0.7978845608028654f * (x + 0.044715f * x * x * x);
  float e = __expf(2.f * z);
  float th = 1.f - 2.f / (e + 1.f);
  return 0.5f * x * (1.f + th);
}
DI float wave_sum(float v) {
#pragma unroll
  for (int o = 32; o > 0; o >>= 1) v += __shfl_xor(v, o);
  return v;
}
DI f32x4 mfma16(bf16x8 a, bf16x8 b, f32x4 c) { return __builtin_amdgcn_mfma_f32_16x16x32_bf16(a, b, c, 0, 0, 0); }

template <bool SWAP, int DEPTH = 1>
DI void gemm_core(f32x4 (&acc)[4][4], const u16* __restrict__ A, int lda, const u16* __restrict__ Bt, int ldb, int K, char* smem) {
  const int tid = threadIdx.x, lane = tid & 63, w = tid >> 6, wr = w >> 1, wc = w & 1, l15 = lane & 15, g = lane >> 4;
  const int lrow = tid >> 3, lch = tid & 7;
  const char* ap = (const char*)A;
  const char* bp = (const char*)Bt;
  const unsigned aoff = (unsigned)(lrow * lda + lch * 8) * 2u;
  const unsigned boff = (unsigned)(lrow * ldb + lch * 8) * 2u;
  u32x4 ra0[4], rb0[4], ra1[4], rb1[4];
  const int nk = K >> 6;
#define G_LOAD(RA, RB, KT)                                                        \
  _Pragma("unroll") for (int c = 0; c < 4; ++c) {                                 \
    RA[c] = *(const u32x4*)(ap + ((size_t)c * 64 * lda + (KT) * 128) + aoff);     \
    RB[c] = *(const u32x4*)(bp + ((size_t)c * 64 * ldb + (KT) * 128) + boff);     \
  }
#define G_STORE(RA, RB, BO)                                                       \
  _Pragma("unroll") for (int c = 0; c < 4; ++c) {                                 \
    *(u32x4*)(wbase + (BO) + c * 32 * 128) = RA[c];                               \
    *(u32x4*)(wbase + (BO) + 16384 + c * 32 * 128) = RB[c];                       \
  }
#define G_COMPUTE(BO)                                                             \
  {                                                                               \
    bf16x8 af[2][4], bfr[2][4];                                                   \
    _Pragma("unroll") for (int i = 0; i < 4; ++i) af[0][i] = *(const bf16x8*)(ard0 + (BO) + i * 16 * 128);  \
    _Pragma("unroll") for (int j = 0; j < 4; ++j) bfr[0][j] = *(const bf16x8*)(brd0 + (BO) + j * 16 * 128); \
    _Pragma("unroll") for (int i = 0; i < 4; ++i) af[1][i] = *(const bf16x8*)(ard1 + (BO) + i * 16 * 128);  \
    _Pragma("unroll") for (int j = 0; j < 4; ++j) bfr[1][j] = *(const bf16x8*)(brd1 + (BO) + j * 16 * 128); \
    __builtin_amdgcn_sched_barrier(0);                                            \
    __builtin_amdgcn_s_setprio(1);                                                \
    _Pragma("unroll") for (int s = 0; s < 2; ++s)                                 \
      _Pragma("unroll") for (int i = 0; i < 4; ++i)                               \
        _Pragma("unroll") for (int j = 0; j < 4; ++j)                             \
          acc[i][j] = SWAP ? mfma16(bfr[s][j], af[s][i], acc[i][j]) : mfma16(af[s][i], bfr[s][j], acc[i][j]); \
    __builtin_amdgcn_s_setprio(0);                                                \
  }
  char* wbase = smem + lrow * 128 + ((lch ^ ((lrow >> 1) & 7)) << 4);
  const int hsw = l15 >> 1;
  const char* ard0 = smem + (wr * 64 + l15) * 128 + ((g ^ hsw) << 4);
  const char* ard1 = smem + (wr * 64 + l15) * 128 + (((4 + g) ^ hsw) << 4);
  const char* brd0 = smem + 16384 + (wc * 64 + l15) * 128 + ((g ^ hsw) << 4);
  const char* brd1 = smem + 16384 + (wc * 64 + l15) * 128 + (((4 + g) ^ hsw) << 4);
  if constexpr (DEPTH == 2) {
    G_LOAD(ra0, rb0, 0);
    G_LOAD(ra1, rb1, 1);
    G_STORE(ra0, rb0, 0);
    __syncthreads();
    for (int kt = 0; kt < nk; kt += 2) {
      if (kt + 2 < nk) G_LOAD(ra0, rb0, kt + 2);
      __builtin_amdgcn_sched_barrier(0);
      G_COMPUTE(0);
      __builtin_amdgcn_sched_barrier(0);
      G_STORE(ra1, rb1, 32768);
      __syncthreads();
      if (kt + 3 < nk) G_LOAD(ra1, rb1, kt + 3);
      __builtin_amdgcn_sched_barrier(0);
      G_COMPUTE(32768);
      __builtin_amdgcn_sched_barrier(0);
      if (kt + 2 < nk) G_STORE(ra0, rb0, 0);
      __syncthreads();
    }
  } else {
    G_LOAD(ra0, rb0, 0);
    G_STORE(ra0, rb0, 0);
    __syncthreads();
    for (int kt = 0; kt < nk; kt += 2) {
      G_LOAD(ra0, rb0, kt + 1);
      __builtin_amdgcn_sched_barrier(0);
      G_COMPUTE(0);
      __builtin_amdgcn_sched_barrier(0);
      G_STORE(ra0, rb0, 32768);
      __syncthreads();
      if (kt + 2 < nk) G_LOAD(ra0, rb0, kt + 2);
      __builtin_amdgcn_sched_barrier(0);
      G_COMPUTE(32768);
      __builtin_amdgcn_sched_barrier(0);
      if (kt + 2 < nk) G_STORE(ra0, rb0, 0);
      __syncthreads();
    }
  }
#undef G_LOAD
#undef G_STORE
#undef G_COMPUTE
}

DI void zero_acc(f32x4 (&acc)[4][4]) {
#pragma unroll
  for (int i = 0; i < 4; ++i)
#pragma unroll
    for (int j = 0; j < 4; ++j) acc[i][j] = f32x4{0.f, 0.f, 0.f, 0.f};
}

DI void swz(int v, int NT, int GN, int& mt, int& nt) {
#if XCD_MODE == 0
  int xcd = v & 7, j = v >> 3;
#else
  int xcd = (v & 511) >> 6, j = ((v >> 9) << 6) + (v & 63);
#endif
  int per_mg = 8 * NT;
  int mg = j / per_mg, r = j - mg * per_mg;
  int ng = r / (8 * GN), wv = r - ng * (8 * GN);
  mt = xcd * 32 + mg * 8 + (wv & 7);
  nt = ng * GN + (wv >> 3);
}

DI void epi_rowmajor(const f32x4 (&acc)[4][4], u16* dst, int ld, int m0, int c0, int mode) {
  const int tid = threadIdx.x, lane = tid & 63, w = tid >> 6, wr = w >> 1, wc = w & 1, l15 = lane & 15, g = lane >> 4;
#pragma unroll
  for (int i = 0; i < 4; ++i) {
    const size_t row = (size_t)(m0 + wr * 64 + i * 16 + l15);
#pragma unroll
    for (int j = 0; j < 4; ++j) {
      f32x4 v = acc[i][j];
      if (mode == 1) { v[0] *= 0.125f; v[1] *= 0.125f; v[2] *= 0.125f; v[3] *= 0.125f; }
      else if (mode == 2) { v[0] = siluf_(v[0]); v[1] = siluf_(v[1]); v[2] = siluf_(v[2]); v[3] = siluf_(v[3]); }
      u32x2 o = {pack2(v[0], v[1]), pack2(v[2], v[3])};
      *(u32x2*)(dst + row * ld + c0 + wc * 64 + j * 16 + g * 4) = o;
    }
  }
}
DI void epi_transposed(const f32x4 (&acc)[4][4], u16* dst, int m0, int c0, int H, int lgDh, int lgLk) {
  const int tid = threadIdx.x, lane = tid & 63, w = tid >> 6, wr = w >> 1, wc = w & 1, l15 = lane & 15, g = lane >> 4;
#pragma unroll
  for (int i = 0; i < 4; ++i) {
    const int token = m0 + wr * 64 + i * 16 + g * 4;
    const int bidx = token >> lgLk, tl = token & ((1 << lgLk) - 1);
#pragma unroll
    for (int j = 0; j < 4; ++j) {
      const int col = c0 + wc * 64 + j * 16 + l15;
      const int head = col >> lgDh, d = col & ((1 << lgDh) - 1);
      f32x4 v = acc[i][j];
      u32x2 o = {pack2(v[0], v[1]), pack2(v[2], v[3])};
      *(u32x2*)(dst + ((((((size_t)bidx * H + head) << lgDh) + d) << lgLk) + tl)) = o;
    }
  }
}

template <int D, bool FOX, bool PF, int NQ>
DI void attn_item(const u16* __restrict__ qbase, int ldq, const u16* __restrict__ kbase, int ldk,
                  const u16* __restrict__ vtbase, int ldv, const float* __restrict__ Fseq, int q0, int nkv,
                  const u16* __restrict__ gate, u16* outp, float scale, float kmaxv, char* smem) {
  const int tid = threadIdx.x, lane = tid & 63, w = tid >> 6, l15 = lane & 15, g = lane >> 4;
  constexpr int KROW = D * 2 + 16;
  constexpr int KBYTES = 64 * KROW;
  constexpr int VBYTES = D * 144;
  constexpr int BUF = KBYTES + VBYTES + 256;
  constexpr int NL = D / 32;
  constexpr int KCH = D / 8;
  static_assert(2 * BUF <= LDS_BYTES, "attn lds");

  bf16x8 qf[NQ][D / 32];
#pragma unroll
  for (int qi = 0; qi < NQ; ++qi)
#pragma unroll
    for (int s = 0; s < D / 32; ++s)
      qf[qi][s] = *(const bf16x8*)(qbase + (size_t)(w * (16 * NQ) + qi * 16 + l15) * ldq + s * 32 + g * 8);
  float fq[NQ];
#pragma unroll
  for (int qi = 0; qi < NQ; ++qi) fq[qi] = FOX ? Fseq[q0 + w * (16 * NQ) + qi * 16 + l15] : 0.f;
  f32x4 ot[D / 16][NQ];
#pragma unroll
  for (int dt = 0; dt < D / 16; ++dt)
#pragma unroll
    for (int qi = 0; qi < NQ; ++qi) ot[dt][qi] = f32x4{0, 0, 0, 0};
  float mrun[NQ], lsum[NQ];
#pragma unroll
  for (int qi = 0; qi < NQ; ++qi) { mrun[qi] = -1e30f; lsum[qi] = 0.f; }
  float qk[NQ];
#pragma unroll
  for (int qi = 0; qi < NQ; ++qi) {
    float ss = 0.f;
    if (FOX) {
#pragma unroll
      for (int s = 0; s < D / 32; ++s)
#pragma unroll
        for (int e = 0; e < 8; ++e) {
          const float v = __uint_as_float(((unsigned)(unsigned short)qf[qi][s][e]) << 16);
          ss += v * v;
        }
      ss += __shfl_xor(ss, 16);
      ss += __shfl_xor(ss, 32);
    }
    qk[qi] = sqrtf(ss) * kmaxv * 1.002f + 1e-3f;
  }
  int* flags = (int*)(smem + 73664);

  u32x4 kr[NL], vr[NL];
  f32x4 fr = {0, 0, 0, 0};
#define krow(c) (((c) * 256 + tid) / KCH)
#define kch(c) (((c) * 256 + tid) % KCH)
#define vrow(c) (((c) * 256 + tid) >> 3)
#define vch(c) (tid & 7)
#define ATT_LOAD(J)                                                                                   \
  {                                                                                                   \
    const int s0_ = (J) * 64;                                                                         \
    _Pragma("unroll") for (int c = 0; c < NL; ++c) {                                                  \
      kr[c] = *(const u32x4*)(kbase + (size_t)(s0_ + krow(c)) * ldk + kch(c) * 8);                    \
      vr[c] = *(const u32x4*)(vtbase + (size_t)vrow(c) * ldv + s0_ + vch(c) * 8);                     \
    }                                                                                                 \
    if (FOX && tid < 16) fr = *(const f32x4*)(Fseq + s0_ + tid * 4);                                  \
  }
#define ATT_STORE(BO)                                                                                 \
  {                                                                                                   \
    char* b_ = smem + (BO);                                                                           \
    _Pragma("unroll") for (int c = 0; c < NL; ++c) {                                                  \
      *(u32x4*)(b_ + krow(c) * KROW + kch(c) * 16) = kr[c];                                           \
      *(u32x4*)(b_ + KBYTES + vrow(c) * 144 + vch(c) * 16) = vr[c];                                   \
    }                                                                                                 \
    if (FOX && tid < 16) *(f32x4*)(b_ + KBYTES + VBYTES + tid * 16) = fr;                             \
  }
  ATT_LOAD(nkv - 1);
  ATT_STORE(0);
  __syncthreads();
  const int qlo = q0 + w * (16 * NQ);
  for (int j = nkv - 1, itn = 0; j >= 0; --j, ++itn) {
    const int cur = (itn & 1) * BUF;
    if (j > 0) {
      ATT_LOAD(j - 1);
      if (!PF) ATT_STORE(cur ^ BUF);
    }
    __builtin_amdgcn_sched_barrier(0);
    bool ok = false;
    const int s0 = j * 64;
    const bool active = !FOX || (s0 <= qlo + 16 * NQ - 1);
    if (active) {
      const char* Ks = smem + cur;
      const char* Vs = smem + cur + KBYTES;
      const char* Fs = smem + cur + KBYTES + VBYTES;
      f32x4 st[4][NQ];
#pragma unroll
      for (int kt = 0; kt < 4; ++kt)
#pragma unroll
        for (int qi = 0; qi < NQ; ++qi) st[kt][qi] = f32x4{0, 0, 0, 0};
#pragma unroll
      for (int s = 0; s < D / 32; ++s) {
        bf16x8 kf[4];
#pragma unroll
        for (int kt = 0; kt < 4; ++kt) kf[kt] = *(const bf16x8*)(Ks + (kt * 16 + l15) * KROW + s * 64 + g * 16);
#pragma unroll
        for (int kt = 0; kt < 4; ++kt)
#pragma unroll
          for (int qi = 0; qi < NQ; ++qi) st[kt][qi] = mfma16(kf[kt], qf[qi][s], st[kt][qi]);
      }
      if (FOX) {
        const bool need_mask = (s0 + 63 > qlo);
#pragma unroll
        for (int kt = 0; kt < 4; ++kt) {
          f32x4 fk = *(const f32x4*)(Fs + (kt * 16 + g * 4) * 4);
#pragma unroll
          for (int qi = 0; qi < NQ; ++qi) {
            const int qpos = qlo + qi * 16 + l15;
#pragma unroll
            for (int r = 0; r < 4; ++r) {
              float v = st[kt][qi][r] + fq[qi] - fk[r];
              if (need_mask && (s0 + kt * 16 + g * 4 + r > qpos)) v = -1e30f;
              st[kt][qi][r] = v;
            }
          }
        }
      } else {
#pragma unroll
        for (int kt = 0; kt < 4; ++kt)
#pragma unroll
          for (int qi = 0; qi < NQ; ++qi)
#pragma unroll
            for (int r = 0; r < 4; ++r) st[kt][qi][r] *= scale;
      }
      float alpha[NQ];
#pragma unroll
      for (int qi = 0; qi < NQ; ++qi) {
        float mx = st[0][qi][0];
#pragma unroll
        for (int kt = 0; kt < 4; ++kt)
#pragma unroll
          for (int r = 0; r < 4; ++r) mx = fmaxf(mx, st[kt][qi][r]);
        mx = fmaxf(mx, __shfl_xor(mx, 16));
        mx = fmaxf(mx, __shfl_xor(mx, 32));
        const float mnew = fmaxf(mrun[qi], mx);
        alpha[qi] = __expf(mrun[qi] - mnew);
        mrun[qi] = mnew;
        float ps = 0.f;
#pragma unroll
        for (int kt = 0; kt < 4; ++kt)
#pragma unroll
          for (int r = 0; r < 4; ++r) {
            float p = __expf(st[kt][qi][r] - mnew);
            st[kt][qi][r] = p;
            ps += p;
          }
        lsum[qi] = lsum[qi] * alpha[qi] + ps;
      }
      bf16x8 pb[2][NQ];
#pragma unroll
      for (int kp = 0; kp < 2; ++kp)
#pragma unroll
        for (int qi = 0; qi < NQ; ++qi) {
          u32x4 t = {pack2(st[2 * kp][qi][0], st[2 * kp][qi][1]), pack2(st[2 * kp][qi][2], st[2 * kp][qi][3]),
                     pack2(st[2 * kp + 1][qi][0], st[2 * kp + 1][qi][1]), pack2(st[2 * kp + 1][qi][2], st[2 * kp + 1][qi][3])};
          pb[kp][qi] = __builtin_bit_cast(bf16x8, t);
        }
#pragma unroll
      for (int dt = 0; dt < D / 16; ++dt) {
#pragma unroll
        for (int r = 0; r < 4; ++r)
#pragma unroll
          for (int qi = 0; qi < NQ; ++qi) ot[dt][qi][r] *= alpha[qi];
#pragma unroll
        for (int kp = 0; kp < 2; ++kp) {
          u32x2 lo = *(const u32x2*)(Vs + (dt * 16 + l15) * 144 + (kp * 32 + g * 4) * 2);
          u32x2 hi = *(const u32x2*)(Vs + (dt * 16 + l15) * 144 + (kp * 32 + 16 + g * 4) * 2);
          u32x4 t = {lo[0], lo[1], hi[0], hi[1]};
          bf16x8 vf = __builtin_bit_cast(bf16x8, t);
#pragma unroll
          for (int qi = 0; qi < NQ; ++qi) ot[dt][qi] = mfma16(vf, pb[kp][qi], ot[dt][qi]);
        }
      }
      if (FOX) {
        const float f0 = *(const float*)Fs;
        ok = true;
#pragma unroll
        for (int qi = 0; qi < NQ; ++qi) ok = ok && (qk[qi] + fq[qi] - f0 - mrun[qi] <= -30.f);
      }
    }
    __builtin_amdgcn_sched_barrier(0);
    if (PF && j > 0) ATT_STORE(cur ^ BUF);
    if (FOX) {
      const bool wave_ok = (__ballot(ok) == ~0ull);
      if (lane == 0) flags[(itn & 1) * 4 + w] = wave_ok ? 1 : 0;
      __syncthreads();
      const int* fl = flags + (itn & 1) * 4;
      if (fl[0] & fl[1] & fl[2] & fl[3]) break;
    } else {
      __syncthreads();
    }
  }
#undef ATT_LOAD
#undef ATT_STORE
#undef krow
#undef kch
#undef vrow
#undef vch
#pragma unroll
  for (int qi = 0; qi < NQ; ++qi) {
    float l = lsum[qi];
    l += __shfl_xor(l, 16);
    l += __shfl_xor(l, 32);
    const float inv = 1.f / l;
    const size_t rowoff = (size_t)(w * (16 * NQ) + qi * 16 + l15) * ldq;
#pragma unroll
    for (int dt = 0; dt < D / 16; ++dt) {
      const int col = dt * 16 + g * 4;
      u32x2 gv = *(const u32x2*)(gate + rowoff + col);
      u32x2 o = {pack2(ot[dt][qi][0] * inv * bflo(gv[0]), ot[dt][qi][1] * inv * bfhi(gv[0])),
                 pack2(ot[dt][qi][2] * inv * bflo(gv[1]), ot[dt][qi][3] * inv * bfhi(gv[1]))};
      *(u32x2*)(outp + rowoff + col) = o;
    }
  }
}

typedef float v2f __attribute__((ext_vector_type(2)));
DI void s5_load_u(const u16* ubuf, int b, int c, int g, char* ut, int lane) {
  const u16* src = ubuf + ((size_t)(b * L_ + c * 64 + lane)) * 768 + g * 16;
  u32x4 a = *(const u32x4*)src, bb = *(const u32x4*)(src + 8);
  f32x4 o0 = {bflo(a[0]), bfhi(a[0]), bflo(a[1]), bfhi(a[1])};
  f32x4 o1 = {bflo(a[2]), bfhi(a[2]), bflo(a[3]), bfhi(a[3])};
  f32x4 o2 = {bflo(bb[0]), bfhi(bb[0]), bflo(bb[1]), bfhi(bb[1])};
  f32x4 o3 = {bflo(bb[2]), bfhi(bb[2]), bflo(bb[3]), bfhi(bb[3])};
  *(f32x4*)(ut + lane * 64) = o0;
  *(f32x4*)(ut + lane * 64 + 16) = o1;
  *(f32x4*)(ut + lane * 64 + 32) = o2;
  *(f32x4*)(ut + lane * 64 + 48) = o3;
}
DI void s5_load_b(const float* bbar, int gp, v2f (&b2)[16]) {
#pragma unroll
  for (int q = 0; q < 4; ++q) {
    float4 t0 = *(const float4*)(bbar + (size_t)gp * 32 + q * 4);
    float4 t1 = *(const float4*)(bbar + (size_t)gp * 32 + 16 + q * 4);
    b2[4 * q] = v2f{t0.x, t1.x}; b2[4 * q + 1] = v2f{t0.y, t1.y};
    b2[4 * q + 2] = v2f{t0.z, t1.z}; b2[4 * q + 3] = v2f{t0.w, t1.w};
  }
}
DI v2f s5_x(const char* ut, int t, const v2f (&b2)[16]) {
  v2f xa = {0.f, 0.f}, xb = {0.f, 0.f};
#pragma unroll
  for (int q = 0; q < 4; ++q) {
    const f32x4 u = *(const f32x4*)(ut + t * 64 + q * 16);
    xa += b2[4 * q] * u[0];
    xb += b2[4 * q + 1] * u[1];
    xa += b2[4 * q + 2] * u[2];
    xb += b2[4 * q + 3] * u[3];
  }
  return xa + xb;
}

DI void s5_load_bfrag(const float* bbar, int g, int l15, int g4, bf16x8 (&ah)[8], bf16x8 (&al)[8]) {
#pragma unroll
  for (int kt = 0; kt < 8; ++kt) {
    u32x4 h = {0u, 0u, 0u, 0u}, l = {0u, 0u, 0u, 0u};
    if (g4 < 2) {
      const float* src = bbar + (size_t)(g * 64 + (kt & 3) * 16 + l15) * 32 + (kt >> 2) * 16 + g4 * 8;
      const float4 t0 = *(const float4*)src, t1 = *(const float4*)(src + 4);
      const float v[8] = {t0.x, t0.y, t0.z, t0.w, t1.x, t1.y, t1.z, t1.w};
#pragma unroll
      for (int q = 0; q < 4; ++q) {
        const unsigned h0 = f2bf(v[2 * q]), h1 = f2bf(v[2 * q + 1]);
        h[q] = h0 | (h1 << 16);
        l[q] = pack2(v[2 * q] - __uint_as_float(h0 << 16), v[2 * q + 1] - __uint_as_float(h1 << 16));
      }
    }
    ah[kt] = __builtin_bit_cast(bf16x8, h);
    al[kt] = __builtin_bit_cast(bf16x8, l);
  }
}
DI void s5_xsub(const u16* urow, const bf16x8 (&ah)[8], const bf16x8 (&al)[8], char* xs, int l15, int g4) {
  u32x4 uraw = {0u, 0u, 0u, 0u};
  if (g4 < 2) uraw = *(const u32x4*)(urow + g4 * 8);
  const bf16x8 ub = __builtin_bit_cast(bf16x8, uraw);
#pragma unroll
  for (int kt = 0; kt < 8; ++kt) {
    f32x4 x = {0.f, 0.f, 0.f, 0.f};
    x = mfma16(ah[kt], ub, x);
    x = mfma16(al[kt], ub, x);
    *(f32x4*)(xs + l15 * 528 + (kt * 16 + g4 * 4) * 4) = x;
  }
}

#define XB_TMO      128
#define XB_XCNT(j)  (256  + 64 * (j))
#define XB_XSUB(j)  (1280 + 64 * (j))
#define XB_XGEN(j)  (2304 + 64 * (j))
#define XB_TOP      3328
#define XB_TOPGEN   3392
#define XCD_BAR_WORDS 3456
#define XB_SPIN_CAP (1u << 18)
DI unsigned xb_ld(unsigned* p) { return __hip_atomic_load(p, __ATOMIC_RELAXED, __HIP_MEMORY_SCOPE_AGENT); }
DI unsigned xb_add(unsigned* p, unsigned v) { return __hip_atomic_fetch_add(p, v, __ATOMIC_RELAXED, __HIP_MEMORY_SCOPE_AGENT); }
DI unsigned xb_xcc_id() { return (unsigned)__builtin_amdgcn_s_getreg((3 << 11) | 20) & 0xFu; }
#define XB_SPIN(cond, bar) do { unsigned _sp = 0; while (cond) { __builtin_amdgcn_s_sleep(1); \
    if ((++_sp & 255u) == 0u) { if (xb_ld(&(bar)[XB_TMO])) break; if (_sp > XB_SPIN_CAP) { atomicAdd(&(bar)[XB_TMO], 1u); break; } } } } while (0)
struct XcdBarrier { unsigned* bar; unsigned x; volatile unsigned* st; };
DI XcdBarrier xcd_barrier_post(unsigned* bar, volatile unsigned* st) {
  XcdBarrier b; b.bar = bar; b.x = xb_xcc_id(); b.st = st;
  if (threadIdx.x == 0) (void)xb_add(&bar[XB_XCNT(b.x)], 1u);
  return b;
}
DI void xcd_barrier_complete(unsigned* bar, unsigned x, unsigned& nloc, unsigned& nx) {
  const unsigned G = gridDim.x * gridDim.y * gridDim.z;
  unsigned sum, cnt, mine, sp = 0u;
  for (;;) {
    sum = 0u; cnt = 0u; mine = 0u;
#pragma unroll
    for (unsigned j = 0; j < 16; ++j) { const unsigned c = xb_ld(&bar[XB_XCNT(j)]); sum += c; cnt += (c > 0u) ? 1u : 0u; mine = (j == x) ? c : mine; }
    if (sum == G) break;
    __builtin_amdgcn_s_sleep(1);
    if ((++sp & 255u) == 0u) { if (xb_ld(&bar[XB_TMO])) break; if (sp > XB_SPIN_CAP) { atomicAdd(&bar[XB_TMO], 1u); break; } }
  }
  nloc = mine > 0u ? mine : 1u; nx = cnt > 0u ? cnt : 1u;
}
DI void xcd_barrier(const XcdBarrier& b) {
  asm volatile("s_waitcnt vmcnt(0)" ::: "memory");
  __syncthreads();
  if (threadIdx.x == 0) {
    unsigned* bar = b.bar;
    __builtin_amdgcn_s_waitcnt(0);
    unsigned nloc = b.st[0], nx = b.st[1];
    if (nloc == 0u) { xcd_barrier_complete(bar, b.x, nloc, nx); b.st[0] = nloc; b.st[1] = nx; }
    const unsigned old = xb_add(&bar[XB_XSUB(b.x)], 1u);
    const unsigned gen = old / nloc;
    if (old + 1u == (gen + 1u) * nloc) {
      __builtin_amdgcn_fence(__ATOMIC_RELEASE, "agent");
      asm volatile("s_waitcnt vmcnt(0)" ::: "memory");
      const unsigned og = xb_add(&bar[XB_TOP], 1u);
      const unsigned tg = og / nx;
      if (og + 1u == (tg + 1u) * nx) xb_add(&bar[XB_TOPGEN], 1u);
      else XB_SPIN(xb_ld(&bar[XB_TOPGEN]) == tg, bar);
      __builtin_amdgcn_fence(__ATOMIC_ACQUIRE, "agent");
      xb_add(&bar[XB_XGEN(b.x)], 1u);
      asm volatile("s_waitcnt vmcnt(0)" ::: "memory");
    } else {
      XB_SPIN(xb_ld(&bar[XB_XGEN(b.x)]) == gen, bar);
      __builtin_amdgcn_fence(__ATOMIC_ACQUIRE, "agent");
      asm volatile("s_waitcnt vmcnt(0)" ::: "memory");
    }
  }
  __syncthreads();
}

extern "C" __global__ void __launch_bounds__(256, 2) mega(Params p) {
  extern __shared__ __attribute__((aligned(16))) char smem[];
  cg::grid_group grid = cg::this_grid();
#define TIDVARS                                                                  \
  int tid = threadIdx.x;                                                         \
  asm volatile("" : "+v"(tid));                                                  \
  const int lane = tid & 63, w = tid >> 6, l15 = lane & 15, g4 = lane >> 4;      \
  (void)lane; (void)w; (void)l15; (void)g4;
  const int nblk = gridDim.x, bid = blockIdx.x;
  char* ws = p.ws;
  XcdBarrier xb;
  xb.bar = (unsigned*)(ws + OFF_CTL + 4096); xb.x = 0; xb.st = (volatile unsigned*)(smem + 73712);
  if (p.phase_lo < p.phase_hi) {
    if (threadIdx.x < 2) xb.st[threadIdx.x] = 0u;
    __syncthreads();
    xb = xcd_barrier_post((unsigned*)(ws + OFF_CTL + 4096), (volatile unsigned*)(smem + 73712));
    grid.sync();
  }
  u16* hbuf = (u16*)(ws + OFF_H);
  u16* qbuf = (u16*)(ws + OFF_Q);
  u16* gfbuf = (u16*)(ws + OFF_GF);
  u16* ubuf = (u16*)(ws + OFF_U);
  u16* gsbuf = (u16*)(ws + OFF_GS);
  u16* ys5a = (u16*)(ws + OFF_YS5A);
  u16* qmbuf = (u16*)(ws + OFF_QM);
  u16* gmbuf = (u16*)(ws + OFF_GM);
  u16* merged = (u16*)(ws + OFF_MERGED);
  u16* WinT = (u16*)(ws + OFF_WINT);
  u16* WglT = (u16*)(ws + OFF_WGLT);
  u16* WkvT = (u16*)(ws + OFF_WKVT);
  u16* WoutT = (u16*)(ws + OFF_WOUTT);
  u16* WpfT = (u16*)(ws + OFF_WPFT);
  u16* WpsT = (u16*)(ws + OFF_WPST);
  u16* WpmT = (u16*)(ws + OFF_WPMT);
  u16* WgluT = (u16*)(ws + OFF_WGLUT);
  u16* memn = (u16*)(ws + OFF_MEMN);
  u16* mkbuf = (u16*)(ws + OFF_MK);
  u16* mvT = (u16*)(ws + OFF_MVT);
  float* logf = (float*)(ws + OFF_LOGF);
  float* Fbuf = (float*)(ws + OFF_F);
  float2* abar = (float2*)(ws + OFF_S5AB);
  float* bbar = (float*)(ws + OFF_S5BB);
  float2* Sst = (float2*)(ws + OFF_S5S);
  float* part = (float*)(ws + OFF_PART);
  unsigned* ctl = (unsigned*)(ws + OFF_CTL);
  u16* kbuf = (u16*)p.out;
  u16* vT = (u16*)((char*)p.out + 48 * MiB);

  {
    if (PH(0)) {
      TIDVARS
      if (bid == 0 && tid < 128) ctl[tid] = 0u;
      float* tile = (float*)smem;
      for (int ti = bid; ti < 3344; ti += nblk) {
        const float* src; int ld, col0, K; u16* dst; int tt;
        if (ti < 576) { src = p.w_in; ld = 8716; col0 = 0; K = 1024; dst = WinT; tt = ti; }
        else if (ti < 1408) { src = p.w_in; ld = 8716; col0 = 2316; K = 1024; dst = WinT + (size_t)2304 * KLD; tt = ti - 576; }
        else if (ti < 2176) { src = p.w_in; ld = 8716; col0 = 5644; K = 1024; dst = WglT; tt = ti - 1408; }
        else if (ti < 2432) { src = p.w_mem_kv; ld = 1024; col0 = 0; K = 1024; dst = WkvT; tt = ti - 2176; }
        else if (ti < 2688) { src = p.w_out; ld = 1024; col0 = 0; K = 1024; dst = WoutT; tt = ti - 2432; }
        else if (ti < 2880) { src = p.w_pf; ld = 1024; col0 = 0; K = 768; dst = WpfT; tt = ti - 2688; }
        else if (ti < 3072) { src = p.w_ps; ld = 1024; col0 = 0; K = 768; dst = WpsT; tt = ti - 2880; }
        else if (ti < 3200) { src = p.w_pm; ld = 1024; col0 = 0; K = 512; dst = WpmT; tt = ti - 3072; }
        else { src = p.w_glu; ld = 768; col0 = 0; K = 768; dst = WgluT; tt = ti - 3200; }
        const int nkt = K >> 6;
        const int dld = (K == 1024) ? KLD : K;
        const int k0 = (tt % nkt) * 64, n0 = (tt / nkt) * 64;
#pragma unroll 4
        for (int i = 0; i < 16; ++i) {
          int k = i * 4 + w, n = lane;
          tile[k * 65 + n] = src[(size_t)(k0 + k) * ld + col0 + n0 + n];
        }
        __syncthreads();
#pragma unroll 4
        for (int i = 0; i < 16; ++i) {
          int n = i * 4 + w, k = lane;
          dst[(size_t)(n0 + n) * dld + k0 + k] = f2bf(tile[k * 65 + n]);
        }
        __syncthreads();
      }
      float* wfl = (float*)smem;
      for (int idx = tid; idx < 12288; idx += 256) {
        int k = idx / 12, j = idx - k * 12;
        wfl[j * 1024 + k] = p.w_in[(size_t)k * 8716 + 2304 + j];
      }
      __syncthreads();
      for (int row = bid * 4 + w; row < T_ + 1024; row += nblk * 4) {
        const bool isx = row < T_;
        const float* src = isx ? p.x + (size_t)row * 1024 : p.mem + (size_t)(row - T_) * 1024;
        const float* gsrc = isx ? p.g_norm : p.g_mem_norm;
        u16* dst = isx ? hbuf + (size_t)row * KLD : memn + (size_t)(row - T_) * KLD;
        float4 xv[4];
        float ss = 0.f;
#pragma unroll
        for (int i = 0; i < 4; ++i) {
          xv[i] = *(const float4*)(src + i * 256 + lane * 4);
          ss += xv[i].x * xv[i].x + xv[i].y * xv[i].y + xv[i].z * xv[i].z + xv[i].w * xv[i].w;
        }
        ss = wave_sum(ss);
        const float rstd = rsqrtf(ss * (1.f / 1024.f) + 1e-6f);
#pragma unroll
        for (int i = 0; i < 4; ++i) {
          float4 gv = *(const float4*)(gsrc + i * 256 + lane * 4);
          xv[i].x *= rstd * gv.x; xv[i].y *= rstd * gv.y; xv[i].z *= rstd * gv.z; xv[i].w *= rstd * gv.w;
          u32x2 o = {pack2(xv[i].x, xv[i].y), pack2(xv[i].z, xv[i].w)};
          *(u32x2*)(dst + i * 256 + lane * 4) = o;
        }
        if (isx) {
          float myfl = 0.f;
#pragma unroll
          for (int j = 0; j < 12; ++j) {
            float a = 0.f;
#pragma unroll
            for (int i = 0; i < 4; ++i) {
              float4 wv = *(const float4*)(wfl + j * 1024 + i * 256 + lane * 4);
              a += xv[i].x * wv.x + xv[i].y * wv.y + xv[i].z * wv.z + xv[i].w * wv.w;
            }
            a = wave_sum(a);
            if (lane == j) myfl = a;
          }
          if (lane < 12) {
            float xx = myfl + p.b_forget[lane];
            float lf = fminf(xx, 0.f) - log1pf(__expf(-fabsf(xx)));
            const int b = row >> 13, t = row & (L_ - 1);
            logf[(size_t)(b * 12 + lane) * L_ + t] = lf;
          }
        }
      }
      {
        const int gid = bid * 256 + tid;
        if (gid < 3072) {
          const int g = gid >> 6;
          const float step = expf(p.log_step[g]);
          const float lr = p.lam_re[gid], li = p.lam_im[gid];
          const float mag = expf(lr * step);
          const float ar = mag * cosf(li * step), ai = mag * sinf(li * step);
          const float den = lr * lr + li * li;
          const float nr = ar - 1.f, ni = ai;
          const float fr = (nr * lr + ni * li) / den, fi = (ni * lr - nr * li) / den;
          abar[gid] = make_float2(ar, ai);
#pragma unroll
          for (int h = 0; h < 16; ++h) {
            const float br = p.b_re[(size_t)gid * 16 + h], bi = p.b_im[(size_t)gid * 16 + h];
            bbar[(size_t)gid * 32 + h] = fr * br - fi * bi;
            bbar[(size_t)gid * 32 + 16 + h] = fr * bi + fi * br;
          }
        }
      }
      __syncthreads();
    }
    SYNC_BEFORE(1);
    if (PH(1)) {
      TIDVARS
      float* sm = (float*)smem;
      for (int seq = bid; seq < 48; seq += nblk) {
        const float* src = logf + (size_t)seq * L_ + tid * 32;
        float* dst = Fbuf + (size_t)seq * L_ + tid * 32;
        float v[32];
#pragma unroll
        for (int i = 0; i < 8; ++i) {
          float4 t = *(const float4*)(src + i * 4);
          v[4 * i] = t.x; v[4 * i + 1] = t.y; v[4 * i + 2] = t.z; v[4 * i + 3] = t.w;
        }
        float run = 0.f;
#pragma unroll
        for (int i = 0; i < 32; ++i) { run += v[i]; v[i] = run; }
        float incl = run;
#pragma unroll
        for (int o = 1; o < 64; o <<= 1) {
          float t = __shfl_up(incl, o);
          if (lane >= o) incl += t;
        }
        if (lane == 63) sm[w] = incl;
        __syncthreads();
        float base = incl - run;
        for (int w2 = 0; w2 < w; ++w2) base += sm[w2];
#pragma unroll
        for (int i = 0; i < 8; ++i) {
          float4 t = make_float4(v[4 * i] + base, v[4 * i + 1] + base, v[4 * i + 2] + base, v[4 * i + 3] + base);
          *(float4*)(dst + i * 4) = t;
        }
        __syncthreads();
      }
      for (int v = bid; v < 11264 + 64; v += nblk) {
        const u16 *A, *Bt;
        int m0, n0;
        bool kvtile = v >= 11264;
        if (!kvtile) {
          int mt, nt;
          swz(v, 44, 4, mt, nt);
          m0 = mt * 128; n0 = nt * 128;
          A = hbuf + (size_t)m0 * KLD; Bt = WinT + (size_t)n0 * KLD;
        } else {
          int kv = v - 11264;
          m0 = (kv >> 3) * 128; n0 = (kv & 7) * 128;
          A = memn + (size_t)m0 * KLD; Bt = WkvT + (size_t)n0 * KLD;
        }
        const bool transp = kvtile ? (n0 >= 512) : (n0 >= 1536 && n0 < 2304);
        f32x4 acc[4][4];
        zero_acc(acc);
        if (transp) {
          gemm_core<false, 1>(acc, A, KLD, Bt, KLD, 1024, smem);
          if (kvtile) epi_transposed(acc, mvT, m0, n0 - 512, 4, 7, 8);
          else epi_transposed(acc, vT, m0, n0 - 1536, 12, 6, 13);
        } else {
          gemm_core<true>(acc, A, KLD, Bt, KLD, 1024, smem);
          u16* dst; int ld, c0, mode;
          if (kvtile) { dst = mkbuf; ld = 512; c0 = n0; mode = 0; }
          else if (n0 < 768) { dst = qbuf; ld = 768; c0 = n0; mode = 1; }
          else if (n0 < 1536) { dst = kbuf; ld = 768; c0 = n0 - 768; mode = 0; }
          else if (n0 < 3072) { dst = gfbuf; ld = 768; c0 = n0 - 2304; mode = 2; }
          else if (n0 < 3840) { dst = ubuf; ld = 768; c0 = n0 - 3072; mode = 0; }
          else if (n0 < 4608) { dst = gsbuf; ld = 768; c0 = n0 - 3840; mode = 2; }
          else if (n0 < 5120) { dst = qmbuf; ld = 512; c0 = n0 - 4608; mode = 0; }
          else { dst = gmbuf; ld = 512; c0 = n0 - 5120; mode = 2; }
          epi_rowmajor(acc, dst, ld, m0, c0, mode);
          if (!kvtile && n0 >= 768 && n0 < 1536) {
            float mxv = 0.f;
#pragma unroll
            for (int i = 0; i < 4; ++i) {
              float ss = 0.f;
#pragma unroll
              for (int j = 0; j < 4; ++j)
#pragma unroll
                for (int r = 0; r < 4; ++r) {
                  const float v = __uint_as_float(((unsigned)f2bf(acc[i][j][r])) << 16);
                  ss += v * v;
                }
              ss += __shfl_xor(ss, 16);
              ss += __shfl_xor(ss, 32);
              mxv = fmaxf(mxv, ss);
            }
#pragma unroll
            for (int o = 1; o < 16; o <<= 1) mxv = fmaxf(mxv, __shfl_xor(mxv, o));
            if (lane == 0) atomicMax(&ctl[(m0 >> 13) * 12 + ((n0 - 768) >> 6) + (w & 1)], __float_as_uint(mxv));
          }
        }
      }
    }
    SYNC_BEFORE(2);
    if (PH(2)) {
      TIDVARS
      int* qslot = (int*)(smem + 73696);
#define NEXT_ITEM(CTR)                                        \
      {                                                       \
        if (tid == 0) *qslot = (int)atomicAdd(&ctl[CTR], 1u); \
        __syncthreads();                                      \
        it = *qslot;                                          \
        __syncthreads();                                      \
      }
      int it;
      for (;;) {
        NEXT_ITEM(64);
        if (it >= 3072) break;
        {
#ifndef NO_FOX
          const int qt = 63 - it / 48, bh = it % 48, b = bh / 12, h = bh % 12;
          const int q0 = qt * 128;
          const size_t qoff = ((size_t)(b * L_ + q0)) * 768 + h * 64;
          attn_item<64, true, true, 2>(qbuf + qoff, 768, kbuf + (size_t)b * L_ * 768 + h * 64, 768,
                              vT + (size_t)(b * 12 + h) * 64 * L_, L_, Fbuf + (size_t)(b * 12 + h) * L_, q0, 2 * qt + 2,
                              gfbuf + qoff, qbuf + qoff, 1.f, sqrtf(__uint_as_float(ctl[b * 12 + h])), smem);
#endif
        }
      }
      for (;;) {
        NEXT_ITEM(65);
        if (it >= 2048) break;
        {
#ifndef NO_MEM
          const int im = it;
          const int hm = im & 3, qt = (im >> 2) & 127, b = im >> 9;
          const int q0 = qt * 64;
          const size_t qoff = ((size_t)(b * L_ + q0)) * 512 + hm * 128;
          attn_item<128, false, false, 1>(qmbuf + qoff, 512, mkbuf + (size_t)b * 256 * 512 + hm * 128, 512,
                                mvT + (size_t)(b * 4 + hm) * 128 * 256, 256, nullptr, q0, 4,
                                gmbuf + qoff, qmbuf + qoff, 0.08838834764831845f, 0.f, smem);
#endif
        }
      }
      for (;;) {
        NEXT_ITEM(66);
        if (it >= 6144) break;
        {
#ifndef NO_S5P1
          const int wi = it * 4 + w;
          const int g = wi % 48, c = (wi / 48) & 127, b = wi / (48 * 128);
          char* xs = smem + w * 12800;
          const int gp = g * 64 + lane;
          bf16x8 ah[8], al[8];
          s5_load_bfrag(bbar, g, l15, g4, ah, al);
          const float2 ab = abar[gp];
          const u16* ub0 = ubuf + ((size_t)(b * L_ + c * 64 + l15)) * 768 + g * 16;
          float hr = 0.f, hi = 0.f;
#pragma unroll 1
          for (int sub = 0; sub < 4; ++sub) {
            s5_xsub(ub0 + (size_t)sub * 16 * 768, ah, al, xs, l15, g4);
            asm volatile("s_waitcnt lgkmcnt(0)" ::: "memory");
#pragma unroll
            for (int tt = 0; tt < 16; ++tt) {
              const float xr = *(const float*)(xs + tt * 528 + lane * 4);
              const float xi = *(const float*)(xs + tt * 528 + 256 + lane * 4);
              const float nhr = ab.x * hr - ab.y * hi + xr;
              const float nhi = ab.x * hi + ab.y * hr + xi;
              hr = nhr; hi = nhi;
            }
            asm volatile("s_waitcnt lgkmcnt(0)" ::: "memory");
          }
          Sst[((size_t)(b * 128 + c) * 48 + g) * 64 + lane] = make_float2(hr, hi);
          __syncthreads();
#endif
        }
      }
    }
    SYNC_BEFORE(3);
    if (PH(3)) {
      TIDVARS
      for (int it = bid; it < 6144; it += nblk) {
        const int wi = it * 4 + w;
        const int g = wi % 48, c = (wi / 48) & 127, b = wi / (48 * 128);
        char* xs = smem + w * 12800;
        char* stt = xs + 8448;
        const int gp = g * 64 + lane;
        bf16x8 ah[8], al[8];
        s5_load_bfrag(bbar, g, l15, g4, ah, al);
        const float2 ab = abar[gp];
        const u16* ub0 = ubuf + ((size_t)(b * L_ + c * 64 + l15)) * 768 + g * 16;
        bf16x8 cf[4];
#pragma unroll
        for (int s = 0; s < 4; ++s) {
          const float* cs = (s < 2 ? p.c_re : p.c_im) + (size_t)(g * 16 + l15) * 64 + (s & 1) * 32 + g4 * 8;
          float4 t0 = *(const float4*)cs, t1 = *(const float4*)(cs + 4);
          const float sg = (s < 2) ? 1.f : -1.f;
          u32x4 t = {pack2(sg * t0.x, sg * t0.y), pack2(sg * t0.z, sg * t0.w), pack2(sg * t1.x, sg * t1.y), pack2(sg * t1.z, sg * t1.w)};
          cf[s] = __builtin_bit_cast(bf16x8, t);
        }
        const float4 dsk = *(const float4*)(p.s5_d + g * 16 + g4 * 4);
        float a64r = ab.x, a64i = ab.y;
#pragma unroll
        for (int q = 0; q < 6; ++q) {
          const float nr = a64r * a64r - a64i * a64i, ni = 2.f * a64r * a64i;
          a64r = nr; a64i = ni;
        }
        float hr = 0.f, hi = 0.f;
        {
          const float2* sp = Sst + ((size_t)(b * 128) * 48 + g) * 64 + lane;
          int cc = 0;
          for (; cc + 8 <= c; cc += 8) {
            float2 sv[8];
#pragma unroll
            for (int q = 0; q < 8; ++q) sv[q] = sp[(size_t)(cc + q) * 48 * 64];
#pragma unroll
            for (int q = 0; q < 8; ++q) {
              const float nhr = a64r * hr - a64i * hi + sv[q].x;
              const float nhi = a64r * hi + a64i * hr + sv[q].y;
              hr = nhr; hi = nhi;
            }
          }
          for (; cc < c; ++cc) {
            const float2 s = sp[(size_t)cc * 48 * 64];
            const float nhr = a64r * hr - a64i * hi + s.x;
            const float nhi = a64r * hi + a64i * hr + s.y;
            hr = nhr; hi = nhi;
          }
        }
        asm volatile("s_waitcnt lgkmcnt(0)" ::: "memory");
#pragma unroll 1
        for (int sub = 0; sub < 4; ++sub) {
          s5_xsub(ub0 + (size_t)sub * 16 * 768, ah, al, xs, l15, g4);
          asm volatile("s_waitcnt lgkmcnt(0)" ::: "memory");
#pragma unroll
          for (int tt = 0; tt < 16; ++tt) {
            const float xr = *(const float*)(xs + tt * 528 + lane * 4);
            const float xi = *(const float*)(xs + tt * 528 + 256 + lane * 4);
            const float nhr = ab.x * hr - ab.y * hi + xr;
            const float nhi = ab.x * hi + ab.y * hr + xi;
            hr = nhr; hi = nhi;
            *(u16*)(stt + tt * 272 + lane * 2) = f2bf(hr);
            *(u16*)(stt + tt * 272 + 128 + lane * 2) = f2bf(hi);
          }
          asm volatile("s_waitcnt lgkmcnt(0)" ::: "memory");
          f32x4 y = {0, 0, 0, 0};
#pragma unroll
          for (int s = 0; s < 4; ++s) {
            bf16x8 bfr = *(const bf16x8*)(stt + l15 * 272 + s * 64 + g4 * 16);
            y = mfma16(cf[s], bfr, y);
          }
          const int t = sub * 16 + l15;
          const u32x2 uv = *(const u32x2*)(ub0 + (size_t)sub * 16 * 768 + g4 * 4);
          float o0 = gelu_tanh(y[0] + dsk.x * bflo(uv[0]));
          float o1 = gelu_tanh(y[1] + dsk.y * bfhi(uv[0]));
          float o2 = gelu_tanh(y[2] + dsk.z * bflo(uv[1]));
          float o3 = gelu_tanh(y[3] + dsk.w * bfhi(uv[1]));
          u32x2 o = {pack2(o0, o1), pack2(o2, o3)};
          *(u32x2*)(ys5a + ((size_t)(b * L_ + c * 64 + t)) * 768 + g * 16 + g4 * 4) = o;
          asm volatile("s_waitcnt lgkmcnt(0)" ::: "memory");
        }
        __syncthreads();
      }
    }
    SYNC_BEFORE(4);
    if (PH(4)) {
      TIDVARS
      for (int v = bid; v < 256 * 6; v += nblk) {
        int mt, nt;
        swz(v, 6, 6, mt, nt);
        const int m0 = mt * 128, n0 = nt * 128;
        f32x4 acc[4][4];
        zero_acc(acc);
        gemm_core<true>(acc, ys5a + (size_t)m0 * 768, 768, WgluT + (size_t)n0 * 768, 768, 768, smem);
        const int wr = w >> 1, wc = w & 1;
#pragma unroll
        for (int i = 0; i < 4; ++i) {
          const size_t row = (size_t)(m0 + wr * 64 + i * 16 + l15);
#pragma unroll
          for (int j = 0; j < 4; ++j) {
            const int n = n0 + wc * 64 + j * 16 + g4 * 4;
            const float4 bg = *(const float4*)(p.b_glu + n);
            const u32x2 av = *(const u32x2*)(ys5a + row * 768 + n);
            const u32x2 sv = *(const u32x2*)(gsbuf + row * 768 + n);
            float o0 = bflo(av[0]) * sigmoidf_(acc[i][j][0] + bg.x) * bflo(sv[0]);
            float o1 = bfhi(av[0]) * sigmoidf_(acc[i][j][1] + bg.y) * bfhi(sv[0]);
            float o2 = bflo(av[1]) * sigmoidf_(acc[i][j][2] + bg.z) * bflo(sv[1]);
            float o3 = bfhi(av[1]) * sigmoidf_(acc[i][j][3] + bg.w) * bfhi(sv[1]);
            u32x2 o = {pack2(o0, o1), pack2(o2, o3)};
            *(u32x2*)(ubuf + row * 768 + n) = o;
          }
        }
      }
    }
    SYNC_BEFORE(5);
    if (PH(5)) {
      TIDVARS
      for (int v = bid; v < 256 * 8; v += nblk) {
        int mt, nt;
        swz(v, 8, 4, mt, nt);
        const int m0 = mt * 128, n0 = nt * 128;
        const int wr = w >> 1, wc = w & 1;
        char* gstash = ws + OFF_GATE + (size_t)bid * 32768;
        char* mstash = ws + OFF_GF + (size_t)bid * 65536;
        const unsigned toff = (unsigned)tid * 16u;
#pragma unroll 1
        for (int stp = 0; stp < 6; ++stp) {
          const int br = stp >> 1;
          const u16* Ab; const u16* Wb; int Kb; int ldk;
          if (!(stp & 1)) { Ab = hbuf + (size_t)m0 * KLD; Wb = WglT + (size_t)(br * 1024 + n0) * KLD; Kb = 1024; }
          else if (br == 0) { Ab = qbuf + (size_t)m0 * 768; Wb = WpfT + (size_t)n0 * 768; Kb = 768; }
          else if (br == 1) { Ab = ubuf + (size_t)m0 * 768; Wb = WpsT + (size_t)n0 * 768; Kb = 768; }
          else { Ab = qmbuf + (size_t)m0 * 512; Wb = WpmT + (size_t)n0 * 512; Kb = 512; }
          f32x4 acc[4][4];
          zero_acc(acc);
          ldk = (Kb == 1024) ? KLD : Kb;
          gemm_core<true, 1>(acc, Ab, ldk, Wb, ldk, Kb, smem);
          if (!(stp & 1)) {
#pragma unroll
            for (int j = 0; j < 4; ++j) {
              const float4 bm = *(const float4*)(p.b_merge + br * 1024 + n0 + wc * 64 + j * 16 + g4 * 4);
#pragma unroll
              for (int i = 0; i < 4; i += 2) {
                u32x4 gq = {pack2(sigmoidf_(acc[i][j][0] + bm.x), sigmoidf_(acc[i][j][1] + bm.y)),
                            pack2(sigmoidf_(acc[i][j][2] + bm.z), sigmoidf_(acc[i][j][3] + bm.w)),
                            pack2(sigmoidf_(acc[i + 1][j][0] + bm.x), sigmoidf_(acc[i + 1][j][1] + bm.y)),
                            pack2(sigmoidf_(acc[i + 1][j][2] + bm.z), sigmoidf_(acc[i + 1][j][3] + bm.w))};
                *(u32x4*)(gstash + (j * 2 + (i >> 1)) * 4096 + toff) = gq;
              }
            }
          } else {
#pragma unroll
            for (int j = 0; j < 4; ++j)
#pragma unroll
              for (int i = 0; i < 4; i += 2) {
                const u32x4 gq = *(const u32x4*)(gstash + (j * 2 + (i >> 1)) * 4096 + toff);
                acc[i][j][0] *= bflo(gq[0]); acc[i][j][1] *= bfhi(gq[0]);
                acc[i][j][2] *= bflo(gq[1]); acc[i][j][3] *= bfhi(gq[1]);
                acc[i + 1][j][0] *= bflo(gq[2]); acc[i + 1][j][1] *= bfhi(gq[2]);
                acc[i + 1][j][2] *= bflo(gq[3]); acc[i + 1][j][3] *= bfhi(gq[3]);
              }
            if (br > 0) {
#pragma unroll
              for (int i = 0; i < 4; ++i)
#pragma unroll
                for (int j = 0; j < 4; ++j) {
                  const f32x4 pv = *(const f32x4*)(mstash + (i * 4 + j) * 4096 + toff);
                  acc[i][j] += pv;
                }
            }
            if (br < 2) {
#pragma unroll
              for (int i = 0; i < 4; ++i)
#pragma unroll
                for (int j = 0; j < 4; ++j) *(f32x4*)(mstash + (i * 4 + j) * 4096 + toff) = acc[i][j];
            } else {
              epi_rowmajor(acc, merged, KLD, m0, n0, 0);
            }
          }
        }
      }
    }
    SYNC_BEFORE(6);
    if (PH(6)) {
      TIDVARS
      for (int v = bid; v < 256 * 8; v += nblk) {
        int mt, nt;
        swz(v, 8, 4, mt, nt);
        const int m0 = mt * 128, n0 = nt * 128;
        const int wr = w >> 1, wc = w & 1;
        f32x4 acc[4][4];
        zero_acc(acc);
        gemm_core<true>(acc, merged + (size_t)m0 * KLD, KLD, WoutT + (size_t)n0 * KLD, KLD, 1024, smem);
#pragma unroll
        for (int i = 0; i < 4; ++i) {
          const size_t row = (size_t)(m0 + wr * 64 + i * 16 + l15);
          float ss = 0.f;
#pragma unroll
          for (int j = 0; j < 4; ++j) {
            const int n = n0 + wc * 64 + j * 16 + g4 * 4;
            const float4 xv = *(const float4*)(p.x + row * 1024 + n);
            float4 o = make_float4(xv.x + acc[i][j][0], xv.y + acc[i][j][1], xv.z + acc[i][j][2], xv.w + acc[i][j][3]);
            ss += o.x * o.x + o.y * o.y + o.z * o.z + o.w * o.w;
            *(float4*)(p.out + row * 1024 + n) = o;
          }
          ss += __shfl_xor(ss, 16);
          ss += __shfl_xor(ss, 32);
          if (g4 == 0) part[row * 16 + nt * 2 + wc] = ss;
        }
      }
    }
    SYNC_BEFORE(7);
    if (PH(7)) {
      TIDVARS
      for (int row = bid * 4 + w; row < T_; row += nblk * 4) {
        float ss = (lane < 16) ? part[(size_t)row * 16 + lane] : 0.f;
        ss = wave_sum(ss);
        const float rstd = rsqrtf(ss * (1.f / 1024.f) + 1e-6f);
        float* o = p.out + (size_t)row * 1024;
#pragma unroll
        for (int i = 0; i < 4; ++i) {
          float4 v = *(const float4*)(o + i * 256 + lane * 4);
          const float4 gv = *(const float4*)(p.g_final + i * 256 + lane * 4);
          v.x *= rstd * gv.x; v.y *= rstd * gv.y; v.z *= rstd * gv.z; v.w *= rstd * gv.w;
          *(float4*)(o + i * 256 + lane * 4) = v;
        }
      }
    }
  }
}

extern "C" void kernel_launch(void* const* d_in, const int* in_sizes, int n_in, void* d_out, int out_size, void* d_ws,
                              size_t ws_size, hipStream_t stream) {
  static int grid_blocks = 0;
  if (!grid_blocks) {
    if (ws_size < WS_END || n_in != 23) {
      fprintf(stderr, "kernel_launch: unexpected ws_size %zu (need %zu) or n_in %d\n", ws_size, (size_t)WS_END, n_in);
      grid_blocks = -1;
      return;
    }
    int dev = 0, cus = 0, per_cu = 0;
    (void)hipGetDevice(&dev);
    (void)hipDeviceGetAttribute(&cus, hipDeviceAttributeMultiprocessorCount, dev);
    (void)hipFuncSetAttribute((const void*)mega, hipFuncAttributeMaxDynamicSharedMemorySize, LDS_BYTES);
    (void)hipOccupancyMaxActiveBlocksPerMultiprocessor(&per_cu, (const void*)mega, 256, LDS_BYTES);
    fprintf(stderr, "occupancy query: %d blocks/CU, %d CUs\n", per_cu, cus);
    per_cu = 2;
    grid_blocks = cus * per_cu;
  }
  if (grid_blocks < 0) return;
  Params p{};
  const float** pp = (const float**)&p;
  for (int i = 0; i < 23; ++i) pp[i] = (const float*)d_in[i];
  p.out = (float*)d_out;
  p.ws = (char*)d_ws;
#if COOP
  (void)hipMemsetAsync((char*)d_ws + OFF_CTL + 4096, 0, XCD_BAR_WORDS * 4, stream);
  p.phase_lo = 0;
  p.phase_hi = NPHASE - 1;
  void* args[] = {&p};
  hipError_t e = hipLaunchCooperativeKernel((const void*)mega, dim3(grid_blocks), dim3(256), args, LDS_BYTES, stream);
  if (e != hipSuccess) fprintf(stderr, "cooperative launch failed: %s (grid %d)\n", hipGetErrorString(e), grid_blocks);
#else
  for (int ph = 0; ph < NPHASE; ++ph) {
    p.phase_lo = ph;
    p.phase_hi = ph;
    hipLaunchKernelGGL(mega, dim3(grid_blocks), dim3(256), LDS_BYTES, stream, p);
#ifdef PROBE_DUP
    if (ph == PROBE_DUP) {
      for (int rep = 0; rep < 2; ++rep) {
        if (ph == 2) { p.phase_lo = p.phase_hi = 1; hipLaunchKernelGGL(mega, dim3(grid_blocks), dim3(256), LDS_BYTES, stream, p); p.phase_lo = p.phase_hi = 2; }
        hipLaunchKernelGGL(mega, dim3(grid_blocks), dim3(256), LDS_BYTES, stream, p);
      }
    }
#endif
  }
#endif
}
```

```cpp
#include <hip/hip_runtime.h>
#include <hip/hip_cooperative_groups.h>
#include <stdint.h>
#include <stdio.h>
namespace cg = cooperative_groups;

#ifndef COOP
#define COOP 1
#define XCD_MODE 0
#endif

#define DI __device__ __forceinline__
#ifdef ONLY_PHASE
#define PH(n) ((n) == ONLY_PHASE && p.phase_lo <= (n) && (n) <= p.phase_hi)
#else
#define PH(n) (p.phase_lo <= (n) && (n) <= p.phase_hi)
#endif
#define SYNC_BEFORE(n)                                        \
  if (p.phase_lo < (n) && (n) <= p.phase_hi) {                \
    xcd_barrier(xb);                                          \
  }
typedef unsigned short u16;
using bf16x8 = __attribute__((ext_vector_type(8))) short;
using f32x4 = __attribute__((ext_vector_type(4))) float;
using u32x4 = __attribute__((ext_vector_type(4))) unsigned;
using u32x2 = __attribute__((ext_vector_type(2))) unsigned;

constexpr int T_ = 32768, L_ = 8192;
constexpr int LDS_BYTES = 73728;
constexpr int NPHASE = 9;

constexpr size_t MiB = 1u << 20;
constexpr int KLD = 1088;
constexpr size_t OFF_H = 0;
constexpr size_t OFF_Q = 68 * MiB;
constexpr size_t OFF_GF = 116 * MiB;
constexpr size_t OFF_U = 164 * MiB;
constexpr size_t OFF_GS = 212 * MiB;
constexpr size_t OFF_YS5A = 260 * MiB;
constexpr size_t OFF_QM = 308 * MiB;
constexpr size_t OFF_GM = 340 * MiB;
constexpr size_t OFF_MERGED = 372 * MiB;
constexpr size_t OFF_WINT = 440 * MiB;
constexpr size_t OFF_WGLT = 453 * MiB;
constexpr size_t OFF_WKVT = 460 * MiB;
constexpr size_t OFF_WOUTT = 463 * MiB;
constexpr size_t OFF_WPFT = 466 * MiB;
constexpr size_t OFF_WPST = 468 * MiB;
constexpr size_t OFF_WPMT = 470 * MiB;
constexpr size_t OFF_WGLUT = 471 * MiB;
constexpr size_t OFF_MEMN = 473 * MiB;
constexpr size_t OFF_MK = 476 * MiB;
constexpr size_t OFF_MVT = 477 * MiB;
constexpr size_t OFF_LOGF = 478 * MiB;
constexpr size_t OFF_F = 480 * MiB;
constexpr size_t OFF_S5AB = 482 * MiB;
constexpr size_t OFF_S5BB = 483 * MiB;
constexpr size_t OFF_S5S = 484 * MiB;
constexpr size_t OFF_PART = 496 * MiB;
constexpr size_t OFF_GATE = OFF_GS;
constexpr size_t OFF_CTL = 498 * MiB;
constexpr size_t WS_END = 499 * MiB;

struct Params {
  const float *x, *mem, *g_norm, *g_mem_norm, *g_final, *w_in, *b_forget, *b_merge, *w_mem_kv;
  const float *lam_re, *lam_im, *log_step, *b_re, *b_im, *c_re, *c_im, *s5_d, *w_glu, *b_glu;
  const float *w_pf, *w_ps, *w_pm, *w_out;
  float* out;
  char* ws;
  int phase_lo, phase_hi;
};

DI u16 f2bf(float x) { unsigned u = __float_as_uint(x); u += 0x7fffu + ((u >> 16) & 1u); return (u16)(u >> 16); }
DI unsigned pack2(float a, float b) { return (unsigned)f2bf(a) | ((unsigned)f2bf(b) << 16); }
DI float bflo(unsigned v) { return __uint_as_float(v << 16); }
DI float bfhi(unsigned v) { return __uint_as_float(v & 0xffff0000u); }
DI float sigmoidf_(float x) { return 1.f / (1.f + __expf(-x)); }
DI float siluf_(float x) { return x / (1.f + __expf(-x)); }
DI float gelu_tanh(float x) {
  float z = 0.7978845608028654f * (x + 0.044715f * x * x * x);
  float e = __expf(2.f * z);
  float th = 1.f - 2.f / (e + 1.f);
  return 0.5f * x * (1.f + th);
}
DI float wave_sum(float v) {
#pragma unroll
  for (int o = 32; o > 0; o >>= 1) v += __shfl_xor(v, o);
  return v;
}
DI f32x4 mfma16(bf16x8 a, bf16x8 b, f32x4 c) { return __builtin_amdgcn_mfma_f32_16x16x32_bf16(a, b, c, 0, 0, 0); }

template <bool SWAP, int DEPTH = 1>
DI void gemm_core(f32x4 (&acc)[4][4], const u16* __restrict__ A, int lda, const u16* __restrict__ Bt, int ldb, int K, char* smem) {
  const int tid = threadIdx.x, lane = tid & 63, w = tid >> 6, wr = w >> 1, wc = w & 1, l15 = lane & 15, g = lane >> 4;
  const int lrow = tid >> 3, lch = tid & 7;
  const char* ap = (const char*)A;
  const char* bp = (const char*)Bt;
  const unsigned aoff = (unsigned)(lrow * lda + lch * 8) * 2u;
  const unsigned boff = (unsigned)(lrow * ldb + lch * 8) * 2u;
  u32x4 ra0[4], rb0[4], ra1[4], rb1[4];
  const int nk = K >> 6;
#define G_LOAD(RA, RB, KT)                                                        \
  _Pragma("unroll") for (int c = 0; c < 4; ++c) {                                 \
    RA[c] = *(const u32x4*)(ap + ((size_t)c * 64 * lda + (KT) * 128) + aoff);     \
    RB[c] = *(const u32x4*)(bp + ((size_t)c * 64 * ldb + (KT) * 128) + boff);     \
  }
#define G_STORE(RA, RB, BO)                                                       \
  _Pragma("unroll") for (int c = 0; c < 4; ++c) {                                 \
    *(u32x4*)(wbase + (BO) + c * 32 * 128) = RA[c];                               \
    *(u32x4*)(wbase + (BO) + 16384 + c * 32 * 128) = RB[c];                       \
  }
#define G_COMPUTE(BO)                                                             \
  {                                                                               \
    bf16x8 af[2][4], bfr[2][4];                                                   \
    _Pragma("unroll") for (int i = 0; i < 4; ++i) af[0][i] = *(const bf16x8*)(ard0 + (BO) + i * 16 * 128);  \
    _Pragma("unroll") for (int j = 0; j < 4; ++j) bfr[0][j] = *(const bf16x8*)(brd0 + (BO) + j * 16 * 128); \
    _Pragma("unroll") for (int i = 0; i < 4; ++i) af[1][i] = *(const bf16x8*)(ard1 + (BO) + i * 16 * 128);  \
    _Pragma("unroll") for (int j = 0; j < 4; ++j) bfr[1][j] = *(const bf16x8*)(brd1 + (BO) + j * 16 * 128); \
    __builtin_amdgcn_sched_barrier(0);                                            \
    __builtin_amdgcn_s_setprio(1);                                                \
    _Pragma("unroll") for (int s = 0; s < 2; ++s)                                 \
      _Pragma("unroll") for (int i = 0; i < 4; ++i)                               \
        _Pragma("unroll") for (int j = 0; j < 4; ++j)                             \
          acc[i][j] = SWAP ? mfma16(bfr[s][j], af[s][i], acc[i][j]) : mfma16(af[s][i], bfr[s][j], acc[i][j]); \
    __builtin_amdgcn_s_setprio(0);                                                \
  }
  char* wbase = smem + lrow * 128 + ((lch ^ ((lrow >> 1) & 7)) << 4);
  const int hsw = l15 >> 1;
  const char* ard0 = smem + (wr * 64 + l15) * 128 + ((g ^ hsw) << 4);
  const char* ard1 = smem + (wr * 64 + l15) * 128 + (((4 + g) ^ hsw) << 4);
  const char* brd0 = smem + 16384 + (wc * 64 + l15) * 128 + ((g ^ hsw) << 4);
  const char* brd1 = smem + 16384 + (wc * 64 + l15) * 128 + (((4 + g) ^ hsw) << 4);
  if constexpr (DEPTH == 2) {
    G_LOAD(ra0, rb0, 0);
    G_LOAD(ra1, rb1, 1);
    G_STORE(ra0, rb0, 0);
    __syncthreads();
    for (int kt = 0; kt < nk; kt += 2) {
      if (kt + 2 < nk) G_LOAD(ra0, rb0, kt + 2);
      __builtin_amdgcn_sched_barrier(0);
      G_COMPUTE(0);
      __builtin_amdgcn_sched_barrier(0);
      G_STORE(ra1, rb1, 32768);
      __syncthreads();
      if (kt + 3 < nk) G_LOAD(ra1, rb1, kt + 3);
      __builtin_amdgcn_sched_barrier(0);
      G_COMPUTE(32768);
      __builtin_amdgcn_sched_barrier(0);
      if (kt + 2 < nk) G_STORE(ra0, rb0, 0);
      __syncthreads();
    }
  } else {
    G_LOAD(ra0, rb0, 0);
    G_STORE(ra0, rb0, 0);
    __syncthreads();
    for (int kt = 0; kt < nk; kt += 2) {
      G_LOAD(ra0, rb0, kt + 1);
      __builtin_amdgcn_sched_barrier(0);
      G_COMPUTE(0);
      __builtin_amdgcn_sched_barrier(0);
      G_STORE(ra0, rb0, 32768);
      __syncthreads();
      if (kt + 2 < nk) G_LOAD(ra0, rb0, kt + 2);
      __builtin_amdgcn_sched_barrier(0);
      G_COMPUTE(32768);
      __builtin_amdgcn_sched_barrier(0);
      if (kt + 2 < nk) G_STORE(ra0, rb0, 0);
      __syncthreads();
    }
  }
#undef G_LOAD
#undef G_STORE
#undef G_COMPUTE
}

DI void zero_acc(f32x4 (&acc)[4][4]) {
#pragma unroll
  for (int i = 0; i < 4; ++i)
#pragma unroll
    for (int j = 0; j < 4; ++j) acc[i][j] = f32x4{0.f, 0.f, 0.f, 0.f};
}

DI void swz(int v, int NT, int GN, int& mt, int& nt) {
#if XCD_MODE == 0
  int xcd = v & 7, j = v >> 3;
#else
  int xcd = (v & 511) >> 6, j = ((v >> 9) << 6) + (v & 63);
#endif
  int per_mg = 8 * NT;
  int mg = j / per_mg, r = j - mg * per_mg;
  int ng = r / (8 * GN), wv = r - ng * (8 * GN);
  mt = xcd * 32 + mg * 8 + (wv & 7);
  nt = ng * GN + (wv >> 3);
}

DI void epi_rowmajor(const f32x4 (&acc)[4][4], u16* dst, int ld, int m0, int c0, int mode) {
  const int tid = threadIdx.x, lane = tid & 63, w = tid >> 6, wr = w >> 1, wc = w & 1, l15 = lane & 15, g = lane >> 4;
#pragma unroll
  for (int i = 0; i < 4; ++i) {
    const size_t row = (size_t)(m0 + wr * 64 + i * 16 + l15);
#pragma unroll
    for (int j = 0; j < 4; ++j) {
      f32x4 v = acc[i][j];
      if (mode == 1) { v[0] *= 0.125f; v[1] *= 0.125f; v[2] *= 0.125f; v[3] *= 0.125f; }
      else if (mode == 2) { v[0] = siluf_(v[0]); v[1] = siluf_(v[1]); v[2] = siluf_(v[2]); v[3] = siluf_(v[3]); }
      u32x2 o = {pack2(v[0], v[1]), pack2(v[2], v[3])};
      *(u32x2*)(dst + row * ld + c0 + wc * 64 + j * 16 + g * 4) = o;
    }
  }
}
DI void epi_transposed(const f32x4 (&acc)[4][4], u16* dst, int m0, int c0, int H, int lgDh, int lgLk) {
  const int tid = threadIdx.x, lane = tid & 63, w = tid >> 6, wr = w >> 1, wc = w & 1, l15 = lane & 15, g = lane >> 4;
#pragma unroll
  for (int i = 0; i < 4; ++i) {
    const int token = m0 + wr * 64 + i * 16 + g * 4;
    const int bidx = token >> lgLk, tl = token & ((1 << lgLk) - 1);
#pragma unroll
    for (int j = 0; j < 4; ++j) {
      const int col = c0 + wc * 64 + j * 16 + l15;
      const int head = col >> lgDh, d = col & ((1 << lgDh) - 1);
      f32x4 v = acc[i][j];
      u32x2 o = {pack2(v[0], v[1]), pack2(v[2], v[3])};
      *(u32x2*)(dst + ((((((size_t)bidx * H + head) << lgDh) + d) << lgLk) + tl)) = o;
    }
  }
}

template <int D, bool FOX, bool PF, int NQ>
DI void attn_item(const u16* __restrict__ qbase, int ldq, const u16* __restrict__ kbase, int ldk,
                  const u16* __restrict__ vtbase, int ldv, const float* __restrict__ Fseq, int q0, int nkv,
                  const u16* __restrict__ gate, u16* outp, float scale, float kmaxv, char* smem) {
  const int tid = threadIdx.x, lane = tid & 63, w = tid >> 6, l15 = lane & 15, g = lane >> 4;
  constexpr int KROW = D * 2 + 16;
  constexpr int KBYTES = 64 * KROW;
  constexpr int VBYTES = D * 144;
  constexpr int BUF = KBYTES + VBYTES + 256;
  constexpr int NL = D / 32;
  constexpr int KCH = D / 8;
  static_assert(2 * BUF <= LDS_BYTES, "attn lds");

  bf16x8 qf[NQ][D / 32];
#pragma unroll
  for (int qi = 0; qi < NQ; ++qi)
#pragma unroll
    for (int s = 0; s < D / 32; ++s)
      qf[qi][s] = *(const bf16x8*)(qbase + (size_t)(w * (16 * NQ) + qi * 16 + l15) * ldq + s * 32 + g * 8);
  float fq[NQ];
#pragma unroll
  for (int qi = 0; qi < NQ; ++qi) fq[qi] = FOX ? Fseq[q0 + w * (16 * NQ) + qi * 16 + l15] : 0.f;
  f32x4 ot[D / 16][NQ];
#pragma unroll
  for (int dt = 0; dt < D / 16; ++dt)
#pragma unroll
    for (int qi = 0; qi < NQ; ++qi) ot[dt][qi] = f32x4{0, 0, 0, 0};
  float mrun[NQ], lsum[NQ];
#pragma unroll
  for (int qi = 0; qi < NQ; ++qi) { mrun[qi] = -1e30f; lsum[qi] = 0.f; }
  float qk[NQ];
#pragma unroll
  for (int qi = 0; qi < NQ; ++qi) {
    float ss = 0.f;
    if (FOX) {
#pragma unroll
      for (int s = 0; s < D / 32; ++s)
#pragma unroll
        for (int e = 0; e < 8; ++e) {
          const float v = __uint_as_float(((unsigned)(unsigned short)qf[qi][s][e]) << 16);
          ss += v * v;
        }
      ss += __shfl_xor(ss, 16);
      ss += __shfl_xor(ss, 32);
    }
    qk[qi] = sqrtf(ss) * kmaxv * 1.002f + 1e-3f;
  }
  int* flags = (int*)(smem + 73664);

  u32x4 kr[NL], vr[NL];
  f32x4 fr = {0, 0, 0, 0};
#define krow(c) (((c) * 256 + tid) / KCH)
#define kch(c) (((c) * 256 + tid) % KCH)
#define vrow(c) (((c) * 256 + tid) >> 3)
#define vch(c) (tid & 7)
#define ATT_LOAD(J)                                                                                   \
  {                                                                                                   \
    const int s0_ = (J) * 64;                                                                         \
    _Pragma("unroll") for (int c = 0; c < NL; ++c) {                                                  \
      kr[c] = *(const u32x4*)(kbase + (size_t)(s0_ + krow(c)) * ldk + kch(c) * 8);                    \
      vr[c] = *(const u32x4*)(vtbase + (size_t)vrow(c) * ldv + s0_ + vch(c) * 8);                     \
    }                                                                                                 \
    if (FOX && tid < 16) fr = *(const f32x4*)(Fseq + s0_ + tid * 4);                                  \
  }
#define ATT_STORE(BO)                                                                                 \
  {                                                                                                   \
    char* b_ = smem + (BO);                                                                           \
    _Pragma("unroll") for (int c = 0; c < NL; ++c) {                                                  \
      *(u32x4*)(b_ + krow(c) * KROW + kch(c) * 16) = kr[c];                                           \
      *(u32x4*)(b_ + KBYTES + vrow(c) * 144 + vch(c) * 16) = vr[c];                                   \
    }                                                                                                 \
    if (FOX && tid < 16) *(f32x4*)(b_ + KBYTES + VBYTES + tid * 16) = fr;                             \
  }
  ATT_LOAD(nkv - 1);
  ATT_STORE(0);
  __syncthreads();
  const int qlo = q0 + w * (16 * NQ);
  for (int j = nkv - 1, itn = 0; j >= 0; --j, ++itn) {
    const int cur = (itn & 1) * BUF;
    if (j > 0) {
      ATT_LOAD(j - 1);
      if (!PF) ATT_STORE(cur ^ BUF);
    }
    __builtin_amdgcn_sched_barrier(0);
    bool ok = false;
    const int s0 = j * 64;
    const bool active = !FOX || (s0 <= qlo + 16 * NQ - 1);
    if (active) {
      const char* Ks = smem + cur;
      const char* Vs = smem + cur + KBYTES;
      const char* Fs = smem + cur + KBYTES + VBYTES;
      f32x4 st[4][NQ];
#pragma unroll
      for (int kt = 0; kt < 4; ++kt)
#pragma unroll
        for (int qi = 0; qi < NQ; ++qi) st[kt][qi] = f32x4{0, 0, 0, 0};
#pragma unroll
      for (int s = 0; s < D / 32; ++s) {
        bf16x8 kf[4];
#pragma unroll
        for (int kt = 0; kt < 4; ++kt) kf[kt] = *(const bf16x8*)(Ks + (kt * 16 + l15) * KROW + s * 64 + g * 16);
#pragma unroll
        for (int kt = 0; kt < 4; ++kt)
#pragma unroll
          for (int qi = 0; qi < NQ; ++qi) st[kt][qi] = mfma16(kf[kt], qf[qi][s], st[kt][qi]);
      }
      if (FOX) {
        const bool need_mask = (s0 + 63 > qlo);
#pragma unroll
        for (int kt = 0; kt < 4; ++kt) {
          f32x4 fk = *(const f32x4*)(Fs + (kt * 16 + g * 4) * 4);
#pragma unroll
          for (int qi = 0; qi < NQ; ++qi) {
            const int qpos = qlo + qi * 16 + l15;
#pragma unroll
            for (int r = 0; r < 4; ++r) {
              float v = st[kt][qi][r] + fq[qi] - fk[r];
              if (need_mask && (s0 + kt * 16 + g * 4 + r > qpos)) v = -1e30f;
              st[kt][qi][r] = v;
            }
          }
        }
      } else {
#pragma unroll
        for (int kt = 0; kt < 4; ++kt)
#pragma unroll
          for (int qi = 0; qi < NQ; ++qi)
#pragma unroll
            for (int r = 0; r < 4; ++r) st[kt][qi][r] *= scale;
      }
      float alpha[NQ];
#pragma unroll
      for (int qi = 0; qi < NQ; ++qi) {
        float mx = st[0][qi][0];
#pragma unroll
        for (int kt = 0; kt < 4; ++kt)
#pragma unroll
          for (int r = 0; r < 4; ++r) mx = fmaxf(mx, st[kt][qi][r]);
        mx = fmaxf(mx, __shfl_xor(mx, 16));
        mx = fmaxf(mx, __shfl_xor(mx, 32));
        const float mnew = fmaxf(mrun[qi], mx);
        alpha[qi] = __expf(mrun[qi] - mnew);
        mrun[qi] = mnew;
        float ps = 0.f;
#pragma unroll
        for (int kt = 0; kt < 4; ++kt)
#pragma unroll
          for (int r = 0; r < 4; ++r) {
            float p = __expf(st[kt][qi][r] - mnew);
            st[kt][qi][r] = p;
            ps += p;
          }
        lsum[qi] = lsum[qi] * alpha[qi] + ps;
      }
      bf16x8 pb[2][NQ];
#pragma unroll
      for (int kp = 0; kp < 2; ++kp)
#pragma unroll
        for (int qi = 0; qi < NQ; ++qi) {
          u32x4 t = {pack2(st[2 * kp][qi][0], st[2 * kp][qi][1]), pack2(st[2 * kp][qi][2], st[2 * kp][qi][3]),
                     pack2(st[2 * kp + 1][qi][0], st[2 * kp + 1][qi][1]), pack2(st[2 * kp + 1][qi][2], st[2 * kp + 1][qi][3])};
          pb[kp][qi] = __builtin_bit_cast(bf16x8, t);
        }
#pragma unroll
      for (int dt = 0; dt < D / 16; ++dt) {
#pragma unroll
        for (int r = 0; r < 4; ++r)
#pragma unroll
          for (int qi = 0; qi < NQ; ++qi) ot[dt][qi][r] *= alpha[qi];
#pragma unroll
        for (int kp = 0; kp < 2; ++kp) {
          u32x2 lo = *(const u32x2*)(Vs + (dt * 16 + l15) * 144 + (kp * 32 + g * 4) * 2);
          u32x2 hi = *(const u32x2*)(Vs + (dt * 16 + l15) * 144 + (kp * 32 + 16 + g * 4) * 2);
          u32x4 t = {lo[0], lo[1], hi[0], hi[1]};
          bf16x8 vf = __builtin_bit_cast(bf16x8, t);
#pragma unroll
          for (int qi = 0; qi < NQ; ++qi) ot[dt][qi] = mfma16(vf, pb[kp][qi], ot[dt][qi]);
        }
      }
      if (FOX) {
        const float f0 = *(const float*)Fs;
        ok = true;
#pragma unroll
        for (int qi = 0; qi < NQ; ++qi) ok = ok && (qk[qi] + fq[qi] - f0 - mrun[qi] <= -30.f);
      }
    }
    __builtin_amdgcn_sched_barrier(0);
    if (PF && j > 0) ATT_STORE(cur ^ BUF);
    if (FOX) {
      const bool wave_ok = (__ballot(ok) == ~0ull);
      if (lane == 0) flags[(itn & 1) * 4 + w] = wave_ok ? 1 : 0;
      __syncthreads();
      const int* fl = flags + (itn & 1) * 4;
      if (fl[0] & fl[1] & fl[2] & fl[3]) break;
    } else {
      __syncthreads();
    }
  }
#undef ATT_LOAD
#undef ATT_STORE
#undef krow
#undef kch
#undef vrow
#undef vch
#pragma unroll
  for (int qi = 0; qi < NQ; ++qi) {
    float l = lsum[qi];
    l += __shfl_xor(l, 16);
    l += __shfl_xor(l, 32);
    const float inv = 1.f / l;
    const size_t rowoff = (size_t)(w * (16 * NQ) + qi * 16 + l15) * ldq;
#pragma unroll
    for (int dt = 0; dt < D / 16; ++dt) {
      const int col = dt * 16 + g * 4;
      u32x2 gv = *(const u32x2*)(gate + rowoff + col);
      u32x2 o = {pack2(ot[dt][qi][0] * inv * bflo(gv[0]), ot[dt][qi][1] * inv * bfhi(gv[0])),
                 pack2(ot[dt][qi][2] * inv * bflo(gv[1]), ot[dt][qi][3] * inv * bfhi(gv[1]))};
      *(u32x2*)(outp + rowoff + col) = o;
    }
  }
}

typedef float v2f __attribute__((ext_vector_type(2)));
DI void s5_load_u(const u16* ubuf, int b, int c, int g, char* ut, int lane) {
  const u16* src = ubuf + ((size_t)(b * L_ + c * 64 + lane)) * 768 + g * 16;
  u32x4 a = *(const u32x4*)src, bb = *(const u32x4*)(src + 8);
  f32x4 o0 = {bflo(a[0]), bfhi(a[0]), bflo(a[1]), bfhi(a[1])};
  f32x4 o1 = {bflo(a[2]), bfhi(a[2]), bflo(a[3]), bfhi(a[3])};
  f32x4 o2 = {bflo(bb[0]), bfhi(bb[0]), bflo(bb[1]), bfhi(bb[1])};
  f32x4 o3 = {bflo(bb[2]), bfhi(bb[2]), bflo(bb[3]), bfhi(bb[3])};
  *(f32x4*)(ut + lane * 64) = o0;
  *(f32x4*)(ut + lane * 64 + 16) = o1;
  *(f32x4*)(ut + lane * 64 + 32) = o2;
  *(f32x4*)(ut + lane * 64 + 48) = o3;
}
DI void s5_load_b(const float* bbar, int gp, v2f (&b2)[16]) {
#pragma unroll
  for (int q = 0; q < 4; ++q) {
    float4 t0 = *(const float4*)(bbar + (size_t)gp * 32 + q * 4);
    float4 t1 = *(const float4*)(bbar + (size_t)gp * 32 + 16 + q * 4);
    b2[4 * q] = v2f{t0.x, t1.x}; b2[4 * q + 1] = v2f{t0.y, t1.y};
    b2[4 * q + 2] = v2f{t0.z, t1.z}; b2[4 * q + 3] = v2f{t0.w, t1.w};
  }
}
DI v2f s5_x(const char* ut, int t, const v2f (&b2)[16]) {
  v2f xa = {0.f, 0.f}, xb = {0.f, 0.f};
#pragma unroll
  for (int q = 0; q < 4; ++q) {
    const f32x4 u = *(const f32x4*)(ut + t * 64 + q * 16);
    xa += b2[4 * q] * u[0];
    xb += b2[4 * q + 1] * u[1];
    xa += b2[4 * q + 2] * u[2];
    xb += b2[4 * q + 3] * u[3];
  }
  return xa + xb;
}

DI void s5_load_bfrag(const float* bbar, int g, int l15, int g4, bf16x8 (&ah)[8], bf16x8 (&al)[8]) {
#pragma unroll
  for (int kt = 0; kt < 8; ++kt) {
    u32x4 h = {0u, 0u, 0u, 0u}, l = {0u, 0u, 0u, 0u};
    if (g4 < 2) {
      const float* src = bbar + (size_t)(g * 64 + (kt & 3) * 16 + l15) * 32 + (kt >> 2) * 16 + g4 * 8;
      const float4 t0 = *(const float4*)src, t1 = *(const float4*)(src + 4);
      const float v[8] = {t0.x, t0.y, t0.z, t0.w, t1.x, t1.y, t1.z, t1.w};
#pragma unroll
      for (int q = 0; q < 4; ++q) {
        const unsigned h0 = f2bf(v[2 * q]), h1 = f2bf(v[2 * q + 1]);
        h[q] = h0 | (h1 << 16);
        l[q] = pack2(v[2 * q] - __uint_as_float(h0 << 16), v[2 * q + 1] - __uint_as_float(h1 << 16));
      }
    }
    ah[kt] = __builtin_bit_cast(bf16x8, h);
    al[kt] = __builtin_bit_cast(bf16x8, l);
  }
}
DI void s5_xsub(const u32x4 uraw, const bf16x8 (&ah)[8], const bf16x8 (&al)[8], char* xs, int l15, int g4) {
  const bf16x8 ub = __builtin_bit_cast(bf16x8, uraw);
#pragma unroll
  for (int kt = 0; kt < 8; ++kt) {
    f32x4 x = {0.f, 0.f, 0.f, 0.f};
    x = mfma16(ah[kt], ub, x);
    x = mfma16(al[kt], ub, x);
    *(f32x4*)(xs + l15 * 528 + (kt * 16 + g4 * 4) * 4) = x;
  }
}

#define XB_TMO      128
#define XB_XCNT(j)  (256  + 64 * (j))
#define XB_XSUB(j)  (1280 + 64 * (j))
#define XB_XGEN(j)  (2304 + 64 * (j))
#define XB_TOP      3328
#define XB_TOPGEN   3392
#define XCD_BAR_WORDS 3456
#define XB_SPIN_CAP (1u << 18)
DI unsigned xb_ld(unsigned* p) { return __hip_atomic_load(p, __ATOMIC_RELAXED, __HIP_MEMORY_SCOPE_AGENT); }
DI unsigned xb_add(unsigned* p, unsigned v) { return __hip_atomic_fetch_add(p, v, __ATOMIC_RELAXED, __HIP_MEMORY_SCOPE_AGENT); }
DI unsigned xb_xcc_id() { return (unsigned)__builtin_amdgcn_s_getreg((3 << 11) | 20) & 0xFu; }
#define XB_SPIN(cond, bar) do { unsigned _sp = 0; while (cond) { __builtin_amdgcn_s_sleep(1); \
    if ((++_sp & 255u) == 0u) { if (xb_ld(&(bar)[XB_TMO])) break; if (_sp > XB_SPIN_CAP) { atomicAdd(&(bar)[XB_TMO], 1u); break; } } } } while (0)
struct XcdBarrier { unsigned* bar; unsigned x; volatile unsigned* st; };
DI XcdBarrier xcd_barrier_post(unsigned* bar, volatile unsigned* st) {
  XcdBarrier b; b.bar = bar; b.x = xb_xcc_id(); b.st = st;
  if (threadIdx.x == 0) (void)xb_add(&bar[XB_XCNT(b.x)], 1u);
  return b;
}
DI void xcd_barrier_complete(unsigned* bar, unsigned x, unsigned& nloc, unsigned& nx) {
  const unsigned G = gridDim.x * gridDim.y * gridDim.z;
  unsigned sum, cnt, mine, sp = 0u;
  for (;;) {
    sum = 0u; cnt = 0u; mine = 0u;
#pragma unroll
    for (unsigned j = 0; j < 16; ++j) { const unsigned c = xb_ld(&bar[XB_XCNT(j)]); sum += c; cnt += (c > 0u) ? 1u : 0u; mine = (j == x) ? c : mine; }
    if (sum == G) break;
    __builtin_amdgcn_s_sleep(1);
    if ((++sp & 255u) == 0u) { if (xb_ld(&bar[XB_TMO])) break; if (sp > XB_SPIN_CAP) { atomicAdd(&bar[XB_TMO], 1u); break; } }
  }
  nloc = mine > 0u ? mine : 1u; nx = cnt > 0u ? cnt : 1u;
}
DI void xcd_barrier(const XcdBarrier& b) {
  asm volatile("s_waitcnt vmcnt(0)" ::: "memory");
  __syncthreads();
  if (threadIdx.x == 0) {
    unsigned* bar = b.bar;
    __builtin_amdgcn_s_waitcnt(0);
    unsigned nloc = b.st[0], nx = b.st[1];
    if (nloc == 0u) { xcd_barrier_complete(bar, b.x, nloc, nx); b.st[0] = nloc; b.st[1] = nx; }
    const unsigned old = xb_add(&bar[XB_XSUB(b.x)], 1u);
    const unsigned gen = old / nloc;
    if (old + 1u == (gen + 1u) * nloc) {
      __builtin_amdgcn_fence(__ATOMIC_RELEASE, "agent");
      asm volatile("s_waitcnt vmcnt(0)" ::: "memory");
      const unsigned og = xb_add(&bar[XB_TOP], 1u);
      const unsigned tg = og / nx;
      if (og + 1u == (tg + 1u) * nx) xb_add(&bar[XB_TOPGEN], 1u);
      else XB_SPIN(xb_ld(&bar[XB_TOPGEN]) == tg, bar);
      __builtin_amdgcn_fence(__ATOMIC_ACQUIRE, "agent");
      xb_add(&bar[XB_XGEN(b.x)], 1u);
      asm volatile("s_waitcnt vmcnt(0)" ::: "memory");
    } else {
      XB_SPIN(xb_ld(&bar[XB_XGEN(b.x)]) == gen, bar);
      __builtin_amdgcn_fence(__ATOMIC_ACQUIRE, "agent");
      asm volatile("s_waitcnt vmcnt(0)" ::: "memory");
    }
  }
  __syncthreads();
}

extern "C" __global__ void __launch_bounds__(256, 2) mega(Params p) {
  extern __shared__ __attribute__((aligned(16))) char smem[];
  cg::grid_group grid = cg::this_grid();
#define TIDVARS                                                                  \
  int tid = threadIdx.x;                                                         \
  asm volatile("" : "+v"(tid));                                                  \
  const int lane = tid & 63, w = tid >> 6, l15 = lane & 15, g4 = lane >> 4;      \
  (void)lane; (void)w; (void)l15; (void)g4;
  const int nblk = gridDim.x, bid = blockIdx.x;
  char* ws = p.ws;
  XcdBarrier xb;
  xb.bar = (unsigned*)(ws + OFF_CTL + 4096); xb.x = 0; xb.st = (volatile unsigned*)(smem + 73712);
  if (p.phase_lo < p.phase_hi) {
    if (threadIdx.x < 2) xb.st[threadIdx.x] = 0u;
    __syncthreads();
    xb = xcd_barrier_post((unsigned*)(ws + OFF_CTL + 4096), (volatile unsigned*)(smem + 73712));
    grid.sync();
  }
  u16* hbuf = (u16*)(ws + OFF_H);
  u16* qbuf = (u16*)(ws + OFF_Q);
  u16* gfbuf = (u16*)(ws + OFF_GF);
  u16* ubuf = (u16*)(ws + OFF_U);
  u16* gsbuf = (u16*)(ws + OFF_GS);
  u16* ys5a = (u16*)(ws + OFF_YS5A);
  u16* qmbuf = (u16*)(ws + OFF_QM);
  u16* gmbuf = (u16*)(ws + OFF_GM);
  u16* merged = (u16*)(ws + OFF_MERGED);
  u16* WinT = (u16*)(ws + OFF_WINT);
  u16* WglT = (u16*)(ws + OFF_WGLT);
  u16* WkvT = (u16*)(ws + OFF_WKVT);
  u16* WoutT = (u16*)(ws + OFF_WOUTT);
  u16* WpfT = (u16*)(ws + OFF_WPFT);
  u16* WpsT = (u16*)(ws + OFF_WPST);
  u16* WpmT = (u16*)(ws + OFF_WPMT);
  u16* WgluT = (u16*)(ws + OFF_WGLUT);
  u16* memn = (u16*)(ws + OFF_MEMN);
  u16* mkbuf = (u16*)(ws + OFF_MK);
  u16* mvT = (u16*)(ws + OFF_MVT);
  float* logf = (float*)(ws + OFF_LOGF);
  float* Fbuf = (float*)(ws + OFF_F);
  float2* abar = (float2*)(ws + OFF_S5AB);
  float* bbar = (float*)(ws + OFF_S5BB);
  float2* Sst = (float2*)(ws + OFF_S5S);
  float* part = (float*)(ws + OFF_PART);
  unsigned* ctl = (unsigned*)(ws + OFF_CTL);
  u16* kbuf = (u16*)p.out;
  u16* vT = (u16*)((char*)p.out + 48 * MiB);

  {
    if (PH(0)) {
      TIDVARS
      if (bid == 0 && tid < 128) ctl[tid] = 0u;
      float* tile = (float*)smem;
      for (int ti = bid; ti < 3344; ti += nblk) {
        const float* src; int ld, col0, K; u16* dst; int tt;
        if (ti < 576) { src = p.w_in; ld = 8716; col0 = 0; K = 1024; dst = WinT; tt = ti; }
        else if (ti < 1408) { src = p.w_in; ld = 8716; col0 = 2316; K = 1024; dst = WinT + (size_t)2304 * KLD; tt = ti - 576; }
        else if (ti < 2176) { src = p.w_in; ld = 8716; col0 = 5644; K = 1024; dst = WglT; tt = ti - 1408; }
        else if (ti < 2432) { src = p.w_mem_kv; ld = 1024; col0 = 0; K = 1024; dst = WkvT; tt = ti - 2176; }
        else if (ti < 2688) { src = p.w_out; ld = 1024; col0 = 0; K = 1024; dst = WoutT; tt = ti - 2432; }
        else if (ti < 2880) { src = p.w_pf; ld = 1024; col0 = 0; K = 768; dst = WpfT; tt = ti - 2688; }
        else if (ti < 3072) { src = p.w_ps; ld = 1024; col0 = 0; K = 768; dst = WpsT; tt = ti - 2880; }
        else if (ti < 3200) { src = p.w_pm; ld = 1024; col0 = 0; K = 512; dst = WpmT; tt = ti - 3072; }
        else { src = p.w_glu; ld = 768; col0 = 0; K = 768; dst = WgluT; tt = ti - 3200; }
        const int nkt = K >> 6;
        const int dld = (K == 1024) ? KLD : K;
        const int k0 = (tt % nkt) * 64, n0 = (tt / nkt) * 64;
#pragma unroll 4
        for (int i = 0; i < 16; ++i) {
          int k = i * 4 + w, n = lane;
          tile[k * 65 + n] = src[(size_t)(k0 + k) * ld + col0 + n0 + n];
        }
        __syncthreads();
#pragma unroll 4
        for (int i = 0; i < 16; ++i) {
          int n = i * 4 + w, k = lane;
          dst[(size_t)(n0 + n) * dld + k0 + k] = f2bf(tile[k * 65 + n]);
        }
        __syncthreads();
      }
      float* wfl = (float*)smem;
      for (int idx = tid; idx < 12288; idx += 256) {
        int k = idx / 12, j = idx - k * 12;
        wfl[j * 1024 + k] = p.w_in[(size_t)k * 8716 + 2304 + j];
      }
      __syncthreads();
      for (int row = bid * 4 + w; row < T_ + 1024; row += nblk * 4) {
        const bool isx = row < T_;
        const float* src = isx ? p.x + (size_t)row * 1024 : p.mem + (size_t)(row - T_) * 1024;
        const float* gsrc = isx ? p.g_norm : p.g_mem_norm;
        u16* dst = isx ? hbuf + (size_t)row * KLD : memn + (size_t)(row - T_) * KLD;
        float4 xv[4];
        float ss = 0.f;
#pragma unroll
        for (int i = 0; i < 4; ++i) {
          xv[i] = *(const float4*)(src + i * 256 + lane * 4);
          ss += xv[i].x * xv[i].x + xv[i].y * xv[i].y + xv[i].z * xv[i].z + xv[i].w * xv[i].w;
        }
        ss = wave_sum(ss);
        const float rstd = rsqrtf(ss * (1.f / 1024.f) + 1e-6f);
#pragma unroll
        for (int i = 0; i < 4; ++i) {
          float4 gv = *(const float4*)(gsrc + i * 256 + lane * 4);
          xv[i].x *= rstd * gv.x; xv[i].y *= rstd * gv.y; xv[i].z *= rstd * gv.z; xv[i].w *= rstd * gv.w;
          u32x2 o = {pack2(xv[i].x, xv[i].y), pack2(xv[i].z, xv[i].w)};
          *(u32x2*)(dst + i * 256 + lane * 4) = o;
        }
        if (isx) {
          float myfl = 0.f;
#pragma unroll
          for (int j = 0; j < 12; ++j) {
            float a = 0.f;
#pragma unroll
            for (int i = 0; i < 4; ++i) {
              float4 wv = *(const float4*)(wfl + j * 1024 + i * 256 + lane * 4);
              a += xv[i].x * wv.x + xv[i].y * wv.y + xv[i].z * wv.z + xv[i].w * wv.w;
            }
            a = wave_sum(a);
            if (lane == j) myfl = a;
          }
          if (lane < 12) {
            float xx = myfl + p.b_forget[lane];
            float lf = fminf(xx, 0.f) - log1pf(__expf(-fabsf(xx)));
            const int b = row >> 13, t = row & (L_ - 1);
            logf[(size_t)(b * 12 + lane) * L_ + t] = lf;
          }
        }
      }
      {
        const int gid = bid * 256 + tid;
        if (gid < 3072) {
          const int g = gid >> 6;
          const float step = expf(p.log_step[g]);
          const float lr = p.lam_re[gid], li = p.lam_im[gid];
          const float mag = expf(lr * step);
          const float ar = mag * cosf(li * step), ai = mag * sinf(li * step);
          const float den = lr * lr + li * li;
          const float nr = ar - 1.f, ni = ai;
          const float fr = (nr * lr + ni * li) / den, fi = (ni * lr - nr * li) / den;
          abar[gid] = make_float2(ar, ai);
#pragma unroll
          for (int h = 0; h < 16; ++h) {
            const float br = p.b_re[(size_t)gid * 16 + h], bi = p.b_im[(size_t)gid * 16 + h];
            bbar[(size_t)gid * 32 + h] = fr * br - fi * bi;
            bbar[(size_t)gid * 32 + 16 + h] = fr * bi + fi * br;
          }
        }
      }
      __syncthreads();
    }
    SYNC_BEFORE(1);
    if (PH(1)) {
      TIDVARS
      float* sm = (float*)smem;
      for (int seq = bid; seq < 48; seq += nblk) {
        const float* src = logf + (size_t)seq * L_ + tid * 32;
        float* dst = Fbuf + (size_t)seq * L_ + tid * 32;
        float v[32];
#pragma unroll
        for (int i = 0; i < 8; ++i) {
          float4 t = *(const float4*)(src + i * 4);
          v[4 * i] = t.x; v[4 * i + 1] = t.y; v[4 * i + 2] = t.z; v[4 * i + 3] = t.w;
        }
        float run = 0.f;
#pragma unroll
        for (int i = 0; i < 32; ++i) { run += v[i]; v[i] = run; }
        float incl = run;
#pragma unroll
        for (int o = 1; o < 64; o <<= 1) {
          float t = __shfl_up(incl, o);
          if (lane >= o) incl += t;
        }
        if (lane == 63) sm[w] = incl;
        __syncthreads();
        float base = incl - run;
        for (int w2 = 0; w2 < w; ++w2) base += sm[w2];
#pragma unroll
        for (int i = 0; i < 8; ++i) {
          float4 t = make_float4(v[4 * i] + base, v[4 * i + 1] + base, v[4 * i + 2] + base, v[4 * i + 3] + base);
          *(float4*)(dst + i * 4) = t;
        }
        __syncthreads();
      }
      for (int v = bid; v < 11264 + 64; v += nblk) {
        const u16 *A, *Bt;
        int m0, n0;
        bool kvtile = v >= 11264;
        if (!kvtile) {
          int mt, nt;
          swz(v, 44, 4, mt, nt);
          m0 = mt * 128; n0 = nt * 128;
          A = hbuf + (size_t)m0 * KLD; Bt = WinT + (size_t)n0 * KLD;
        } else {
          int kv = v - 11264;
          m0 = (kv >> 3) * 128; n0 = (kv & 7) * 128;
          A = memn + (size_t)m0 * KLD; Bt = WkvT + (size_t)n0 * KLD;
        }
        const bool transp = kvtile ? (n0 >= 512) : (n0 >= 1536 && n0 < 2304);
        f32x4 acc[4][4];
        zero_acc(acc);
        if (transp) {
          gemm_core<false, 1>(acc, A, KLD, Bt, KLD, 1024, smem);
          if (kvtile) epi_transposed(acc, mvT, m0, n0 - 512, 4, 7, 8);
          else epi_transposed(acc, vT, m0, n0 - 1536, 12, 6, 13);
        } else {
          gemm_core<true>(acc, A, KLD, Bt, KLD, 1024, smem);
          u16* dst; int ld, c0, mode;
          if (kvtile) { dst = mkbuf; ld = 512; c0 = n0; mode = 0; }
          else if (n0 < 768) { dst = qbuf; ld = 768; c0 = n0; mode = 1; }
          else if (n0 < 1536) { dst = kbuf; ld = 768; c0 = n0 - 768; mode = 0; }
          else if (n0 < 3072) { dst = gfbuf; ld = 768; c0 = n0 - 2304; mode = 2; }
          else if (n0 < 3840) { dst = ubuf; ld = 768; c0 = n0 - 3072; mode = 0; }
          else if (n0 < 4608) { dst = gsbuf; ld = 768; c0 = n0 - 3840; mode = 2; }
          else if (n0 < 5120) { dst = qmbuf; ld = 512; c0 = n0 - 4608; mode = 0; }
          else { dst = gmbuf; ld = 512; c0 = n0 - 5120; mode = 2; }
          epi_rowmajor(acc, dst, ld, m0, c0, mode);
          if (!kvtile && n0 >= 768 && n0 < 1536) {
            float mxv = 0.f;
#pragma unroll
            for (int i = 0; i < 4; ++i) {
              float ss = 0.f;
#pragma unroll
              for (int j = 0; j < 4; ++j)
#pragma unroll
                for (int r = 0; r < 4; ++r) {
                  const float v = __uint_as_float(((unsigned)f2bf(acc[i][j][r])) << 16);
                  ss += v * v;
                }
              ss += __shfl_xor(ss, 16);
              ss += __shfl_xor(ss, 32);
              mxv = fmaxf(mxv, ss);
            }
#pragma unroll
            for (int o = 1; o < 16; o <<= 1) mxv = fmaxf(mxv, __shfl_xor(mxv, o));
            if (lane == 0) atomicMax(&ctl[(m0 >> 13) * 12 + ((n0 - 768) >> 6) + (w & 1)], __float_as_uint(mxv));
          }
        }
      }
    }
    SYNC_BEFORE(2);
    if (PH(2)) {
      TIDVARS
      int* qslot = (int*)(smem + 73696);
#define NEXT_ITEM(CTR)                                        \
      {                                                       \
        if (tid == 0) *qslot = (int)atomicAdd(&ctl[CTR], 1u); \
        __syncthreads();                                      \
        it = *qslot;                                          \
        __syncthreads();                                      \
      }
      int it;
      for (;;) {
        NEXT_ITEM(64);
        if (it >= 3072) break;
        {
#ifndef NO_FOX
          const int qt = 63 - it / 48, bh = it % 48, b = bh / 12, h = bh % 12;
          const int q0 = qt * 128;
          const size_t qoff = ((size_t)(b * L_ + q0)) * 768 + h * 64;
          attn_item<64, true, true, 2>(qbuf + qoff, 768, kbuf + (size_t)b * L_ * 768 + h * 64, 768,
                              vT + (size_t)(b * 12 + h) * 64 * L_, L_, Fbuf + (size_t)(b * 12 + h) * L_, q0, 2 * qt + 2,
                              gfbuf + qoff, qbuf + qoff, 1.f, sqrtf(__uint_as_float(ctl[b * 12 + h])), smem);
#endif
        }
      }
      for (;;) {
        NEXT_ITEM(65);
        if (it >= 2048) break;
        {
#ifndef NO_MEM
          const int im = it;
          const int hm = im & 3, qt = (im >> 2) & 127, b = im >> 9;
          const int q0 = qt * 64;
          const size_t qoff = ((size_t)(b * L_ + q0)) * 512 + hm * 128;
          attn_item<128, false, false, 1>(qmbuf + qoff, 512, mkbuf + (size_t)b * 256 * 512 + hm * 128, 512,
                                mvT + (size_t)(b * 4 + hm) * 128 * 256, 256, nullptr, q0, 4,
                                gmbuf + qoff, qmbuf + qoff, 0.08838834764831845f, 0.f, smem);
#endif
        }
      }
      for (;;) {
        NEXT_ITEM(66);
        if (it >= 1536) break;
        {
#ifndef NO_S5P1
          const int wi = it * 4 + w;
          const int g = wi % 48, cg = (wi / 48) & 31, b = wi / (48 * 32);
          char* xs = smem + w * 12800;
          const int gp = g * 64 + lane;
          bf16x8 ah[8], al[8];
          s5_load_bfrag(bbar, g, l15, g4, ah, al);
          const float2 ab = abar[gp];
#pragma unroll 1
          for (int ci = 0; ci < 4; ++ci) {
          const int c = cg * 4 + ci;
          const u16* ub0 = ubuf + ((size_t)(b * L_ + c * 64 + l15)) * 768 + g * 16;
          u32x4 uq[4];
#pragma unroll
          for (int sub = 0; sub < 4; ++sub) {
            uq[sub] = u32x4{0u, 0u, 0u, 0u};
            if (g4 < 2) uq[sub] = *(const u32x4*)(ub0 + (size_t)sub * 16 * 768 + g4 * 8);
          }
          float hr = 0.f, hi = 0.f;
#pragma unroll
          for (int sub = 0; sub < 4; ++sub) {
            s5_xsub(uq[sub], ah, al, xs, l15, g4);
            asm volatile("s_waitcnt lgkmcnt(0)" ::: "memory");
#pragma unroll
            for (int tt = 0; tt < 16; ++tt) {
              const float xr = *(const float*)(xs + tt * 528 + lane * 4);
              const float xi = *(const float*)(xs + tt * 528 + 256 + lane * 4);
              const float nhr = ab.x * hr - ab.y * hi + xr;
              const float nhi = ab.x * hi + ab.y * hr + xi;
              hr = nhr; hi = nhi;
            }
            asm volatile("s_waitcnt lgkmcnt(0)" ::: "memory");
          }
          Sst[((size_t)(b * 128 + c) * 48 + g) * 64 + lane] = make_float2(hr, hi);
          }
          __syncthreads();
#endif
        }
      }
    }
    SYNC_BEFORE(3);
    if (PH(3)) {
      TIDVARS
      for (int wi = bid * 4 + w; wi < 192; wi += nblk * 4) {
        const int g = wi % 48, b = wi / 48;
        const float2 ab = abar[g * 64 + lane];
        float a64r = ab.x, a64i = ab.y;
#pragma unroll
        for (int q = 0; q < 6; ++q) {
          const float nr = a64r * a64r - a64i * a64i, ni = 2.f * a64r * a64i;
          a64r = nr; a64i = ni;
        }
        float2* sp = Sst + ((size_t)(b * 128) * 48 + g) * 64 + lane;
        float hr = 0.f, hi = 0.f;
        for (int cc = 0; cc < 128; cc += 16) {
          float2 sv[16];
#pragma unroll
          for (int q = 0; q < 16; ++q) sv[q] = sp[(size_t)(cc + q) * 48 * 64];
#pragma unroll
          for (int q = 0; q < 16; ++q) {
            sp[(size_t)(cc + q) * 48 * 64] = make_float2(hr, hi);
            const float nhr = a64r * hr - a64i * hi + sv[q].x;
            const float nhi = a64r * hi + a64i * hr + sv[q].y;
            hr = nhr; hi = nhi;
          }
        }
      }
    }
    SYNC_BEFORE(4);
    if (PH(4)) {
      TIDVARS
      for (int it = bid; it < 1536; it += nblk) {
        const int wi = it * 4 + w;
        const int g = wi % 48, cg = (wi / 48) & 31, b = wi / (48 * 32);
        char* xs = smem + w * 12800;
        char* stt = xs + 8448;
        const int gp = g * 64 + lane;
        bf16x8 ah[8], al[8];
        s5_load_bfrag(bbar, g, l15, g4, ah, al);
        const float2 ab = abar[gp];
        bf16x8 cf[4];
#pragma unroll
        for (int s = 0; s < 4; ++s) {
          const float* cs = (s < 2 ? p.c_re : p.c_im) + (size_t)(g * 16 + l15) * 64 + (s & 1) * 32 + g4 * 8;
          float4 t0 = *(const float4*)cs, t1 = *(const float4*)(cs + 4);
          const float sg = (s < 2) ? 1.f : -1.f;
          u32x4 t = {pack2(sg * t0.x, sg * t0.y), pack2(sg * t0.z, sg * t0.w), pack2(sg * t1.x, sg * t1.y), pack2(sg * t1.z, sg * t1.w)};
          cf[s] = __builtin_bit_cast(bf16x8, t);
        }
        const float4 dsk = *(const float4*)(p.s5_d + g * 16 + g4 * 4);
#pragma unroll 1
        for (int ci = 0; ci < 4; ++ci) {
        const int c = cg * 4 + ci;
        const u16* ub0 = ubuf + ((size_t)(b * L_ + c * 64 + l15)) * 768 + g * 16;
        const float2 hc = Sst[((size_t)(b * 128 + c) * 48 + g) * 64 + lane];
        float hr = hc.x, hi = hc.y;
        u32x4 uq[4];
        u32x2 uvq[4];
#pragma unroll
        for (int sub = 0; sub < 4; ++sub) {
          uq[sub] = u32x4{0u, 0u, 0u, 0u};
          if (g4 < 2) uq[sub] = *(const u32x4*)(ub0 + (size_t)sub * 16 * 768 + g4 * 8);
          uvq[sub] = *(const u32x2*)(ub0 + (size_t)sub * 16 * 768 + g4 * 4);
        }
        asm volatile("s_waitcnt lgkmcnt(0)" ::: "memory");
#pragma unroll
        for (int sub = 0; sub < 4; ++sub) {
          s5_xsub(uq[sub], ah, al, xs, l15, g4);
          asm volatile("s_waitcnt lgkmcnt(0)" ::: "memory");
#pragma unroll
          for (int tt = 0; tt < 16; ++tt) {
            const float xr = *(const float*)(xs + tt * 528 + lane * 4);
            const float xi = *(const float*)(xs + tt * 528 + 256 + lane * 4);
            const float nhr = ab.x * hr - ab.y * hi + xr;
            const float nhi = ab.x * hi + ab.y * hr + xi;
            hr = nhr; hi = nhi;
            *(u16*)(stt + tt * 272 + lane * 2) = f2bf(hr);
            *(u16*)(stt + tt * 272 + 128 + lane * 2) = f2bf(hi);
          }
          asm volatile("s_waitcnt lgkmcnt(0)" ::: "memory");
          f32x4 y = {0, 0, 0, 0};
#pragma unroll
          for (int s = 0; s < 4; ++s) {
            bf16x8 bfr = *(const bf16x8*)(stt + l15 * 272 + s * 64 + g4 * 16);
            y = mfma16(cf[s], bfr, y);
          }
          const int t = sub * 16 + l15;
          const u32x2 uv = uvq[sub];
          float o0 = gelu_tanh(y[0] + dsk.x * bflo(uv[0]));
          float o1 = gelu_tanh(y[1] + dsk.y * bfhi(uv[0]));
          float o2 = gelu_tanh(y[2] + dsk.z * bflo(uv[1]));
          float o3 = gelu_tanh(y[3] + dsk.w * bfhi(uv[1]));
          u32x2 o = {pack2(o0, o1), pack2(o2, o3)};
          *(u32x2*)(ys5a + ((size_t)(b * L_ + c * 64 + t)) * 768 + g * 16 + g4 * 4) = o;
          asm volatile("s_waitcnt lgkmcnt(0)" ::: "memory");
        }
        }
        __syncthreads();
      }
    }
    SYNC_BEFORE(5);
    if (PH(5)) {
      TIDVARS
      for (int v = bid; v < 256 * 6; v += nblk) {
        int mt, nt;
        swz(v, 6, 6, mt, nt);
        const int m0 = mt * 128, n0 = nt * 128;
        f32x4 acc[4][4];
        zero_acc(acc);
        gemm_core<true>(acc, ys5a + (size_t)m0 * 768, 768, WgluT + (size_t)n0 * 768, 768, 768, smem);
        const int wr = w >> 1, wc = w & 1;
#pragma unroll
        for (int i = 0; i < 4; ++i) {
          const size_t row = (size_t)(m0 + wr * 64 + i * 16 + l15);
#pragma unroll
          for (int j = 0; j < 4; ++j) {
            const int n = n0 + wc * 64 + j * 16 + g4 * 4;
            const float4 bg = *(const float4*)(p.b_glu + n);
            const u32x2 av = *(const u32x2*)(ys5a + row * 768 + n);
            const u32x2 sv = *(const u32x2*)(gsbuf + row * 768 + n);
            float o0 = bflo(av[0]) * sigmoidf_(acc[i][j][0] + bg.x) * bflo(sv[0]);
            float o1 = bfhi(av[0]) * sigmoidf_(acc[i][j][1] + bg.y) * bfhi(sv[0]);
            float o2 = bflo(av[1]) * sigmoidf_(acc[i][j][2] + bg.z) * bflo(sv[1]);
            float o3 = bfhi(av[1]) * sigmoidf_(acc[i][j][3] + bg.w) * bfhi(sv[1]);
            u32x2 o = {pack2(o0, o1), pack2(o2, o3)};
            *(u32x2*)(ubuf + row * 768 + n) = o;
          }
        }
      }
    }
    SYNC_BEFORE(6);
    if (PH(6)) {
      TIDVARS
      for (int v = bid; v < 256 * 8; v += nblk) {
        int mt, nt;
        swz(v, 8, 4, mt, nt);
        const int m0 = mt * 128, n0 = nt * 128;
        const int wr = w >> 1, wc = w & 1;
        char* gstash = ws + OFF_GATE + (size_t)bid * 32768;
        char* mstash = ws + OFF_GF + (size_t)bid * 65536;
        const unsigned toff = (unsigned)tid * 16u;
#pragma unroll 1
        for (int stp = 0; stp < 6; ++stp) {
          const int br = stp >> 1;
          const u16* Ab; const u16* Wb; int Kb; int ldk;
          if (!(stp & 1)) { Ab = hbuf + (size_t)m0 * KLD; Wb = WglT + (size_t)(br * 1024 + n0) * KLD; Kb = 1024; }
          else if (br == 0) { Ab = qbuf + (size_t)m0 * 768; Wb = WpfT + (size_t)n0 * 768; Kb = 768; }
          else if (br == 1) { Ab = ubuf + (size_t)m0 * 768; Wb = WpsT + (size_t)n0 * 768; Kb = 768; }
          else { Ab = qmbuf + (size_t)m0 * 512; Wb = WpmT + (size_t)n0 * 512; Kb = 512; }
          f32x4 acc[4][4];
          zero_acc(acc);
          ldk = (Kb == 1024) ? KLD : Kb;
          gemm_core<true, 1>(acc, Ab, ldk, Wb, ldk, Kb, smem);
          if (!(stp & 1)) {
#pragma unroll
            for (int j = 0; j < 4; ++j) {
              const float4 bm = *(const float4*)(p.b_merge + br * 1024 + n0 + wc * 64 + j * 16 + g4 * 4);
#pragma unroll
              for (int i = 0; i < 4; i += 2) {
                u32x4 gq = {pack2(sigmoidf_(acc[i][j][0] + bm.x), sigmoidf_(acc[i][j][1] + bm.y)),
                            pack2(sigmoidf_(acc[i][j][2] + bm.z), sigmoidf_(acc[i][j][3] + bm.w)),
                            pack2(sigmoidf_(acc[i + 1][j][0] + bm.x), sigmoidf_(acc[i + 1][j][1] + bm.y)),
                            pack2(sigmoidf_(acc[i + 1][j][2] + bm.z), sigmoidf_(acc[i + 1][j][3] + bm.w))};
                *(u32x4*)(gstash + (j * 2 + (i >> 1)) * 4096 + toff) = gq;
              }
            }
          } else {
#pragma unroll
            for (int j = 0; j < 4; ++j)
#pragma unroll
              for (int i = 0; i < 4; i += 2) {
                const u32x4 gq = *(const u32x4*)(gstash + (j * 2 + (i >> 1)) * 4096 + toff);
                acc[i][j][0] *= bflo(gq[0]); acc[i][j][1] *= bfhi(gq[0]);
                acc[i][j][2] *= bflo(gq[1]); acc[i][j][3] *= bfhi(gq[1]);
                acc[i + 1][j][0] *= bflo(gq[2]); acc[i + 1][j][1] *= bfhi(gq[2]);
                acc[i + 1][j][2] *= bflo(gq[3]); acc[i + 1][j][3] *= bfhi(gq[3]);
              }
            if (br > 0) {
#pragma unroll
              for (int i = 0; i < 4; ++i)
#pragma unroll
                for (int j = 0; j < 4; ++j) {
                  const f32x4 pv = *(const f32x4*)(mstash + (i * 4 + j) * 4096 + toff);
                  acc[i][j] += pv;
                }
            }
            if (br < 2) {
#pragma unroll
              for (int i = 0; i < 4; ++i)
#pragma unroll
                for (int j = 0; j < 4; ++j) *(f32x4*)(mstash + (i * 4 + j) * 4096 + toff) = acc[i][j];
            } else {
              epi_rowmajor(acc, merged, KLD, m0, n0, 0);
            }
          }
        }
      }
    }
    SYNC_BEFORE(7);
    if (PH(7)) {
      TIDVARS
      for (int v = bid; v < 256 * 8; v += nblk) {
        int mt, nt;
        swz(v, 8, 4, mt, nt);
        const int m0 = mt * 128, n0 = nt * 128;
        const int wr = w >> 1, wc = w & 1;
        f32x4 acc[4][4];
        zero_acc(acc);
        gemm_core<true>(acc, merged + (size_t)m0 * KLD, KLD, WoutT + (size_t)n0 * KLD, KLD, 1024, smem);
#pragma unroll
        for (int i = 0; i < 4; ++i) {
          const size_t row = (size_t)(m0 + wr * 64 + i * 16 + l15);
          float ss = 0.f;
#pragma unroll
          for (int j = 0; j < 4; ++j) {
            const int n = n0 + wc * 64 + j * 16 + g4 * 4;
            const float4 xv = *(const float4*)(p.x + row * 1024 + n);
            float4 o = make_float4(xv.x + acc[i][j][0], xv.y + acc[i][j][1], xv.z + acc[i][j][2], xv.w + acc[i][j][3]);
            ss += o.x * o.x + o.y * o.y + o.z * o.z + o.w * o.w;
            *(float4*)(p.out + row * 1024 + n) = o;
          }
          ss += __shfl_xor(ss, 16);
          ss += __shfl_xor(ss, 32);
          if (g4 == 0) part[row * 16 + nt * 2 + wc] = ss;
        }
      }
    }
    SYNC_BEFORE(8);
    if (PH(8)) {
      TIDVARS
      for (int row = bid * 4 + w; row < T_; row += nblk * 4) {
        float ss = (lane < 16) ? part[(size_t)row * 16 + lane] : 0.f;
        ss = wave_sum(ss);
        const float rstd = rsqrtf(ss * (1.f / 1024.f) + 1e-6f);
        float* o = p.out + (size_t)row * 1024;
#pragma unroll
        for (int i = 0; i < 4; ++i) {
          float4 v = *(const float4*)(o + i * 256 + lane * 4);
          const float4 gv = *(const float4*)(p.g_final + i * 256 + lane * 4);
          v.x *= rstd * gv.x; v.y *= rstd * gv.y; v.z *= rstd * gv.z; v.w *= rstd * gv.w;
          *(float4*)(o + i * 256 + lane * 4) = v;
        }
      }
    }
  }
}

extern "C" void kernel_launch(void* const* d_in, const int* in_sizes, int n_in, void* d_out, int out_size, void* d_ws,
                              size_t ws_size, hipStream_t stream) {
  static int grid_blocks = 0;
  if (!grid_blocks) {
    if (ws_size < WS_END || n_in != 23) {
      fprintf(stderr, "kernel_launch: unexpected ws_size %zu (need %zu) or n_in %d\n", ws_size, (size_t)WS_END, n_in);
      grid_blocks = -1;
      return;
    }
    int dev = 0, cus = 0, per_cu = 0;
    (void)hipGetDevice(&dev);
    (void)hipDeviceGetAttribute(&cus, hipDeviceAttributeMultiprocessorCount, dev);
    (void)hipFuncSetAttribute((const void*)mega, hipFuncAttributeMaxDynamicSharedMemorySize, LDS_BYTES);
    (void)hipOccupancyMaxActiveBlocksPerMultiprocessor(&per_cu, (const void*)mega, 256, LDS_BYTES);
    per_cu = (per_cu >= 2) ? 2 : 1;
    grid_blocks = cus * per_cu;
  }
  if (grid_blocks < 0) return;
  Params p{};
  const float** pp = (const float**)&p;
  for (int i = 0; i < 23; ++i) pp[i] = (const float*)d_in[i];
  p.out = (float*)d_out;
  p.ws = (char*)d_ws;
#if COOP
  (void)hipMemsetAsync((char*)d_ws + OFF_CTL + 4096, 0, XCD_BAR_WORDS * 4, stream);
  p.phase_lo = 0;
  p.phase_hi = NPHASE - 1;
  void* args[] = {&p};
  hipError_t e = hipLaunchCooperativeKernel((const void*)mega, dim3(grid_blocks), dim3(256), args, LDS_BYTES, stream);
  if (e != hipSuccess) fprintf(stderr, "cooperative launch failed: %s (grid %d)\n", hipGetErrorString(e), grid_blocks);
#else
  for (int ph = 0; ph < NPHASE; ++ph) {
    p.phase_lo = ph;
    p.phase_hi = ph;
    hipLaunchKernelGGL(mega, dim3(grid_blocks), dim3(256), LDS_BYTES, stream, p);
#ifdef PROBE_DUP
    if (ph == PROBE_DUP) {
      for (int rep = 0; rep < 2; ++rep) {
        if (ph == 2) { p.phase_lo = p.phase_hi = 1; hipLaunchKernelGGL(mega, dim3(grid_blocks), dim3(256), LDS_BYTES, stream, p); p.phase_lo = p.phase_hi = 2; }
        hipLaunchKernelGGL(mega, dim3(grid_blocks), dim3(256), LDS_BYTES, stream, p);
      }
    }
#endif
  }
#endif
}
```

```cpp
#include <hip/hip_runtime.h>
#include <hip/hip_cooperative_groups.h>
#include <stdint.h>
#include <stdio.h>
namespace cg = cooperative_groups;

#ifndef COOP
#define COOP 1
#define XCD_MODE 0
#endif

#define DI __device__ __forceinline__
#ifdef ONLY_PHASE
#define PH(n) ((n) == ONLY_PHASE && p.phase_lo <= (n) && (n) <= p.phase_hi)
#else
#define PH(n) (p.phase_lo <= (n) && (n) <= p.phase_hi)
#endif
#define SYNC_BEFORE(n)                                        \
  if (p.phase_lo < (n) && (n) <= p.phase_hi) {                \
    xcd_barrier(xb);                                          \
  }
typedef unsigned short u16;
using bf16x8 = __attribute__((ext_vector_type(8))) short;
using f32x4 = __attribute__((ext_vector_type(4))) float;
using u32x4 = __attribute__((ext_vector_type(4))) unsigned;
using u32x2 = __attribute__((ext_vector_type(2))) unsigned;

constexpr int T_ = 32768, L_ = 8192;
constexpr int LDS_BYTES = 73728;
constexpr int NPHASE = 9;

constexpr size_t MiB = 1u << 20;
constexpr float LOG2E = 1.4426950408889634f;
constexpr float QSCALE = 0.125f * LOG2E;
constexpr int KLD = 1088;
constexpr size_t OFF_H = 0;
constexpr size_t OFF_Q = 68 * MiB;
constexpr size_t OFF_GF = 116 * MiB;
constexpr size_t OFF_U = 164 * MiB;
constexpr size_t OFF_GS = 212 * MiB;
constexpr size_t OFF_YS5A = 260 * MiB;
constexpr size_t OFF_QM = 308 * MiB;
constexpr size_t OFF_GM = 340 * MiB;
constexpr size_t OFF_MERGED = 372 * MiB;
constexpr size_t OFF_WINT = 440 * MiB;
constexpr size_t OFF_WGLT = 453 * MiB;
constexpr size_t OFF_WKVT = 460 * MiB;
constexpr size_t OFF_WOUTT = 463 * MiB;
constexpr size_t OFF_WPFT = 466 * MiB;
constexpr size_t OFF_WPST = 468 * MiB;
constexpr size_t OFF_WPMT = 470 * MiB;
constexpr size_t OFF_WGLUT = 471 * MiB;
constexpr size_t OFF_MEMN = 473 * MiB;
constexpr size_t OFF_MK = 476 * MiB;
constexpr size_t OFF_MVT = 477 * MiB;
constexpr size_t OFF_LOGF = 478 * MiB;
constexpr size_t OFF_F = 480 * MiB;
constexpr size_t OFF_S5AB = 482 * MiB;
constexpr size_t OFF_S5BB = 483 * MiB;
constexpr size_t OFF_S5S = 484 * MiB;
constexpr size_t OFF_PART = 496 * MiB;
constexpr size_t OFF_GATE = OFF_GS;
constexpr size_t OFF_CTL = 498 * MiB;
constexpr size_t WS_END = 499 * MiB;

struct Params {
  const float *x, *mem, *g_norm, *g_mem_norm, *g_final, *w_in, *b_forget, *b_merge, *w_mem_kv;
  const float *lam_re, *lam_im, *log_step, *b_re, *b_im, *c_re, *c_im, *s5_d, *w_glu, *b_glu;
  const float *w_pf, *w_ps, *w_pm, *w_out;
  float* out;
  char* ws;
  int phase_lo, phase_hi;
};

DI unsigned pack2(float a, float b) {
  unsigned r;
  asm volatile("v_cvt_pk_bf16_f32 %0, %1, %2" : "=v"(r) : "v"(a), "v"(b));
  return r;
}
DI u32x4 pack8_mfma(float a0, float a1, float a2, float a3, float a4, float a5, float a6, float a7) {
  u32x4 r;
  asm volatile("v_cvt_pk_bf16_f32 %0, %4, %5\n\tv_cvt_pk_bf16_f32 %1, %6, %7\n\tv_cvt_pk_bf16_f32 %2, %8, %9\n\tv_cvt_pk_bf16_f32 %3, %10, %11\n\ts_nop 1"
               : "=&v"(r[0]), "=&v"(r[1]), "=&v"(r[2]), "=&v"(r[3])
               : "v"(a0), "v"(a1), "v"(a2), "v"(a3), "v"(a4), "v"(a5), "v"(a6), "v"(a7));
  return r;
}
DI u16 f2bf(float x) { return (u16)(pack2(x, x) & 0xffffu); }
DI float bflo(unsigned v) { return __uint_as_float(v << 16); }
DI float bfhi(unsigned v) { return __uint_as_float(v & 0xffff0000u); }
DI float sigmoidf_(float x) { return 1.f / (1.f + __expf(-x)); }
DI float siluf_(float x) { return x / (1.f + __expf(-x)); }
DI float gelu_tanh(float x) {
  float z = 0.7978845608028654f * (x + 0.044715f * x * x * x);
  float e = __expf(2.f * z);
  float th = 1.f - 2.f / (e + 1.f);
  return 0.5f * x * (1.f + th);
}
DI float wave_sum(float v) {
#pragma unroll
  for (int o = 32; o > 0; o >>= 1) v += __shfl_xor(v, o);
  return v;
}
DI f32x4 mfma16(bf16x8 a, bf16x8 b, f32x4 c) { return __builtin_amdgcn_mfma_f32_16x16x32_bf16(a, b, c, 0, 0, 0); }

template <bool SWAP, int DEPTH = 1, bool LEAN = false>
DI void gemm_core(f32x4 (&acc)[4][4], const u16* __restrict__ A, int lda, const u16* __restrict__ Bt, int ldb, int K, char* smem) {
  const int tid = threadIdx.x, lane = tid & 63, w = tid >> 6, wr = w >> 1, wc = w & 1, l15 = lane & 15, g = lane >> 4;
  const int lrow = tid >> 3, lch = tid & 7;
  const char* ap = (const char*)A;
  const char* bp = (const char*)Bt;
  const unsigned aoff = (unsigned)(lrow * lda + lch * 8) * 2u;
  const unsigned boff = (unsigned)(lrow * ldb + lch * 8) * 2u;
  u32x4 ra0[4], rb0[4], ra1[4], rb1[4];
  const int nk = K >> 6;
#define G_LOAD(RA, RB, KT)                                                        \
  _Pragma("unroll") for (int c = 0; c < 4; ++c) {                                 \
    RA[c] = *(const u32x4*)(ap + ((size_t)c * 64 * lda + (KT) * 128) + aoff);     \
    RB[c] = *(const u32x4*)(bp + ((size_t)c * 64 * ldb + (KT) * 128) + boff);     \
  }
#define G_STORE(RA, RB, BO)                                                       \
  _Pragma("unroll") for (int c = 0; c < 4; ++c) {                                 \
    *(u32x4*)(wbase + (BO) + c * 32 * 128) = RA[c];                               \
    *(u32x4*)(wbase + (BO) + 16384 + c * 32 * 128) = RB[c];                       \
  }
#define G_COMPUTE_FULL(BO)                                                             \
  {                                                                               \
    bf16x8 af[2][4], bfr[2][4];                                                   \
    _Pragma("unroll") for (int i = 0; i < 4; ++i) af[0][i] = *(const bf16x8*)(ard0 + (BO) + i * 16 * 128);  \
    _Pragma("unroll") for (int j = 0; j < 4; ++j) bfr[0][j] = *(const bf16x8*)(brd0 + (BO) + j * 16 * 128); \
    _Pragma("unroll") for (int i = 0; i < 4; ++i) af[1][i] = *(const bf16x8*)(ard1 + (BO) + i * 16 * 128);  \
    _Pragma("unroll") for (int j = 0; j < 4; ++j) bfr[1][j] = *(const bf16x8*)(brd1 + (BO) + j * 16 * 128); \
    __builtin_amdgcn_sched_barrier(0);                                            \
    __builtin_amdgcn_s_setprio(1);                                                \
    _Pragma("unroll") for (int s = 0; s < 2; ++s)                                 \
      _Pragma("unroll") for (int i = 0; i < 4; ++i)                               \
        _Pragma("unroll") for (int j = 0; j < 4; ++j)                             \
          acc[i][j] = SWAP ? mfma16(bfr[s][j], af[s][i], acc[i][j]) : mfma16(af[s][i], bfr[s][j], acc[i][j]); \
    __builtin_amdgcn_s_setprio(0);                                                \
  }
#define G_COMPUTE_LEAN(BO)                                                        \
  _Pragma("unroll") for (int s = 0; s < 2; ++s) {                                 \
    bf16x8 af[4];                                                                 \
    _Pragma("unroll") for (int i = 0; i < 4; ++i) af[i] = *(const bf16x8*)((s ? ard1 : ard0) + (BO) + i * 16 * 128);  \
    _Pragma("unroll") for (int j = 0; j < 4; ++j) {                               \
      const bf16x8 bfr = *(const bf16x8*)((s ? brd1 : brd0) + (BO) + j * 16 * 128);   \
      _Pragma("unroll") for (int i = 0; i < 4; ++i)                               \
        acc[i][j] = SWAP ? mfma16(bfr, af[i], acc[i][j]) : mfma16(af[i], bfr, acc[i][j]); \
    }                                                                             \
  }
#define G_COMPUTE(BO) if constexpr (LEAN) { G_COMPUTE_LEAN(BO) } else { G_COMPUTE_FULL(BO) }
  char* wbase = smem + lrow * 128 + ((lch ^ ((lrow >> 1) & 7)) << 4);
  const int hsw = l15 >> 1;
  const char* ard0 = smem + (wr * 64 + l15) * 128 + ((g ^ hsw) << 4);
  const char* ard1 = smem + (wr * 64 + l15) * 128 + (((4 + g) ^ hsw) << 4);
  const char* brd0 = smem + 16384 + (wc * 64 + l15) * 128 + ((g ^ hsw) << 4);
  const char* brd1 = smem + 16384 + (wc * 64 + l15) * 128 + (((4 + g) ^ hsw) << 4);
  if constexpr (DEPTH == 2) {
    G_LOAD(ra0, rb0, 0);
    G_LOAD(ra1, rb1, 1);
    G_STORE(ra0, rb0, 0);
    __syncthreads();
    for (int kt = 0; kt < nk; kt += 2) {
      if (kt + 2 < nk) G_LOAD(ra0, rb0, kt + 2);
      __builtin_amdgcn_sched_barrier(0);
      G_COMPUTE(0);
      __builtin_amdgcn_sched_barrier(0);
      G_STORE(ra1, rb1, 32768);
      __syncthreads();
      if (kt + 3 < nk) G_LOAD(ra1, rb1, kt + 3);
      __builtin_amdgcn_sched_barrier(0);
      G_COMPUTE(32768);
      __builtin_amdgcn_sched_barrier(0);
      if (kt + 2 < nk) G_STORE(ra0, rb0, 0);
      __syncthreads();
    }
  } else if constexpr (LEAN) {
#define G_LOADH(P, OFF, LD, KT)                                                   \
  _Pragma("unroll") for (int c = 0; c < 4; ++c) ra0[c] = *(const u32x4*)((P) + ((size_t)c * 64 * (LD) + (KT) * 128) + (OFF));
#define G_STOREH(BO)                                                              \
  _Pragma("unroll") for (int c = 0; c < 4; ++c) *(u32x4*)(wbase + (BO) + c * 32 * 128) = ra0[c];
#define G_COMPUTE_S(BO, S)                                                        \
  {                                                                               \
    bf16x8 af[4];                                                                 \
    _Pragma("unroll") for (int i = 0; i < 4; ++i) af[i] = *(const bf16x8*)((S ? ard1 : ard0) + (BO) + i * 16 * 128);  \
    _Pragma("unroll") for (int j = 0; j < 4; ++j) {                               \
      const bf16x8 bfr = *(const bf16x8*)((S ? brd1 : brd0) + (BO) + j * 16 * 128);   \
      _Pragma("unroll") for (int i = 0; i < 4; ++i)                               \
        acc[i][j] = SWAP ? mfma16(bfr, af[i], acc[i][j]) : mfma16(af[i], bfr, acc[i][j]); \
    }                                                                             \
  }
#define G_HALF(CUR, NXT, KTN)                                                     \
  {                                                                               \
    const int ktn_ = (KTN) < nk ? (KTN) : nk - 1;                                 \
    G_LOADH(ap, aoff, lda, ktn_)                                                  \
    __builtin_amdgcn_sched_barrier(0);                                            \
    G_COMPUTE_S(CUR, 0)                                                           \
    __builtin_amdgcn_sched_barrier(0);                                            \
    G_STOREH(NXT)                                                                 \
    G_LOADH(bp, boff, ldb, ktn_)                                                  \
    __builtin_amdgcn_sched_barrier(0);                                            \
    G_COMPUTE_S(CUR, 1)                                                           \
    __builtin_amdgcn_sched_barrier(0);                                            \
    G_STOREH((NXT) + 16384)                                                       \
    __syncthreads();                                                              \
  }
    G_LOADH(ap, aoff, lda, 0)
    G_STOREH(0)
    G_LOADH(bp, boff, ldb, 0)
    G_STOREH(16384)
    __syncthreads();
    for (int kt = 0; kt < nk; kt += 2) {
      G_HALF(0, 32768, kt + 1)
      G_HALF(32768, 0, kt + 2)
    }
#undef G_LOADH
#undef G_STOREH
#undef G_COMPUTE_S
#undef G_HALF
  } else {
    G_LOAD(ra0, rb0, 0);
    G_STORE(ra0, rb0, 0);
    __syncthreads();
    for (int kt = 0; kt < nk; kt += 2) {
      G_LOAD(ra0, rb0, kt + 1);
      __builtin_amdgcn_sched_barrier(0);
      G_COMPUTE(0);
      __builtin_amdgcn_sched_barrier(0);
      G_STORE(ra0, rb0, 32768);
      __syncthreads();
      if (kt + 2 < nk) G_LOAD(ra0, rb0, kt + 2);
      __builtin_amdgcn_sched_barrier(0);
      G_COMPUTE(32768);
      __builtin_amdgcn_sched_barrier(0);
      if (kt + 2 < nk) G_STORE(ra0, rb0, 0);
      __syncthreads();
    }
  }
#undef G_LOAD
#undef G_STORE
#undef G_COMPUTE
#undef G_COMPUTE_FULL
#undef G_COMPUTE_LEAN
}

DI void zero_acc(f32x4 (&acc)[4][4]) {
#pragma unroll
  for (int i = 0; i < 4; ++i)
#pragma unroll
    for (int j = 0; j < 4; ++j) acc[i][j] = f32x4{0.f, 0.f, 0.f, 0.f};
}

DI void swz(int v, int NT, int GN, int& mt, int& nt) {
#if XCD_MODE == 0
  int xcd = v & 7, j = v >> 3;
#else
  int xcd = (v & 511) >> 6, j = ((v >> 9) << 6) + (v & 63);
#endif
  int per_mg = 8 * NT;
  int mg = j / per_mg, r = j - mg * per_mg;
  int ng = r / (8 * GN), wv = r - ng * (8 * GN);
  mt = xcd * 32 + mg * 8 + (wv & 7);
  nt = ng * GN + (wv >> 3);
}

DI void epi_rowmajor(const f32x4 (&acc)[4][4], u16* dst, int ld, int m0, int c0, int mode, char* smem) {
  const int tid = threadIdx.x, lane = tid & 63, w = tid >> 6, wr = w >> 1, wc = w & 1, l15 = lane & 15, g = lane >> 4;
#pragma unroll
  for (int i = 0; i < 4; ++i) {
    const int row = wr * 64 + i * 16 + l15;
#pragma unroll
    for (int j = 0; j < 4; ++j) {
      f32x4 v = acc[i][j];
      if (mode == 1) { v[0] *= QSCALE; v[1] *= QSCALE; v[2] *= QSCALE; v[3] *= QSCALE; }
      else if (mode == 2) { v[0] = siluf_(v[0]); v[1] = siluf_(v[1]); v[2] = siluf_(v[2]); v[3] = siluf_(v[3]); }
      u32x2 o = {pack2(v[0], v[1]), pack2(v[2], v[3])};
      *(u32x2*)(smem + row * 272 + (wc * 64 + j * 16 + g * 4) * 2) = o;
    }
  }
  __syncthreads();
#pragma unroll
  for (int c = 0; c < 8; ++c) {
    const int id = c * 256 + tid, row = id >> 4, ch = id & 15;
    const u32x4 v = *(const u32x4*)(smem + row * 272 + ch * 16);
    *(u32x4*)(dst + (size_t)(m0 + row) * ld + c0 + ch * 8) = v;
  }
  __syncthreads();
}
DI void epi_rowmajor_direct(const f32x4 (&acc)[4][4], u16* dst, int ld, int m0, int c0, int mode) {
  const int tid = threadIdx.x, lane = tid & 63, w = tid >> 6, wr = w >> 1, wc = w & 1, l15 = lane & 15, g = lane >> 4;
#pragma unroll
  for (int i = 0; i < 4; ++i) {
    const size_t row = (size_t)(m0 + wr * 64 + i * 16 + l15);
#pragma unroll
    for (int j = 0; j < 4; ++j) {
      f32x4 v = acc[i][j];
      if (mode == 1) { v[0] *= QSCALE; v[1] *= QSCALE; v[2] *= QSCALE; v[3] *= QSCALE; }
      else if (mode == 2) { v[0] = siluf_(v[0]); v[1] = siluf_(v[1]); v[2] = siluf_(v[2]); v[3] = siluf_(v[3]); }
      u32x2 o = {pack2(v[0], v[1]), pack2(v[2], v[3])};
      *(u32x2*)(dst + row * ld + c0 + wc * 64 + j * 16 + g * 4) = o;
    }
  }
}
DI void epi_transposed(const f32x4 (&acc)[4][4], u16* dst, int m0, int c0, int H, int lgDh, int lgLk) {
  const int tid = threadIdx.x, lane = tid & 63, w = tid >> 6, wr = w >> 1, wc = w & 1, l15 = lane & 15, g = lane >> 4;
#pragma unroll
  for (int i = 0; i < 4; ++i) {
    const int token = m0 + wr * 64 + i * 16 + g * 4;
    const int bidx = token >> lgLk, tl = token & ((1 << lgLk) - 1);
#pragma unroll
    for (int j = 0; j < 4; ++j) {
      const int col = c0 + wc * 64 + j * 16 + l15;
      const int head = col >> lgDh, d = col & ((1 << lgDh) - 1);
      f32x4 v = acc[i][j];
      u32x2 o = {pack2(v[0], v[1]), pack2(v[2], v[3])};
      *(u32x2*)(dst + ((((((size_t)bidx * H + head) << lgDh) + d) << lgLk) + tl)) = o;
    }
  }
}

template <int D, bool FOX, bool PF, int NQ>
DI void attn_item(const u16* __restrict__ qbase, int ldq, const u16* __restrict__ kbase, int ldk,
                  const u16* __restrict__ vtbase, int ldv, const float* __restrict__ Fseq, int q0, int nkv,
                  const u16* __restrict__ gate, u16* outp, float scale, float kmaxv, char* smem) {
  const int tid = threadIdx.x, lane = tid & 63, w = tid >> 6, l15 = lane & 15, g = lane >> 4;
  constexpr int KROW = D * 2 + 16;
  constexpr int KBYTES = 64 * KROW;
  constexpr int VBYTES = D * 144;
  constexpr int BUF = KBYTES + VBYTES + 256;
  constexpr int NL = D / 32;
  constexpr int KCH = D / 8;
  static_assert(2 * BUF <= LDS_BYTES, "attn lds");

  bf16x8 qf[NQ][D / 32];
#pragma unroll
  for (int qi = 0; qi < NQ; ++qi)
#pragma unroll
    for (int s = 0; s < D / 32; ++s)
      qf[qi][s] = *(const bf16x8*)(qbase + (size_t)(w * (16 * NQ) + qi * 16 + l15) * ldq + s * 32 + g * 8);
  float fq[NQ];
#pragma unroll
  for (int qi = 0; qi < NQ; ++qi) fq[qi] = FOX ? Fseq[q0 + w * (16 * NQ) + qi * 16 + l15] : 0.f;
  f32x4 ot[D / 16][NQ];
#pragma unroll
  for (int dt = 0; dt < D / 16; ++dt)
#pragma unroll
    for (int qi = 0; qi < NQ; ++qi) ot[dt][qi] = f32x4{0, 0, 0, 0};
  float mrun[NQ], lsum[NQ];
#pragma unroll
  for (int qi = 0; qi < NQ; ++qi) { mrun[qi] = -1e30f; lsum[qi] = 0.f; }
  float qk[NQ];
#pragma unroll
  for (int qi = 0; qi < NQ; ++qi) {
    float ss = 0.f;
    if (FOX) {
#pragma unroll
      for (int s = 0; s < D / 32; ++s)
#pragma unroll
        for (int e = 0; e < 8; ++e) {
          const float v = __uint_as_float(((unsigned)(unsigned short)qf[qi][s][e]) << 16);
          ss += v * v;
        }
      ss += __shfl_xor(ss, 16);
      ss += __shfl_xor(ss, 32);
    }
    qk[qi] = sqrtf(ss) * kmaxv * 1.002f + 1e-3f;
  }
  int* flags = (int*)(smem + 73664);

  u32x4 kr[NL], vr[NL];
  f32x4 fr = {0, 0, 0, 0};
#define krow(c) (((c) * 256 + tid) / KCH)
#define kch(c) (((c) * 256 + tid) % KCH)
#define vrow(c) (((c) * 256 + tid) >> 3)
#define vch(c) (tid & 7)
#define ATT_LOAD(J)                                                                                   \
  {                                                                                                   \
    const int s0_ = (J) * 64;                                                                         \
    _Pragma("unroll") for (int c = 0; c < NL; ++c) {                                                  \
      kr[c] = *(const u32x4*)(kbase + (size_t)(s0_ + krow(c)) * ldk + kch(c) * 8);                    \
      vr[c] = *(const u32x4*)(vtbase + (size_t)vrow(c) * ldv + s0_ + vch(c) * 8);                     \
    }                                                                                                 \
    if (FOX && tid < 16) fr = *(const f32x4*)(Fseq + s0_ + tid * 4);                                  \
  }
#define ATT_STORE(BO)                                                                                 \
  {                                                                                                   \
    char* b_ = smem + (BO);                                                                           \
    _Pragma("unroll") for (int c = 0; c < NL; ++c) {                                                  \
      *(u32x4*)(b_ + krow(c) * KROW + kch(c) * 16) = kr[c];                                           \
      *(u32x4*)(b_ + KBYTES + vrow(c) * 144 + vch(c) * 16) = vr[c];                                   \
    }                                                                                                 \
    if (FOX && tid < 16) *(f32x4*)(b_ + KBYTES + VBYTES + tid * 16) = fr;                             \
  }
  ATT_LOAD(nkv - 1);
  ATT_STORE(0);
  __syncthreads();
  const int qlo = q0 + w * (16 * NQ);
  for (int j = nkv - 1, itn = 0; j >= 0; --j, ++itn) {
    const int cur = (itn & 1) * BUF;
    if (j > 0) {
      ATT_LOAD(j - 1);
      if (!PF) ATT_STORE(cur ^ BUF);
    }
    __builtin_amdgcn_sched_barrier(0);
    bool ok = false;
    const int s0 = j * 64;
    const bool active = !FOX || (s0 <= qlo + 16 * NQ - 1);
    if (active) {
      const char* Ks = smem + cur;
      const char* Vs = smem + cur + KBYTES;
      const char* Fs = smem + cur + KBYTES + VBYTES;
      f32x4 st[4][NQ];
#pragma unroll
      for (int kt = 0; kt < 4; ++kt)
#pragma unroll
        for (int qi = 0; qi < NQ; ++qi) st[kt][qi] = f32x4{0, 0, 0, 0};
#pragma unroll
      for (int s = 0; s < D / 32; ++s) {
        bf16x8 kf[4];
#pragma unroll
        for (int kt = 0; kt < 4; ++kt) kf[kt] = *(const bf16x8*)(Ks + (kt * 16 + l15) * KROW + s * 64 + g * 16);
#pragma unroll
        for (int kt = 0; kt < 4; ++kt)
#pragma unroll
          for (int qi = 0; qi < NQ; ++qi) st[kt][qi] = mfma16(kf[kt], qf[qi][s], st[kt][qi]);
      }
      if (FOX) {
        const bool need_mask = (s0 + 63 > qlo);
#pragma unroll
        for (int kt = 0; kt < 4; ++kt) {
          f32x4 fk = *(const f32x4*)(Fs + (kt * 16 + g * 4) * 4);
#pragma unroll
          for (int qi = 0; qi < NQ; ++qi) {
            const int qpos = qlo + qi * 16 + l15;
#pragma unroll
            for (int r = 0; r < 4; ++r) {
              float v = st[kt][qi][r] - fk[r];
              if (need_mask && (s0 + kt * 16 + g * 4 + r > qpos)) v = -1e30f;
              st[kt][qi][r] = v;
            }
          }
        }
      } else {
#pragma unroll
        for (int kt = 0; kt < 4; ++kt)
#pragma unroll
          for (int qi = 0; qi < NQ; ++qi)
#pragma unroll
            for (int r = 0; r < 4; ++r) st[kt][qi][r] *= scale;
      }
      float mxl[NQ];
      bool upd = false;
#pragma unroll
      for (int qi = 0; qi < NQ; ++qi) {
        float mx = st[0][qi][0];
#pragma unroll
        for (int kt = 0; kt < 4; ++kt)
#pragma unroll
          for (int r = 0; r < 4; ++r) mx = fmaxf(mx, st[kt][qi][r]);
        mxl[qi] = mx;
        upd = upd || (mx > mrun[qi]);
      }
      const bool resc = __any(upd);
      if (resc) {
#pragma unroll
        for (int qi = 0; qi < NQ; ++qi) {
          float mx = mxl[qi];
          mx = fmaxf(mx, __shfl_xor(mx, 16));
          mx = fmaxf(mx, __shfl_xor(mx, 32));
          const float mnew = fmaxf(mrun[qi], mx);
          const float al = __builtin_amdgcn_exp2f(mrun[qi] - mnew);
          mrun[qi] = mnew;
          lsum[qi] *= al;
#pragma unroll
          for (int dt = 0; dt < D / 16; ++dt)
#pragma unroll
            for (int r = 0; r < 4; ++r) ot[dt][qi][r] *= al;
        }
      }
#pragma unroll
      for (int qi = 0; qi < NQ; ++qi) {
        const float mref = mrun[qi];
        float ps = 0.f;
#pragma unroll
        for (int kt = 0; kt < 4; ++kt)
#pragma unroll
          for (int r = 0; r < 4; ++r) {
            float p = __builtin_amdgcn_exp2f(st[kt][qi][r] - mref);
            st[kt][qi][r] = p;
            ps += p;
          }
        lsum[qi] += ps;
      }
      bf16x8 pb[2][NQ];
#pragma unroll
      for (int kp = 0; kp < 2; ++kp)
#pragma unroll
        for (int qi = 0; qi < NQ; ++qi) {
          u32x4 t = pack8_mfma(st[2 * kp][qi][0], st[2 * kp][qi][1], st[2 * kp][qi][2], st[2 * kp][qi][3],
                               st[2 * kp + 1][qi][0], st[2 * kp + 1][qi][1], st[2 * kp + 1][qi][2], st[2 * kp + 1][qi][3]);
          pb[kp][qi] = __builtin_bit_cast(bf16x8, t);
        }
#pragma unroll
      for (int dt = 0; dt < D / 16; ++dt) {
#pragma unroll
        for (int kp = 0; kp < 2; ++kp) {
          u32x2 lo = *(const u32x2*)(Vs + (dt * 16 + l15) * 144 + (kp * 32 + g * 4) * 2);
          u32x2 hi = *(const u32x2*)(Vs + (dt * 16 + l15) * 144 + (kp * 32 + 16 + g * 4) * 2);
          u32x4 t = {lo[0], lo[1], hi[0], hi[1]};
          bf16x8 vf = __builtin_bit_cast(bf16x8, t);
#pragma unroll
          for (int qi = 0; qi < NQ; ++qi) ot[dt][qi] = mfma16(vf, pb[kp][qi], ot[dt][qi]);
        }
      }
      if (FOX) {
        const float f0 = *(const float*)Fs;
        ok = true;
#pragma unroll
        for (int qi = 0; qi < NQ; ++qi) ok = ok && (qk[qi] - f0 - mrun[qi] <= -30.f * LOG2E);
      }
    }
    __builtin_amdgcn_sched_barrier(0);
    if (PF && j > 0) ATT_STORE(cur ^ BUF);
    if (FOX) {
      const bool wave_ok = (__ballot(ok) == ~0ull);
      if (lane == 0) flags[(itn & 1) * 4 + w] = wave_ok ? 1 : 0;
      __syncthreads();
      const int* fl = flags + (itn & 1) * 4;
      if (fl[0] & fl[1] & fl[2] & fl[3]) break;
    } else {
      __syncthreads();
    }
  }
#undef ATT_LOAD
#undef ATT_STORE
#undef krow
#undef kch
#undef vrow
#undef vch
#pragma unroll
  for (int qi = 0; qi < NQ; ++qi) {
    float l = lsum[qi];
    l += __shfl_xor(l, 16);
    l += __shfl_xor(l, 32);
    const float inv = 1.f / l;
    const size_t rowoff = (size_t)(w * (16 * NQ) + qi * 16 + l15) * ldq;
#pragma unroll
    for (int dt = 0; dt < D / 16; ++dt) {
      const int col = dt * 16 + g * 4;
      u32x2 gv = *(const u32x2*)(gate + rowoff + col);
      u32x2 o = {pack2(ot[dt][qi][0] * inv * bflo(gv[0]), ot[dt][qi][1] * inv * bfhi(gv[0])),
                 pack2(ot[dt][qi][2] * inv * bflo(gv[1]), ot[dt][qi][3] * inv * bfhi(gv[1]))};
      *(u32x2*)(outp + rowoff + col) = o;
    }
  }
}

typedef float v2f __attribute__((ext_vector_type(2)));
DI void s5_load_u(const u16* ubuf, int b, int c, int g, char* ut, int lane) {
  const u16* src = ubuf + ((size_t)(b * L_ + c * 64 + lane)) * 768 + g * 16;
  u32x4 a = *(const u32x4*)src, bb = *(const u32x4*)(src + 8);
  f32x4 o0 = {bflo(a[0]), bfhi(a[0]), bflo(a[1]), bfhi(a[1])};
  f32x4 o1 = {bflo(a[2]), bfhi(a[2]), bflo(a[3]), bfhi(a[3])};
  f32x4 o2 = {bflo(bb[0]), bfhi(bb[0]), bflo(bb[1]), bfhi(bb[1])};
  f32x4 o3 = {bflo(bb[2]), bfhi(bb[2]), bflo(bb[3]), bfhi(bb[3])};
  *(f32x4*)(ut + lane * 64) = o0;
  *(f32x4*)(ut + lane * 64 + 16) = o1;
  *(f32x4*)(ut + lane * 64 + 32) = o2;
  *(f32x4*)(ut + lane * 64 + 48) = o3;
}
DI void s5_load_b(const float* bbar, int gp, v2f (&b2)[16]) {
#pragma unroll
  for (int q = 0; q < 4; ++q) {
    float4 t0 = *(const float4*)(bbar + (size_t)gp * 32 + q * 4);
    float4 t1 = *(const float4*)(bbar + (size_t)gp * 32 + 16 + q * 4);
    b2[4 * q] = v2f{t0.x, t1.x}; b2[4 * q + 1] = v2f{t0.y, t1.y};
    b2[4 * q + 2] = v2f{t0.z, t1.z}; b2[4 * q + 3] = v2f{t0.w, t1.w};
  }
}
DI v2f s5_x(const char* ut, int t, const v2f (&b2)[16]) {
  v2f xa = {0.f, 0.f}, xb = {0.f, 0.f};
#pragma unroll
  for (int q = 0; q < 4; ++q) {
    const f32x4 u = *(const f32x4*)(ut + t * 64 + q * 16);
    xa += b2[4 * q] * u[0];
    xb += b2[4 * q + 1] * u[1];
    xa += b2[4 * q + 2] * u[2];
    xb += b2[4 * q + 3] * u[3];
  }
  return xa + xb;
}

DI void s5_load_bfrag(const float* bbar, int g, int l15, int g4, bf16x8 (&ah)[8], bf16x8 (&al)[8]) {
#pragma unroll
  for (int kt = 0; kt < 8; ++kt) {
    u32x4 h = {0u, 0u, 0u, 0u}, l = {0u, 0u, 0u, 0u};
    if (g4 < 2) {
      const float* src = bbar + (size_t)(g * 64 + (kt & 3) * 16 + l15) * 32 + (kt >> 2) * 16 + g4 * 8;
      const float4 t0 = *(const float4*)src, t1 = *(const float4*)(src + 4);
      const float v[8] = {t0.x, t0.y, t0.z, t0.w, t1.x, t1.y, t1.z, t1.w};
#pragma unroll
      for (int q = 0; q < 4; ++q) {
        const unsigned h0 = f2bf(v[2 * q]), h1 = f2bf(v[2 * q + 1]);
        h[q] = h0 | (h1 << 16);
        l[q] = pack2(v[2 * q] - __uint_as_float(h0 << 16), v[2 * q + 1] - __uint_as_float(h1 << 16));
      }
    }
    ah[kt] = __builtin_bit_cast(bf16x8, h);
    al[kt] = __builtin_bit_cast(bf16x8, l);
  }
}
DI void s5_xsub(const u32x4 uraw, const bf16x8 (&ah)[8], const bf16x8 (&al)[8], char* xs, int l15, int g4) {
  const bf16x8 ub = __builtin_bit_cast(bf16x8, uraw);
#pragma unroll
  for (int kt = 0; kt < 8; ++kt) {
    f32x4 x = {0.f, 0.f, 0.f, 0.f};
    x = mfma16(ah[kt], ub, x);
    x = mfma16(al[kt], ub, x);
    *(f32x4*)(xs + l15 * 528 + (kt * 16 + g4 * 4) * 4) = x;
  }
}

#define XB_TMO      128
#define XB_XCNT(j)  (256  + 64 * (j))
#define XB_XSUB(j)  (1280 + 64 * (j))
#define XB_XGEN(j)  (2304 + 64 * (j))
#define XB_TOP      3328
#define XB_TOPGEN   3392
#define XCD_BAR_WORDS 3456
#define XB_SPIN_CAP (1u << 18)
DI unsigned xb_ld(unsigned* p) { return __hip_atomic_load(p, __ATOMIC_RELAXED, __HIP_MEMORY_SCOPE_AGENT); }
DI unsigned xb_add(unsigned* p, unsigned v) { return __hip_atomic_fetch_add(p, v, __ATOMIC_RELAXED, __HIP_MEMORY_SCOPE_AGENT); }
DI unsigned xb_xcc_id() { return (unsigned)__builtin_amdgcn_s_getreg((3 << 11) | 20) & 0xFu; }
#define XB_SPIN(cond, bar) do { unsigned _sp = 0; while (cond) { __builtin_amdgcn_s_sleep(1); \
    if ((++_sp & 255u) == 0u) { if (xb_ld(&(bar)[XB_TMO])) break; if (_sp > XB_SPIN_CAP) { atomicAdd(&(bar)[XB_TMO], 1u); break; } } } } while (0)
struct XcdBarrier { unsigned* bar; unsigned x; volatile unsigned* st; };
DI XcdBarrier xcd_barrier_post(unsigned* bar, volatile unsigned* st) {
  XcdBarrier b; b.bar = bar; b.x = xb_xcc_id(); b.st = st;
  if (threadIdx.x == 0) (void)xb_add(&bar[XB_XCNT(b.x)], 1u);
  return b;
}
DI void xcd_barrier_complete(unsigned* bar, unsigned x, unsigned& nloc, unsigned& nx) {
  const unsigned G = gridDim.x * gridDim.y * gridDim.z;
  unsigned sum, cnt, mine, sp = 0u;
  for (;;) {
    sum = 0u; cnt = 0u; mine = 0u;
#pragma unroll
    for (unsigned j = 0; j < 16; ++j) { const unsigned c = xb_ld(&bar[XB_XCNT(j)]); sum += c; cnt += (c > 0u) ? 1u : 0u; mine = (j == x) ? c : mine; }
    if (sum == G) break;
    __builtin_amdgcn_s_sleep(1);
    if ((++sp & 255u) == 0u) { if (xb_ld(&bar[XB_TMO])) break; if (sp > XB_SPIN_CAP) { atomicAdd(&bar[XB_TMO], 1u); break; } }
  }
  nloc = mine > 0u ? mine : 1u; nx = cnt > 0u ? cnt : 1u;
}
DI void xcd_barrier(const XcdBarrier& b) {
  asm volatile("s_waitcnt vmcnt(0)" ::: "memory");
  __syncthreads();
  if (threadIdx.x == 0) {
    unsigned* bar = b.bar;
    __builtin_amdgcn_s_waitcnt(0);
    unsigned nloc = b.st[0], nx = b.st[1];
    if (nloc == 0u) { xcd_barrier_complete(bar, b.x, nloc, nx); b.st[0] = nloc; b.st[1] = nx; }
    const unsigned old = xb_add(&bar[XB_XSUB(b.x)], 1u);
    const unsigned gen = old / nloc;
    if (old + 1u == (gen + 1u) * nloc) {
      __builtin_amdgcn_fence(__ATOMIC_RELEASE, "agent");
      asm volatile("s_waitcnt vmcnt(0)" ::: "memory");
      const unsigned og = xb_add(&bar[XB_TOP], 1u);
      const unsigned tg = og / nx;
      if (og + 1u == (tg + 1u) * nx) xb_add(&bar[XB_TOPGEN], 1u);
      else XB_SPIN(xb_ld(&bar[XB_TOPGEN]) == tg, bar);
      __builtin_amdgcn_fence(__ATOMIC_ACQUIRE, "agent");
      xb_add(&bar[XB_XGEN(b.x)], 1u);
      asm volatile("s_waitcnt vmcnt(0)" ::: "memory");
    } else {
      XB_SPIN(xb_ld(&bar[XB_XGEN(b.x)]) == gen, bar);
      __builtin_amdgcn_fence(__ATOMIC_ACQUIRE, "agent");
      asm volatile("s_waitcnt vmcnt(0)" ::: "memory");
    }
  }
  __syncthreads();
}

extern "C" __global__ void __launch_bounds__(256, 2) mega(Params p) {
  extern __shared__ __attribute__((aligned(16))) char smem[];
  cg::grid_group grid = cg::this_grid();
#define TIDVARS                                                                  \
  int tid = threadIdx.x;                                                         \
  asm volatile("" : "+v"(tid));                                                  \
  const int lane = tid & 63, w = tid >> 6, l15 = lane & 15, g4 = lane >> 4;      \
  (void)lane; (void)w; (void)l15; (void)g4;
  const int nblk = gridDim.x, bid = blockIdx.x;
  char* ws = p.ws;
  XcdBarrier xb;
  xb.bar = (unsigned*)(ws + OFF_CTL + 4096); xb.x = 0; xb.st = (volatile unsigned*)(smem + 73712);
  if (p.phase_lo < p.phase_hi) {
    if (threadIdx.x < 2) xb.st[threadIdx.x] = 0u;
    __syncthreads();
    xb = xcd_barrier_post((unsigned*)(ws + OFF_CTL + 4096), (volatile unsigned*)(smem + 73712));
    grid.sync();
  }
  u16* hbuf = (u16*)(ws + OFF_H);
  u16* qbuf = (u16*)(ws + OFF_Q);
  u16* gfbuf = (u16*)(ws + OFF_GF);
  u16* ubuf = (u16*)(ws + OFF_U);
  u16* gsbuf = (u16*)(ws + OFF_GS);
  u16* ys5a = (u16*)(ws + OFF_YS5A);
  u16* qmbuf = (u16*)(ws + OFF_QM);
  u16* gmbuf = (u16*)(ws + OFF_GM);
  u16* merged = (u16*)(ws + OFF_MERGED);
  u16* WinT = (u16*)(ws + OFF_WINT);
  u16* WglT = (u16*)(ws + OFF_WGLT);
  u16* WkvT = (u16*)(ws + OFF_WKVT);
  u16* WoutT = (u16*)(ws + OFF_WOUTT);
  u16* WpfT = (u16*)(ws + OFF_WPFT);
  u16* WpsT = (u16*)(ws + OFF_WPST);
  u16* WpmT = (u16*)(ws + OFF_WPMT);
  u16* WgluT = (u16*)(ws + OFF_WGLUT);
  u16* memn = (u16*)(ws + OFF_MEMN);
  u16* mkbuf = (u16*)(ws + OFF_MK);
  u16* mvT = (u16*)(ws + OFF_MVT);
  float* logf = (float*)(ws + OFF_LOGF);
  float* Fbuf = (float*)(ws + OFF_F);
  float2* abar = (float2*)(ws + OFF_S5AB);
  float* bbar = (float*)(ws + OFF_S5BB);
  float2* Sst = (float2*)(ws + OFF_S5S);
  float* part = (float*)(ws + OFF_PART);
  unsigned* ctl = (unsigned*)(ws + OFF_CTL);
  u16* kbuf = (u16*)p.out;
  u16* vT = (u16*)((char*)p.out + 48 * MiB);

  {
    if (PH(0)) {
      TIDVARS
      if (bid == 0 && tid < 128) ctl[tid] = 0u;
      float* tile = (float*)smem;
      for (int ti = bid; ti < 3344; ti += nblk) {
        const float* src; int ld, col0, K; u16* dst; int tt;
        if (ti < 576) { src = p.w_in; ld = 8716; col0 = 0; K = 1024; dst = WinT; tt = ti; }
        else if (ti < 1408) { src = p.w_in; ld = 8716; col0 = 2316; K = 1024; dst = WinT + (size_t)2304 * KLD; tt = ti - 576; }
        else if (ti < 2176) { src = p.w_in; ld = 8716; col0 = 5644; K = 1024; dst = WglT; tt = ti - 1408; }
        else if (ti < 2432) { src = p.w_mem_kv; ld = 1024; col0 = 0; K = 1024; dst = WkvT; tt = ti - 2176; }
        else if (ti < 2688) { src = p.w_out; ld = 1024; col0 = 0; K = 1024; dst = WoutT; tt = ti - 2432; }
        else if (ti < 2880) { src = p.w_pf; ld = 1024; col0 = 0; K = 768; dst = WpfT; tt = ti - 2688; }
        else if (ti < 3072) { src = p.w_ps; ld = 1024; col0 = 0; K = 768; dst = WpsT; tt = ti - 2880; }
        else if (ti < 3200) { src = p.w_pm; ld = 1024; col0 = 0; K = 512; dst = WpmT; tt = ti - 3072; }
        else { src = p.w_glu; ld = 768; col0 = 0; K = 768; dst = WgluT; tt = ti - 3200; }
        const int nkt = K >> 6;
        const int dld = (K == 1024) ? KLD : K;
        const int k0 = (tt % nkt) * 64, n0 = (tt / nkt) * 64;
#pragma unroll 4
        for (int i = 0; i < 16; ++i) {
          int k = i * 4 + w, n = lane;
          tile[k * 65 + n] = src[(size_t)(k0 + k) * ld + col0 + n0 + n];
        }
        __syncthreads();
#pragma unroll 4
        for (int i = 0; i < 16; ++i) {
          int n = i * 4 + w, k = lane;
          dst[(size_t)(n0 + n) * dld + k0 + k] = f2bf(tile[k * 65 + n]);
        }
        __syncthreads();
      }
      float* wfl = (float*)smem;
      for (int idx = tid; idx < 12288; idx += 256) {
        int k = idx / 12, j = idx - k * 12;
        wfl[j * 1024 + k] = p.w_in[(size_t)k * 8716 + 2304 + j];
      }
      __syncthreads();
      for (int row = bid * 4 + w; row < T_ + 1024; row += nblk * 4) {
        const bool isx = row < T_;
        const float* src = isx ? p.x + (size_t)row * 1024 : p.mem + (size_t)(row - T_) * 1024;
        const float* gsrc = isx ? p.g_norm : p.g_mem_norm;
        u16* dst = isx ? hbuf + (size_t)row * KLD : memn + (size_t)(row - T_) * KLD;
        float4 xv[4];
        float ss = 0.f;
#pragma unroll
        for (int i = 0; i < 4; ++i) {
          xv[i] = *(const float4*)(src + i * 256 + lane * 4);
          ss += xv[i].x * xv[i].x + xv[i].y * xv[i].y + xv[i].z * xv[i].z + xv[i].w * xv[i].w;
        }
        ss = wave_sum(ss);
        const float rstd = rsqrtf(ss * (1.f / 1024.f) + 1e-6f);
#pragma unroll
        for (int i = 0; i < 4; ++i) {
          float4 gv = *(const float4*)(gsrc + i * 256 + lane * 4);
          xv[i].x *= rstd * gv.x; xv[i].y *= rstd * gv.y; xv[i].z *= rstd * gv.z; xv[i].w *= rstd * gv.w;
          u32x2 o = {pack2(xv[i].x, xv[i].y), pack2(xv[i].z, xv[i].w)};
          *(u32x2*)(dst + i * 256 + lane * 4) = o;
        }
        if (isx) {
          float myfl = 0.f;
#pragma unroll
          for (int j = 0; j < 12; ++j) {
            float a = 0.f;
#pragma unroll
            for (int i = 0; i < 4; ++i) {
              float4 wv = *(const float4*)(wfl + j * 1024 + i * 256 + lane * 4);
              a += xv[i].x * wv.x + xv[i].y * wv.y + xv[i].z * wv.z + xv[i].w * wv.w;
            }
            a = wave_sum(a);
            if (lane == j) myfl = a;
          }
          if (lane < 12) {
            float xx = myfl + p.b_forget[lane];
            float lf = fminf(xx, 0.f) - log1pf(__expf(-fabsf(xx)));
            const int b = row >> 13, t = row & (L_ - 1);
            logf[(size_t)(b * 12 + lane) * L_ + t] = lf;
          }
        }
      }
      {
        const int gid = bid * 256 + tid;
        if (gid < 3072) {
          const int g = gid >> 6;
          const float step = expf(p.log_step[g]);
          const float lr = p.lam_re[gid], li = p.lam_im[gid];
          const float mag = expf(lr * step);
          const float ar = mag * cosf(li * step), ai = mag * sinf(li * step);
          const float den = lr * lr + li * li;
          const float nr = ar - 1.f, ni = ai;
          const float fr = (nr * lr + ni * li) / den, fi = (ni * lr - nr * li) / den;
          abar[gid] = make_float2(ar, ai);
#pragma unroll
          for (int h = 0; h < 16; ++h) {
            const float br = p.b_re[(size_t)gid * 16 + h], bi = p.b_im[(size_t)gid * 16 + h];
            bbar[(size_t)gid * 32 + h] = fr * br - fi * bi;
            bbar[(size_t)gid * 32 + 16 + h] = fr * bi + fi * br;
          }
        }
      }
      __syncthreads();
    }
    SYNC_BEFORE(1);
    if (PH(1)) {
      TIDVARS
      float* sm = (float*)smem;
      for (int seq = bid; seq < 48; seq += nblk) {
        const float* src = logf + (size_t)seq * L_ + tid * 32;
        float* dst = Fbuf + (size_t)seq * L_ + tid * 32;
        float v[32];
#pragma unroll
        for (int i = 0; i < 8; ++i) {
          float4 t = *(const float4*)(src + i * 4);
          v[4 * i] = t.x; v[4 * i + 1] = t.y; v[4 * i + 2] = t.z; v[4 * i + 3] = t.w;
        }
        float run = 0.f;
#pragma unroll
        for (int i = 0; i < 32; ++i) { run += v[i]; v[i] = run; }
        float incl = run;
#pragma unroll
        for (int o = 1; o < 64; o <<= 1) {
          float t = __shfl_up(incl, o);
          if (lane >= o) incl += t;
        }
        if (lane == 63) sm[w] = incl;
        __syncthreads();
        float base = incl - run;
        for (int w2 = 0; w2 < w; ++w2) base += sm[w2];
#pragma unroll
        for (int i = 0; i < 8; ++i) {
          float4 t = make_float4((v[4 * i] + base) * LOG2E, (v[4 * i + 1] + base) * LOG2E, (v[4 * i + 2] + base) * LOG2E, (v[4 * i + 3] + base) * LOG2E);
          *(float4*)(dst + i * 4) = t;
        }
        __syncthreads();
      }
      for (int v = bid; v < 11264 + 64; v += nblk) {
        const u16 *A, *Bt;
        int m0, n0;
        bool kvtile = v >= 11264;
        if (!kvtile) {
          int mt, nt;
          swz(v, 44, 4, mt, nt);
          m0 = mt * 128; n0 = nt * 128;
          A = hbuf + (size_t)m0 * KLD; Bt = WinT + (size_t)n0 * KLD;
        } else {
          int kv = v - 11264;
          m0 = (kv >> 3) * 128; n0 = (kv & 7) * 128;
          A = memn + (size_t)m0 * KLD; Bt = WkvT + (size_t)n0 * KLD;
        }
        const bool transp = kvtile ? (n0 >= 512) : (n0 >= 1536 && n0 < 2304);
        f32x4 acc[4][4];
        zero_acc(acc);
        if (transp) {
          gemm_core<false, 1>(acc, A, KLD, Bt, KLD, 1024, smem);
          if (kvtile) epi_transposed(acc, mvT, m0, n0 - 512, 4, 7, 8);
          else epi_transposed(acc, vT, m0, n0 - 1536, 12, 6, 13);
        } else {
          gemm_core<true>(acc, A, KLD, Bt, KLD, 1024, smem);
          u16* dst; int ld, c0, mode;
          if (kvtile) { dst = mkbuf; ld = 512; c0 = n0; mode = 0; }
          else if (n0 < 768) { dst = qbuf; ld = 768; c0 = n0; mode = 1; }
          else if (n0 < 1536) { dst = kbuf; ld = 768; c0 = n0 - 768; mode = 0; }
          else if (n0 < 3072) { dst = gfbuf; ld = 768; c0 = n0 - 2304; mode = 2; }
          else if (n0 < 3840) { dst = ubuf; ld = 768; c0 = n0 - 3072; mode = 0; }
          else if (n0 < 4608) { dst = gsbuf; ld = 768; c0 = n0 - 3840; mode = 2; }
          else if (n0 < 5120) { dst = qmbuf; ld = 512; c0 = n0 - 4608; mode = 0; }
          else { dst = gmbuf; ld = 512; c0 = n0 - 5120; mode = 2; }
          epi_rowmajor(acc, dst, ld, m0, c0, mode, smem);
          if (!kvtile && n0 >= 768 && n0 < 1536) {
            float mxv = 0.f;
#pragma unroll
            for (int i = 0; i < 4; ++i) {
              float ss = 0.f;
#pragma unroll
              for (int j = 0; j < 4; ++j)
#pragma unroll
                for (int r = 0; r < 4; ++r) {
                  const float v = __uint_as_float(((unsigned)f2bf(acc[i][j][r])) << 16);
                  ss += v * v;
                }
              ss += __shfl_xor(ss, 16);
              ss += __shfl_xor(ss, 32);
              mxv = fmaxf(mxv, ss);
            }
#pragma unroll
            for (int o = 1; o < 16; o <<= 1) mxv = fmaxf(mxv, __shfl_xor(mxv, o));
            if (lane == 0) atomicMax(&ctl[(m0 >> 13) * 12 + ((n0 - 768) >> 6) + (w & 1)], __float_as_uint(mxv));
          }
        }
      }
    }
    SYNC_BEFORE(2);
    if (PH(2)) {
      TIDVARS
      int* qslot = (int*)(smem + 73696);
#define NEXT_ITEM(CTR)                                        \
      {                                                       \
        if (tid == 0) *qslot = (int)atomicAdd(&ctl[CTR], 1u); \
        __syncthreads();                                      \
        it = *qslot;                                          \
        __syncthreads();                                      \
      }
      int it;
      for (;;) {
        NEXT_ITEM(64);
        if (it >= 3072) break;
        {
#ifndef NO_FOX
          const int qt = 63 - it / 48, bh = it % 48, b = bh / 12, h = bh % 12;
          const int q0 = qt * 128;
          const size_t qoff = ((size_t)(b * L_ + q0)) * 768 + h * 64;
          attn_item<64, true, true, 2>(qbuf + qoff, 768, kbuf + (size_t)b * L_ * 768 + h * 64, 768,
                              vT + (size_t)(b * 12 + h) * 64 * L_, L_, Fbuf + (size_t)(b * 12 + h) * L_, q0, 2 * qt + 2,
                              gfbuf + qoff, qbuf + qoff, 1.f, sqrtf(__uint_as_float(ctl[b * 12 + h])), smem);
#endif
        }
      }
      for (;;) {
        NEXT_ITEM(65);
        if (it >= 2048) break;
        {
#ifndef NO_MEM
          const int im = it;
          const int hm = im & 3, qt = (im >> 2) & 127, b = im >> 9;
          const int q0 = qt * 64;
          const size_t qoff = ((size_t)(b * L_ + q0)) * 512 + hm * 128;
          attn_item<128, false, false, 1>(qmbuf + qoff, 512, mkbuf + (size_t)b * 256 * 512 + hm * 128, 512,
                                mvT + (size_t)(b * 4 + hm) * 128 * 256, 256, nullptr, q0, 4,
                                gmbuf + qoff, qmbuf + qoff, 0.08838834764831845f * LOG2E, 0.f, smem);
#endif
        }
      }
      for (;;) {
        NEXT_ITEM(66);
        if (it >= 1536) break;
        {
#ifndef NO_S5P1
          const int wi = it * 4 + w;
          const int g = wi % 48, cg = (wi / 48) & 31, b = wi / (48 * 32);
          char* xs = smem + w * 12800;
          const int gp = g * 64 + lane;
          bf16x8 ah[8], al[8];
          s5_load_bfrag(bbar, g, l15, g4, ah, al);
          const float2 ab = abar[gp];
#pragma unroll 1
          for (int ci = 0; ci < 4; ++ci) {
          const int c = cg * 4 + ci;
          const u16* ub0 = ubuf + ((size_t)(b * L_ + c * 64 + l15)) * 768 + g * 16;
          u32x4 uq[4];
#pragma unroll
          for (int sub = 0; sub < 4; ++sub) {
            uq[sub] = u32x4{0u, 0u, 0u, 0u};
            if (g4 < 2) uq[sub] = *(const u32x4*)(ub0 + (size_t)sub * 16 * 768 + g4 * 8);
          }
          float hr = 0.f, hi = 0.f;
#pragma unroll
          for (int sub = 0; sub < 4; ++sub) {
            s5_xsub(uq[sub], ah, al, xs, l15, g4);
            asm volatile("s_waitcnt lgkmcnt(0)" ::: "memory");
#pragma unroll
            for (int tt = 0; tt < 16; ++tt) {
              const float xr = *(const float*)(xs + tt * 528 + lane * 4);
              const float xi = *(const float*)(xs + tt * 528 + 256 + lane * 4);
              const float nhr = ab.x * hr - ab.y * hi + xr;
              const float nhi = ab.x * hi + ab.y * hr + xi;
              hr = nhr; hi = nhi;
            }
            asm volatile("s_waitcnt lgkmcnt(0)" ::: "memory");
          }
          Sst[((size_t)(b * 128 + c) * 48 + g) * 64 + lane] = make_float2(hr, hi);
          }
          __syncthreads();
#endif
        }
      }
    }
    SYNC_BEFORE(3);
    if (PH(3)) {
      TIDVARS
      for (int wi = bid * 4 + w; wi < 192; wi += nblk * 4) {
        const int g = wi % 48, b = wi / 48;
        const float2 ab = abar[g * 64 + lane];
        float a64r = ab.x, a64i = ab.y;
#pragma unroll
        for (int q = 0; q < 6; ++q) {
          const float nr = a64r * a64r - a64i * a64i, ni = 2.f * a64r * a64i;
          a64r = nr; a64i = ni;
        }
        float2* sp = Sst + ((size_t)(b * 128) * 48 + g) * 64 + lane;
        float hr = 0.f, hi = 0.f;
        for (int cc = 0; cc < 128; cc += 16) {
          float2 sv[16];
#pragma unroll
          for (int q = 0; q < 16; ++q) sv[q] = sp[(size_t)(cc + q) * 48 * 64];
#pragma unroll
          for (int q = 0; q < 16; ++q) {
            sp[(size_t)(cc + q) * 48 * 64] = make_float2(hr, hi);
            const float nhr = a64r * hr - a64i * hi + sv[q].x;
            const float nhi = a64r * hi + a64i * hr + sv[q].y;
            hr = nhr; hi = nhi;
          }
        }
      }
    }
    SYNC_BEFORE(4);
    if (PH(4)) {
      TIDVARS
      for (int it = bid; it < 1536; it += nblk) {
        const int wi = it * 4 + w;
        const int g = wi % 48, cg = (wi / 48) & 31, b = wi / (48 * 32);
        char* xs = smem + w * 12800;
        char* stt = xs + 8448;
        const int gp = g * 64 + lane;
        bf16x8 ah[8], al[8];
        s5_load_bfrag(bbar, g, l15, g4, ah, al);
        const float2 ab = abar[gp];
        bf16x8 cf[4];
#pragma unroll
        for (int s = 0; s < 4; ++s) {
          const float* cs = (s < 2 ? p.c_re : p.c_im) + (size_t)(g * 16 + l15) * 64 + (s & 1) * 32 + g4 * 8;
          float4 t0 = *(const float4*)cs, t1 = *(const float4*)(cs + 4);
          const float sg = (s < 2) ? 1.f : -1.f;
          u32x4 t = pack8_mfma(sg * t0.x, sg * t0.y, sg * t0.z, sg * t0.w, sg * t1.x, sg * t1.y, sg * t1.z, sg * t1.w);
          cf[s] = __builtin_bit_cast(bf16x8, t);
        }
        const float4 dsk = *(const float4*)(p.s5_d + g * 16 + g4 * 4);
#pragma unroll 1
        for (int ci = 0; ci < 4; ++ci) {
        const int c = cg * 4 + ci;
        const u16* ub0 = ubuf + ((size_t)(b * L_ + c * 64 + l15)) * 768 + g * 16;
        const float2 hc = Sst[((size_t)(b * 128 + c) * 48 + g) * 64 + lane];
        float hr = hc.x, hi = hc.y;
        u32x4 uq[4];
        u32x2 uvq[4];
#pragma unroll
        for (int sub = 0; sub < 4; ++sub) {
          uq[sub] = u32x4{0u, 0u, 0u, 0u};
          if (g4 < 2) uq[sub] = *(const u32x4*)(ub0 + (size_t)sub * 16 * 768 + g4 * 8);
          uvq[sub] = *(const u32x2*)(ub0 + (size_t)sub * 16 * 768 + g4 * 4);
        }
        asm volatile("s_waitcnt lgkmcnt(0)" ::: "memory");
#pragma unroll
        for (int sub = 0; sub < 4; ++sub) {
          s5_xsub(uq[sub], ah, al, xs, l15, g4);
          asm volatile("s_waitcnt lgkmcnt(0)" ::: "memory");
#pragma unroll
          for (int tt = 0; tt < 16; ++tt) {
            const float xr = *(const float*)(xs + tt * 528 + lane * 4);
            const float xi = *(const float*)(xs + tt * 528 + 256 + lane * 4);
            const float nhr = ab.x * hr - ab.y * hi + xr;
            const float nhi = ab.x * hi + ab.y * hr + xi;
            hr = nhr; hi = nhi;
            *(u16*)(stt + tt * 272 + lane * 2) = f2bf(hr);
            *(u16*)(stt + tt * 272 + 128 + lane * 2) = f2bf(hi);
          }
          asm volatile("s_waitcnt lgkmcnt(0)" ::: "memory");
          f32x4 y = {0, 0, 0, 0};
#pragma unroll
          for (int s = 0; s < 4; ++s) {
            bf16x8 bfr = *(const bf16x8*)(stt + l15 * 272 + s * 64 + g4 * 16);
            y = mfma16(cf[s], bfr, y);
          }
          const int t = sub * 16 + l15;
          const u32x2 uv = uvq[sub];
          float o0 = gelu_tanh(y[0] + dsk.x * bflo(uv[0]));
          float o1 = gelu_tanh(y[1] + dsk.y * bfhi(uv[0]));
          float o2 = gelu_tanh(y[2] + dsk.z * bflo(uv[1]));
          float o3 = gelu_tanh(y[3] + dsk.w * bfhi(uv[1]));
          u32x2 o = {pack2(o0, o1), pack2(o2, o3)};
          *(u32x2*)(ys5a + ((size_t)(b * L_ + c * 64 + t)) * 768 + g * 16 + g4 * 4) = o;
          asm volatile("s_waitcnt lgkmcnt(0)" ::: "memory");
        }
        }
        __syncthreads();
      }
    }
    SYNC_BEFORE(5);
    if (PH(5)) {
      TIDVARS
      for (int v = bid; v < 256 * 6; v += nblk) {
        int mt, nt;
        swz(v, 6, 6, mt, nt);
        const int m0 = mt * 128, n0 = nt * 128;
        f32x4 acc[4][4];
        zero_acc(acc);
        gemm_core<true>(acc, ys5a + (size_t)m0 * 768, 768, WgluT + (size_t)n0 * 768, 768, 768, smem);
        const int wr = w >> 1, wc = w & 1;
#pragma unroll
        for (int i = 0; i < 4; ++i) {
          const size_t row = (size_t)(m0 + wr * 64 + i * 16 + l15);
#pragma unroll
          for (int j = 0; j < 4; ++j) {
            const int n = n0 + wc * 64 + j * 16 + g4 * 4;
            const float4 bg = *(const float4*)(p.b_glu + n);
            const u32x2 av = *(const u32x2*)(ys5a + row * 768 + n);
            const u32x2 sv = *(const u32x2*)(gsbuf + row * 768 + n);
            float o0 = bflo(av[0]) * sigmoidf_(acc[i][j][0] + bg.x) * bflo(sv[0]);
            float o1 = bfhi(av[0]) * sigmoidf_(acc[i][j][1] + bg.y) * bfhi(sv[0]);
            float o2 = bflo(av[1]) * sigmoidf_(acc[i][j][2] + bg.z) * bflo(sv[1]);
            float o3 = bfhi(av[1]) * sigmoidf_(acc[i][j][3] + bg.w) * bfhi(sv[1]);
            u32x2 o = {pack2(o0, o1), pack2(o2, o3)};
            *(u32x2*)(ubuf + row * 768 + n) = o;
          }
        }
      }
    }
    SYNC_BEFORE(6);
    if (PH(6)) {
      TIDVARS
      for (int v = bid; v < 256 * 8; v += nblk) {
        int mt, nt;
        swz(v, 8, 4, mt, nt);
        const int m0 = mt * 128, n0 = nt * 128;
        const int wr = w >> 1, wc = w & 1;
        char* gstash = ws + OFF_GATE + (size_t)bid * 32768;
        f32x4 accm[4][4];
        zero_acc(accm);
        const unsigned toff = (unsigned)tid * 16u;
#pragma unroll 1
        for (int stp = 0; stp < 6; ++stp) {
          const int br = stp >> 1;
          const u16* Ab; const u16* Wb; int Kb; int ldk;
          if (!(stp & 1)) { Ab = hbuf + (size_t)m0 * KLD; Wb = WglT + (size_t)(br * 1024 + n0) * KLD; Kb = 1024; }
          else if (br == 0) { Ab = qbuf + (size_t)m0 * 768; Wb = WpfT + (size_t)n0 * 768; Kb = 768; }
          else if (br == 1) { Ab = ubuf + (size_t)m0 * 768; Wb = WpsT + (size_t)n0 * 768; Kb = 768; }
          else { Ab = qmbuf + (size_t)m0 * 512; Wb = WpmT + (size_t)n0 * 512; Kb = 512; }
          f32x4 acc[4][4];
          zero_acc(acc);
          ldk = (Kb == 1024) ? KLD : Kb;
          gemm_core<true, 1, true>(acc, Ab, ldk, Wb, ldk, Kb, smem);
          if (!(stp & 1)) {
#pragma unroll
            for (int j = 0; j < 4; ++j) {
              const float4 bm = *(const float4*)(p.b_merge + br * 1024 + n0 + wc * 64 + j * 16 + g4 * 4);
#pragma unroll
              for (int i = 0; i < 4; i += 2) {
                u32x4 gq = {pack2(sigmoidf_(acc[i][j][0] + bm.x), sigmoidf_(acc[i][j][1] + bm.y)),
                            pack2(sigmoidf_(acc[i][j][2] + bm.z), sigmoidf_(acc[i][j][3] + bm.w)),
                            pack2(sigmoidf_(acc[i + 1][j][0] + bm.x), sigmoidf_(acc[i + 1][j][1] + bm.y)),
                            pack2(sigmoidf_(acc[i + 1][j][2] + bm.z), sigmoidf_(acc[i + 1][j][3] + bm.w))};
                *(u32x4*)(gstash + (j * 2 + (i >> 1)) * 4096 + toff) = gq;
              }
            }
          } else {
#pragma unroll
            for (int j = 0; j < 4; ++j)
#pragma unroll
              for (int i = 0; i < 4; i += 2) {
                const u32x4 gq = *(const u32x4*)(gstash + (j * 2 + (i >> 1)) * 4096 + toff);
                acc[i][j][0] *= bflo(gq[0]); acc[i][j][1] *= bfhi(gq[0]);
                acc[i][j][2] *= bflo(gq[1]); acc[i][j][3] *= bfhi(gq[1]);
                acc[i + 1][j][0] *= bflo(gq[2]); acc[i + 1][j][1] *= bfhi(gq[2]);
                acc[i + 1][j][2] *= bflo(gq[3]); acc[i + 1][j][3] *= bfhi(gq[3]);
                accm[i][j] += acc[i][j];
                accm[i + 1][j] += acc[i + 1][j];
                __builtin_amdgcn_sched_barrier(0);
              }
            if (br == 2) epi_rowmajor_direct(accm, merged, KLD, m0, n0, 0);
          }
        }
      }
    }
    SYNC_BEFORE(7);
    if (PH(7)) {
      TIDVARS
      for (int v = bid; v < 256 * 8; v += nblk) {
        int mt, nt;
        swz(v, 8, 4, mt, nt);
        const int m0 = mt * 128, n0 = nt * 128;
        const int wr = w >> 1, wc = w & 1;
        f32x4 acc[4][4];
        zero_acc(acc);
        gemm_core<true>(acc, merged + (size_t)m0 * KLD, KLD, WoutT + (size_t)n0 * KLD, KLD, 1024, smem);
#pragma unroll
        for (int i = 0; i < 4; ++i) {
          const size_t row = (size_t)(m0 + wr * 64 + i * 16 + l15);
          float ss = 0.f;
#pragma unroll
          for (int j = 0; j < 4; ++j) {
            const int n = n0 + wc * 64 + j * 16 + g4 * 4;
            const float4 xv = *(const float4*)(p.x + row * 1024 + n);
            float4 o = make_float4(xv.x + acc[i][j][0], xv.y + acc[i][j][1], xv.z + acc[i][j][2], xv.w + acc[i][j][3]);
            ss += o.x * o.x + o.y * o.y + o.z * o.z + o.w * o.w;
            *(float4*)(p.out + row * 1024 + n) = o;
          }
          ss += __shfl_xor(ss, 16);
          ss += __shfl_xor(ss, 32);
          if (g4 == 0) part[row * 16 + nt * 2 + wc] = ss;
        }
      }
    }
    SYNC_BEFORE(8);
    if (PH(8)) {
      TIDVARS
      for (int row = bid * 4 + w; row < T_; row += nblk * 8) {
        const int row2 = row + nblk * 4;
        const bool has2 = row2 < T_;
        float ssa = (lane < 16) ? part[(size_t)row * 16 + lane] : 0.f;
        float ssb = (has2 && lane < 16) ? part[(size_t)row2 * 16 + lane] : 0.f;
        float* oa = p.out + (size_t)row * 1024;
        float* ob = p.out + (size_t)(has2 ? row2 : row) * 1024;
        float4 va[4], vb[4];
#pragma unroll
        for (int i = 0; i < 4; ++i) {
          va[i] = *(const float4*)(oa + i * 256 + lane * 4);
          vb[i] = *(const float4*)(ob + i * 256 + lane * 4);
        }
        ssa = wave_sum(ssa);
        ssb = wave_sum(ssb);
        const float ra = rsqrtf(ssa * (1.f / 1024.f) + 1e-6f);
        const float rb = rsqrtf(ssb * (1.f / 1024.f) + 1e-6f);
#pragma unroll
        for (int i = 0; i < 4; ++i) {
          const float4 gv = *(const float4*)(p.g_final + i * 256 + lane * 4);
          va[i].x *= ra * gv.x; va[i].y *= ra * gv.y; va[i].z *= ra * gv.z; va[i].w *= ra * gv.w;
          *(float4*)(oa + i * 256 + lane * 4) = va[i];
          if (has2) {
            vb[i].x *= rb * gv.x; vb[i].y *= rb * gv.y; vb[i].z *= rb * gv.z; vb[i].w *= rb * gv.w;
            *(float4*)(ob + i * 256 + lane * 4) = vb[i];
          }
        }
      }
    }
  }
}

extern "C" void kernel_launch(void* const* d_in, const int* in_sizes, int n_in, void* d_out, int out_size, void* d_ws,
                              size_t ws_size, hipStream_t stream) {
  static int grid_blocks = 0;
  if (!grid_blocks) {
    if (ws_size < WS_END || n_in != 23) {
      fprintf(stderr, "kernel_launch: unexpected ws_size %zu (need %zu) or n_in %d\n", ws_size, (size_t)WS_END, n_in);
      grid_blocks = -1;
      return;
    }
    int dev = 0, cus = 0, per_cu = 0;
    (void)hipGetDevice(&dev);
    (void)hipDeviceGetAttribute(&cus, hipDeviceAttributeMultiprocessorCount, dev);
    (void)hipFuncSetAttribute((const void*)mega, hipFuncAttributeMaxDynamicSharedMemorySize, LDS_BYTES);
    (void)hipOccupancyMaxActiveBlocksPerMultiprocessor(&per_cu, (const void*)mega, 256, LDS_BYTES);
    per_cu = (per_cu >= 2) ? 2 : 1;
    grid_blocks = cus * per_cu;
  }
  if (grid_blocks < 0) return;
  Params p{};
  const float** pp = (const float**)&p;
  for (int i = 0; i < 23; ++i) pp[i] = (const float*)d_in[i];
  p.out = (float*)d_out;
  p.ws = (char*)d_ws;
#if COOP
  (void)hipMemsetAsync((char*)d_ws + OFF_CTL + 4096, 0, XCD_BAR_WORDS * 4, stream);
  p.phase_lo = 0;
  p.phase_hi = NPHASE - 1;
  void* args[] = {&p};
  hipError_t e = hipLaunchCooperativeKernel((const void*)mega, dim3(grid_blocks), dim3(256), args, LDS_BYTES, stream);
  if (e != hipSuccess) fprintf(stderr, "cooperative launch failed: %s (grid %d)\n", hipGetErrorString(e), grid_blocks);
#else
  for (int ph = 0; ph < NPHASE; ++ph) {
    p.phase_lo = ph;
    p.phase_hi = ph;
    hipLaunchKernelGGL(mega, dim3(grid_blocks), dim3(256), LDS_BYTES, stream, p);
#ifdef PROBE_DUP
    if (ph == PROBE_DUP) {
      for (int rep = 0; rep < 2; ++rep) {
        if (ph == 2) { p.phase_lo = p.phase_hi = 1; hipLaunchKernelGGL(mega, dim3(grid_blocks), dim3(256), LDS_BYTES, stream, p); p.phase_lo = p.phase_hi = 2; }
        hipLaunchKernelGGL(mega, dim3(grid_blocks), dim3(256), LDS_BYTES, stream, p);
      }
    }
#endif
  }
#endif
}
```

```cpp
#include <hip/hip_runtime.h>
#include <hip/hip_cooperative_groups.h>
#include <stdint.h>
#include <stdio.h>
namespace cg = cooperative_groups;

#ifndef COOP
#define COOP 1
#define XCD_MODE 0
#endif

#define DI __device__ __forceinline__
#ifdef ONLY_PHASE
#define PH(n) ((n) == ONLY_PHASE && p.phase_lo <= (n) && (n) <= p.phase_hi)
#else
#define PH(n) (p.phase_lo <= (n) && (n) <= p.phase_hi)
#endif
#define SYNC_BEFORE(n)                                        \
  if (p.phase_lo < (n) && (n) <= p.phase_hi) {                \
    xcd_barrier(xb);                                          \
  }
typedef unsigned short u16;
using bf16x8 = __attribute__((ext_vector_type(8))) short;
using f32x4 = __attribute__((ext_vector_type(4))) float;
using u32x4 = __attribute__((ext_vector_type(4))) unsigned;
using u32x2 = __attribute__((ext_vector_type(2))) unsigned;

constexpr int T_ = 32768, L_ = 8192;
constexpr int LDS_BYTES = 73728;
constexpr int NPHASE = 9;

constexpr size_t MiB = 1u << 20;
constexpr float LOG2E = 1.4426950408889634f;
constexpr float QSCALE = 0.125f * LOG2E;
constexpr int KLD = 1088;
constexpr size_t OFF_H = 0;
constexpr size_t OFF_Q = 68 * MiB;
constexpr size_t OFF_GF = 116 * MiB;
constexpr size_t OFF_U = 164 * MiB;
constexpr size_t OFF_GS = 212 * MiB;
constexpr size_t OFF_YS5A = 260 * MiB;
constexpr size_t OFF_QM = 308 * MiB;
constexpr size_t OFF_GM = 340 * MiB;
constexpr size_t OFF_MERGED = 372 * MiB;
constexpr size_t OFF_WINT = 440 * MiB;
constexpr size_t OFF_WGLT = 453 * MiB;
constexpr size_t OFF_WKVT = 460 * MiB;
constexpr size_t OFF_WOUTT = 463 * MiB;
constexpr size_t OFF_WPFT = 466 * MiB;
constexpr size_t OFF_WPST = 468 * MiB;
constexpr size_t OFF_WPMT = 470 * MiB;
constexpr size_t OFF_WGLUT = 471 * MiB;
constexpr size_t OFF_MEMN = 473 * MiB;
constexpr size_t OFF_MK = 476 * MiB;
constexpr size_t OFF_MVT = 477 * MiB;
constexpr size_t OFF_LOGF = 478 * MiB;
constexpr size_t OFF_F = 480 * MiB;
constexpr size_t OFF_S5AB = 482 * MiB;
constexpr size_t OFF_S5BB = 483 * MiB;
constexpr size_t OFF_S5S = 484 * MiB;
constexpr size_t OFF_PART = 496 * MiB;
constexpr size_t OFF_GATE = OFF_GS;
constexpr size_t OFF_CTL = 498 * MiB;
constexpr size_t WS_END = 499 * MiB;

struct Params {
  const float *x, *mem, *g_norm, *g_mem_norm, *g_final, *w_in, *b_forget, *b_merge, *w_mem_kv;
  const float *lam_re, *lam_im, *log_step, *b_re, *b_im, *c_re, *c_im, *s5_d, *w_glu, *b_glu;
  const float *w_pf, *w_ps, *w_pm, *w_out;
  float* out;
  char* ws;
  int phase_lo, phase_hi;
};

DI unsigned pack2(float a, float b) {
  unsigned r;
  asm volatile("v_cvt_pk_bf16_f32 %0, %1, %2" : "=v"(r) : "v"(a), "v"(b));
  return r;
}
DI u32x4 pack8_mfma(float a0, float a1, float a2, float a3, float a4, float a5, float a6, float a7) {
  u32x4 r;
  asm volatile("v_cvt_pk_bf16_f32 %0, %4, %5\n\tv_cvt_pk_bf16_f32 %1, %6, %7\n\tv_cvt_pk_bf16_f32 %2, %8, %9\n\tv_cvt_pk_bf16_f32 %3, %10, %11\n\ts_nop 1"
               : "=&v"(r[0]), "=&v"(r[1]), "=&v"(r[2]), "=&v"(r[3])
               : "v"(a0), "v"(a1), "v"(a2), "v"(a3), "v"(a4), "v"(a5), "v"(a6), "v"(a7));
  return r;
}
DI u16 f2bf(float x) { return (u16)(pack2(x, x) & 0xffffu); }
DI float bflo(unsigned v) { return __uint_as_float(v << 16); }
DI float bfhi(unsigned v) { return __uint_as_float(v & 0xffff0000u); }
DI float sigmoidf_(float x) { return 1.f / (1.f + __expf(-x)); }
DI float siluf_(float x) { return x / (1.f + __expf(-x)); }
DI float gelu_tanh(float x) {
  float z = 0.7978845608028654f * (x + 0.044715f * x * x * x);
  float e = __expf(2.f * z);
  float th = 1.f - 2.f / (e + 1.f);
  return 0.5f * x * (1.f + th);
}
DI float wave_sum(float v) {
#pragma unroll
  for (int o = 32; o > 0; o >>= 1) v += __shfl_xor(v, o);
  return v;
}
DI f32x4 mfma16(bf16x8 a, bf16x8 b, f32x4 c) { return __builtin_amdgcn_mfma_f32_16x16x32_bf16(a, b, c, 0, 0, 0); }

template <bool SWAP, int DEPTH = 1, bool LEAN = false>
DI void gemm_core(f32x4 (&acc)[4][4], const u16* __restrict__ A, int lda, const u16* __restrict__ Bt, int ldb, int K, char* smem) {
  const int tid = threadIdx.x, lane = tid & 63, w = tid >> 6, wr = w >> 1, wc = w & 1, l15 = lane & 15, g = lane >> 4;
  const int lrow = tid >> 3, lch = tid & 7;
  const char* ap = (const char*)A;
  const char* bp = (const char*)Bt;
  const unsigned aoff = (unsigned)(lrow * lda + lch * 8) * 2u;
  const unsigned boff = (unsigned)(lrow * ldb + lch * 8) * 2u;
  u32x4 ra0[4], rb0[4], ra1[4], rb1[4];
  const int nk = K >> 6;
#define G_LOAD(RA, RB, KT)                                                        \
  _Pragma("unroll") for (int c = 0; c < 4; ++c) {                                 \
    RA[c] = *(const u32x4*)(ap + ((size_t)c * 64 * lda + (KT) * 128) + aoff);     \
    RB[c] = *(const u32x4*)(bp + ((size_t)c * 64 * ldb + (KT) * 128) + boff);     \
  }
#define G_STORE(RA, RB, BO)                                                       \
  _Pragma("unroll") for (int c = 0; c < 4; ++c) {                                 \
    *(u32x4*)(wbase + (BO) + c * 32 * 128) = RA[c];                               \
    *(u32x4*)(wbase + (BO) + 16384 + c * 32 * 128) = RB[c];                       \
  }
#define G_COMPUTE_FULL(BO)                                                             \
  {                                                                               \
    bf16x8 af[2][4], bfr[2][4];                                                   \
    _Pragma("unroll") for (int i = 0; i < 4; ++i) af[0][i] = *(const bf16x8*)(ard0 + (BO) + i * 16 * 128);  \
    _Pragma("unroll") for (int j = 0; j < 4; ++j) bfr[0][j] = *(const bf16x8*)(brd0 + (BO) + j * 16 * 128); \
    _Pragma("unroll") for (int i = 0; i < 4; ++i) af[1][i] = *(const bf16x8*)(ard1 + (BO) + i * 16 * 128);  \
    _Pragma("unroll") for (int j = 0; j < 4; ++j) bfr[1][j] = *(const bf16x8*)(brd1 + (BO) + j * 16 * 128); \
    __builtin_amdgcn_sched_barrier(0);                                            \
    __builtin_amdgcn_s_setprio(1);                                                \
    _Pragma("unroll") for (int s = 0; s < 2; ++s)                                 \
      _Pragma("unroll") for (int i = 0; i < 4; ++i)                               \
        _Pragma("unroll") for (int j = 0; j < 4; ++j)                             \
          acc[i][j] = SWAP ? mfma16(bfr[s][j], af[s][i], acc[i][j]) : mfma16(af[s][i], bfr[s][j], acc[i][j]); \
    __builtin_amdgcn_s_setprio(0);                                                \
  }
#define G_COMPUTE_LEAN(BO)                                                        \
  _Pragma("unroll") for (int s = 0; s < 2; ++s) {                                 \
    bf16x8 af[4];                                                                 \
    _Pragma("unroll") for (int i = 0; i < 4; ++i) af[i] = *(const bf16x8*)((s ? ard1 : ard0) + (BO) + i * 16 * 128);  \
    _Pragma("unroll") for (int j = 0; j < 4; ++j) {                               \
      const bf16x8 bfr = *(const bf16x8*)((s ? brd1 : brd0) + (BO) + j * 16 * 128);   \
      _Pragma("unroll") for (int i = 0; i < 4; ++i)                               \
        acc[i][j] = SWAP ? mfma16(bfr, af[i], acc[i][j]) : mfma16(af[i], bfr, acc[i][j]); \
    }                                                                             \
  }
#define G_COMPUTE(BO) if constexpr (LEAN) { G_COMPUTE_LEAN(BO) } else { G_COMPUTE_FULL(BO) }
  char* wbase = smem + lrow * 128 + ((lch ^ ((lrow >> 1) & 7)) << 4);
  const int hsw = l15 >> 1;
  const char* ard0 = smem + (wr * 64 + l15) * 128 + ((g ^ hsw) << 4);
  const char* ard1 = smem + (wr * 64 + l15) * 128 + (((4 + g) ^ hsw) << 4);
  const char* brd0 = smem + 16384 + (wc * 64 + l15) * 128 + ((g ^ hsw) << 4);
  const char* brd1 = smem + 16384 + (wc * 64 + l15) * 128 + (((4 + g) ^ hsw) << 4);
  if constexpr (DEPTH == 2) {
    G_LOAD(ra0, rb0, 0);
    G_LOAD(ra1, rb1, 1);
    G_STORE(ra0, rb0, 0);
    __syncthreads();
    for (int kt = 0; kt < nk; kt += 2) {
      if (kt + 2 < nk) G_LOAD(ra0, rb0, kt + 2);
      __builtin_amdgcn_sched_barrier(0);
      G_COMPUTE(0);
      __builtin_amdgcn_sched_barrier(0);
      G_STORE(ra1, rb1, 32768);
      __syncthreads();
      if (kt + 3 < nk) G_LOAD(ra1, rb1, kt + 3);
      __builtin_amdgcn_sched_barrier(0);
      G_COMPUTE(32768);
      __builtin_amdgcn_sched_barrier(0);
      if (kt + 2 < nk) G_STORE(ra0, rb0, 0);
      __syncthreads();
    }
  } else if constexpr (LEAN) {
#define G_LOADH(P, OFF, LD, KT)                                                   \
  _Pragma("unroll") for (int c = 0; c < 4; ++c) ra0[c] = *(const u32x4*)((P) + ((size_t)c * 64 * (LD) + (KT) * 128) + (OFF));
#define G_STOREH(BO)                                                              \
  _Pragma("unroll") for (int c = 0; c < 4; ++c) *(u32x4*)(wbase + (BO) + c * 32 * 128) = ra0[c];
#define G_COMPUTE_S(BO, S)                                                        \
  {                                                                               \
    bf16x8 af[4];                                                                 \
    _Pragma("unroll") for (int i = 0; i < 4; ++i) af[i] = *(const bf16x8*)((S ? ard1 : ard0) + (BO) + i * 16 * 128);  \
    _Pragma("unroll") for (int j = 0; j < 4; ++j) {                               \
      const bf16x8 bfr = *(const bf16x8*)((S ? brd1 : brd0) + (BO) + j * 16 * 128);   \
      _Pragma("unroll") for (int i = 0; i < 4; ++i)                               \
        acc[i][j] = SWAP ? mfma16(bfr, af[i], acc[i][j]) : mfma16(af[i], bfr, acc[i][j]); \
    }                                                                             \
  }
#define G_HALF(CUR, NXT, KTN)                                                     \
  {                                                                               \
    const int ktn_ = (KTN) < nk ? (KTN) : nk - 1;                                 \
    G_LOADH(ap, aoff, lda, ktn_)                                                  \
    __builtin_amdgcn_sched_barrier(0);                                            \
    G_COMPUTE_S(CUR, 0)                                                           \
    __builtin_amdgcn_sched_barrier(0);                                            \
    G_STOREH(NXT)                                                                 \
    G_LOADH(bp, boff, ldb, ktn_)                                                  \
    __builtin_amdgcn_sched_barrier(0);                                            \
    G_COMPUTE_S(CUR, 1)                                                           \
    __builtin_amdgcn_sched_barrier(0);                                            \
    G_STOREH((NXT) + 16384)                                                       \
    __syncthreads();                                                              \
  }
    G_LOADH(ap, aoff, lda, 0)
    G_STOREH(0)
    G_LOADH(bp, boff, ldb, 0)
    G_STOREH(16384)
    __syncthreads();
    for (int kt = 0; kt < nk; kt += 2) {
      G_HALF(0, 32768, kt + 1)
      G_HALF(32768, 0, kt + 2)
    }
#undef G_LOADH
#undef G_STOREH
#undef G_COMPUTE_S
#undef G_HALF
  } else {
    G_LOAD(ra0, rb0, 0);
    G_STORE(ra0, rb0, 0);
    __syncthreads();
    for (int kt = 0; kt < nk; kt += 2) {
      G_LOAD(ra0, rb0, kt + 1);
      __builtin_amdgcn_sched_barrier(0);
      G_COMPUTE(0);
      __builtin_amdgcn_sched_barrier(0);
      G_STORE(ra0, rb0, 32768);
      __syncthreads();
      if (kt + 2 < nk) G_LOAD(ra0, rb0, kt + 2);
      __builtin_amdgcn_sched_barrier(0);
      G_COMPUTE(32768);
      __builtin_amdgcn_sched_barrier(0);
      if (kt + 2 < nk) G_STORE(ra0, rb0, 0);
      __syncthreads();
    }
  }
#undef G_LOAD
#undef G_STORE
#undef G_COMPUTE
#undef G_COMPUTE_FULL
#undef G_COMPUTE_LEAN
}

DI void zero_acc(f32x4 (&acc)[4][4]) {
#pragma unroll
  for (int i = 0; i < 4; ++i)
#pragma unroll
    for (int j = 0; j < 4; ++j) acc[i][j] = f32x4{0.f, 0.f, 0.f, 0.f};
}

DI void swz(int v, int NT, int GN, int& mt, int& nt) {
#if XCD_MODE == 0
  int xcd = v & 7, j = v >> 3;
#else
  int xcd = (v & 511) >> 6, j = ((v >> 9) << 6) + (v & 63);
#endif
  int per_mg = 8 * NT;
  int mg = j / per_mg, r = j - mg * per_mg;
  int ng = r / (8 * GN), wv = r - ng * (8 * GN);
  mt = xcd * 32 + mg * 8 + (wv & 7);
  nt = ng * GN + (wv >> 3);
}

DI void epi_rowmajor(const f32x4 (&acc)[4][4], u16* dst, int ld, int m0, int c0, int mode, char* smem) {
  const int tid = threadIdx.x, lane = tid & 63, w = tid >> 6, wr = w >> 1, wc = w & 1, l15 = lane & 15, g = lane >> 4;
#pragma unroll
  for (int i = 0; i < 4; ++i) {
    const int row = wr * 64 + i * 16 + l15;
#pragma unroll
    for (int j = 0; j < 4; ++j) {
      f32x4 v = acc[i][j];
      if (mode == 1) { v[0] *= QSCALE; v[1] *= QSCALE; v[2] *= QSCALE; v[3] *= QSCALE; }
      else if (mode == 2) { v[0] = siluf_(v[0]); v[1] = siluf_(v[1]); v[2] = siluf_(v[2]); v[3] = siluf_(v[3]); }
      u32x2 o = {pack2(v[0], v[1]), pack2(v[2], v[3])};
      *(u32x2*)(smem + row * 272 + (wc * 64 + j * 16 + g * 4) * 2) = o;
    }
  }
  __syncthreads();
#pragma unroll
  for (int c = 0; c < 8; ++c) {
    const int id = c * 256 + tid, row = id >> 4, ch = id & 15;
    const u32x4 v = *(const u32x4*)(smem + row * 272 + ch * 16);
    *(u32x4*)(dst + (size_t)(m0 + row) * ld + c0 + ch * 8) = v;
  }
  __syncthreads();
}
DI void epi_rowmajor_direct(const f32x4 (&acc)[4][4], u16* dst, int ld, int m0, int c0, int mode) {
  const int tid = threadIdx.x, lane = tid & 63, w = tid >> 6, wr = w >> 1, wc = w & 1, l15 = lane & 15, g = lane >> 4;
#pragma unroll
  for (int i = 0; i < 4; ++i) {
    const size_t row = (size_t)(m0 + wr * 64 + i * 16 + l15);
#pragma unroll
    for (int j = 0; j < 4; ++j) {
      f32x4 v = acc[i][j];
      if (mode == 1) { v[0] *= QSCALE; v[1] *= QSCALE; v[2] *= QSCALE; v[3] *= QSCALE; }
      else if (mode == 2) { v[0] = siluf_(v[0]); v[1] = siluf_(v[1]); v[2] = siluf_(v[2]); v[3] = siluf_(v[3]); }
      u32x2 o = {pack2(v[0], v[1]), pack2(v[2], v[3])};
      *(u32x2*)(dst + row * ld + c0 + wc * 64 + j * 16 + g * 4) = o;
    }
  }
}
DI void epi_transposed(const f32x4 (&acc)[4][4], u16* dst, int m0, int c0, int H, int lgDh, int lgLk) {
  const int tid = threadIdx.x, lane = tid & 63, w = tid >> 6, wr = w >> 1, wc = w & 1, l15 = lane & 15, g = lane >> 4;
#pragma unroll
  for (int i = 0; i < 4; ++i) {
    const int token = m0 + wr * 64 + i * 16 + g * 4;
    const int bidx = token >> lgLk, tl = token & ((1 << lgLk) - 1);
#pragma unroll
    for (int j = 0; j < 4; ++j) {
      const int col = c0 + wc * 64 + j * 16 + l15;
      const int head = col >> lgDh, d = col & ((1 << lgDh) - 1);
      f32x4 v = acc[i][j];
      u32x2 o = {pack2(v[0], v[1]), pack2(v[2], v[3])};
      *(u32x2*)(dst + ((((((size_t)bidx * H + head) << lgDh) + d) << lgLk) + tl)) = o;
    }
  }
}

template <int D, bool FOX, bool PF, int NQ>
DI void attn_item(const u16* __restrict__ qbase, int ldq, const u16* __restrict__ kbase, int ldk,
                  const u16* __restrict__ vtbase, int ldv, const float* __restrict__ Fseq, int q0, int nkv,
                  const u16* __restrict__ gate, u16* outp, float scale, float kmaxv, char* smem) {
  const int tid = threadIdx.x, lane = tid & 63, w = tid >> 6, l15 = lane & 15, g = lane >> 4;
  constexpr int KROW = D * 2 + 16;
  constexpr int KBYTES = 64 * KROW;
  constexpr int VBYTES = D * 144;
  constexpr int BUF = KBYTES + VBYTES + 256;
  constexpr int NL = D / 32;
  constexpr int KCH = D / 8;
  static_assert(2 * BUF <= LDS_BYTES, "attn lds");

  bf16x8 qf[NQ][D / 32];
#pragma unroll
  for (int qi = 0; qi < NQ; ++qi)
#pragma unroll
    for (int s = 0; s < D / 32; ++s)
      qf[qi][s] = *(const bf16x8*)(qbase + (size_t)(w * (16 * NQ) + qi * 16 + l15) * ldq + s * 32 + g * 8);
  float fq[NQ];
#pragma unroll
  for (int qi = 0; qi < NQ; ++qi) fq[qi] = FOX ? Fseq[q0 + w * (16 * NQ) + qi * 16 + l15] : 0.f;
  f32x4 ot[D / 16][NQ];
#pragma unroll
  for (int dt = 0; dt < D / 16; ++dt)
#pragma unroll
    for (int qi = 0; qi < NQ; ++qi) ot[dt][qi] = f32x4{0, 0, 0, 0};
  float mrun[NQ], lsum[NQ];
#pragma unroll
  for (int qi = 0; qi < NQ; ++qi) { mrun[qi] = -1e30f; lsum[qi] = 0.f; }
  float qk[NQ];
#pragma unroll
  for (int qi = 0; qi < NQ; ++qi) {
    float ss = 0.f;
    if (FOX) {
#pragma unroll
      for (int s = 0; s < D / 32; ++s)
#pragma unroll
        for (int e = 0; e < 8; ++e) {
          const float v = __uint_as_float(((unsigned)(unsigned short)qf[qi][s][e]) << 16);
          ss += v * v;
        }
      ss += __shfl_xor(ss, 16);
      ss += __shfl_xor(ss, 32);
    }
    qk[qi] = sqrtf(ss) * kmaxv * 1.002f + 1e-3f;
  }
  int* flags = (int*)(smem + 73664);

  u32x4 kr[NL], vr[NL];
  f32x4 fr = {0, 0, 0, 0};
#define krow(c) (((c) * 256 + tid) / KCH)
#define kch(c) (((c) * 256 + tid) % KCH)
#define vrow(c) (((c) * 256 + tid) >> 3)
#define vch(c) (tid & 7)
#define ATT_LOAD(J)                                                                                   \
  {                                                                                                   \
    const int s0_ = (J) * 64;                                                                         \
    _Pragma("unroll") for (int c = 0; c < NL; ++c) {                                                  \
      kr[c] = *(const u32x4*)(kbase + (size_t)(s0_ + krow(c)) * ldk + kch(c) * 8);                    \
      vr[c] = *(const u32x4*)(vtbase + (size_t)vrow(c) * ldv + s0_ + vch(c) * 8);                     \
    }                                                                                                 \
    if (FOX && tid < 16) fr = *(const f32x4*)(Fseq + s0_ + tid * 4);                                  \
  }
#define ATT_STORE(BO)                                                                                 \
  {                                                                                                   \
    char* b_ = smem + (BO);                                                                           \
    _Pragma("unroll") for (int c = 0; c < NL; ++c) {                                                  \
      *(u32x4*)(b_ + krow(c) * KROW + kch(c) * 16) = kr[c];                                           \
      *(u32x4*)(b_ + KBYTES + vrow(c) * 144 + vch(c) * 16) = vr[c];                                   \
    }                                                                                                 \
    if (FOX && tid < 16) *(f32x4*)(b_ + KBYTES + VBYTES + tid * 16) = fr;                             \
  }
  ATT_LOAD(nkv - 1);
  ATT_STORE(0);
  __syncthreads();
  const int qlo = q0 + w * (16 * NQ);
  for (int j = nkv - 1, itn = 0; j >= 0; --j, ++itn) {
    const int cur = (itn & 1) * BUF;
    if (j > 0) {
      ATT_LOAD(j - 1);
      if (!PF) ATT_STORE(cur ^ BUF);
    }
    __builtin_amdgcn_sched_barrier(0);
    bool ok = false;
    const int s0 = j * 64;
    const bool active = !FOX || (s0 <= qlo + 16 * NQ - 1);
    if (active) {
      const char* Ks = smem + cur;
      const char* Vs = smem + cur + KBYTES;
      const char* Fs = smem + cur + KBYTES + VBYTES;
      f32x4 st[4][NQ];
#pragma unroll
      for (int kt = 0; kt < 4; ++kt)
#pragma unroll
        for (int qi = 0; qi < NQ; ++qi) st[kt][qi] = f32x4{0, 0, 0, 0};
#pragma unroll
      for (int s = 0; s < D / 32; ++s) {
        bf16x8 kf[4];
#pragma unroll
        for (int kt = 0; kt < 4; ++kt) kf[kt] = *(const bf16x8*)(Ks + (kt * 16 + l15) * KROW + s * 64 + g * 16);
#pragma unroll
        for (int kt = 0; kt < 4; ++kt)
#pragma unroll
          for (int qi = 0; qi < NQ; ++qi) st[kt][qi] = mfma16(kf[kt], qf[qi][s], st[kt][qi]);
      }
      if (FOX) {
        const bool need_mask = (s0 + 63 > qlo);
#pragma unroll
        for (int kt = 0; kt < 4; ++kt) {
          f32x4 fk = *(const f32x4*)(Fs + (kt * 16 + g * 4) * 4);
#pragma unroll
          for (int qi = 0; qi < NQ; ++qi) {
            const int qpos = qlo + qi * 16 + l15;
#pragma unroll
            for (int r = 0; r < 4; ++r) {
              float v = st[kt][qi][r] - fk[r];
              if (need_mask && (s0 + kt * 16 + g * 4 + r > qpos)) v = -1e30f;
              st[kt][qi][r] = v;
            }
          }
        }
      } else {
#pragma unroll
        for (int kt = 0; kt < 4; ++kt)
#pragma unroll
          for (int qi = 0; qi < NQ; ++qi)
#pragma unroll
            for (int r = 0; r < 4; ++r) st[kt][qi][r] *= scale;
      }
      float mxl[NQ];
      bool upd = false;
#pragma unroll
      for (int qi = 0; qi < NQ; ++qi) {
        float mx = st[0][qi][0];
#pragma unroll
        for (int kt = 0; kt < 4; ++kt)
#pragma unroll
          for (int r = 0; r < 4; ++r) mx = fmaxf(mx, st[kt][qi][r]);
        mxl[qi] = mx;
        upd = upd || (mx > mrun[qi]);
      }
      const bool resc = __any(upd);
      if (resc) {
#pragma unroll
        for (int qi = 0; qi < NQ; ++qi) {
          float mx = mxl[qi];
          mx = fmaxf(mx, __shfl_xor(mx, 16));
          mx = fmaxf(mx, __shfl_xor(mx, 32));
          const float mnew = fmaxf(mrun[qi], mx);
          const float al = __builtin_amdgcn_exp2f(mrun[qi] - mnew);
          mrun[qi] = mnew;
          lsum[qi] *= al;
#pragma unroll
          for (int dt = 0; dt < D / 16; ++dt)
#pragma unroll
            for (int r = 0; r < 4; ++r) ot[dt][qi][r] *= al;
        }
      }
#pragma unroll
      for (int qi = 0; qi < NQ; ++qi) {
        const float mref = mrun[qi];
        float ps = 0.f;
#pragma unroll
        for (int kt = 0; kt < 4; ++kt)
#pragma unroll
          for (int r = 0; r < 4; ++r) {
            float p = __builtin_amdgcn_exp2f(st[kt][qi][r] - mref);
            st[kt][qi][r] = p;
            ps += p;
          }
        lsum[qi] += ps;
      }
      bf16x8 pb[2][NQ];
#pragma unroll
      for (int kp = 0; kp < 2; ++kp)
#pragma unroll
        for (int qi = 0; qi < NQ; ++qi) {
          u32x4 t = pack8_mfma(st[2 * kp][qi][0], st[2 * kp][qi][1], st[2 * kp][qi][2], st[2 * kp][qi][3],
                               st[2 * kp + 1][qi][0], st[2 * kp + 1][qi][1], st[2 * kp + 1][qi][2], st[2 * kp + 1][qi][3]);
          pb[kp][qi] = __builtin_bit_cast(bf16x8, t);
        }
#pragma unroll
      for (int dt = 0; dt < D / 16; ++dt) {
#pragma unroll
        for (int kp = 0; kp < 2; ++kp) {
          u32x2 lo = *(const u32x2*)(Vs + (dt * 16 + l15) * 144 + (kp * 32 + g * 4) * 2);
          u32x2 hi = *(const u32x2*)(Vs + (dt * 16 + l15) * 144 + (kp * 32 + 16 + g * 4) * 2);
          u32x4 t = {lo[0], lo[1], hi[0], hi[1]};
          bf16x8 vf = __builtin_bit_cast(bf16x8, t);
#pragma unroll
          for (int qi = 0; qi < NQ; ++qi) ot[dt][qi] = mfma16(vf, pb[kp][qi], ot[dt][qi]);
        }
      }
      if (FOX) {
        const float f0 = *(const float*)Fs;
        ok = true;
#pragma unroll
        for (int qi = 0; qi < NQ; ++qi) ok = ok && (qk[qi] - f0 - mrun[qi] <= -30.f * LOG2E);
      }
    }
    __builtin_amdgcn_sched_barrier(0);
    if (PF && j > 0) ATT_STORE(cur ^ BUF);
    if (FOX) {
      const bool wave_ok = (__ballot(ok) == ~0ull);
      if (lane == 0) flags[(itn & 1) * 4 + w] = wave_ok ? 1 : 0;
      __syncthreads();
      const int* fl = flags + (itn & 1) * 4;
      if (fl[0] & fl[1] & fl[2] & fl[3]) break;
    } else {
      __syncthreads();
    }
  }
#undef ATT_LOAD
#undef ATT_STORE
#undef krow
#undef kch
#undef vrow
#undef vch
#pragma unroll
  for (int qi = 0; qi < NQ; ++qi) {
    float l = lsum[qi];
    l += __shfl_xor(l, 16);
    l += __shfl_xor(l, 32);
    const float inv = 1.f / l;
    const size_t rowoff = (size_t)(w * (16 * NQ) + qi * 16 + l15) * ldq;
#pragma unroll
    for (int dt = 0; dt < D / 16; ++dt) {
      const int col = dt * 16 + g * 4;
      u32x2 gv = *(const u32x2*)(gate + rowoff + col);
      u32x2 o = {pack2(ot[dt][qi][0] * inv * bflo(gv[0]), ot[dt][qi][1] * inv * bfhi(gv[0])),
                 pack2(ot[dt][qi][2] * inv * bflo(gv[1]), ot[dt][qi][3] * inv * bfhi(gv[1]))};
      *(u32x2*)(outp + rowoff + col) = o;
    }
  }
}

typedef float v2f __attribute__((ext_vector_type(2)));
DI void s5_load_u(const u16* ubuf, int b, int c, int g, char* ut, int lane) {
  const u16* src = ubuf + ((size_t)(b * L_ + c * 64 + lane)) * 768 + g * 16;
  u32x4 a = *(const u32x4*)src, bb = *(const u32x4*)(src + 8);
  f32x4 o0 = {bflo(a[0]), bfhi(a[0]), bflo(a[1]), bfhi(a[1])};
  f32x4 o1 = {bflo(a[2]), bfhi(a[2]), bflo(a[3]), bfhi(a[3])};
  f32x4 o2 = {bflo(bb[0]), bfhi(bb[0]), bflo(bb[1]), bfhi(bb[1])};
  f32x4 o3 = {bflo(bb[2]), bfhi(bb[2]), bflo(bb[3]), bfhi(bb[3])};
  *(f32x4*)(ut + lane * 64) = o0;
  *(f32x4*)(ut + lane * 64 + 16) = o1;
  *(f32x4*)(ut + lane * 64 + 32) = o2;
  *(f32x4*)(ut + lane * 64 + 48) = o3;
}
DI void s5_load_b(const float* bbar, int gp, v2f (&b2)[16]) {
#pragma unroll
  for (int q = 0; q < 4; ++q) {
    float4 t0 = *(const float4*)(bbar + (size_t)gp * 32 + q * 4);
    float4 t1 = *(const float4*)(bbar + (size_t)gp * 32 + 16 + q * 4);
    b2[4 * q] = v2f{t0.x, t1.x}; b2[4 * q + 1] = v2f{t0.y, t1.y};
    b2[4 * q + 2] = v2f{t0.z, t1.z}; b2[4 * q + 3] = v2f{t0.w, t1.w};
  }
}
DI v2f s5_x(const char* ut, int t, const v2f (&b2)[16]) {
  v2f xa = {0.f, 0.f}, xb = {0.f, 0.f};
#pragma unroll
  for (int q = 0; q < 4; ++q) {
    const f32x4 u = *(const f32x4*)(ut + t * 64 + q * 16);
    xa += b2[4 * q] * u[0];
    xb += b2[4 * q + 1] * u[1];
    xa += b2[4 * q + 2] * u[2];
    xb += b2[4 * q + 3] * u[3];
  }
  return xa + xb;
}

DI void s5_load_bfrag(const float* bbar, int g, int l15, int g4, bf16x8 (&ah)[8], bf16x8 (&al)[8]) {
#pragma unroll
  for (int kt = 0; kt < 8; ++kt) {
    u32x4 h = {0u, 0u, 0u, 0u}, l = {0u, 0u, 0u, 0u};
    if (g4 < 2) {
      const float* src = bbar + (size_t)(g * 64 + (kt & 3) * 16 + l15) * 32 + (kt >> 2) * 16 + g4 * 8;
      const float4 t0 = *(const float4*)src, t1 = *(const float4*)(src + 4);
      const float v[8] = {t0.x, t0.y, t0.z, t0.w, t1.x, t1.y, t1.z, t1.w};
#pragma unroll
      for (int q = 0; q < 4; ++q) {
        const unsigned h0 = f2bf(v[2 * q]), h1 = f2bf(v[2 * q + 1]);
        h[q] = h0 | (h1 << 16);
        l[q] = pack2(v[2 * q] - __uint_as_float(h0 << 16), v[2 * q + 1] - __uint_as_float(h1 << 16));
      }
    }
    ah[kt] = __builtin_bit_cast(bf16x8, h);
    al[kt] = __builtin_bit_cast(bf16x8, l);
  }
}
DI void s5_xsub(const u32x4 uraw, const bf16x8 (&ah)[8], const bf16x8 (&al)[8], char* xs, int l15, int g4) {
  const bf16x8 ub = __builtin_bit_cast(bf16x8, uraw);
#pragma unroll
  for (int kt = 0; kt < 8; ++kt) {
    f32x4 x = {0.f, 0.f, 0.f, 0.f};
    x = mfma16(ah[kt], ub, x);
    x = mfma16(al[kt], ub, x);
    *(f32x4*)(xs + l15 * 528 + (kt * 16 + g4 * 4) * 4) = x;
  }
}

#define XB_TMO      128
#define XB_XCNT(j)  (256  + 64 * (j))
#define XB_XSUB(j)  (1280 + 64 * (j))
#define XB_XGEN(j)  (2304 + 64 * (j))
#define XB_TOP      3328
#define XB_TOPGEN   3392
#define XCD_BAR_WORDS 3456
#define XB_SPIN_CAP (1u << 18)
DI unsigned xb_ld(unsigned* p) { return __hip_atomic_load(p, __ATOMIC_RELAXED, __HIP_MEMORY_SCOPE_AGENT); }
DI unsigned xb_add(unsigned* p, unsigned v) { return __hip_atomic_fetch_add(p, v, __ATOMIC_RELAXED, __HIP_MEMORY_SCOPE_AGENT); }
DI unsigned xb_xcc_id() { return (unsigned)__builtin_amdgcn_s_getreg((3 << 11) | 20) & 0xFu; }
#define XB_SPIN(cond, bar) do { unsigned _sp = 0; while (cond) { __builtin_amdgcn_s_sleep(1); \
    if ((++_sp & 255u) == 0u) { if (xb_ld(&(bar)[XB_TMO])) break; if (_sp > XB_SPIN_CAP) { atomicAdd(&(bar)[XB_TMO], 1u); break; } } } } while (0)
struct XcdBarrier { unsigned* bar; unsigned x; volatile unsigned* st; };
DI XcdBarrier xcd_barrier_post(unsigned* bar, volatile unsigned* st) {
  XcdBarrier b; b.bar = bar; b.x = xb_xcc_id(); b.st = st;
  if (threadIdx.x == 0) (void)xb_add(&bar[XB_XCNT(b.x)], 1u);
  return b;
}
DI void xcd_barrier_complete(unsigned* bar, unsigned x, unsigned& nloc, unsigned& nx) {
  const unsigned G = gridDim.x * gridDim.y * gridDim.z;
  unsigned sum, cnt, mine, sp = 0u;
  for (;;) {
    sum = 0u; cnt = 0u; mine = 0u;
#pragma unroll
    for (unsigned j = 0; j < 16; ++j) { const unsigned c = xb_ld(&bar[XB_XCNT(j)]); sum += c; cnt += (c > 0u) ? 1u : 0u; mine = (j == x) ? c : mine; }
    if (sum == G) break;
    __builtin_amdgcn_s_sleep(1);
    if ((++sp & 255u) == 0u) { if (xb_ld(&bar[XB_TMO])) break; if (sp > XB_SPIN_CAP) { atomicAdd(&bar[XB_TMO], 1u); break; } }
  }
  nloc = mine > 0u ? mine : 1u; nx = cnt > 0u ? cnt : 1u;
}
DI void xcd_barrier(const XcdBarrier& b) {
  asm volatile("s_waitcnt vmcnt(0)" ::: "memory");
  __syncthreads();
  if (threadIdx.x == 0) {
    unsigned* bar = b.bar;
    __builtin_amdgcn_s_waitcnt(0);
    unsigned nloc = b.st[0], nx = b.st[1];
    if (nloc == 0u) { xcd_barrier_complete(bar, b.x, nloc, nx); b.st[0] = nloc; b.st[1] = nx; }
    const unsigned old = xb_add(&bar[XB_XSUB(b.x)], 1u);
    const unsigned gen = old / nloc;
    if (old + 1u == (gen + 1u) * nloc) {
      __builtin_amdgcn_fence(__ATOMIC_RELEASE, "agent");
      asm volatile("s_waitcnt vmcnt(0)" ::: "memory");
      const unsigned og = xb_add(&bar[XB_TOP], 1u);
      const unsigned tg = og / nx;
      if (og + 1u == (tg + 1u) * nx) xb_add(&bar[XB_TOPGEN], 1u);
      else XB_SPIN(xb_ld(&bar[XB_TOPGEN]) == tg, bar);
      __builtin_amdgcn_fence(__ATOMIC_ACQUIRE, "agent");
      xb_add(&bar[XB_XGEN(b.x)], 1u);
      asm volatile("s_waitcnt vmcnt(0)" ::: "memory");
    } else {
      XB_SPIN(xb_ld(&bar[XB_XGEN(b.x)]) == gen, bar);
      __builtin_amdgcn_fence(__ATOMIC_ACQUIRE, "agent");
      asm volatile("s_waitcnt vmcnt(0)" ::: "memory");
    }
  }
  __syncthreads();
}

extern "C" __global__ void __launch_bounds__(256, 2) mega(Params p) {
  extern __shared__ __attribute__((aligned(16))) char smem[];
  cg::grid_group grid = cg::this_grid();
#define TIDVARS                                                                  \
  int tid = threadIdx.x;                                                         \
  asm volatile("" : "+v"(tid));                                                  \
  const int lane = tid & 63, w = tid >> 6, l15 = lane & 15, g4 = lane >> 4;      \
  (void)lane; (void)w; (void)l15; (void)g4;
  const int nblk = gridDim.x, bid = blockIdx.x;
  char* ws = p.ws;
  XcdBarrier xb;
  xb.bar = (unsigned*)(ws + OFF_CTL + 4096); xb.x = 0; xb.st = (volatile unsigned*)(smem + 73712);
  if (p.phase_lo < p.phase_hi) {
    if (threadIdx.x < 2) xb.st[threadIdx.x] = 0u;
    __syncthreads();
    xb = xcd_barrier_post((unsigned*)(ws + OFF_CTL + 4096), (volatile unsigned*)(smem + 73712));
    grid.sync();
  }
  u16* hbuf = (u16*)(ws + OFF_H);
  u16* qbuf = (u16*)(ws + OFF_Q);
  u16* gfbuf = (u16*)(ws + OFF_GF);
  u16* ubuf = (u16*)(ws + OFF_U);
  u16* gsbuf = (u16*)(ws + OFF_GS);
  u16* ys5a = (u16*)(ws + OFF_YS5A);
  u16* qmbuf = (u16*)(ws + OFF_QM);
  u16* gmbuf = (u16*)(ws + OFF_GM);
  u16* merged = (u16*)(ws + OFF_MERGED);
  u16* WinT = (u16*)(ws + OFF_WINT);
  u16* WglT = (u16*)(ws + OFF_WGLT);
  u16* WkvT = (u16*)(ws + OFF_WKVT);
  u16* WoutT = (u16*)(ws + OFF_WOUTT);
  u16* WpfT = (u16*)(ws + OFF_WPFT);
  u16* WpsT = (u16*)(ws + OFF_WPST);
  u16* WpmT = (u16*)(ws + OFF_WPMT);
  u16* WgluT = (u16*)(ws + OFF_WGLUT);
  u16* memn = (u16*)(ws + OFF_MEMN);
  u16* mkbuf = (u16*)(ws + OFF_MK);
  u16* mvT = (u16*)(ws + OFF_MVT);
  float* logf = (float*)(ws + OFF_LOGF);
  float* Fbuf = (float*)(ws + OFF_F);
  float2* abar = (float2*)(ws + OFF_S5AB);
  float* bbar = (float*)(ws + OFF_S5BB);
  float2* Sst = (float2*)(ws + OFF_S5S);
  float* part = (float*)(ws + OFF_PART);
  unsigned* ctl = (unsigned*)(ws + OFF_CTL);
  u16* kbuf = (u16*)p.out;
  u16* vT = (u16*)((char*)p.out + 48 * MiB);

  {
    if (PH(0)) {
      TIDVARS
      if (bid == 0 && tid < 128) ctl[tid] = 0u;
      float* tile = (float*)smem;
      for (int ti = bid; ti < 3344; ti += nblk) {
        const float* src; int ld, col0, K; u16* dst; int tt;
        if (ti < 576) { src = p.w_in; ld = 8716; col0 = 0; K = 1024; dst = WinT; tt = ti; }
        else if (ti < 1408) { src = p.w_in; ld = 8716; col0 = 2316; K = 1024; dst = WinT + (size_t)2304 * KLD; tt = ti - 576; }
        else if (ti < 2176) { src = p.w_in; ld = 8716; col0 = 5644; K = 1024; dst = WglT; tt = ti - 1408; }
        else if (ti < 2432) { src = p.w_mem_kv; ld = 1024; col0 = 0; K = 1024; dst = WkvT; tt = ti - 2176; }
        else if (ti < 2688) { src = p.w_out; ld = 1024; col0 = 0; K = 1024; dst = WoutT; tt = ti - 2432; }
        else if (ti < 2880) { src = p.w_pf; ld = 1024; col0 = 0; K = 768; dst = WpfT; tt = ti - 2688; }
        else if (ti < 3072) { src = p.w_ps; ld = 1024; col0 = 0; K = 768; dst = WpsT; tt = ti - 2880; }
        else if (ti < 3200) { src = p.w_pm; ld = 1024; col0 = 0; K = 512; dst = WpmT; tt = ti - 3072; }
        else { src = p.w_glu; ld = 768; col0 = 0; K = 768; dst = WgluT; tt = ti - 3200; }
        const int nkt = K >> 6;
        const int dld = (K == 1024) ? KLD : K;
        const int k0 = (tt % nkt) * 64, n0 = (tt / nkt) * 64;
#pragma unroll 4
        for (int i = 0; i < 16; ++i) {
          int k = i * 4 + w, n = lane;
          tile[k * 65 + n] = src[(size_t)(k0 + k) * ld + col0 + n0 + n];
        }
        __syncthreads();
#pragma unroll 4
        for (int i = 0; i < 16; ++i) {
          int n = i * 4 + w, k = lane;
          dst[(size_t)(n0 + n) * dld + k0 + k] = f2bf(tile[k * 65 + n]);
        }
        __syncthreads();
      }
      float* wfl = (float*)smem;
      for (int idx = tid; idx < 12288; idx += 256) {
        int k = idx / 12, j = idx - k * 12;
        wfl[j * 1024 + k] = p.w_in[(size_t)k * 8716 + 2304 + j];
      }
      __syncthreads();
      for (int row = bid * 4 + w; row < T_ + 1024; row += nblk * 4) {
        const bool isx = row < T_;
        const float* src = isx ? p.x + (size_t)row * 1024 : p.mem + (size_t)(row - T_) * 1024;
        const float* gsrc = isx ? p.g_norm : p.g_mem_norm;
        u16* dst = isx ? hbuf + (size_t)row * KLD : memn + (size_t)(row - T_) * KLD;
        float4 xv[4];
        float ss = 0.f;
#pragma unroll
        for (int i = 0; i < 4; ++i) {
          xv[i] = *(const float4*)(src + i * 256 + lane * 4);
          ss += xv[i].x * xv[i].x + xv[i].y * xv[i].y + xv[i].z * xv[i].z + xv[i].w * xv[i].w;
        }
        ss = wave_sum(ss);
        const float rstd = rsqrtf(ss * (1.f / 1024.f) + 1e-6f);
#pragma unroll
        for (int i = 0; i < 4; ++i) {
          float4 gv = *(const float4*)(gsrc + i * 256 + lane * 4);
          xv[i].x *= rstd * gv.x; xv[i].y *= rstd * gv.y; xv[i].z *= rstd * gv.z; xv[i].w *= rstd * gv.w;
          u32x2 o = {pack2(xv[i].x, xv[i].y), pack2(xv[i].z, xv[i].w)};
          *(u32x2*)(dst + i * 256 + lane * 4) = o;
        }
        if (isx) {
          float myfl = 0.f;
#pragma unroll
          for (int j = 0; j < 12; ++j) {
            float a = 0.f;
#pragma unroll
            for (int i = 0; i < 4; ++i) {
              float4 wv = *(const float4*)(wfl + j * 1024 + i * 256 + lane * 4);
              a += xv[i].x * wv.x + xv[i].y * wv.y + xv[i].z * wv.z + xv[i].w * wv.w;
            }
            a = wave_sum(a);
            if (lane == j) myfl = a;
          }
          if (lane < 12) {
            float xx = myfl + p.b_forget[lane];
            float lf = fminf(xx, 0.f) - log1pf(__expf(-fabsf(xx)));
            const int b = row >> 13, t = row & (L_ - 1);
            logf[(size_t)(b * 12 + lane) * L_ + t] = lf;
          }
        }
      }
      {
        const int gid = bid * 256 + tid;
        if (gid < 3072) {
          const int g = gid >> 6;
          const float step = expf(p.log_step[g]);
          const float lr = p.lam_re[gid], li = p.lam_im[gid];
          const float mag = expf(lr * step);
          const float ar = mag * cosf(li * step), ai = mag * sinf(li * step);
          const float den = lr * lr + li * li;
          const float nr = ar - 1.f, ni = ai;
          const float fr = (nr * lr + ni * li) / den, fi = (ni * lr - nr * li) / den;
          abar[gid] = make_float2(ar, ai);
#pragma unroll
          for (int h = 0; h < 16; ++h) {
            const float br = p.b_re[(size_t)gid * 16 + h], bi = p.b_im[(size_t)gid * 16 + h];
            bbar[(size_t)gid * 32 + h] = fr * br - fi * bi;
            bbar[(size_t)gid * 32 + 16 + h] = fr * bi + fi * br;
          }
        }
      }
      __syncthreads();
    }
    SYNC_BEFORE(1);
    if (PH(1)) {
      TIDVARS
      float* sm = (float*)smem;
      for (int seq = bid; seq < 48; seq += nblk) {
        const float* src = logf + (size_t)seq * L_ + tid * 32;
        float* dst = Fbuf + (size_t)seq * L_ + tid * 32;
        float v[32];
#pragma unroll
        for (int i = 0; i < 8; ++i) {
          float4 t = *(const float4*)(src + i * 4);
          v[4 * i] = t.x; v[4 * i + 1] = t.y; v[4 * i + 2] = t.z; v[4 * i + 3] = t.w;
        }
        float run = 0.f;
#pragma unroll
        for (int i = 0; i < 32; ++i) { run += v[i]; v[i] = run; }
        float incl = run;
#pragma unroll
        for (int o = 1; o < 64; o <<= 1) {
          float t = __shfl_up(incl, o);
          if (lane >= o) incl += t;
        }
        if (lane == 63) sm[w] = incl;
        __syncthreads();
        float base = incl - run;
        for (int w2 = 0; w2 < w; ++w2) base += sm[w2];
#pragma unroll
        for (int i = 0; i < 8; ++i) {
          float4 t = make_float4((v[4 * i] + base) * LOG2E, (v[4 * i + 1] + base) * LOG2E, (v[4 * i + 2] + base) * LOG2E, (v[4 * i + 3] + base) * LOG2E);
          *(float4*)(dst + i * 4) = t;
        }
        __syncthreads();
      }
      for (int pn = 0;; ++pn) {
        int v;
        if (nblk == 512) {
          const int i_ = bid >> 3, x_ = bid & 7;
          int j_;
          if (pn < 20) j_ = 64 * pn + i_;
          else if (i_ < 32 && pn < 24) j_ = 1280 + 32 * (pn - 20) + i_;
          else if (i_ < 8 && pn == 24) j_ = 1408 + i_;
          else break;
          v = j_ * 8 + x_;
        } else {
          v = bid + pn * nblk;
          if (v >= 11264 + 64) break;
        }
        const u16 *A, *Bt;
        int m0, n0;
        bool kvtile = v >= 11264;
        if (!kvtile) {
          int mt, nt;
          swz(v, 44, 4, mt, nt);
          m0 = mt * 128; n0 = nt * 128;
          A = hbuf + (size_t)m0 * KLD; Bt = WinT + (size_t)n0 * KLD;
        } else {
          int kv = v - 11264;
          m0 = (kv >> 3) * 128; n0 = (kv & 7) * 128;
          A = memn + (size_t)m0 * KLD; Bt = WkvT + (size_t)n0 * KLD;
        }
        const bool transp = kvtile ? (n0 >= 512) : (n0 >= 1536 && n0 < 2304);
        f32x4 acc[4][4];
        zero_acc(acc);
        if (transp) {
          gemm_core<false, 1>(acc, A, KLD, Bt, KLD, 1024, smem);
          if (kvtile) epi_transposed(acc, mvT, m0, n0 - 512, 4, 7, 8);
          else epi_transposed(acc, vT, m0, n0 - 1536, 12, 6, 13);
        } else {
          gemm_core<true>(acc, A, KLD, Bt, KLD, 1024, smem);
          u16* dst; int ld, c0, mode;
          if (kvtile) { dst = mkbuf; ld = 512; c0 = n0; mode = 0; }
          else if (n0 < 768) { dst = qbuf; ld = 768; c0 = n0; mode = 1; }
          else if (n0 < 1536) { dst = kbuf; ld = 768; c0 = n0 - 768; mode = 0; }
          else if (n0 < 3072) { dst = gfbuf; ld = 768; c0 = n0 - 2304; mode = 2; }
          else if (n0 < 3840) { dst = ubuf; ld = 768; c0 = n0 - 3072; mode = 0; }
          else if (n0 < 4608) { dst = gsbuf; ld = 768; c0 = n0 - 3840; mode = 2; }
          else if (n0 < 5120) { dst = qmbuf; ld = 512; c0 = n0 - 4608; mode = 0; }
          else { dst = gmbuf; ld = 512; c0 = n0 - 5120; mode = 2; }
          epi_rowmajor(acc, dst, ld, m0, c0, mode, smem);
          if (!kvtile && n0 >= 768 && n0 < 1536) {
            float mxv = 0.f;
#pragma unroll
            for (int i = 0; i < 4; ++i) {
              float ss = 0.f;
#pragma unroll
              for (int j = 0; j < 4; ++j)
#pragma unroll
                for (int r = 0; r < 4; ++r) {
                  const float v = __uint_as_float(((unsigned)f2bf(acc[i][j][r])) << 16);
                  ss += v * v;
                }
              ss += __shfl_xor(ss, 16);
              ss += __shfl_xor(ss, 32);
              mxv = fmaxf(mxv, ss);
            }
#pragma unroll
            for (int o = 1; o < 16; o <<= 1) mxv = fmaxf(mxv, __shfl_xor(mxv, o));
            if (lane == 0) atomicMax(&ctl[(m0 >> 13) * 12 + ((n0 - 768) >> 6) + (w & 1)], __float_as_uint(mxv));
          }
        }
      }
    }
    SYNC_BEFORE(2);
    if (PH(2)) {
      TIDVARS
      int* qslot = (int*)(smem + 73696);
#define NEXT_ITEM(CTR)                                        \
      {                                                       \
        if (tid == 0) *qslot = (int)atomicAdd(&ctl[CTR], 1u); \
        __syncthreads();                                      \
        it = *qslot;                                          \
        __syncthreads();                                      \
      }
      int it;
      for (;;) {
        NEXT_ITEM(64);
        if (it >= 3072) break;
        {
#ifndef NO_FOX
          const int qt = 63 - it / 48, bh = it % 48, b = bh / 12, h = bh % 12;
          const int q0 = qt * 128;
          const size_t qoff = ((size_t)(b * L_ + q0)) * 768 + h * 64;
          attn_item<64, true, true, 2>(qbuf + qoff, 768, kbuf + (size_t)b * L_ * 768 + h * 64, 768,
                              vT + (size_t)(b * 12 + h) * 64 * L_, L_, Fbuf + (size_t)(b * 12 + h) * L_, q0, 2 * qt + 2,
                              gfbuf + qoff, qbuf + qoff, 1.f, sqrtf(__uint_as_float(ctl[b * 12 + h])), smem);
#endif
        }
      }
      for (;;) {
        NEXT_ITEM(65);
        if (it >= 2048) break;
        {
#ifndef NO_MEM
          const int im = it;
          const int hm = im & 3, qt = (im >> 2) & 127, b = im >> 9;
          const int q0 = qt * 64;
          const size_t qoff = ((size_t)(b * L_ + q0)) * 512 + hm * 128;
          attn_item<128, false, false, 1>(qmbuf + qoff, 512, mkbuf + (size_t)b * 256 * 512 + hm * 128, 512,
                                mvT + (size_t)(b * 4 + hm) * 128 * 256, 256, nullptr, q0, 4,
                                gmbuf + qoff, qmbuf + qoff, 0.08838834764831845f * LOG2E, 0.f, smem);
#endif
        }
      }
      for (;;) {
        NEXT_ITEM(66);
        if (it >= 1536) break;
        {
#ifndef NO_S5P1
          const int wi = it * 4 + w;
          const int g = wi % 48, cg = (wi / 48) & 31, b = wi / (48 * 32);
          char* xs = smem + w * 12800;
          const int gp = g * 64 + lane;
          bf16x8 ah[8], al[8];
          s5_load_bfrag(bbar, g, l15, g4, ah, al);
          const float2 ab = abar[gp];
#pragma unroll 1
          for (int ci = 0; ci < 4; ++ci) {
          const int c = cg * 4 + ci;
          const u16* ub0 = ubuf + ((size_t)(b * L_ + c * 64 + l15)) * 768 + g * 16;
          u32x4 uq[4];
#pragma unroll
          for (int sub = 0; sub < 4; ++sub) {
            uq[sub] = u32x4{0u, 0u, 0u, 0u};
            if (g4 < 2) uq[sub] = *(const u32x4*)(ub0 + (size_t)sub * 16 * 768 + g4 * 8);
          }
          float hr = 0.f, hi = 0.f;
#pragma unroll
          for (int sub = 0; sub < 4; ++sub) {
            s5_xsub(uq[sub], ah, al, xs, l15, g4);
            asm volatile("s_waitcnt lgkmcnt(0)" ::: "memory");
#pragma unroll
            for (int tt = 0; tt < 16; ++tt) {
              const float xr = *(const float*)(xs + tt * 528 + lane * 4);
              const float xi = *(const float*)(xs + tt * 528 + 256 + lane * 4);
              const float nhr = ab.x * hr - ab.y * hi + xr;
              const float nhi = ab.x * hi + ab.y * hr + xi;
              hr = nhr; hi = nhi;
            }
            asm volatile("s_waitcnt lgkmcnt(0)" ::: "memory");
          }
          Sst[((size_t)(b * 128 + c) * 48 + g) * 64 + lane] = make_float2(hr, hi);
          }
          __syncthreads();
#endif
        }
      }
    }
    SYNC_BEFORE(3);
    if (PH(3)) {
      TIDVARS
      for (int wi = bid * 4 + w; wi < 192; wi += nblk * 4) {
        const int g = wi % 48, b = wi / 48;
        const float2 ab = abar[g * 64 + lane];
        float a64r = ab.x, a64i = ab.y;
#pragma unroll
        for (int q = 0; q < 6; ++q) {
          const float nr = a64r * a64r - a64i * a64i, ni = 2.f * a64r * a64i;
          a64r = nr; a64i = ni;
        }
        float2* sp = Sst + ((size_t)(b * 128) * 48 + g) * 64 + lane;
        float hr = 0.f, hi = 0.f;
        for (int cc = 0; cc < 128; cc += 16) {
          float2 sv[16];
#pragma unroll
          for (int q = 0; q < 16; ++q) sv[q] = sp[(size_t)(cc + q) * 48 * 64];
#pragma unroll
          for (int q = 0; q < 16; ++q) {
            sp[(size_t)(cc + q) * 48 * 64] = make_float2(hr, hi);
            const float nhr = a64r * hr - a64i * hi + sv[q].x;
            const float nhi = a64r * hi + a64i * hr + sv[q].y;
            hr = nhr; hi = nhi;
          }
        }
      }
    }
    SYNC_BEFORE(4);
    if (PH(4)) {
      TIDVARS
      for (int it = bid; it < 1536; it += nblk) {
        const int wi = it * 4 + w;
        const int g = wi % 48, cg = (wi / 48) & 31, b = wi / (48 * 32);
        char* xs = smem + w * 12800;
        char* stt = xs + 8448;
        const int gp = g * 64 + lane;
        bf16x8 ah[8], al[8];
        s5_load_bfrag(bbar, g, l15, g4, ah, al);
        const float2 ab = abar[gp];
        bf16x8 cf[4];
#pragma unroll
        for (int s = 0; s < 4; ++s) {
          const float* cs = (s < 2 ? p.c_re : p.c_im) + (size_t)(g * 16 + l15) * 64 + (s & 1) * 32 + g4 * 8;
          float4 t0 = *(const float4*)cs, t1 = *(const float4*)(cs + 4);
          const float sg = (s < 2) ? 1.f : -1.f;
          u32x4 t = pack8_mfma(sg * t0.x, sg * t0.y, sg * t0.z, sg * t0.w, sg * t1.x, sg * t1.y, sg * t1.z, sg * t1.w);
          cf[s] = __builtin_bit_cast(bf16x8, t);
        }
        const float4 dsk = *(const float4*)(p.s5_d + g * 16 + g4 * 4);
#pragma unroll 1
        for (int ci = 0; ci < 4; ++ci) {
        const int c = cg * 4 + ci;
        const u16* ub0 = ubuf + ((size_t)(b * L_ + c * 64 + l15)) * 768 + g * 16;
        const float2 hc = Sst[((size_t)(b * 128 + c) * 48 + g) * 64 + lane];
        float hr = hc.x, hi = hc.y;
        u32x4 uq[4];
        u32x2 uvq[4];
#pragma unroll
        for (int sub = 0; sub < 4; ++sub) {
          uq[sub] = u32x4{0u, 0u, 0u, 0u};
          if (g4 < 2) uq[sub] = *(const u32x4*)(ub0 + (size_t)sub * 16 * 768 + g4 * 8);
          uvq[sub] = *(const u32x2*)(ub0 + (size_t)sub * 16 * 768 + g4 * 4);
        }
        asm volatile("s_waitcnt lgkmcnt(0)" ::: "memory");
#pragma unroll
        for (int sub = 0; sub < 4; ++sub) {
          s5_xsub(uq[sub], ah, al, xs, l15, g4);
          asm volatile("s_waitcnt lgkmcnt(0)" ::: "memory");
#pragma unroll
          for (int tt = 0; tt < 16; ++tt) {
            const float xr = *(const float*)(xs + tt * 528 + lane * 4);
            const float xi = *(const float*)(xs + tt * 528 + 256 + lane * 4);
            const float nhr = ab.x * hr - ab.y * hi + xr;
            const float nhi = ab.x * hi + ab.y * hr + xi;
            hr = nhr; hi = nhi;
            *(u16*)(stt + tt * 272 + lane * 2) = f2bf(hr);
            *(u16*)(stt + tt * 272 + 128 + lane * 2) = f2bf(hi);
          }
          asm volatile("s_waitcnt lgkmcnt(0)" ::: "memory");
          f32x4 y = {0, 0, 0, 0};
#pragma unroll
          for (int s = 0; s < 4; ++s) {
            bf16x8 bfr = *(const bf16x8*)(stt + l15 * 272 + s * 64 + g4 * 16);
            y = mfma16(cf[s], bfr, y);
          }
          const int t = sub * 16 + l15;
          const u32x2 uv = uvq[sub];
          float o0 = gelu_tanh(y[0] + dsk.x * bflo(uv[0]));
          float o1 = gelu_tanh(y[1] + dsk.y * bfhi(uv[0]));
          float o2 = gelu_tanh(y[2] + dsk.z * bflo(uv[1]));
          float o3 = gelu_tanh(y[3] + dsk.w * bfhi(uv[1]));
          u32x2 o = {pack2(o0, o1), pack2(o2, o3)};
          *(u32x2*)(ys5a + ((size_t)(b * L_ + c * 64 + t)) * 768 + g * 16 + g4 * 4) = o;
          asm volatile("s_waitcnt lgkmcnt(0)" ::: "memory");
        }
        }
        __syncthreads();
      }
    }
    SYNC_BEFORE(5);
    if (PH(5)) {
      TIDVARS
      for (int v = bid; v < 256 * 6; v += nblk) {
        int mt, nt;
        swz(v, 6, 6, mt, nt);
        const int m0 = mt * 128, n0 = nt * 128;
        f32x4 acc[4][4];
        zero_acc(acc);
        gemm_core<true>(acc, ys5a + (size_t)m0 * 768, 768, WgluT + (size_t)n0 * 768, 768, 768, smem);
        const int wr = w >> 1, wc = w & 1;
#pragma unroll
        for (int i = 0; i < 4; ++i) {
          const size_t row = (size_t)(m0 + wr * 64 + i * 16 + l15);
#pragma unroll
          for (int j = 0; j < 4; ++j) {
            const int n = n0 + wc * 64 + j * 16 + g4 * 4;
            const float4 bg = *(const float4*)(p.b_glu + n);
            const u32x2 av = *(const u32x2*)(ys5a + row * 768 + n);
            const u32x2 sv = *(const u32x2*)(gsbuf + row * 768 + n);
            float o0 = bflo(av[0]) * sigmoidf_(acc[i][j][0] + bg.x) * bflo(sv[0]);
            float o1 = bfhi(av[0]) * sigmoidf_(acc[i][j][1] + bg.y) * bfhi(sv[0]);
            float o2 = bflo(av[1]) * sigmoidf_(acc[i][j][2] + bg.z) * bflo(sv[1]);
            float o3 = bfhi(av[1]) * sigmoidf_(acc[i][j][3] + bg.w) * bfhi(sv[1]);
            u32x2 o = {pack2(o0, o1), pack2(o2, o3)};
            *(u32x2*)(ubuf + row * 768 + n) = o;
          }
        }
      }
    }
    SYNC_BEFORE(6);
    if (PH(6)) {
      TIDVARS
      for (int v = bid; v < 256 * 8; v += nblk) {
        int mt, nt;
        swz(v, 8, 4, mt, nt);
        const int m0 = mt * 128, n0 = nt * 128;
        const int wr = w >> 1, wc = w & 1;
        char* gstash = ws + OFF_GATE + (size_t)bid * 32768;
        f32x4 accm[4][4];
        zero_acc(accm);
        const unsigned toff = (unsigned)tid * 16u;
#pragma unroll 1
        for (int stp = 0; stp < 6; ++stp) {
          const int br = stp >> 1;
          const u16* Ab; const u16* Wb; int Kb; int ldk;
          if (!(stp & 1)) { Ab = hbuf + (size_t)m0 * KLD; Wb = WglT + (size_t)(br * 1024 + n0) * KLD; Kb = 1024; }
          else if (br == 0) { Ab = qbuf + (size_t)m0 * 768; Wb = WpfT + (size_t)n0 * 768; Kb = 768; }
          else if (br == 1) { Ab = ubuf + (size_t)m0 * 768; Wb = WpsT + (size_t)n0 * 768; Kb = 768; }
          else { Ab = qmbuf + (size_t)m0 * 512; Wb = WpmT + (size_t)n0 * 512; Kb = 512; }
          f32x4 acc[4][4];
          zero_acc(acc);
          ldk = (Kb == 1024) ? KLD : Kb;
          gemm_core<true, 1, true>(acc, Ab, ldk, Wb, ldk, Kb, smem);
          if (!(stp & 1)) {
#pragma unroll
            for (int j = 0; j < 4; ++j) {
              const float4 bm = *(const float4*)(p.b_merge + br * 1024 + n0 + wc * 64 + j * 16 + g4 * 4);
#pragma unroll
              for (int i = 0; i < 4; i += 2) {
                u32x4 gq = {pack2(sigmoidf_(acc[i][j][0] + bm.x), sigmoidf_(acc[i][j][1] + bm.y)),
                            pack2(sigmoidf_(acc[i][j][2] + bm.z), sigmoidf_(acc[i][j][3] + bm.w)),
                            pack2(sigmoidf_(acc[i + 1][j][0] + bm.x), sigmoidf_(acc[i + 1][j][1] + bm.y)),
                            pack2(sigmoidf_(acc[i + 1][j][2] + bm.z), sigmoidf_(acc[i + 1][j][3] + bm.w))};
                *(u32x4*)(gstash + (j * 2 + (i >> 1)) * 4096 + toff) = gq;
              }
            }
          } else {
#pragma unroll
            for (int j = 0; j < 4; ++j)
#pragma unroll
              for (int i = 0; i < 4; i += 2) {
                const u32x4 gq = *(const u32x4*)(gstash + (j * 2 + (i >> 1)) * 4096 + toff);
                acc[i][j][0] *= bflo(gq[0]); acc[i][j][1] *= bfhi(gq[0]);
                acc[i][j][2] *= bflo(gq[1]); acc[i][j][3] *= bfhi(gq[1]);
                acc[i + 1][j][0] *= bflo(gq[2]); acc[i + 1][j][1] *= bfhi(gq[2]);
                acc[i + 1][j][2] *= bflo(gq[3]); acc[i + 1][j][3] *= bfhi(gq[3]);
                accm[i][j] += acc[i][j];
                accm[i + 1][j] += acc[i + 1][j];
                __builtin_amdgcn_sched_barrier(0);
              }
            if (br == 2) epi_rowmajor_direct(accm, merged, KLD, m0, n0, 0);
          }
        }
      }
    }
    SYNC_BEFORE(7);
    if (PH(7)) {
      TIDVARS
      for (int v = bid; v < 256 * 8; v += nblk) {
        int mt, nt;
        swz(v, 8, 4, mt, nt);
        const int m0 = mt * 128, n0 = nt * 128;
        const int wr = w >> 1, wc = w & 1;
        f32x4 acc[4][4];
        zero_acc(acc);
        gemm_core<true>(acc, merged + (size_t)m0 * KLD, KLD, WoutT + (size_t)n0 * KLD, KLD, 1024, smem);
#pragma unroll
        for (int i = 0; i < 4; ++i) {
          const size_t row = (size_t)(m0 + wr * 64 + i * 16 + l15);
          float ss = 0.f;
#pragma unroll
          for (int j = 0; j < 4; ++j) {
            const int n = n0 + wc * 64 + j * 16 + g4 * 4;
            const float4 xv = *(const float4*)(p.x + row * 1024 + n);
            float4 o = make_float4(xv.x + acc[i][j][0], xv.y + acc[i][j][1], xv.z + acc[i][j][2], xv.w + acc[i][j][3]);
            ss += o.x * o.x + o.y * o.y + o.z * o.z + o.w * o.w;
            *(float4*)(p.out + row * 1024 + n) = o;
          }
          ss += __shfl_xor(ss, 16);
          ss += __shfl_xor(ss, 32);
          if (g4 == 0) part[row * 16 + nt * 2 + wc] = ss;
        }
      }
    }
    SYNC_BEFORE(8);
    if (PH(8)) {
      TIDVARS
      for (int row = bid * 4 + w; row < T_; row += nblk * 8) {
        const int row2 = row + nblk * 4;
        const bool has2 = row2 < T_;
        float ssa = (lane < 16) ? part[(size_t)row * 16 + lane] : 0.f;
        float ssb = (has2 && lane < 16) ? part[(size_t)row2 * 16 + lane] : 0.f;
        float* oa = p.out + (size_t)row * 1024;
        float* ob = p.out + (size_t)(has2 ? row2 : row) * 1024;
        float4 va[4], vb[4];
#pragma unroll
        for (int i = 0; i < 4; ++i) {
          va[i] = *(const float4*)(oa + i * 256 + lane * 4);
          vb[i] = *(const float4*)(ob + i * 256 + lane * 4);
        }
        ssa = wave_sum(ssa);
        ssb = wave_sum(ssb);
        const float ra = rsqrtf(ssa * (1.f / 1024.f) + 1e-6f);
        const float rb = rsqrtf(ssb * (1.f / 1024.f) + 1e-6f);
#pragma unroll
        for (int i = 0; i < 4; ++i) {
          const float4 gv = *(const float4*)(p.g_final + i * 256 + lane * 4);
          va[i].x *= ra * gv.x; va[i].y *= ra * gv.y; va[i].z *= ra * gv.z; va[i].w *= ra * gv.w;
          *(float4*)(oa + i * 256 + lane * 4) = va[i];
          if (has2) {
            vb[i].x *= rb * gv.x; vb[i].y *= rb * gv.y; vb[i].z *= rb * gv.z; vb[i].w *= rb * gv.w;
            *(float4*)(ob + i * 256 + lane * 4) = vb[i];
          }
        }
      }
    }
  }
}

extern "C" void kernel_launch(void* const* d_in, const int* in_sizes, int n_in, void* d_out, int out_size, void* d_ws,
                              size_t ws_size, hipStream_t stream) {
  static int grid_blocks = 0;
  if (!grid_blocks) {
    if (ws_size < WS_END || n_in != 23) {
      fprintf(stderr, "kernel_launch: unexpected ws_size %zu (need %zu) or n_in %d\n", ws_size, (size_t)WS_END, n_in);
      grid_blocks = -1;
      return;
    }
    int dev = 0, cus = 0, per_cu = 0;
    (void)hipGetDevice(&dev);
    (void)hipDeviceGetAttribute(&cus, hipDeviceAttributeMultiprocessorCount, dev);
    (void)hipFuncSetAttribute((const void*)mega, hipFuncAttributeMaxDynamicSharedMemorySize, LDS_BYTES);
    (void)hipOccupancyMaxActiveBlocksPerMultiprocessor(&per_cu, (const void*)mega, 256, LDS_BYTES);
    per_cu = (per_cu >= 2) ? 2 : 1;
    grid_blocks = cus * per_cu;
  }
  if (grid_blocks < 0) return;
  Params p{};
  const float** pp = (const float**)&p;
  for (int i = 0; i < 23; ++i) pp[i] = (const float*)d_in[i];
  p.out = (float*)d_out;
  p.ws = (char*)d_ws;
#if COOP
  (void)hipMemsetAsync((char*)d_ws + OFF_CTL + 4096, 0, XCD_BAR_WORDS * 4, stream);
  p.phase_lo = 0;
  p.phase_hi = NPHASE - 1;
  void* args[] = {&p};
  hipError_t e = hipLaunchCooperativeKernel((const void*)mega, dim3(grid_blocks), dim3(256), args, LDS_BYTES, stream);
  if (e != hipSuccess) fprintf(stderr, "cooperative launch failed: %s (grid %d)\n", hipGetErrorString(e), grid_blocks);
#else
  for (int ph = 0; ph < NPHASE; ++ph) {
    p.phase_lo = ph;
    p.phase_hi = ph;
    hipLaunchKernelGGL(mega, dim3(grid_blocks), dim3(256), LDS_BYTES, stream, p);
#ifdef PROBE_DUP
    if (ph == PROBE_DUP) {
      for (int rep = 0; rep < 2; ++rep) {
        if (ph == 2) { p.phase_lo = p.phase_hi = 1; hipLaunchKernelGGL(mega, dim3(grid_blocks), dim3(256), LDS_BYTES, stream, p); p.phase_lo = p.phase_hi = 2; }
        hipLaunchKernelGGL(mega, dim3(grid_blocks), dim3(256), LDS_BYTES, stream, p);
      }
    }
#endif
  }
#endif
}
```

```cpp
#include <hip/hip_runtime.h>
#include <hip/hip_cooperative_groups.h>
#include <stdint.h>
#include <stdio.h>
namespace cg = cooperative_groups;

#ifndef COOP
#define COOP 1
#define XCD_MODE 0
#endif

#define DI __device__ __forceinline__
#ifdef ONLY_PHASE
#define PH(n) ((n) == ONLY_PHASE && p.phase_lo <= (n) && (n) <= p.phase_hi)
#else
#define PH(n) (p.phase_lo <= (n) && (n) <= p.phase_hi)
#endif
#define SYNC_BEFORE(n)                                        \
  if (p.phase_lo < (n) && (n) <= p.phase_hi) {                \
    xcd_barrier(xb);                                          \
  }
typedef unsigned short u16;
using bf16x8 = __attribute__((ext_vector_type(8))) short;
using f32x4 = __attribute__((ext_vector_type(4))) float;
using u32x4 = __attribute__((ext_vector_type(4))) unsigned;
using u32x2 = __attribute__((ext_vector_type(2))) unsigned;

constexpr int T_ = 32768, L_ = 8192;
constexpr int LDS_BYTES = 73728;
constexpr int NPHASE = 9;

constexpr size_t MiB = 1u << 20;
constexpr float LOG2E = 1.4426950408889634f;
constexpr float QSCALE = 0.125f * LOG2E;
constexpr int KLD = 1088;
constexpr size_t OFF_H = 0;
constexpr size_t OFF_Q = 68 * MiB;
constexpr size_t OFF_GF = 116 * MiB;
constexpr size_t OFF_U = 164 * MiB;
constexpr size_t OFF_GS = 212 * MiB;
constexpr size_t OFF_YS5A = 260 * MiB;
constexpr size_t OFF_QM = 308 * MiB;
constexpr size_t OFF_GM = 340 * MiB;
constexpr size_t OFF_MERGED = 372 * MiB;
constexpr size_t OFF_WINT = 440 * MiB;
constexpr size_t OFF_WGLT = 453 * MiB;
constexpr size_t OFF_WKVT = 460 * MiB;
constexpr size_t OFF_WOUTT = 463 * MiB;
constexpr size_t OFF_WPFT = 466 * MiB;
constexpr size_t OFF_WPST = 468 * MiB;
constexpr size_t OFF_WPMT = 470 * MiB;
constexpr size_t OFF_WGLUT = 471 * MiB;
constexpr size_t OFF_MEMN = 473 * MiB;
constexpr size_t OFF_MK = 476 * MiB;
constexpr size_t OFF_MVT = 477 * MiB;
constexpr size_t OFF_LOGF = 478 * MiB;
constexpr size_t OFF_F = 480 * MiB;
constexpr size_t OFF_S5AB = 482 * MiB;
constexpr size_t OFF_S5BB = 483 * MiB;
constexpr size_t OFF_S5S = 484 * MiB;
constexpr size_t OFF_PART = 496 * MiB;
constexpr size_t OFF_GATE = OFF_GS;
constexpr size_t OFF_CTL = 498 * MiB;
constexpr size_t WS_END = 499 * MiB;

struct Params {
  const float *x, *mem, *g_norm, *g_mem_norm, *g_final, *w_in, *b_forget, *b_merge, *w_mem_kv;
  const float *lam_re, *lam_im, *log_step, *b_re, *b_im, *c_re, *c_im, *s5_d, *w_glu, *b_glu;
  const float *w_pf, *w_ps, *w_pm, *w_out;
  float* out;
  char* ws;
  int phase_lo, phase_hi;
};

DI unsigned pack2(float a, float b) {
  unsigned r;
  asm volatile("v_cvt_pk_bf16_f32 %0, %1, %2" : "=v"(r) : "v"(a), "v"(b));
  return r;
}
DI u32x4 pack8_mfma(float a0, float a1, float a2, float a3, float a4, float a5, float a6, float a7) {
  u32x4 r;
  asm volatile("v_cvt_pk_bf16_f32 %0, %4, %5\n\tv_cvt_pk_bf16_f32 %1, %6, %7\n\tv_cvt_pk_bf16_f32 %2, %8, %9\n\tv_cvt_pk_bf16_f32 %3, %10, %11\n\ts_nop 1"
               : "=&v"(r[0]), "=&v"(r[1]), "=&v"(r[2]), "=&v"(r[3])
               : "v"(a0), "v"(a1), "v"(a2), "v"(a3), "v"(a4), "v"(a5), "v"(a6), "v"(a7));
  return r;
}
DI u16 f2bf(float x) { return (u16)(pack2(x, x) & 0xffffu); }
DI float bflo(unsigned v) { return __uint_as_float(v << 16); }
DI float bfhi(unsigned v) { return __uint_as_float(v & 0xffff0000u); }
DI float sigmoidf_(float x) { return 1.f / (1.f + __expf(-x)); }
DI float siluf_(float x) { return x / (1.f + __expf(-x)); }
DI float gelu_tanh(float x) {
  float z = 0.7978845608028654f * (x + 0.044715f * x * x * x);
  float e = __expf(2.f * z);
  float th = 1.f - 2.f / (e + 1.f);
  return 0.5f * x * (1.f + th);
}
DI float wave_sum(float v) {
#pragma unroll
  for (int o = 32; o > 0; o >>= 1) v += __shfl_xor(v, o);
  return v;
}
DI f32x4 mfma16(bf16x8 a, bf16x8 b, f32x4 c) { return __builtin_amdgcn_mfma_f32_16x16x32_bf16(a, b, c, 0, 0, 0); }

template <bool SWAP, int DEPTH = 1, bool LEAN = false>
DI void gemm_core(f32x4 (&acc)[4][4], const u16* __restrict__ A, int lda, const u16* __restrict__ Bt, int ldb, int K, char* smem) {
  const int tid = threadIdx.x, lane = tid & 63, w = tid >> 6, wr = w >> 1, wc = w & 1, l15 = lane & 15, g = lane >> 4;
  const int lrow = tid >> 3, lch = tid & 7;
  const char* ap = (const char*)A;
  const char* bp = (const char*)Bt;
  const unsigned aoff = (unsigned)(lrow * lda + lch * 8) * 2u;
  const unsigned boff = (unsigned)(lrow * ldb + lch * 8) * 2u;
  u32x4 ra0[4], rb0[4], ra1[4], rb1[4];
  const int nk = K >> 6;
#define G_LOAD(RA, RB, KT)                                                        \
  _Pragma("unroll") for (int c = 0; c < 4; ++c) {                                 \
    RA[c] = *(const u32x4*)(ap + ((size_t)c * 64 * lda + (KT) * 128) + aoff);     \
    RB[c] = *(const u32x4*)(bp + ((size_t)c * 64 * ldb + (KT) * 128) + boff);     \
  }
#define G_STORE(RA, RB, BO)                                                       \
  _Pragma("unroll") for (int c = 0; c < 4; ++c) {                                 \
    *(u32x4*)(wbase + (BO) + c * 32 * 128) = RA[c];                               \
    *(u32x4*)(wbase + (BO) + 16384 + c * 32 * 128) = RB[c];                       \
  }
#define G_COMPUTE_FULL(BO)                                                             \
  {                                                                               \
    bf16x8 af[2][4], bfr[2][4];                                                   \
    _Pragma("unroll") for (int i = 0; i < 4; ++i) af[0][i] = *(const bf16x8*)(ard0 + (BO) + i * 16 * 128);  \
    _Pragma("unroll") for (int j = 0; j < 4; ++j) bfr[0][j] = *(const bf16x8*)(brd0 + (BO) + j * 16 * 128); \
    _Pragma("unroll") for (int i = 0; i < 4; ++i) af[1][i] = *(const bf16x8*)(ard1 + (BO) + i * 16 * 128);  \
    _Pragma("unroll") for (int j = 0; j < 4; ++j) bfr[1][j] = *(const bf16x8*)(brd1 + (BO) + j * 16 * 128); \
    __builtin_amdgcn_sched_barrier(0);                                            \
    __builtin_amdgcn_s_setprio(1);                                                \
    _Pragma("unroll") for (int s = 0; s < 2; ++s)                                 \
      _Pragma("unroll") for (int i = 0; i < 4; ++i)                               \
        _Pragma("unroll") for (int j = 0; j < 4; ++j)                             \
          acc[i][j] = SWAP ? mfma16(bfr[s][j], af[s][i], acc[i][j]) : mfma16(af[s][i], bfr[s][j], acc[i][j]); \
    __builtin_amdgcn_s_setprio(0);                                                \
  }
#define G_COMPUTE_LEAN(BO)                                                        \
  _Pragma("unroll") for (int s = 0; s < 2; ++s) {                                 \
    bf16x8 af[4];                                                                 \
    _Pragma("unroll") for (int i = 0; i < 4; ++i) af[i] = *(const bf16x8*)((s ? ard1 : ard0) + (BO) + i * 16 * 128);  \
    _Pragma("unroll") for (int j = 0; j < 4; ++j) {                               \
      const bf16x8 bfr = *(const bf16x8*)((s ? brd1 : brd0) + (BO) + j * 16 * 128);   \
      _Pragma("unroll") for (int i = 0; i < 4; ++i)                               \
        acc[i][j] = SWAP ? mfma16(bfr, af[i], acc[i][j]) : mfma16(af[i], bfr, acc[i][j]); \
    }                                                                             \
  }
#define G_COMPUTE(BO) if constexpr (LEAN) { G_COMPUTE_LEAN(BO) } else { G_COMPUTE_FULL(BO) }
  char* wbase = smem + lrow * 128 + ((lch ^ ((lrow >> 1) & 7)) << 4);
  const int hsw = l15 >> 1;
  const char* ard0 = smem + (wr * 64 + l15) * 128 + ((g ^ hsw) << 4);
  const char* ard1 = smem + (wr * 64 + l15) * 128 + (((4 + g) ^ hsw) << 4);
  const char* brd0 = smem + 16384 + (wc * 64 + l15) * 128 + ((g ^ hsw) << 4);
  const char* brd1 = smem + 16384 + (wc * 64 + l15) * 128 + (((4 + g) ^ hsw) << 4);
  if constexpr (DEPTH == 2) {
    G_LOAD(ra0, rb0, 0);
    G_LOAD(ra1, rb1, 1);
    G_STORE(ra0, rb0, 0);
    __syncthreads();
    for (int kt = 0; kt < nk; kt += 2) {
      if (kt + 2 < nk) G_LOAD(ra0, rb0, kt + 2);
      __builtin_amdgcn_sched_barrier(0);
      G_COMPUTE(0);
      __builtin_amdgcn_sched_barrier(0);
      G_STORE(ra1, rb1, 32768);
      __syncthreads();
      if (kt + 3 < nk) G_LOAD(ra1, rb1, kt + 3);
      __builtin_amdgcn_sched_barrier(0);
      G_COMPUTE(32768);
      __builtin_amdgcn_sched_barrier(0);
      if (kt + 2 < nk) G_STORE(ra0, rb0, 0);
      __syncthreads();
    }
  } else if constexpr (LEAN) {
#define G_LOADH(P, OFF, LD, KT)                                                   \
  _Pragma("unroll") for (int c = 0; c < 4; ++c) ra0[c] = *(const u32x4*)((P) + ((size_t)c * 64 * (LD) + (KT) * 128) + (OFF));
#define G_STOREH(BO)                                                              \
  _Pragma("unroll") for (int c = 0; c < 4; ++c) *(u32x4*)(wbase + (BO) + c * 32 * 128) = ra0[c];
#define G_COMPUTE_S(BO, S)                                                        \
  {                                                                               \
    bf16x8 af[4];                                                                 \
    _Pragma("unroll") for (int i = 0; i < 4; ++i) af[i] = *(const bf16x8*)((S ? ard1 : ard0) + (BO) + i * 16 * 128);  \
    _Pragma("unroll") for (int j = 0; j < 4; ++j) {                               \
      const bf16x8 bfr = *(const bf16x8*)((S ? brd1 : brd0) + (BO) + j * 16 * 128);   \
      _Pragma("unroll") for (int i = 0; i < 4; ++i)                               \
        acc[i][j] = SWAP ? mfma16(bfr, af[i], acc[i][j]) : mfma16(af[i], bfr, acc[i][j]); \
    }                                                                             \
  }
#define G_HALF(CUR, NXT, KTN)                                                     \
  {                                                                               \
    const int ktn_ = (KTN) < nk ? (KTN) : nk - 1;                                 \
    G_LOADH(ap, aoff, lda, ktn_)                                                  \
    __builtin_amdgcn_sched_barrier(0);                                            \
    G_COMPUTE_S(CUR, 0)                                                           \
    __builtin_amdgcn_sched_barrier(0);                                            \
    G_STOREH(NXT)                                                                 \
    G_LOADH(bp, boff, ldb, ktn_)                                                  \
    __builtin_amdgcn_sched_barrier(0);                                            \
    G_COMPUTE_S(CUR, 1)                                                           \
    __builtin_amdgcn_sched_barrier(0);                                            \
    G_STOREH((NXT) + 16384)                                                       \
    __syncthreads();                                                              \
  }
    G_LOADH(ap, aoff, lda, 0)
    G_STOREH(0)
    G_LOADH(bp, boff, ldb, 0)
    G_STOREH(16384)
    __syncthreads();
    for (int kt = 0; kt < nk; kt += 2) {
      G_HALF(0, 32768, kt + 1)
      G_HALF(32768, 0, kt + 2)
    }
#undef G_LOADH
#undef G_STOREH
#undef G_COMPUTE_S
#undef G_HALF
  } else {
    const int grow = w * 8 + (lane >> 3);
    const int glc = (lane & 7) ^ ((w * 4 + (lane >> 4)) & 7);
    const unsigned gaoff = (unsigned)(grow * lda + glc * 8) * 2u;
    const unsigned gboff = (unsigned)(grow * ldb + glc * 8) * 2u;
    char* gl = smem + w * 1024 + lane * 16;
#define G_GLDS(KT, BO)                                                            \
  _Pragma("unroll") for (int c = 0; c < 4; ++c) {                                 \
    __builtin_amdgcn_global_load_lds((const unsigned*)(ap + ((size_t)c * 64 * lda + (size_t)(KT) * 128) + gaoff),          \
                                     (unsigned*)(gl + (BO) + c * 4096), 16, 0, 0);                                          \
    __builtin_amdgcn_global_load_lds((const unsigned*)(bp + ((size_t)c * 64 * ldb + (size_t)(KT) * 128) + gboff),          \
                                     (unsigned*)(gl + (BO) + 16384 + c * 4096), 16, 0, 0);                                  \
  }
    G_GLDS(0, 0)
    __syncthreads();
    for (int kt = 0; kt < nk; kt += 2) {
      G_GLDS(kt + 1, 32768)
      __builtin_amdgcn_sched_barrier(0);
      G_COMPUTE(0);
      __syncthreads();
      { const int k2 = (kt + 2 < nk) ? kt + 2 : nk - 1; G_GLDS(k2, 0) }
      __builtin_amdgcn_sched_barrier(0);
      G_COMPUTE(32768);
      __syncthreads();
    }
#undef G_GLDS
  }
#undef G_LOAD
#undef G_STORE
#undef G_COMPUTE
#undef G_COMPUTE_FULL
#undef G_COMPUTE_LEAN
}

DI void zero_acc(f32x4 (&acc)[4][4]) {
#pragma unroll
  for (int i = 0; i < 4; ++i)
#pragma unroll
    for (int j = 0; j < 4; ++j) acc[i][j] = f32x4{0.f, 0.f, 0.f, 0.f};
}

DI void swz(int v, int NT, int GN, int& mt, int& nt) {
#if XCD_MODE == 0
  int xcd = v & 7, j = v >> 3;
#else
  int xcd = (v & 511) >> 6, j = ((v >> 9) << 6) + (v & 63);
#endif
  int per_mg = 8 * NT;
  int mg = j / per_mg, r = j - mg * per_mg;
  int ng = r / (8 * GN), wv = r - ng * (8 * GN);
  mt = xcd * 32 + mg * 8 + (wv & 7);
  nt = ng * GN + (wv >> 3);
}

DI void epi_rowmajor(const f32x4 (&acc)[4][4], u16* dst, int ld, int m0, int c0, int mode, char* smem) {
  const int tid = threadIdx.x, lane = tid & 63, w = tid >> 6, wr = w >> 1, wc = w & 1, l15 = lane & 15, g = lane >> 4;
#pragma unroll
  for (int i = 0; i < 4; ++i) {
    const int row = wr * 64 + i * 16 + l15;
#pragma unroll
    for (int j = 0; j < 4; ++j) {
      f32x4 v = acc[i][j];
      if (mode == 1) { v[0] *= QSCALE; v[1] *= QSCALE; v[2] *= QSCALE; v[3] *= QSCALE; }
      else if (mode == 2) { v[0] = siluf_(v[0]); v[1] = siluf_(v[1]); v[2] = siluf_(v[2]); v[3] = siluf_(v[3]); }
      u32x2 o = {pack2(v[0], v[1]), pack2(v[2], v[3])};
      *(u32x2*)(smem + row * 272 + (wc * 64 + j * 16 + g * 4) * 2) = o;
    }
  }
  __syncthreads();
#pragma unroll
  for (int c = 0; c < 8; ++c) {
    const int id = c * 256 + tid, row = id >> 4, ch = id & 15;
    const u32x4 v = *(const u32x4*)(smem + row * 272 + ch * 16);
    *(u32x4*)(dst + (size_t)(m0 + row) * ld + c0 + ch * 8) = v;
  }
  __syncthreads();
}
DI void epi_rowmajor_direct(const f32x4 (&acc)[4][4], u16* dst, int ld, int m0, int c0, int mode) {
  const int tid = threadIdx.x, lane = tid & 63, w = tid >> 6, wr = w >> 1, wc = w & 1, l15 = lane & 15, g = lane >> 4;
#pragma unroll
  for (int i = 0; i < 4; ++i) {
    const size_t row = (size_t)(m0 + wr * 64 + i * 16 + l15);
#pragma unroll
    for (int j = 0; j < 4; ++j) {
      f32x4 v = acc[i][j];
      if (mode == 1) { v[0] *= QSCALE; v[1] *= QSCALE; v[2] *= QSCALE; v[3] *= QSCALE; }
      else if (mode == 2) { v[0] = siluf_(v[0]); v[1] = siluf_(v[1]); v[2] = siluf_(v[2]); v[3] = siluf_(v[3]); }
      u32x2 o = {pack2(v[0], v[1]), pack2(v[2], v[3])};
      *(u32x2*)(dst + row * ld + c0 + wc * 64 + j * 16 + g * 4) = o;
    }
  }
}
DI void epi_transposed(const f32x4 (&acc)[4][4], u16* dst, int m0, int c0, int H, int lgDh, int lgLk) {
  const int tid = threadIdx.x, lane = tid & 63, w = tid >> 6, wr = w >> 1, wc = w & 1, l15 = lane & 15, g = lane >> 4;
#pragma unroll
  for (int i = 0; i < 4; ++i) {
    const int token = m0 + wr * 64 + i * 16 + g * 4;
    const int bidx = token >> lgLk, tl = token & ((1 << lgLk) - 1);
#pragma unroll
    for (int j = 0; j < 4; ++j) {
      const int col = c0 + wc * 64 + j * 16 + l15;
      const int head = col >> lgDh, d = col & ((1 << lgDh) - 1);
      f32x4 v = acc[i][j];
      u32x2 o = {pack2(v[0], v[1]), pack2(v[2], v[3])};
      *(u32x2*)(dst + ((((((size_t)bidx * H + head) << lgDh) + d) << lgLk) + tl)) = o;
    }
  }
}

template <int D, bool FOX, bool PF, int NQ>
DI void attn_item(const u16* __restrict__ qbase, int ldq, const u16* __restrict__ kbase, int ldk,
                  const u16* __restrict__ vtbase, int ldv, const float* __restrict__ Fseq, int q0, int nkv,
                  const u16* __restrict__ gate, u16* outp, float scale, float kmaxv, char* smem) {
  const int tid = threadIdx.x, lane = tid & 63, w = tid >> 6, l15 = lane & 15, g = lane >> 4;
  constexpr int KROW = D * 2 + 16;
  constexpr int KBYTES = 64 * KROW;
  constexpr int VBYTES = D * 144;
  constexpr int BUF = KBYTES + VBYTES + 256;
  constexpr int NL = D / 32;
  constexpr int KCH = D / 8;
  static_assert(2 * BUF <= LDS_BYTES, "attn lds");

  bf16x8 qf[NQ][D / 32];
#pragma unroll
  for (int qi = 0; qi < NQ; ++qi)
#pragma unroll
    for (int s = 0; s < D / 32; ++s)
      qf[qi][s] = *(const bf16x8*)(qbase + (size_t)(w * (16 * NQ) + qi * 16 + l15) * ldq + s * 32 + g * 8);
  float fq[NQ];
#pragma unroll
  for (int qi = 0; qi < NQ; ++qi) fq[qi] = FOX ? Fseq[q0 + w * (16 * NQ) + qi * 16 + l15] : 0.f;
  f32x4 ot[D / 16][NQ];
#pragma unroll
  for (int dt = 0; dt < D / 16; ++dt)
#pragma unroll
    for (int qi = 0; qi < NQ; ++qi) ot[dt][qi] = f32x4{0, 0, 0, 0};
  float mrun[NQ], lsum[NQ];
#pragma unroll
  for (int qi = 0; qi < NQ; ++qi) { mrun[qi] = -1e30f; lsum[qi] = 0.f; }
  float qk[NQ];
#pragma unroll
  for (int qi = 0; qi < NQ; ++qi) {
    float ss = 0.f;
    if (FOX) {
#pragma unroll
      for (int s = 0; s < D / 32; ++s)
#pragma unroll
        for (int e = 0; e < 8; ++e) {
          const float v = __uint_as_float(((unsigned)(unsigned short)qf[qi][s][e]) << 16);
          ss += v * v;
        }
      ss += __shfl_xor(ss, 16);
      ss += __shfl_xor(ss, 32);
    }
    qk[qi] = sqrtf(ss) * kmaxv * 1.002f + 1e-3f;
  }
  int* flags = (int*)(smem + 73664);

  u32x4 kr[NL], vr[NL];
  f32x4 fr = {0, 0, 0, 0};
#define krow(c) (((c) * 256 + tid) / KCH)
#define kch(c) (((c) * 256 + tid) % KCH)
#define vrow(c) (((c) * 256 + tid) >> 3)
#define vch(c) (tid & 7)
#define ATT_LOAD(J)                                                                                   \
  {                                                                                                   \
    const int s0_ = (J) * 64;                                                                         \
    _Pragma("unroll") for (int c = 0; c < NL; ++c) {                                                  \
      kr[c] = *(const u32x4*)(kbase + (size_t)(s0_ + krow(c)) * ldk + kch(c) * 8);                    \
      vr[c] = *(const u32x4*)(vtbase + (size_t)vrow(c) * ldv + s0_ + vch(c) * 8);                     \
    }                                                                                                 \
    if (FOX && tid < 16) fr = *(const f32x4*)(Fseq + s0_ + tid * 4);                                  \
  }
#define ATT_STORE(BO)                                                                                 \
  {                                                                                                   \
    char* b_ = smem + (BO);                                                                           \
    _Pragma("unroll") for (int c = 0; c < NL; ++c) {                                                  \
      *(u32x4*)(b_ + krow(c) * KROW + kch(c) * 16) = kr[c];                                           \
      *(u32x4*)(b_ + KBYTES + vrow(c) * 144 + vch(c) * 16) = vr[c];                                   \
    }                                                                                                 \
    if (FOX && tid < 16) *(f32x4*)(b_ + KBYTES + VBYTES + tid * 16) = fr;                             \
  }
  ATT_LOAD(nkv - 1);
  ATT_STORE(0);
  __syncthreads();
  const int qlo = q0 + w * (16 * NQ);
  for (int j = nkv - 1, itn = 0; j >= 0; --j, ++itn) {
    const int cur = (itn & 1) * BUF;
    if (j > 0) {
      ATT_LOAD(j - 1);
      if (!PF) ATT_STORE(cur ^ BUF);
    }
    __builtin_amdgcn_sched_barrier(0);
    bool ok = false;
    const int s0 = j * 64;
    const bool active = !FOX || (s0 <= qlo + 16 * NQ - 1);
    if (active) {
      const char* Ks = smem + cur;
      const char* Vs = smem + cur + KBYTES;
      const char* Fs = smem + cur + KBYTES + VBYTES;
      f32x4 st[4][NQ];
#pragma unroll
      for (int kt = 0; kt < 4; ++kt)
#pragma unroll
        for (int qi = 0; qi < NQ; ++qi) st[kt][qi] = f32x4{0, 0, 0, 0};
#pragma unroll
      for (int s = 0; s < D / 32; ++s) {
        bf16x8 kf[4];
#pragma unroll
        for (int kt = 0; kt < 4; ++kt) kf[kt] = *(const bf16x8*)(Ks + (kt * 16 + l15) * KROW + s * 64 + g * 16);
#pragma unroll
        for (int kt = 0; kt < 4; ++kt)
#pragma unroll
          for (int qi = 0; qi < NQ; ++qi) st[kt][qi] = mfma16(kf[kt], qf[qi][s], st[kt][qi]);
      }
      if (FOX) {
        const bool need_mask = (s0 + 63 > qlo);
#pragma unroll
        for (int kt = 0; kt < 4; ++kt) {
          f32x4 fk = *(const f32x4*)(Fs + (kt * 16 + g * 4) * 4);
#pragma unroll
          for (int qi = 0; qi < NQ; ++qi) {
            const int qpos = qlo + qi * 16 + l15;
#pragma unroll
            for (int r = 0; r < 4; ++r) {
              float v = st[kt][qi][r] - fk[r];
              if (need_mask && (s0 + kt * 16 + g * 4 + r > qpos)) v = -1e30f;
              st[kt][qi][r] = v;
            }
          }
        }
      } else {
#pragma unroll
        for (int kt = 0; kt < 4; ++kt)
#pragma unroll
          for (int qi = 0; qi < NQ; ++qi)
#pragma unroll
            for (int r = 0; r < 4; ++r) st[kt][qi][r] *= scale;
      }
      float mxl[NQ];
      bool upd = false;
#pragma unroll
      for (int qi = 0; qi < NQ; ++qi) {
        float mx = st[0][qi][0];
#pragma unroll
        for (int kt = 0; kt < 4; ++kt)
#pragma unroll
          for (int r = 0; r < 4; ++r) mx = fmaxf(mx, st[kt][qi][r]);
        mxl[qi] = mx;
        upd = upd || (mx > mrun[qi]);
      }
      const bool resc = __any(upd);
      if (resc) {
#pragma unroll
        for (int qi = 0; qi < NQ; ++qi) {
          float mx = mxl[qi];
          mx = fmaxf(mx, __shfl_xor(mx, 16));
          mx = fmaxf(mx, __shfl_xor(mx, 32));
          const float mnew = fmaxf(mrun[qi], mx);
          const float al = __builtin_amdgcn_exp2f(mrun[qi] - mnew);
          mrun[qi] = mnew;
          lsum[qi] *= al;
#pragma unroll
          for (int dt = 0; dt < D / 16; ++dt)
#pragma unroll
            for (int r = 0; r < 4; ++r) ot[dt][qi][r] *= al;
        }
      }
#pragma unroll
      for (int qi = 0; qi < NQ; ++qi) {
        const float mref = mrun[qi];
        float ps = 0.f;
#pragma unroll
        for (int kt = 0; kt < 4; ++kt)
#pragma unroll
          for (int r = 0; r < 4; ++r) {
            float p = __builtin_amdgcn_exp2f(st[kt][qi][r] - mref);
            st[kt][qi][r] = p;
            ps += p;
          }
        lsum[qi] += ps;
      }
      bf16x8 pb[2][NQ];
#pragma unroll
      for (int kp = 0; kp < 2; ++kp)
#pragma unroll
        for (int qi = 0; qi < NQ; ++qi) {
          u32x4 t = pack8_mfma(st[2 * kp][qi][0], st[2 * kp][qi][1], st[2 * kp][qi][2], st[2 * kp][qi][3],
                               st[2 * kp + 1][qi][0], st[2 * kp + 1][qi][1], st[2 * kp + 1][qi][2], st[2 * kp + 1][qi][3]);
          pb[kp][qi] = __builtin_bit_cast(bf16x8, t);
        }
#pragma unroll
      for (int dt = 0; dt < D / 16; ++dt) {
#pragma unroll
        for (int kp = 0; kp < 2; ++kp) {
          u32x2 lo = *(const u32x2*)(Vs + (dt * 16 + l15) * 144 + (kp * 32 + g * 4) * 2);
          u32x2 hi = *(const u32x2*)(Vs + (dt * 16 + l15) * 144 + (kp * 32 + 16 + g * 4) * 2);
          u32x4 t = {lo[0], lo[1], hi[0], hi[1]};
          bf16x8 vf = __builtin_bit_cast(bf16x8, t);
#pragma unroll
          for (int qi = 0; qi < NQ; ++qi) ot[dt][qi] = mfma16(vf, pb[kp][qi], ot[dt][qi]);
        }
      }
      if (FOX) {
        const float f0 = *(const float*)Fs;
        ok = true;
#pragma unroll
        for (int qi = 0; qi < NQ; ++qi) ok = ok && (qk[qi] - f0 - mrun[qi] <= -30.f * LOG2E);
      }
    }
    __builtin_amdgcn_sched_barrier(0);
    if (PF && j > 0) ATT_STORE(cur ^ BUF);
    if (FOX) {
      const bool wave_ok = (__ballot(ok) == ~0ull);
      if (lane == 0) flags[(itn & 1) * 4 + w] = wave_ok ? 1 : 0;
      __syncthreads();
      const int* fl = flags + (itn & 1) * 4;
      if (fl[0] & fl[1] & fl[2] & fl[3]) break;
    } else {
      __syncthreads();
    }
  }
#undef ATT_LOAD
#undef ATT_STORE
#undef krow
#undef kch
#undef vrow
#undef vch
#pragma unroll
  for (int qi = 0; qi < NQ; ++qi) {
    float l = lsum[qi];
    l += __shfl_xor(l, 16);
    l += __shfl_xor(l, 32);
    const float inv = 1.f / l;
    const size_t rowoff = (size_t)(w * (16 * NQ) + qi * 16 + l15) * ldq;
#pragma unroll
    for (int dt = 0; dt < D / 16; ++dt) {
      const int col = dt * 16 + g * 4;
      u32x2 gv = *(const u32x2*)(gate + rowoff + col);
      u32x2 o = {pack2(ot[dt][qi][0] * inv * bflo(gv[0]), ot[dt][qi][1] * inv * bfhi(gv[0])),
                 pack2(ot[dt][qi][2] * inv * bflo(gv[1]), ot[dt][qi][3] * inv * bfhi(gv[1]))};
      *(u32x2*)(outp + rowoff + col) = o;
    }
  }
}

typedef float v2f __attribute__((ext_vector_type(2)));
DI void s5_load_u(const u16* ubuf, int b, int c, int g, char* ut, int lane) {
  const u16* src = ubuf + ((size_t)(b * L_ + c * 64 + lane)) * 768 + g * 16;
  u32x4 a = *(const u32x4*)src, bb = *(const u32x4*)(src + 8);
  f32x4 o0 = {bflo(a[0]), bfhi(a[0]), bflo(a[1]), bfhi(a[1])};
  f32x4 o1 = {bflo(a[2]), bfhi(a[2]), bflo(a[3]), bfhi(a[3])};
  f32x4 o2 = {bflo(bb[0]), bfhi(bb[0]), bflo(bb[1]), bfhi(bb[1])};
  f32x4 o3 = {bflo(bb[2]), bfhi(bb[2]), bflo(bb[3]), bfhi(bb[3])};
  *(f32x4*)(ut + lane * 64) = o0;
  *(f32x4*)(ut + lane * 64 + 16) = o1;
  *(f32x4*)(ut + lane * 64 + 32) = o2;
  *(f32x4*)(ut + lane * 64 + 48) = o3;
}
DI void s5_load_b(const float* bbar, int gp, v2f (&b2)[16]) {
#pragma unroll
  for (int q = 0; q < 4; ++q) {
    float4 t0 = *(const float4*)(bbar + (size_t)gp * 32 + q * 4);
    float4 t1 = *(const float4*)(bbar + (size_t)gp * 32 + 16 + q * 4);
    b2[4 * q] = v2f{t0.x, t1.x}; b2[4 * q + 1] = v2f{t0.y, t1.y};
    b2[4 * q + 2] = v2f{t0.z, t1.z}; b2[4 * q + 3] = v2f{t0.w, t1.w};
  }
}
DI v2f s5_x(const char* ut, int t, const v2f (&b2)[16]) {
  v2f xa = {0.f, 0.f}, xb = {0.f, 0.f};
#pragma unroll
  for (int q = 0; q < 4; ++q) {
    const f32x4 u = *(const f32x4*)(ut + t * 64 + q * 16);
    xa += b2[4 * q] * u[0];
    xb += b2[4 * q + 1] * u[1];
    xa += b2[4 * q + 2] * u[2];
    xb += b2[4 * q + 3] * u[3];
  }
  return xa + xb;
}

DI void s5_load_bfrag(const float* bbar, int g, int l15, int g4, bf16x8 (&ah)[8], bf16x8 (&al)[8]) {
#pragma unroll
  for (int kt = 0; kt < 8; ++kt) {
    u32x4 h = {0u, 0u, 0u, 0u}, l = {0u, 0u, 0u, 0u};
    if (g4 < 2) {
      const float* src = bbar + (size_t)(g * 64 + (kt & 3) * 16 + l15) * 32 + (kt >> 2) * 16 + g4 * 8;
      const float4 t0 = *(const float4*)src, t1 = *(const float4*)(src + 4);
      const float v[8] = {t0.x, t0.y, t0.z, t0.w, t1.x, t1.y, t1.z, t1.w};
#pragma unroll
      for (int q = 0; q < 4; ++q) {
        const unsigned h0 = f2bf(v[2 * q]), h1 = f2bf(v[2 * q + 1]);
        h[q] = h0 | (h1 << 16);
        l[q] = pack2(v[2 * q] - __uint_as_float(h0 << 16), v[2 * q + 1] - __uint_as_float(h1 << 16));
      }
    }
    ah[kt] = __builtin_bit_cast(bf16x8, h);
    al[kt] = __builtin_bit_cast(bf16x8, l);
  }
}
DI void s5_xsub(const u32x4 uraw, const bf16x8 (&ah)[8], const bf16x8 (&al)[8], char* xs, int l15, int g4) {
  const bf16x8 ub = __builtin_bit_cast(bf16x8, uraw);
#pragma unroll
  for (int kt = 0; kt < 8; ++kt) {
    f32x4 x = {0.f, 0.f, 0.f, 0.f};
    x = mfma16(ah[kt], ub, x);
    x = mfma16(al[kt], ub, x);
    *(f32x4*)(xs + l15 * 528 + (kt * 16 + g4 * 4) * 4) = x;
  }
}

#define XB_TMO      128
#define XB_XCNT(j)  (256  + 64 * (j))
#define XB_XSUB(j)  (1280 + 64 * (j))
#define XB_XGEN(j)  (2304 + 64 * (j))
#define XB_TOP      3328
#define XB_TOPGEN   3392
#define XCD_BAR_WORDS 3456
#define XB_SPIN_CAP (1u << 18)
DI unsigned xb_ld(unsigned* p) { return __hip_atomic_load(p, __ATOMIC_RELAXED, __HIP_MEMORY_SCOPE_AGENT); }
DI unsigned xb_add(unsigned* p, unsigned v) { return __hip_atomic_fetch_add(p, v, __ATOMIC_RELAXED, __HIP_MEMORY_SCOPE_AGENT); }
DI unsigned xb_xcc_id() { return (unsigned)__builtin_amdgcn_s_getreg((3 << 11) | 20) & 0xFu; }
#define XB_SPIN(cond, bar) do { unsigned _sp = 0; while (cond) { __builtin_amdgcn_s_sleep(1); \
    if ((++_sp & 255u) == 0u) { if (xb_ld(&(bar)[XB_TMO])) break; if (_sp > XB_SPIN_CAP) { atomicAdd(&(bar)[XB_TMO], 1u); break; } } } } while (0)
struct XcdBarrier { unsigned* bar; unsigned x; volatile unsigned* st; };
DI XcdBarrier xcd_barrier_post(unsigned* bar, volatile unsigned* st) {
  XcdBarrier b; b.bar = bar; b.x = xb_xcc_id(); b.st = st;
  if (threadIdx.x == 0) (void)xb_add(&bar[XB_XCNT(b.x)], 1u);
  return b;
}
DI void xcd_barrier_complete(unsigned* bar, unsigned x, unsigned& nloc, unsigned& nx) {
  const unsigned G = gridDim.x * gridDim.y * gridDim.z;
  unsigned sum, cnt, mine, sp = 0u;
  for (;;) {
    sum = 0u; cnt = 0u; mine = 0u;
#pragma unroll
    for (unsigned j = 0; j < 16; ++j) { const unsigned c = xb_ld(&bar[XB_XCNT(j)]); sum += c; cnt += (c > 0u) ? 1u : 0u; mine = (j == x) ? c : mine; }
    if (sum == G) break;
    __builtin_amdgcn_s_sleep(1);
    if ((++sp & 255u) == 0u) { if (xb_ld(&bar[XB_TMO])) break; if (sp > XB_SPIN_CAP) { atomicAdd(&bar[XB_TMO], 1u); break; } }
  }
  nloc = mine > 0u ? mine : 1u; nx = cnt > 0u ? cnt : 1u;
}
DI void xcd_barrier(const XcdBarrier& b) {
  asm volatile("s_waitcnt vmcnt(0)" ::: "memory");
  __syncthreads();
  if (threadIdx.x == 0) {
    unsigned* bar = b.bar;
    __builtin_amdgcn_s_waitcnt(0);
    unsigned nloc = b.st[0], nx = b.st[1];
    if (nloc == 0u) { xcd_barrier_complete(bar, b.x, nloc, nx); b.st[0] = nloc; b.st[1] = nx; }
    const unsigned old = xb_add(&bar[XB_XSUB(b.x)], 1u);
    const unsigned gen = old / nloc;
    if (old + 1u == (gen + 1u) * nloc) {
      __builtin_amdgcn_fence(__ATOMIC_RELEASE, "agent");
      asm volatile("s_waitcnt vmcnt(0)" ::: "memory");
      const unsigned og = xb_add(&bar[XB_TOP], 1u);
      const unsigned tg = og / nx;
      if (og + 1u == (tg + 1u) * nx) xb_add(&bar[XB_TOPGEN], 1u);
      else XB_SPIN(xb_ld(&bar[XB_TOPGEN]) == tg, bar);
      __builtin_amdgcn_fence(__ATOMIC_ACQUIRE, "agent");
      xb_add(&bar[XB_XGEN(b.x)], 1u);
      asm volatile("s_waitcnt vmcnt(0)" ::: "memory");
    } else {
      XB_SPIN(xb_ld(&bar[XB_XGEN(b.x)]) == gen, bar);
      __builtin_amdgcn_fence(__ATOMIC_ACQUIRE, "agent");
      asm volatile("s_waitcnt vmcnt(0)" ::: "memory");
    }
  }
  __syncthreads();
}

extern "C" __global__ void __launch_bounds__(256, 2) mega(Params p) {
  extern __shared__ __attribute__((aligned(16))) char smem[];
  cg::grid_group grid = cg::this_grid();
#define TIDVARS                                                                  \
  int tid = threadIdx.x;                                                         \
  asm volatile("" : "+v"(tid));                                                  \
  const int lane = tid & 63, w = tid >> 6, l15 = lane & 15, g4 = lane >> 4;      \
  (void)lane; (void)w; (void)l15; (void)g4;
  const int nblk = gridDim.x, bid = blockIdx.x;
  char* ws = p.ws;
  XcdBarrier xb;
  xb.bar = (unsigned*)(ws + OFF_CTL + 4096); xb.x = 0; xb.st = (volatile unsigned*)(smem + 73712);
  if (p.phase_lo < p.phase_hi) {
    if (threadIdx.x < 2) xb.st[threadIdx.x] = 0u;
    __syncthreads();
    xb = xcd_barrier_post((unsigned*)(ws + OFF_CTL + 4096), (volatile unsigned*)(smem + 73712));
    grid.sync();
  }
  u16* hbuf = (u16*)(ws + OFF_H);
  u16* qbuf = (u16*)(ws + OFF_Q);
  u16* gfbuf = (u16*)(ws + OFF_GF);
  u16* ubuf = (u16*)(ws + OFF_U);
  u16* gsbuf = (u16*)(ws + OFF_GS);
  u16* ys5a = (u16*)(ws + OFF_YS5A);
  u16* qmbuf = (u16*)(ws + OFF_QM);
  u16* gmbuf = (u16*)(ws + OFF_GM);
  u16* merged = (u16*)(ws + OFF_MERGED);
  u16* WinT = (u16*)(ws + OFF_WINT);
  u16* WglT = (u16*)(ws + OFF_WGLT);
  u16* WkvT = (u16*)(ws + OFF_WKVT);
  u16* WoutT = (u16*)(ws + OFF_WOUTT);
  u16* WpfT = (u16*)(ws + OFF_WPFT);
  u16* WpsT = (u16*)(ws + OFF_WPST);
  u16* WpmT = (u16*)(ws + OFF_WPMT);
  u16* WgluT = (u16*)(ws + OFF_WGLUT);
  u16* memn = (u16*)(ws + OFF_MEMN);
  u16* mkbuf = (u16*)(ws + OFF_MK);
  u16* mvT = (u16*)(ws + OFF_MVT);
  float* logf = (float*)(ws + OFF_LOGF);
  float* Fbuf = (float*)(ws + OFF_F);
  float2* abar = (float2*)(ws + OFF_S5AB);
  float* bbar = (float*)(ws + OFF_S5BB);
  float2* Sst = (float2*)(ws + OFF_S5S);
  float* part = (float*)(ws + OFF_PART);
  unsigned* ctl = (unsigned*)(ws + OFF_CTL);
  u16* kbuf = (u16*)p.out;
  u16* vT = (u16*)((char*)p.out + 48 * MiB);

  {
    if (PH(0)) {
      TIDVARS
      if (bid == 0 && tid < 128) ctl[tid] = 0u;
      float* tile = (float*)smem;
      for (int ti = bid; ti < 3344; ti += nblk) {
        const float* src; int ld, col0, K; u16* dst; int tt;
        if (ti < 576) { src = p.w_in; ld = 8716; col0 = 0; K = 1024; dst = WinT; tt = ti; }
        else if (ti < 1408) { src = p.w_in; ld = 8716; col0 = 2316; K = 1024; dst = WinT + (size_t)2304 * KLD; tt = ti - 576; }
        else if (ti < 2176) { src = p.w_in; ld = 8716; col0 = 5644; K = 1024; dst = WglT; tt = ti - 1408; }
        else if (ti < 2432) { src = p.w_mem_kv; ld = 1024; col0 = 0; K = 1024; dst = WkvT; tt = ti - 2176; }
        else if (ti < 2688) { src = p.w_out; ld = 1024; col0 = 0; K = 1024; dst = WoutT; tt = ti - 2432; }
        else if (ti < 2880) { src = p.w_pf; ld = 1024; col0 = 0; K = 768; dst = WpfT; tt = ti - 2688; }
        else if (ti < 3072) { src = p.w_ps; ld = 1024; col0 = 0; K = 768; dst = WpsT; tt = ti - 2880; }
        else if (ti < 3200) { src = p.w_pm; ld = 1024; col0 = 0; K = 512; dst = WpmT; tt = ti - 3072; }
        else { src = p.w_glu; ld = 768; col0 = 0; K = 768; dst = WgluT; tt = ti - 3200; }
        const int nkt = K >> 6;
        const int dld = (K == 1024) ? KLD : K;
        const int k0 = (tt % nkt) * 64, n0 = (tt / nkt) * 64;
#pragma unroll 4
        for (int i = 0; i < 16; ++i) {
          int k = i * 4 + w, n = lane;
          tile[k * 65 + n] = src[(size_t)(k0 + k) * ld + col0 + n0 + n];
        }
        __syncthreads();
#pragma unroll 4
        for (int i = 0; i < 16; ++i) {
          int n = i * 4 + w, k = lane;
          dst[(size_t)(n0 + n) * dld + k0 + k] = f2bf(tile[k * 65 + n]);
        }
        __syncthreads();
      }
      float* wfl = (float*)smem;
      for (int idx = tid; idx < 12288; idx += 256) {
        int k = idx / 12, j = idx - k * 12;
        wfl[j * 1024 + k] = p.w_in[(size_t)k * 8716 + 2304 + j];
      }
      __syncthreads();
      for (int row = bid * 4 + w; row < T_ + 1024; row += nblk * 4) {
        const bool isx = row < T_;
        const float* src = isx ? p.x + (size_t)row * 1024 : p.mem + (size_t)(row - T_) * 1024;
        const float* gsrc = isx ? p.g_norm : p.g_mem_norm;
        u16* dst = isx ? hbuf + (size_t)row * KLD : memn + (size_t)(row - T_) * KLD;
        float4 xv[4];
        float ss = 0.f;
#pragma unroll
        for (int i = 0; i < 4; ++i) {
          xv[i] = *(const float4*)(src + i * 256 + lane * 4);
          ss += xv[i].x * xv[i].x + xv[i].y * xv[i].y + xv[i].z * xv[i].z + xv[i].w * xv[i].w;
        }
        ss = wave_sum(ss);
        const float rstd = rsqrtf(ss * (1.f / 1024.f) + 1e-6f);
#pragma unroll
        for (int i = 0; i < 4; ++i) {
          float4 gv = *(const float4*)(gsrc + i * 256 + lane * 4);
          xv[i].x *= rstd * gv.x; xv[i].y *= rstd * gv.y; xv[i].z *= rstd * gv.z; xv[i].w *= rstd * gv.w;
          u32x2 o = {pack2(xv[i].x, xv[i].y), pack2(xv[i].z, xv[i].w)};
          *(u32x2*)(dst + i * 256 + lane * 4) = o;
        }
        if (isx) {
          float myfl = 0.f;
#pragma unroll
          for (int j = 0; j < 12; ++j) {
            float a = 0.f;
#pragma unroll
            for (int i = 0; i < 4; ++i) {
              float4 wv = *(const float4*)(wfl + j * 1024 + i * 256 + lane * 4);
              a += xv[i].x * wv.x + xv[i].y * wv.y + xv[i].z * wv.z + xv[i].w * wv.w;
            }
            a = wave_sum(a);
            if (lane == j) myfl = a;
          }
          if (lane < 12) {
            float xx = myfl + p.b_forget[lane];
            float lf = fminf(xx, 0.f) - log1pf(__expf(-fabsf(xx)));
            const int b = row >> 13, t = row & (L_ - 1);
            logf[(size_t)(b * 12 + lane) * L_ + t] = lf;
          }
        }
      }
      {
        const int gid = bid * 256 + tid;
        if (gid < 3072) {
          const int g = gid >> 6;
          const float step = expf(p.log_step[g]);
          const float lr = p.lam_re[gid], li = p.lam_im[gid];
          const float mag = expf(lr * step);
          const float ar = mag * cosf(li * step), ai = mag * sinf(li * step);
          const float den = lr * lr + li * li;
          const float nr = ar - 1.f, ni = ai;
          const float fr = (nr * lr + ni * li) / den, fi = (ni * lr - nr * li) / den;
          abar[gid] = make_float2(ar, ai);
#pragma unroll
          for (int h = 0; h < 16; ++h) {
            const float br = p.b_re[(size_t)gid * 16 + h], bi = p.b_im[(size_t)gid * 16 + h];
            bbar[(size_t)gid * 32 + h] = fr * br - fi * bi;
            bbar[(size_t)gid * 32 + 16 + h] = fr * bi + fi * br;
          }
        }
      }
      __syncthreads();
    }
    SYNC_BEFORE(1);
    if (PH(1)) {
      TIDVARS
      float* sm = (float*)smem;
      for (int seq = bid; seq < 48; seq += nblk) {
        const float* src = logf + (size_t)seq * L_ + tid * 32;
        float* dst = Fbuf + (size_t)seq * L_ + tid * 32;
        float v[32];
#pragma unroll
        for (int i = 0; i < 8; ++i) {
          float4 t = *(const float4*)(src + i * 4);
          v[4 * i] = t.x; v[4 * i + 1] = t.y; v[4 * i + 2] = t.z; v[4 * i + 3] = t.w;
        }
        float run = 0.f;
#pragma unroll
        for (int i = 0; i < 32; ++i) { run += v[i]; v[i] = run; }
        float incl = run;
#pragma unroll
        for (int o = 1; o < 64; o <<= 1) {
          float t = __shfl_up(incl, o);
          if (lane >= o) incl += t;
        }
        if (lane == 63) sm[w] = incl;
        __syncthreads();
        float base = incl - run;
        for (int w2 = 0; w2 < w; ++w2) base += sm[w2];
#pragma unroll
        for (int i = 0; i < 8; ++i) {
          float4 t = make_float4((v[4 * i] + base) * LOG2E, (v[4 * i + 1] + base) * LOG2E, (v[4 * i + 2] + base) * LOG2E, (v[4 * i + 3] + base) * LOG2E);
          *(float4*)(dst + i * 4) = t;
        }
        __syncthreads();
      }
      for (int pn = 0;; ++pn) {
        int v;
        if (nblk == 512) {
          const int i_ = bid >> 3, x_ = bid & 7;
          int j_;
          if (pn < 20) j_ = 64 * pn + i_;
          else if (i_ < 32 && pn < 24) j_ = 1280 + 32 * (pn - 20) + i_;
          else if (i_ < 8 && pn == 24) j_ = 1408 + i_;
          else break;
          v = j_ * 8 + x_;
        } else {
          v = bid + pn * nblk;
          if (v >= 11264 + 64) break;
        }
        const u16 *A, *Bt;
        int m0, n0;
        bool kvtile = v >= 11264;
        if (!kvtile) {
          int mt, nt;
          swz(v, 44, 4, mt, nt);
          m0 = mt * 128; n0 = nt * 128;
          A = hbuf + (size_t)m0 * KLD; Bt = WinT + (size_t)n0 * KLD;
        } else {
          int kv = v - 11264;
          m0 = (kv >> 3) * 128; n0 = (kv & 7) * 128;
          A = memn + (size_t)m0 * KLD; Bt = WkvT + (size_t)n0 * KLD;
        }
        const bool transp = kvtile ? (n0 >= 512) : (n0 >= 1536 && n0 < 2304);
        f32x4 acc[4][4];
        zero_acc(acc);
        if (transp) {
          gemm_core<false, 1>(acc, A, KLD, Bt, KLD, 1024, smem);
          if (kvtile) epi_transposed(acc, mvT, m0, n0 - 512, 4, 7, 8);
          else epi_transposed(acc, vT, m0, n0 - 1536, 12, 6, 13);
        } else {
          gemm_core<true>(acc, A, KLD, Bt, KLD, 1024, smem);
          u16* dst; int ld, c0, mode;
          if (kvtile) { dst = mkbuf; ld = 512; c0 = n0; mode = 0; }
          else if (n0 < 768) { dst = qbuf; ld = 768; c0 = n0; mode = 1; }
          else if (n0 < 1536) { dst = kbuf; ld = 768; c0 = n0 - 768; mode = 0; }
          else if (n0 < 3072) { dst = gfbuf; ld = 768; c0 = n0 - 2304; mode = 2; }
          else if (n0 < 3840) { dst = ubuf; ld = 768; c0 = n0 - 3072; mode = 0; }
          else if (n0 < 4608) { dst = gsbuf; ld = 768; c0 = n0 - 3840; mode = 2; }
          else if (n0 < 5120) { dst = qmbuf; ld = 512; c0 = n0 - 4608; mode = 0; }
          else { dst = gmbuf; ld = 512; c0 = n0 - 5120; mode = 2; }
          epi_rowmajor(acc, dst, ld, m0, c0, mode, smem);
          if (!kvtile && n0 >= 768 && n0 < 1536) {
            float mxv = 0.f;
#pragma unroll
            for (int i = 0; i < 4; ++i) {
              float ss = 0.f;
#pragma unroll
              for (int j = 0; j < 4; ++j)
#pragma unroll
                for (int r = 0; r < 4; ++r) {
                  const float v = __uint_as_float(((unsigned)f2bf(acc[i][j][r])) << 16);
                  ss += v * v;
                }
              ss += __shfl_xor(ss, 16);
              ss += __shfl_xor(ss, 32);
              mxv = fmaxf(mxv, ss);
            }
#pragma unroll
            for (int o = 1; o < 16; o <<= 1) mxv = fmaxf(mxv, __shfl_xor(mxv, o));
            if (lane == 0) atomicMax(&ctl[(m0 >> 13) * 12 + ((n0 - 768) >> 6) + (w & 1)], __float_as_uint(mxv));
          }
        }
      }
    }
    SYNC_BEFORE(2);
    if (PH(2)) {
      TIDVARS
      int* qslot = (int*)(smem + 73696);
#define NEXT_ITEM(CTR)                                        \
      {                                                       \
        if (tid == 0) *qslot = (int)atomicAdd(&ctl[CTR], 1u); \
        __syncthreads();                                      \
        it = *qslot;                                          \
        __syncthreads();                                      \
      }
      int it;
      for (;;) {
        NEXT_ITEM(64);
        if (it >= 3072) break;
        {
#ifndef NO_FOX
          const int qt = 63 - it / 48, bh = it % 48, b = bh / 12, h = bh % 12;
          const int q0 = qt * 128;
          const size_t qoff = ((size_t)(b * L_ + q0)) * 768 + h * 64;
          attn_item<64, true, true, 2>(qbuf + qoff, 768, kbuf + (size_t)b * L_ * 768 + h * 64, 768,
                              vT + (size_t)(b * 12 + h) * 64 * L_, L_, Fbuf + (size_t)(b * 12 + h) * L_, q0, 2 * qt + 2,
                              gfbuf + qoff, qbuf + qoff, 1.f, sqrtf(__uint_as_float(ctl[b * 12 + h])), smem);
#endif
        }
      }
      for (;;) {
        NEXT_ITEM(65);
        if (it >= 2048) break;
        {
#ifndef NO_MEM
          const int im = it;
          const int hm = im & 3, qt = (im >> 2) & 127, b = im >> 9;
          const int q0 = qt * 64;
          const size_t qoff = ((size_t)(b * L_ + q0)) * 512 + hm * 128;
          attn_item<128, false, false, 1>(qmbuf + qoff, 512, mkbuf + (size_t)b * 256 * 512 + hm * 128, 512,
                                mvT + (size_t)(b * 4 + hm) * 128 * 256, 256, nullptr, q0, 4,
                                gmbuf + qoff, qmbuf + qoff, 0.08838834764831845f * LOG2E, 0.f, smem);
#endif
        }
      }
      for (;;) {
        NEXT_ITEM(66);
        if (it >= 1536) break;
        {
#ifndef NO_S5P1
          const int wi = it * 4 + w;
          const int g = wi % 48, cg = (wi / 48) & 31, b = wi / (48 * 32);
          char* xs = smem + w * 12800;
          const int gp = g * 64 + lane;
          bf16x8 ah[8], al[8];
          s5_load_bfrag(bbar, g, l15, g4, ah, al);
          const float2 ab = abar[gp];
#pragma unroll 1
          for (int ci = 0; ci < 4; ++ci) {
          const int c = cg * 4 + ci;
          const u16* ub0 = ubuf + ((size_t)(b * L_ + c * 64 + l15)) * 768 + g * 16;
          u32x4 uq[4];
#pragma unroll
          for (int sub = 0; sub < 4; ++sub) {
            uq[sub] = u32x4{0u, 0u, 0u, 0u};
            if (g4 < 2) uq[sub] = *(const u32x4*)(ub0 + (size_t)sub * 16 * 768 + g4 * 8);
          }
          float hr = 0.f, hi = 0.f;
#pragma unroll
          for (int sub = 0; sub < 4; ++sub) {
            s5_xsub(uq[sub], ah, al, xs, l15, g4);
            asm volatile("s_waitcnt lgkmcnt(0)" ::: "memory");
#pragma unroll
            for (int tt = 0; tt < 16; ++tt) {
              const float xr = *(const float*)(xs + tt * 528 + lane * 4);
              const float xi = *(const float*)(xs + tt * 528 + 256 + lane * 4);
              const float nhr = ab.x * hr - ab.y * hi + xr;
              const float nhi = ab.x * hi + ab.y * hr + xi;
              hr = nhr; hi = nhi;
            }
            asm volatile("s_waitcnt lgkmcnt(0)" ::: "memory");
          }
          Sst[((size_t)(b * 128 + c) * 48 + g) * 64 + lane] = make_float2(hr, hi);
          }
          __syncthreads();
#endif
        }
      }
    }
    SYNC_BEFORE(3);
    if (PH(3)) {
      TIDVARS
      for (int wi = bid * 4 + w; wi < 192; wi += nblk * 4) {
        const int g = wi % 48, b = wi / 48;
        const float2 ab = abar[g * 64 + lane];
        float a64r = ab.x, a64i = ab.y;
#pragma unroll
        for (int q = 0; q < 6; ++q) {
          const float nr = a64r * a64r - a64i * a64i, ni = 2.f * a64r * a64i;
          a64r = nr; a64i = ni;
        }
        float2* sp = Sst + ((size_t)(b * 128) * 48 + g) * 64 + lane;
        float hr = 0.f, hi = 0.f;
        for (int cc = 0; cc < 128; cc += 16) {
          float2 sv[16];
#pragma unroll
          for (int q = 0; q < 16; ++q) sv[q] = sp[(size_t)(cc + q) * 48 * 64];
#pragma unroll
          for (int q = 0; q < 16; ++q) {
            sp[(size_t)(cc + q) * 48 * 64] = make_float2(hr, hi);
            const float nhr = a64r * hr - a64i * hi + sv[q].x;
            const float nhi = a64r * hi + a64i * hr + sv[q].y;
            hr = nhr; hi = nhi;
          }
        }
      }
    }
    SYNC_BEFORE(4);
    if (PH(4)) {
      TIDVARS
      for (int it = bid; it < 1536; it += nblk) {
        const int wi = it * 4 + w;
        const int g = wi % 48, cg = (wi / 48) & 31, b = wi / (48 * 32);
        char* xs = smem + w * 12800;
        char* stt = xs + 8448;
        const int gp = g * 64 + lane;
        bf16x8 ah[8], al[8];
        s5_load_bfrag(bbar, g, l15, g4, ah, al);
        const float2 ab = abar[gp];
        bf16x8 cf[4];
#pragma unroll
        for (int s = 0; s < 4; ++s) {
          const float* cs = (s < 2 ? p.c_re : p.c_im) + (size_t)(g * 16 + l15) * 64 + (s & 1) * 32 + g4 * 8;
          float4 t0 = *(const float4*)cs, t1 = *(const float4*)(cs + 4);
          const float sg = (s < 2) ? 1.f : -1.f;
          u32x4 t = pack8_mfma(sg * t0.x, sg * t0.y, sg * t0.z, sg * t0.w, sg * t1.x, sg * t1.y, sg * t1.z, sg * t1.w);
          cf[s] = __builtin_bit_cast(bf16x8, t);
        }
        const float4 dsk = *(const float4*)(p.s5_d + g * 16 + g4 * 4);
#pragma unroll 1
        for (int ci = 0; ci < 4; ++ci) {
        const int c = cg * 4 + ci;
        const u16* ub0 = ubuf + ((size_t)(b * L_ + c * 64 + l15)) * 768 + g * 16;
        const float2 hc = Sst[((size_t)(b * 128 + c) * 48 + g) * 64 + lane];
        float hr = hc.x, hi = hc.y;
        u32x4 uq[4];
        u32x2 uvq[4];
#pragma unroll
        for (int sub = 0; sub < 4; ++sub) {
          uq[sub] = u32x4{0u, 0u, 0u, 0u};
          if (g4 < 2) uq[sub] = *(const u32x4*)(ub0 + (size_t)sub * 16 * 768 + g4 * 8);
          uvq[sub] = *(const u32x2*)(ub0 + (size_t)sub * 16 * 768 + g4 * 4);
        }
        asm volatile("s_waitcnt lgkmcnt(0)" ::: "memory");
#pragma unroll
        for (int sub = 0; sub < 4; ++sub) {
          s5_xsub(uq[sub], ah, al, xs, l15, g4);
          asm volatile("s_waitcnt lgkmcnt(0)" ::: "memory");
#pragma unroll
          for (int tt = 0; tt < 16; ++tt) {
            const float xr = *(const float*)(xs + tt * 528 + lane * 4);
            const float xi = *(const float*)(xs + tt * 528 + 256 + lane * 4);
            const float nhr = ab.x * hr - ab.y * hi + xr;
            const float nhi = ab.x * hi + ab.y * hr + xi;
            hr = nhr; hi = nhi;
            *(u16*)(stt + tt * 272 + lane * 2) = f2bf(hr);
            *(u16*)(stt + tt * 272 + 128 + lane * 2) = f2bf(hi);
          }
          asm volatile("s_waitcnt lgkmcnt(0)" ::: "memory");
          f32x4 y = {0, 0, 0, 0};
#pragma unroll
          for (int s = 0; s < 4; ++s) {
            bf16x8 bfr = *(const bf16x8*)(stt + l15 * 272 + s * 64 + g4 * 16);
            y = mfma16(cf[s], bfr, y);
          }
          const int t = sub * 16 + l15;
          const u32x2 uv = uvq[sub];
          float o0 = gelu_tanh(y[0] + dsk.x * bflo(uv[0]));
          float o1 = gelu_tanh(y[1] + dsk.y * bfhi(uv[0]));
          float o2 = gelu_tanh(y[2] + dsk.z * bflo(uv[1]));
          float o3 = gelu_tanh(y[3] + dsk.w * bfhi(uv[1]));
          u32x2 o = {pack2(o0, o1), pack2(o2, o3)};
          *(u32x2*)(ys5a + ((size_t)(b * L_ + c * 64 + t)) * 768 + g * 16 + g4 * 4) = o;
          asm volatile("s_waitcnt lgkmcnt(0)" ::: "memory");
        }
        }
        __syncthreads();
      }
    }
    SYNC_BEFORE(5);
    if (PH(5)) {
      TIDVARS
      for (int v = bid; v < 256 * 6; v += nblk) {
        int mt, nt;
        swz(v, 6, 6, mt, nt);
        const int m0 = mt * 128, n0 = nt * 128;
        f32x4 acc[4][4];
        zero_acc(acc);
        gemm_core<true>(acc, ys5a + (size_t)m0 * 768, 768, WgluT + (size_t)n0 * 768, 768, 768, smem);
        const int wr = w >> 1, wc = w & 1;
#pragma unroll
        for (int i = 0; i < 4; ++i) {
          const size_t row = (size_t)(m0 + wr * 64 + i * 16 + l15);
#pragma unroll
          for (int j = 0; j < 4; ++j) {
            const int n = n0 + wc * 64 + j * 16 + g4 * 4;
            const float4 bg = *(const float4*)(p.b_glu + n);
            const u32x2 av = *(const u32x2*)(ys5a + row * 768 + n);
            const u32x2 sv = *(const u32x2*)(gsbuf + row * 768 + n);
            float o0 = bflo(av[0]) * sigmoidf_(acc[i][j][0] + bg.x) * bflo(sv[0]);
            float o1 = bfhi(av[0]) * sigmoidf_(acc[i][j][1] + bg.y) * bfhi(sv[0]);
            float o2 = bflo(av[1]) * sigmoidf_(acc[i][j][2] + bg.z) * bflo(sv[1]);
            float o3 = bfhi(av[1]) * sigmoidf_(acc[i][j][3] + bg.w) * bfhi(sv[1]);
            u32x2 o = {pack2(o0, o1), pack2(o2, o3)};
            *(u32x2*)(ubuf + row * 768 + n) = o;
          }
        }
      }
    }
    SYNC_BEFORE(6);
    if (PH(6)) {
      TIDVARS
      for (int v = bid; v < 256 * 8; v += nblk) {
        int mt, nt;
        swz(v, 8, 4, mt, nt);
        const int m0 = mt * 128, n0 = nt * 128;
        const int wr = w >> 1, wc = w & 1;
        char* gstash = ws + OFF_GATE + (size_t)bid * 32768;
        f32x4 accm[4][4];
        zero_acc(accm);
        const unsigned toff = (unsigned)tid * 16u;
#pragma unroll 1
        for (int stp = 0; stp < 6; ++stp) {
          const int br = stp >> 1;
          const u16* Ab; const u16* Wb; int Kb; int ldk;
          if (!(stp & 1)) { Ab = hbuf + (size_t)m0 * KLD; Wb = WglT + (size_t)(br * 1024 + n0) * KLD; Kb = 1024; }
          else if (br == 0) { Ab = qbuf + (size_t)m0 * 768; Wb = WpfT + (size_t)n0 * 768; Kb = 768; }
          else if (br == 1) { Ab = ubuf + (size_t)m0 * 768; Wb = WpsT + (size_t)n0 * 768; Kb = 768; }
          else { Ab = qmbuf + (size_t)m0 * 512; Wb = WpmT + (size_t)n0 * 512; Kb = 512; }
          f32x4 acc[4][4];
          zero_acc(acc);
          ldk = (Kb == 1024) ? KLD : Kb;
          gemm_core<true>(acc, Ab, ldk, Wb, ldk, Kb, smem);
          if (!(stp & 1)) {
#pragma unroll
            for (int j = 0; j < 4; ++j) {
              const float4 bm = *(const float4*)(p.b_merge + br * 1024 + n0 + wc * 64 + j * 16 + g4 * 4);
#pragma unroll
              for (int i = 0; i < 4; i += 2) {
                u32x4 gq = {pack2(sigmoidf_(acc[i][j][0] + bm.x), sigmoidf_(acc[i][j][1] + bm.y)),
                            pack2(sigmoidf_(acc[i][j][2] + bm.z), sigmoidf_(acc[i][j][3] + bm.w)),
                            pack2(sigmoidf_(acc[i + 1][j][0] + bm.x), sigmoidf_(acc[i + 1][j][1] + bm.y)),
                            pack2(sigmoidf_(acc[i + 1][j][2] + bm.z), sigmoidf_(acc[i + 1][j][3] + bm.w))};
                *(u32x4*)(gstash + (j * 2 + (i >> 1)) * 4096 + toff) = gq;
              }
            }
          } else {
#pragma unroll
            for (int j = 0; j < 4; ++j)
#pragma unroll
              for (int i = 0; i < 4; i += 2) {
                const u32x4 gq = *(const u32x4*)(gstash + (j * 2 + (i >> 1)) * 4096 + toff);
                acc[i][j][0] *= bflo(gq[0]); acc[i][j][1] *= bfhi(gq[0]);
                acc[i][j][2] *= bflo(gq[1]); acc[i][j][3] *= bfhi(gq[1]);
                acc[i + 1][j][0] *= bflo(gq[2]); acc[i + 1][j][1] *= bfhi(gq[2]);
                acc[i + 1][j][2] *= bflo(gq[3]); acc[i + 1][j][3] *= bfhi(gq[3]);
                accm[i][j] += acc[i][j];
                accm[i + 1][j] += acc[i + 1][j];
                __builtin_amdgcn_sched_barrier(0);
              }
            if (br == 2) epi_rowmajor_direct(accm, merged, KLD, m0, n0, 0);
          }
        }
      }
    }
    SYNC_BEFORE(7);
    if (PH(7)) {
      TIDVARS
      for (int v = bid; v < 256 * 8; v += nblk) {
        int mt, nt;
        swz(v, 8, 4, mt, nt);
        const int m0 = mt * 128, n0 = nt * 128;
        const int wr = w >> 1, wc = w & 1;
        f32x4 acc[4][4];
        zero_acc(acc);
        gemm_core<true>(acc, merged + (size_t)m0 * KLD, KLD, WoutT + (size_t)n0 * KLD, KLD, 1024, smem);
#pragma unroll
        for (int i = 0; i < 4; ++i) {
          const size_t row = (size_t)(m0 + wr * 64 + i * 16 + l15);
          float ss = 0.f;
#pragma unroll
          for (int j = 0; j < 4; ++j) {
            const int n = n0 + wc * 64 + j * 16 + g4 * 4;
            const float4 xv = *(const float4*)(p.x + row * 1024 + n);
            float4 o = make_float4(xv.x + acc[i][j][0], xv.y + acc[i][j][1], xv.z + acc[i][j][2], xv.w + acc[i][j][3]);
            ss += o.x * o.x + o.y * o.y + o.z * o.z + o.w * o.w;
            *(float4*)(p.out + row * 1024 + n) = o;
          }
          ss += __shfl_xor(ss, 16);
          ss += __shfl_xor(ss, 32);
          if (g4 == 0) part[row * 16 + nt * 2 + wc] = ss;
        }
      }
    }
    SYNC_BEFORE(8);
    if (PH(8)) {
      TIDVARS
      for (int row = bid * 4 + w; row < T_; row += nblk * 8) {
        const int row2 = row + nblk * 4;
        const bool has2 = row2 < T_;
        float ssa = (lane < 16) ? part[(size_t)row * 16 + lane] : 0.f;
        float ssb = (has2 && lane < 16) ? part[(size_t)row2 * 16 + lane] : 0.f;
        float* oa = p.out + (size_t)row * 1024;
        float* ob = p.out + (size_t)(has2 ? row2 : row) * 1024;
        float4 va[4], vb[4];
#pragma unroll
        for (int i = 0; i < 4; ++i) {
          va[i] = *(const float4*)(oa + i * 256 + lane * 4);
          vb[i] = *(const float4*)(ob + i * 256 + lane * 4);
        }
        ssa = wave_sum(ssa);
        ssb = wave_sum(ssb);
        const float ra = rsqrtf(ssa * (1.f / 1024.f) + 1e-6f);
        const float rb = rsqrtf(ssb * (1.f / 1024.f) + 1e-6f);
#pragma unroll
        for (int i = 0; i < 4; ++i) {
          const float4 gv = *(const float4*)(p.g_final + i * 256 + lane * 4);
          va[i].x *= ra * gv.x; va[i].y *= ra * gv.y; va[i].z *= ra * gv.z; va[i].w *= ra * gv.w;
          *(float4*)(oa + i * 256 + lane * 4) = va[i];
          if (has2) {
            vb[i].x *= rb * gv.x; vb[i].y *= rb * gv.y; vb[i].z *= rb * gv.z; vb[i].w *= rb * gv.w;
            *(float4*)(ob + i * 256 + lane * 4) = vb[i];
          }
        }
      }
    }
  }
}

extern "C" void kernel_launch(void* const* d_in, const int* in_sizes, int n_in, void* d_out, int out_size, void* d_ws,
                              size_t ws_size, hipStream_t stream) {
  static int grid_blocks = 0;
  if (!grid_blocks) {
    if (ws_size < WS_END || n_in != 23) {
      fprintf(stderr, "kernel_launch: unexpected ws_size %zu (need %zu) or n_in %d\n", ws_size, (size_t)WS_END, n_in);
      grid_blocks = -1;
      return;
    }
    int dev = 0, cus = 0, per_cu = 0;
    (void)hipGetDevice(&dev);
    (void)hipDeviceGetAttribute(&cus, hipDeviceAttributeMultiprocessorCount, dev);
    (void)hipFuncSetAttribute((const void*)mega, hipFuncAttributeMaxDynamicSharedMemorySize, LDS_BYTES);
    (void)hipOccupancyMaxActiveBlocksPerMultiprocessor(&per_cu, (const void*)mega, 256, LDS_BYTES);
    per_cu = (per_cu >= 2) ? 2 : 1;
    grid_blocks = cus * per_cu;
  }
  if (grid_blocks < 0) return;
  Params p{};
  const float** pp = (const float**)&p;
  for (int i = 0; i < 23; ++i) pp[i] = (const float*)d_in[i];
  p.out = (float*)d_out;
  p.ws = (char*)d_ws;
#if COOP
  (void)hipMemsetAsync((char*)d_ws + OFF_CTL + 4096, 0, XCD_BAR_WORDS * 4, stream);
  p.phase_lo = 0;
  p.phase_hi = NPHASE - 1;
  void* args[] = {&p};
  hipError_t e = hipLaunchCooperativeKernel((const void*)mega, dim3(grid_blocks), dim3(256), args, LDS_BYTES, stream);
  if (e != hipSuccess) fprintf(stderr, "cooperative launch failed: %s (grid %d)\n", hipGetErrorString(e), grid_blocks);
#else
  for (int ph = 0; ph < NPHASE; ++ph) {
    p.phase_lo = ph;
    p.phase_hi = ph;
    hipLaunchKernelGGL(mega, dim3(grid_blocks), dim3(256), LDS_BYTES, stream, p);
#ifdef PROBE_DUP
    if (ph == PROBE_DUP) {
      for (int rep = 0; rep < 2; ++rep) {
        if (ph == 2) { p.phase_lo = p.phase_hi = 1; hipLaunchKernelGGL(mega, dim3(grid_blocks), dim3(256), LDS_BYTES, stream, p); p.phase_lo = p.phase_hi = 2; }
        hipLaunchKernelGGL(mega, dim3(grid_blocks), dim3(256), LDS_BYTES, stream, p);
      }
    }
#endif
  }
#endif
}
```

```cpp
#include <hip/hip_runtime.h>
#include <hip/hip_cooperative_groups.h>
#include <stdint.h>
#include <stdio.h>
namespace cg = cooperative_groups;

#ifndef COOP
#define COOP 1
#define XCD_MODE 0
#endif

#define DI __device__ __forceinline__
#ifdef ONLY_PHASE
#define PH(n) ((n) == ONLY_PHASE && p.phase_lo <= (n) && (n) <= p.phase_hi)
#else
#define PH(n) (p.phase_lo <= (n) && (n) <= p.phase_hi)
#endif
#define SYNC_BEFORE(n)                                        \
  if (p.phase_lo < (n) && (n) <= p.phase_hi) {                \
    xcd_barrier(xb);                                          \
  }
typedef unsigned short u16;
using bf16x8 = __attribute__((ext_vector_type(8))) short;
using f32x4 = __attribute__((ext_vector_type(4))) float;
using u32x4 = __attribute__((ext_vector_type(4))) unsigned;
using u32x2 = __attribute__((ext_vector_type(2))) unsigned;

constexpr int T_ = 32768, L_ = 8192;
constexpr int LDS_BYTES = 73728;
constexpr int NPHASE = 9;

constexpr size_t MiB = 1u << 20;
constexpr float LOG2E = 1.4426950408889634f;
constexpr float QSCALE = 0.125f * LOG2E;
constexpr int KLD = 1088;
constexpr size_t OFF_H = 0;
constexpr size_t OFF_Q = 68 * MiB;
constexpr size_t OFF_GF = 116 * MiB;
constexpr size_t OFF_U = 164 * MiB;
constexpr size_t OFF_GS = 212 * MiB;
constexpr size_t OFF_YS5A = 260 * MiB;
constexpr size_t OFF_QM = 308 * MiB;
constexpr size_t OFF_GM = 340 * MiB;
constexpr size_t OFF_MERGED = 372 * MiB;
constexpr size_t OFF_WINT = 440 * MiB;
constexpr size_t OFF_WGLT = 453 * MiB;
constexpr size_t OFF_WKVT = 460 * MiB;
constexpr size_t OFF_WOUTT = 463 * MiB;
constexpr size_t OFF_WPFT = 466 * MiB;
constexpr size_t OFF_WPST = 468 * MiB;
constexpr size_t OFF_WPMT = 470 * MiB;
constexpr size_t OFF_WGLUT = 471 * MiB;
constexpr size_t OFF_MEMN = 473 * MiB;
constexpr size_t OFF_MK = 476 * MiB;
constexpr size_t OFF_MVT = 477 * MiB;
constexpr size_t OFF_LOGF = 478 * MiB;
constexpr size_t OFF_F = 480 * MiB;
constexpr size_t OFF_S5AB = 482 * MiB;
constexpr size_t OFF_S5BB = 483 * MiB;
constexpr size_t OFF_S5S = 484 * MiB;
constexpr size_t OFF_PART = 496 * MiB;
constexpr size_t OFF_GATE = OFF_GS;
constexpr size_t OFF_CTL = 498 * MiB;
constexpr size_t WS_END = 499 * MiB;

struct Params {
  const float *x, *mem, *g_norm, *g_mem_norm, *g_final, *w_in, *b_forget, *b_merge, *w_mem_kv;
  const float *lam_re, *lam_im, *log_step, *b_re, *b_im, *c_re, *c_im, *s5_d, *w_glu, *b_glu;
  const float *w_pf, *w_ps, *w_pm, *w_out;
  float* out;
  char* ws;
  int phase_lo, phase_hi;
};

DI unsigned pack2(float a, float b) {
  unsigned r;
  asm volatile("v_cvt_pk_bf16_f32 %0, %1, %2" : "=v"(r) : "v"(a), "v"(b));
  return r;
}
DI u32x4 pack8_mfma(float a0, float a1, float a2, float a3, float a4, float a5, float a6, float a7) {
  u32x4 r;
  asm volatile("v_cvt_pk_bf16_f32 %0, %4, %5\n\tv_cvt_pk_bf16_f32 %1, %6, %7\n\tv_cvt_pk_bf16_f32 %2, %8, %9\n\tv_cvt_pk_bf16_f32 %3, %10, %11\n\ts_nop 1"
               : "=&v"(r[0]), "=&v"(r[1]), "=&v"(r[2]), "=&v"(r[3])
               : "v"(a0), "v"(a1), "v"(a2), "v"(a3), "v"(a4), "v"(a5), "v"(a6), "v"(a7));
  return r;
}
DI u16 f2bf(float x) { return (u16)(pack2(x, x) & 0xffffu); }
DI float bflo(unsigned v) { return __uint_as_float(v << 16); }
DI float bfhi(unsigned v) { return __uint_as_float(v & 0xffff0000u); }
DI float sigmoidf_(float x) { return 1.f / (1.f + __expf(-x)); }
DI float siluf_(float x) { return x / (1.f + __expf(-x)); }
DI float gelu_tanh(float x) {
  float z = 0.7978845608028654f * (x + 0.044715f * x * x * x);
  float e = __expf(2.f * z);
  float th = 1.f - 2.f / (e + 1.f);
  return 0.5f * x * (1.f + th);
}
DI float wave_sum(float v) {
#pragma unroll
  for (int o = 32; o > 0; o >>= 1) v += __shfl_xor(v, o);
  return v;
}
DI f32x4 mfma16(bf16x8 a, bf16x8 b, f32x4 c) { return __builtin_amdgcn_mfma_f32_16x16x32_bf16(a, b, c, 0, 0, 0); }

template <bool SWAP, int DEPTH = 1, bool LEAN = false, bool NEXTPF = false>
DI void gemm_core(f32x4 (&acc)[4][4], const u16* __restrict__ A, int lda, const u16* __restrict__ Bt, int ldb, int K, char* smem,
                  bool preloaded = false, const u16* An = nullptr, int ldan = 0, const u16* Btn = nullptr, int ldbn = 0) {
  const int tid = threadIdx.x, lane = tid & 63, w = tid >> 6, wr = w >> 1, wc = w & 1, l15 = lane & 15, g = lane >> 4;
  const int lrow = tid >> 3, lch = tid & 7;
  const char* ap = (const char*)A;
  const char* bp = (const char*)Bt;
  const unsigned aoff = (unsigned)(lrow * lda + lch * 8) * 2u;
  const unsigned boff = (unsigned)(lrow * ldb + lch * 8) * 2u;
  u32x4 ra0[4], rb0[4], ra1[4], rb1[4];
  const int nk = K >> 6;
#define G_LOAD(RA, RB, KT)                                                        \
  _Pragma("unroll") for (int c = 0; c < 4; ++c) {                                 \
    RA[c] = *(const u32x4*)(ap + ((size_t)c * 64 * lda + (KT) * 128) + aoff);     \
    RB[c] = *(const u32x4*)(bp + ((size_t)c * 64 * ldb + (KT) * 128) + boff);     \
  }
#define G_STORE(RA, RB, BO)                                                       \
  _Pragma("unroll") for (int c = 0; c < 4; ++c) {                                 \
    *(u32x4*)(wbase + (BO) + c * 32 * 128) = RA[c];                               \
    *(u32x4*)(wbase + (BO) + 16384 + c * 32 * 128) = RB[c];                       \
  }
#define G_COMPUTE_FULL(BO)                                                             \
  {                                                                               \
    bf16x8 af[2][4], bfr[2][4];                                                   \
    _Pragma("unroll") for (int i = 0; i < 4; ++i) af[0][i] = *(const bf16x8*)(ard0 + (BO) + i * 16 * 128);  \
    _Pragma("unroll") for (int j = 0; j < 4; ++j) bfr[0][j] = *(const bf16x8*)(brd0 + (BO) + j * 16 * 128); \
    _Pragma("unroll") for (int i = 0; i < 4; ++i) af[1][i] = *(const bf16x8*)(ard1 + (BO) + i * 16 * 128);  \
    _Pragma("unroll") for (int j = 0; j < 4; ++j) bfr[1][j] = *(const bf16x8*)(brd1 + (BO) + j * 16 * 128); \
    __builtin_amdgcn_sched_barrier(0);                                            \
    __builtin_amdgcn_s_setprio(1);                                                \
    _Pragma("unroll") for (int s = 0; s < 2; ++s)                                 \
      _Pragma("unroll") for (int i = 0; i < 4; ++i)                               \
        _Pragma("unroll") for (int j = 0; j < 4; ++j)                             \
          acc[i][j] = SWAP ? mfma16(bfr[s][j], af[s][i], acc[i][j]) : mfma16(af[s][i], bfr[s][j], acc[i][j]); \
    __builtin_amdgcn_s_setprio(0);                                                \
  }
#define G_COMPUTE_LEAN(BO)                                                        \
  _Pragma("unroll") for (int s = 0; s < 2; ++s) {                                 \
    bf16x8 af[4];                                                                 \
    _Pragma("unroll") for (int i = 0; i < 4; ++i) af[i] = *(const bf16x8*)((s ? ard1 : ard0) + (BO) + i * 16 * 128);  \
    _Pragma("unroll") for (int j = 0; j < 4; ++j) {                               \
      const bf16x8 bfr = *(const bf16x8*)((s ? brd1 : brd0) + (BO) + j * 16 * 128);   \
      _Pragma("unroll") for (int i = 0; i < 4; ++i)                               \
        acc[i][j] = SWAP ? mfma16(bfr, af[i], acc[i][j]) : mfma16(af[i], bfr, acc[i][j]); \
    }                                                                             \
  }
#define G_COMPUTE(BO) if constexpr (LEAN) { G_COMPUTE_LEAN(BO) } else { G_COMPUTE_FULL(BO) }
  char* wbase = smem + lrow * 128 + ((lch ^ ((lrow >> 1) & 7)) << 4);
  const int hsw = l15 >> 1;
  const char* ard0 = smem + (wr * 64 + l15) * 128 + ((g ^ hsw) << 4);
  const char* ard1 = smem + (wr * 64 + l15) * 128 + (((4 + g) ^ hsw) << 4);
  const char* brd0 = smem + 16384 + (wc * 64 + l15) * 128 + ((g ^ hsw) << 4);
  const char* brd1 = smem + 16384 + (wc * 64 + l15) * 128 + (((4 + g) ^ hsw) << 4);
  if constexpr (DEPTH == 2) {
    G_LOAD(ra0, rb0, 0);
    G_LOAD(ra1, rb1, 1);
    G_STORE(ra0, rb0, 0);
    __syncthreads();
    for (int kt = 0; kt < nk; kt += 2) {
      if (kt + 2 < nk) G_LOAD(ra0, rb0, kt + 2);
      __builtin_amdgcn_sched_barrier(0);
      G_COMPUTE(0);
      __builtin_amdgcn_sched_barrier(0);
      G_STORE(ra1, rb1, 32768);
      __syncthreads();
      if (kt + 3 < nk) G_LOAD(ra1, rb1, kt + 3);
      __builtin_amdgcn_sched_barrier(0);
      G_COMPUTE(32768);
      __builtin_amdgcn_sched_barrier(0);
      if (kt + 2 < nk) G_STORE(ra0, rb0, 0);
      __syncthreads();
    }
  } else if constexpr (LEAN) {
#define G_LOADH(P, OFF, LD, KT)                                                   \
  _Pragma("unroll") for (int c = 0; c < 4; ++c) ra0[c] = *(const u32x4*)((P) + ((size_t)c * 64 * (LD) + (KT) * 128) + (OFF));
#define G_STOREH(BO)                                                              \
  _Pragma("unroll") for (int c = 0; c < 4; ++c) *(u32x4*)(wbase + (BO) + c * 32 * 128) = ra0[c];
#define G_COMPUTE_S(BO, S)                                                        \
  {                                                                               \
    bf16x8 af[4];                                                                 \
    _Pragma("unroll") for (int i = 0; i < 4; ++i) af[i] = *(const bf16x8*)((S ? ard1 : ard0) + (BO) + i * 16 * 128);  \
    _Pragma("unroll") for (int j = 0; j < 4; ++j) {                               \
      const bf16x8 bfr = *(const bf16x8*)((S ? brd1 : brd0) + (BO) + j * 16 * 128);   \
      _Pragma("unroll") for (int i = 0; i < 4; ++i)                               \
        acc[i][j] = SWAP ? mfma16(bfr, af[i], acc[i][j]) : mfma16(af[i], bfr, acc[i][j]); \
    }                                                                             \
  }
#define G_HALF(CUR, NXT, KTN)                                                     \
  {                                                                               \
    const int ktn_ = (KTN) < nk ? (KTN) : nk - 1;                                 \
    G_LOADH(ap, aoff, lda, ktn_)                                                  \
    __builtin_amdgcn_sched_barrier(0);                                            \
    G_COMPUTE_S(CUR, 0)                                                           \
    __builtin_amdgcn_sched_barrier(0);                                            \
    G_STOREH(NXT)                                                                 \
    G_LOADH(bp, boff, ldb, ktn_)                                                  \
    __builtin_amdgcn_sched_barrier(0);                                            \
    G_COMPUTE_S(CUR, 1)                                                           \
    __builtin_amdgcn_sched_barrier(0);                                            \
    G_STOREH((NXT) + 16384)                                                       \
    __syncthreads();                                                              \
  }
    G_LOADH(ap, aoff, lda, 0)
    G_STOREH(0)
    G_LOADH(bp, boff, ldb, 0)
    G_STOREH(16384)
    __syncthreads();
    for (int kt = 0; kt < nk; kt += 2) {
      G_HALF(0, 32768, kt + 1)
      G_HALF(32768, 0, kt + 2)
    }
#undef G_LOADH
#undef G_STOREH
#undef G_COMPUTE_S
#undef G_HALF
  } else {
    const int grow = w * 8 + (lane >> 3);
    const int glc = (lane & 7) ^ ((w * 4 + (lane >> 4)) & 7);
    const unsigned gaoff = (unsigned)(grow * lda + glc * 8) * 2u;
    const unsigned gboff = (unsigned)(grow * ldb + glc * 8) * 2u;
    char* gl = smem + w * 1024 + lane * 16;
#define G_GLDS(KT, BO)                                                            \
  _Pragma("unroll") for (int c = 0; c < 4; ++c) {                                 \
    __builtin_amdgcn_global_load_lds((const unsigned*)(ap + ((size_t)c * 64 * lda + (size_t)(KT) * 128) + gaoff),          \
                                     (unsigned*)(gl + (BO) + c * 4096), 16, 0, 0);                                          \
    __builtin_amdgcn_global_load_lds((const unsigned*)(bp + ((size_t)c * 64 * ldb + (size_t)(KT) * 128) + gboff),          \
                                     (unsigned*)(gl + (BO) + 16384 + c * 4096), 16, 0, 0);                                  \
  }
    if (!(NEXTPF && preloaded)) {
      G_GLDS(0, 0)
      __syncthreads();
    }
    for (int kt = 0; kt < nk; kt += 2) {
      G_GLDS(kt + 1, 32768)
      __builtin_amdgcn_sched_barrier(0);
      G_COMPUTE(0);
      __syncthreads();
      if constexpr (!NEXTPF) {
        const int k2 = (kt + 2 < nk) ? kt + 2 : nk - 1;
        G_GLDS(k2, 0)
      } else if (kt + 2 < nk) {
        G_GLDS(kt + 2, 0)
      } else if (An) {
        const char* apn = (const char*)An;
        const char* bpn = (const char*)Btn;
        const unsigned gan = (unsigned)(grow * ldan + glc * 8) * 2u;
        const unsigned gbn = (unsigned)(grow * ldbn + glc * 8) * 2u;
#pragma unroll
        for (int c = 0; c < 4; ++c) {
          __builtin_amdgcn_global_load_lds((const unsigned*)(apn + ((size_t)c * 64 * ldan) + gan), (unsigned*)(gl + c * 4096), 16, 0, 0);
          __builtin_amdgcn_global_load_lds((const unsigned*)(bpn + ((size_t)c * 64 * ldbn) + gbn), (unsigned*)(gl + 16384 + c * 4096), 16, 0, 0);
        }
      }
      __builtin_amdgcn_sched_barrier(0);
      G_COMPUTE(32768);
      __syncthreads();
    }
#undef G_GLDS
  }
#undef G_LOAD
#undef G_STORE
#undef G_COMPUTE
#undef G_COMPUTE_FULL
#undef G_COMPUTE_LEAN
}

DI void zero_acc(f32x4 (&acc)[4][4]) {
#pragma unroll
  for (int i = 0; i < 4; ++i)
#pragma unroll
    for (int j = 0; j < 4; ++j) acc[i][j] = f32x4{0.f, 0.f, 0.f, 0.f};
}

DI void swz(int v, int NT, int GN, int& mt, int& nt) {
#if XCD_MODE == 0
  int xcd = v & 7, j = v >> 3;
#else
  int xcd = (v & 511) >> 6, j = ((v >> 9) << 6) + (v & 63);
#endif
  int per_mg = 8 * NT;
  int mg = j / per_mg, r = j - mg * per_mg;
  int ng = r / (8 * GN), wv = r - ng * (8 * GN);
  mt = xcd * 32 + mg * 8 + (wv & 7);
  nt = ng * GN + (wv >> 3);
}

DI void epi_rowmajor(const f32x4 (&acc)[4][4], u16* dst, int ld, int m0, int c0, int mode, char* smem) {
  const int tid = threadIdx.x, lane = tid & 63, w = tid >> 6, wr = w >> 1, wc = w & 1, l15 = lane & 15, g = lane >> 4;
#pragma unroll
  for (int i = 0; i < 4; ++i) {
    const int row = wr * 64 + i * 16 + l15;
#pragma unroll
    for (int j = 0; j < 4; ++j) {
      f32x4 v = acc[i][j];
      if (mode == 1) { v[0] *= QSCALE; v[1] *= QSCALE; v[2] *= QSCALE; v[3] *= QSCALE; }
      else if (mode == 2) { v[0] = siluf_(v[0]); v[1] = siluf_(v[1]); v[2] = siluf_(v[2]); v[3] = siluf_(v[3]); }
      u32x2 o = {pack2(v[0], v[1]), pack2(v[2], v[3])};
      *(u32x2*)(smem + row * 272 + (wc * 64 + j * 16 + g * 4) * 2) = o;
    }
  }
  __syncthreads();
#pragma unroll
  for (int c = 0; c < 8; ++c) {
    const int id = c * 256 + tid, row = id >> 4, ch = id & 15;
    const u32x4 v = *(const u32x4*)(smem + row * 272 + ch * 16);
    *(u32x4*)(dst + (size_t)(m0 + row) * ld + c0 + ch * 8) = v;
  }
  __syncthreads();
}
DI void epi_rowmajor_direct(const f32x4 (&acc)[4][4], u16* dst, int ld, int m0, int c0, int mode) {
  const int tid = threadIdx.x, lane = tid & 63, w = tid >> 6, wr = w >> 1, wc = w & 1, l15 = lane & 15, g = lane >> 4;
#pragma unroll
  for (int i = 0; i < 4; ++i) {
    const size_t row = (size_t)(m0 + wr * 64 + i * 16 + l15);
#pragma unroll
    for (int j = 0; j < 4; ++j) {
      f32x4 v = acc[i][j];
      if (mode == 1) { v[0] *= QSCALE; v[1] *= QSCALE; v[2] *= QSCALE; v[3] *= QSCALE; }
      else if (mode == 2) { v[0] = siluf_(v[0]); v[1] = siluf_(v[1]); v[2] = siluf_(v[2]); v[3] = siluf_(v[3]); }
      u32x2 o = {pack2(v[0], v[1]), pack2(v[2], v[3])};
      *(u32x2*)(dst + row * ld + c0 + wc * 64 + j * 16 + g * 4) = o;
    }
  }
}
DI void epi_transposed(const f32x4 (&acc)[4][4], u16* dst, int m0, int c0, int H, int lgDh, int lgLk) {
  const int tid = threadIdx.x, lane = tid & 63, w = tid >> 6, wr = w >> 1, wc = w & 1, l15 = lane & 15, g = lane >> 4;
#pragma unroll
  for (int i = 0; i < 4; ++i) {
    const int token = m0 + wr * 64 + i * 16 + g * 4;
    const int bidx = token >> lgLk, tl = token & ((1 << lgLk) - 1);
#pragma unroll
    for (int j = 0; j < 4; ++j) {
      const int col = c0 + wc * 64 + j * 16 + l15;
      const int head = col >> lgDh, d = col & ((1 << lgDh) - 1);
      f32x4 v = acc[i][j];
      u32x2 o = {pack2(v[0], v[1]), pack2(v[2], v[3])};
      *(u32x2*)(dst + ((((((size_t)bidx * H + head) << lgDh) + d) << lgLk) + tl)) = o;
    }
  }
}

template <int D, bool FOX, bool PF, int NQ>
DI void attn_item(const u16* __restrict__ qbase, int ldq, const u16* __restrict__ kbase, int ldk,
                  const u16* __restrict__ vtbase, int ldv, const float* __restrict__ Fseq, int q0, int nkv,
                  const u16* __restrict__ gate, u16* outp, float scale, float kmaxv, char* smem) {
  const int tid = threadIdx.x, lane = tid & 63, w = tid >> 6, l15 = lane & 15, g = lane >> 4;
  constexpr int KROW = D * 2 + 16;
  constexpr int KBYTES = 64 * KROW;
  constexpr int VBYTES = D * 144;
  constexpr int BUF = KBYTES + VBYTES + 256;
  constexpr int NL = D / 32;
  constexpr int KCH = D / 8;
  static_assert(2 * BUF <= LDS_BYTES, "attn lds");

  bf16x8 qf[NQ][D / 32];
#pragma unroll
  for (int qi = 0; qi < NQ; ++qi)
#pragma unroll
    for (int s = 0; s < D / 32; ++s)
      qf[qi][s] = *(const bf16x8*)(qbase + (size_t)(w * (16 * NQ) + qi * 16 + l15) * ldq + s * 32 + g * 8);
  float fq[NQ];
#pragma unroll
  for (int qi = 0; qi < NQ; ++qi) fq[qi] = FOX ? Fseq[q0 + w * (16 * NQ) + qi * 16 + l15] : 0.f;
  f32x4 ot[D / 16][NQ];
#pragma unroll
  for (int dt = 0; dt < D / 16; ++dt)
#pragma unroll
    for (int qi = 0; qi < NQ; ++qi) ot[dt][qi] = f32x4{0, 0, 0, 0};
  float mrun[NQ], lsum[NQ];
#pragma unroll
  for (int qi = 0; qi < NQ; ++qi) { mrun[qi] = -1e30f; lsum[qi] = 0.f; }
  float qk[NQ];
#pragma unroll
  for (int qi = 0; qi < NQ; ++qi) {
    float ss = 0.f;
    if (FOX) {
#pragma unroll
      for (int s = 0; s < D / 32; ++s)
#pragma unroll
        for (int e = 0; e < 8; ++e) {
          const float v = __uint_as_float(((unsigned)(unsigned short)qf[qi][s][e]) << 16);
          ss += v * v;
        }
      ss += __shfl_xor(ss, 16);
      ss += __shfl_xor(ss, 32);
    }
    qk[qi] = sqrtf(ss) * kmaxv * 1.002f + 1e-3f;
  }
  int* flags = (int*)(smem + 73664);

  u32x4 kr[NL], vr[NL];
  f32x4 fr = {0, 0, 0, 0};
#define krow(c) (((c) * 256 + tid) / KCH)
#define kch(c) (((c) * 256 + tid) % KCH)
#define vrow(c) (((c) * 256 + tid) >> 3)
#define vch(c) (tid & 7)
#define ATT_LOAD(J)                                                                                   \
  {                                                                                                   \
    const int s0_ = (J) * 64;                                                                         \
    _Pragma("unroll") for (int c = 0; c < NL; ++c) {                                                  \
      kr[c] = *(const u32x4*)(kbase + (size_t)(s0_ + krow(c)) * ldk + kch(c) * 8);                    \
      vr[c] = *(const u32x4*)(vtbase + (size_t)vrow(c) * ldv + s0_ + vch(c) * 8);                     \
    }                                                                                                 \
    if (FOX && tid < 16) fr = *(const f32x4*)(Fseq + s0_ + tid * 4);                                  \
  }
#define ATT_STORE(BO)                                                                                 \
  {                                                                                                   \
    char* b_ = smem + (BO);                                                                           \
    _Pragma("unroll") for (int c = 0; c < NL; ++c) {                                                  \
      *(u32x4*)(b_ + krow(c) * KROW + kch(c) * 16) = kr[c];                                           \
      *(u32x4*)(b_ + KBYTES + vrow(c) * 144 + vch(c) * 16) = vr[c];                                   \
    }                                                                                                 \
    if (FOX && tid < 16) *(f32x4*)(b_ + KBYTES + VBYTES + tid * 16) = fr;                             \
  }
  ATT_LOAD(nkv - 1);
  ATT_STORE(0);
  __syncthreads();
  const int qlo = q0 + w * (16 * NQ);
  for (int j = nkv - 1, itn = 0; j >= 0; --j, ++itn) {
    const int cur = (itn & 1) * BUF;
    if (j > 0) {
      ATT_LOAD(j - 1);
      if (!PF) ATT_STORE(cur ^ BUF);
    }
    __builtin_amdgcn_sched_barrier(0);
    bool ok = false;
    const int s0 = j * 64;
    const bool active = !FOX || (s0 <= qlo + 16 * NQ - 1);
    if (active) {
      const char* Ks = smem + cur;
      const char* Vs = smem + cur + KBYTES;
      const char* Fs = smem + cur + KBYTES + VBYTES;
      f32x4 st[4][NQ];
#pragma unroll
      for (int kt = 0; kt < 4; ++kt)
#pragma unroll
        for (int qi = 0; qi < NQ; ++qi) st[kt][qi] = f32x4{0, 0, 0, 0};
#pragma unroll
      for (int s = 0; s < D / 32; ++s) {
        bf16x8 kf[4];
#pragma unroll
        for (int kt = 0; kt < 4; ++kt) kf[kt] = *(const bf16x8*)(Ks + (kt * 16 + l15) * KROW + s * 64 + g * 16);
#pragma unroll
        for (int kt = 0; kt < 4; ++kt)
#pragma unroll
          for (int qi = 0; qi < NQ; ++qi) st[kt][qi] = mfma16(kf[kt], qf[qi][s], st[kt][qi]);
      }
      if (FOX) {
        const bool need_mask = (s0 + 63 > qlo);
#pragma unroll
        for (int kt = 0; kt < 4; ++kt) {
          f32x4 fk = *(const f32x4*)(Fs + (kt * 16 + g * 4) * 4);
#pragma unroll
          for (int qi = 0; qi < NQ; ++qi) {
            const int qpos = qlo + qi * 16 + l15;
#pragma unroll
            for (int r = 0; r < 4; ++r) {
              float v = st[kt][qi][r] - fk[r];
              if (need_mask && (s0 + kt * 16 + g * 4 + r > qpos)) v = -1e30f;
              st[kt][qi][r] = v;
            }
          }
        }
      } else {
#pragma unroll
        for (int kt = 0; kt < 4; ++kt)
#pragma unroll
          for (int qi = 0; qi < NQ; ++qi)
#pragma unroll
            for (int r = 0; r < 4; ++r) st[kt][qi][r] *= scale;
      }
      float mxl[NQ];
      bool upd = false;
#pragma unroll
      for (int qi = 0; qi < NQ; ++qi) {
        float mx = st[0][qi][0];
#pragma unroll
        for (int kt = 0; kt < 4; ++kt)
#pragma unroll
          for (int r = 0; r < 4; ++r) mx = fmaxf(mx, st[kt][qi][r]);
        mxl[qi] = mx;
        upd = upd || (mx > mrun[qi]);
      }
      const bool resc = __any(upd);
      if (resc) {
#pragma unroll
        for (int qi = 0; qi < NQ; ++qi) {
          float mx = mxl[qi];
          mx = fmaxf(mx, __shfl_xor(mx, 16));
          mx = fmaxf(mx, __shfl_xor(mx, 32));
          const float mnew = fmaxf(mrun[qi], mx);
          const float al = __builtin_amdgcn_exp2f(mrun[qi] - mnew);
          mrun[qi] = mnew;
          lsum[qi] *= al;
#pragma unroll
          for (int dt = 0; dt < D / 16; ++dt)
#pragma unroll
            for (int r = 0; r < 4; ++r) ot[dt][qi][r] *= al;
        }
      }
#pragma unroll
      for (int qi = 0; qi < NQ; ++qi) {
        const float mref = mrun[qi];
        float ps = 0.f;
#pragma unroll
        for (int kt = 0; kt < 4; ++kt)
#pragma unroll
          for (int r = 0; r < 4; ++r) {
            float p = __builtin_amdgcn_exp2f(st[kt][qi][r] - mref);
            st[kt][qi][r] = p;
            ps += p;
          }
        lsum[qi] += ps;
      }
      bf16x8 pb[2][NQ];
#pragma unroll
      for (int kp = 0; kp < 2; ++kp)
#pragma unroll
        for (int qi = 0; qi < NQ; ++qi) {
          u32x4 t = pack8_mfma(st[2 * kp][qi][0], st[2 * kp][qi][1], st[2 * kp][qi][2], st[2 * kp][qi][3],
                               st[2 * kp + 1][qi][0], st[2 * kp + 1][qi][1], st[2 * kp + 1][qi][2], st[2 * kp + 1][qi][3]);
          pb[kp][qi] = __builtin_bit_cast(bf16x8, t);
        }
#pragma unroll
      for (int dt = 0; dt < D / 16; ++dt) {
#pragma unroll
        for (int kp = 0; kp < 2; ++kp) {
          u32x2 lo = *(const u32x2*)(Vs + (dt * 16 + l15) * 144 + (kp * 32 + g * 4) * 2);
          u32x2 hi = *(const u32x2*)(Vs + (dt * 16 + l15) * 144 + (kp * 32 + 16 + g * 4) * 2);
          u32x4 t = {lo[0], lo[1], hi[0], hi[1]};
          bf16x8 vf = __builtin_bit_cast(bf16x8, t);
#pragma unroll
          for (int qi = 0; qi < NQ; ++qi) ot[dt][qi] = mfma16(vf, pb[kp][qi], ot[dt][qi]);
        }
      }
      if (FOX) {
        const float f0 = *(const float*)Fs;
        ok = true;
#pragma unroll
        for (int qi = 0; qi < NQ; ++qi) ok = ok && (qk[qi] - f0 - mrun[qi] <= -30.f * LOG2E);
      }
    }
    __builtin_amdgcn_sched_barrier(0);
    if (PF && j > 0) ATT_STORE(cur ^ BUF);
    if (FOX) {
      const bool wave_ok = (__ballot(ok) == ~0ull);
      if (lane == 0) flags[(itn & 1) * 4 + w] = wave_ok ? 1 : 0;
      __syncthreads();
      const int* fl = flags + (itn & 1) * 4;
      if (fl[0] & fl[1] & fl[2] & fl[3]) break;
    } else {
      __syncthreads();
    }
  }
#undef ATT_LOAD
#undef ATT_STORE
#undef krow
#undef kch
#undef vrow
#undef vch
#pragma unroll
  for (int qi = 0; qi < NQ; ++qi) {
    float l = lsum[qi];
    l += __shfl_xor(l, 16);
    l += __shfl_xor(l, 32);
    const float inv = 1.f / l;
    const size_t rowoff = (size_t)(w * (16 * NQ) + qi * 16 + l15) * ldq;
#pragma unroll
    for (int dt = 0; dt < D / 16; ++dt) {
      const int col = dt * 16 + g * 4;
      u32x2 gv = *(const u32x2*)(gate + rowoff + col);
      u32x2 o = {pack2(ot[dt][qi][0] * inv * bflo(gv[0]), ot[dt][qi][1] * inv * bfhi(gv[0])),
                 pack2(ot[dt][qi][2] * inv * bflo(gv[1]), ot[dt][qi][3] * inv * bfhi(gv[1]))};
      *(u32x2*)(outp + rowoff + col) = o;
    }
  }
}

typedef float v2f __attribute__((ext_vector_type(2)));
DI void s5_load_u(const u16* ubuf, int b, int c, int g, char* ut, int lane) {
  const u16* src = ubuf + ((size_t)(b * L_ + c * 64 + lane)) * 768 + g * 16;
  u32x4 a = *(const u32x4*)src, bb = *(const u32x4*)(src + 8);
  f32x4 o0 = {bflo(a[0]), bfhi(a[0]), bflo(a[1]), bfhi(a[1])};
  f32x4 o1 = {bflo(a[2]), bfhi(a[2]), bflo(a[3]), bfhi(a[3])};
  f32x4 o2 = {bflo(bb[0]), bfhi(bb[0]), bflo(bb[1]), bfhi(bb[1])};
  f32x4 o3 = {bflo(bb[2]), bfhi(bb[2]), bflo(bb[3]), bfhi(bb[3])};
  *(f32x4*)(ut + lane * 64) = o0;
  *(f32x4*)(ut + lane * 64 + 16) = o1;
  *(f32x4*)(ut + lane * 64 + 32) = o2;
  *(f32x4*)(ut + lane * 64 + 48) = o3;
}
DI void s5_load_b(const float* bbar, int gp, v2f (&b2)[16]) {
#pragma unroll
  for (int q = 0; q < 4; ++q) {
    float4 t0 = *(const float4*)(bbar + (size_t)gp * 32 + q * 4);
    float4 t1 = *(const float4*)(bbar + (size_t)gp * 32 + 16 + q * 4);
    b2[4 * q] = v2f{t0.x, t1.x}; b2[4 * q + 1] = v2f{t0.y, t1.y};
    b2[4 * q + 2] = v2f{t0.z, t1.z}; b2[4 * q + 3] = v2f{t0.w, t1.w};
  }
}
DI v2f s5_x(const char* ut, int t, const v2f (&b2)[16]) {
  v2f xa = {0.f, 0.f}, xb = {0.f, 0.f};
#pragma unroll
  for (int q = 0; q < 4; ++q) {
    const f32x4 u = *(const f32x4*)(ut + t * 64 + q * 16);
    xa += b2[4 * q] * u[0];
    xb += b2[4 * q + 1] * u[1];
    xa += b2[4 * q + 2] * u[2];
    xb += b2[4 * q + 3] * u[3];
  }
  return xa + xb;
}

DI void s5_load_bfrag(const float* bbar, int g, int l15, int g4, bf16x8 (&ah)[8], bf16x8 (&al)[8]) {
#pragma unroll
  for (int kt = 0; kt < 8; ++kt) {
    u32x4 h = {0u, 0u, 0u, 0u}, l = {0u, 0u, 0u, 0u};
    if (g4 < 2) {
      const float* src = bbar + (size_t)(g * 64 + (kt & 3) * 16 + l15) * 32 + (kt >> 2) * 16 + g4 * 8;
      const float4 t0 = *(const float4*)src, t1 = *(const float4*)(src + 4);
      const float v[8] = {t0.x, t0.y, t0.z, t0.w, t1.x, t1.y, t1.z, t1.w};
#pragma unroll
      for (int q = 0; q < 4; ++q) {
        const unsigned h0 = f2bf(v[2 * q]), h1 = f2bf(v[2 * q + 1]);
        h[q] = h0 | (h1 << 16);
        l[q] = pack2(v[2 * q] - __uint_as_float(h0 << 16), v[2 * q + 1] - __uint_as_float(h1 << 16));
      }
    }
    ah[kt] = __builtin_bit_cast(bf16x8, h);
    al[kt] = __builtin_bit_cast(bf16x8, l);
  }
}
DI void s5_xsub(const u32x4 uraw, const bf16x8 (&ah)[8], const bf16x8 (&al)[8], char* xs, int l15, int g4) {
  const bf16x8 ub = __builtin_bit_cast(bf16x8, uraw);
#pragma unroll
  for (int kt = 0; kt < 8; ++kt) {
    f32x4 x = {0.f, 0.f, 0.f, 0.f};
    x = mfma16(ah[kt], ub, x);
    x = mfma16(al[kt], ub, x);
    *(f32x4*)(xs + l15 * 528 + (kt * 16 + g4 * 4) * 4) = x;
  }
}

#define XB_TMO      128
#define XB_XCNT(j)  (256  + 64 * (j))
#define XB_XSUB(j)  (1280 + 64 * (j))
#define XB_XGEN(j)  (2304 + 64 * (j))
#define XB_TOP      3328
#define XB_TOPGEN   3392
#define XCD_BAR_WORDS 3456
#define XB_SPIN_CAP (1u << 18)
DI unsigned xb_ld(unsigned* p) { return __hip_atomic_load(p, __ATOMIC_RELAXED, __HIP_MEMORY_SCOPE_AGENT); }
DI unsigned xb_add(unsigned* p, unsigned v) { return __hip_atomic_fetch_add(p, v, __ATOMIC_RELAXED, __HIP_MEMORY_SCOPE_AGENT); }
DI unsigned xb_xcc_id() { return (unsigned)__builtin_amdgcn_s_getreg((3 << 11) | 20) & 0xFu; }
#define XB_SPIN(cond, bar) do { unsigned _sp = 0; while (cond) { __builtin_amdgcn_s_sleep(1); \
    if ((++_sp & 255u) == 0u) { if (xb_ld(&(bar)[XB_TMO])) break; if (_sp > XB_SPIN_CAP) { atomicAdd(&(bar)[XB_TMO], 1u); break; } } } } while (0)
struct XcdBarrier { unsigned* bar; unsigned x; volatile unsigned* st; };
DI XcdBarrier xcd_barrier_post(unsigned* bar, volatile unsigned* st) {
  XcdBarrier b; b.bar = bar; b.x = xb_xcc_id(); b.st = st;
  if (threadIdx.x == 0) (void)xb_add(&bar[XB_XCNT(b.x)], 1u);
  return b;
}
DI void xcd_barrier_complete(unsigned* bar, unsigned x, unsigned& nloc, unsigned& nx) {
  const unsigned G = gridDim.x * gridDim.y * gridDim.z;
  unsigned sum, cnt, mine, sp = 0u;
  for (;;) {
    sum = 0u; cnt = 0u; mine = 0u;
#pragma unroll
    for (unsigned j = 0; j < 16; ++j) { const unsigned c = xb_ld(&bar[XB_XCNT(j)]); sum += c; cnt += (c > 0u) ? 1u : 0u; mine = (j == x) ? c : mine; }
    if (sum == G) break;
    __builtin_amdgcn_s_sleep(1);
    if ((++sp & 255u) == 0u) { if (xb_ld(&bar[XB_TMO])) break; if (sp > XB_SPIN_CAP) { atomicAdd(&bar[XB_TMO], 1u); break; } }
  }
  nloc = mine > 0u ? mine : 1u; nx = cnt > 0u ? cnt : 1u;
}
DI void xcd_barrier(const XcdBarrier& b) {
  asm volatile("s_waitcnt vmcnt(0)" ::: "memory");
  __syncthreads();
  if (threadIdx.x == 0) {
    unsigned* bar = b.bar;
    __builtin_amdgcn_s_waitcnt(0);
    unsigned nloc = b.st[0], nx = b.st[1];
    if (nloc == 0u) { xcd_barrier_complete(bar, b.x, nloc, nx); b.st[0] = nloc; b.st[1] = nx; }
    const unsigned old = xb_add(&bar[XB_XSUB(b.x)], 1u);
    const unsigned gen = old / nloc;
    if (old + 1u == (gen + 1u) * nloc) {
      __builtin_amdgcn_fence(__ATOMIC_RELEASE, "agent");
      asm volatile("s_waitcnt vmcnt(0)" ::: "memory");
      const unsigned og = xb_add(&bar[XB_TOP], 1u);
      const unsigned tg = og / nx;
      if (og + 1u == (tg + 1u) * nx) xb_add(&bar[XB_TOPGEN], 1u);
      else XB_SPIN(xb_ld(&bar[XB_TOPGEN]) == tg, bar);
      __builtin_amdgcn_fence(__ATOMIC_ACQUIRE, "agent");
      xb_add(&bar[XB_XGEN(b.x)], 1u);
      asm volatile("s_waitcnt vmcnt(0)" ::: "memory");
    } else {
      XB_SPIN(xb_ld(&bar[XB_XGEN(b.x)]) == gen, bar);
      __builtin_amdgcn_fence(__ATOMIC_ACQUIRE, "agent");
      asm volatile("s_waitcnt vmcnt(0)" ::: "memory");
    }
  }
  __syncthreads();
}

extern "C" __global__ void __launch_bounds__(256, 2) mega(Params p) {
  extern __shared__ __attribute__((aligned(16))) char smem[];
  cg::grid_group grid = cg::this_grid();
#define TIDVARS                                                                  \
  int tid = threadIdx.x;                                                         \
  asm volatile("" : "+v"(tid));                                                  \
  const int lane = tid & 63, w = tid >> 6, l15 = lane & 15, g4 = lane >> 4;      \
  (void)lane; (void)w; (void)l15; (void)g4;
  const int nblk = gridDim.x, bid = blockIdx.x;
  char* ws = p.ws;
  XcdBarrier xb;
  xb.bar = (unsigned*)(ws + OFF_CTL + 4096); xb.x = 0; xb.st = (volatile unsigned*)(smem + 73712);
  if (p.phase_lo < p.phase_hi) {
    if (threadIdx.x < 2) xb.st[threadIdx.x] = 0u;
    __syncthreads();
    xb = xcd_barrier_post((unsigned*)(ws + OFF_CTL + 4096), (volatile unsigned*)(smem + 73712));
    grid.sync();
  }
  u16* hbuf = (u16*)(ws + OFF_H);
  u16* qbuf = (u16*)(ws + OFF_Q);
  u16* gfbuf = (u16*)(ws + OFF_GF);
  u16* ubuf = (u16*)(ws + OFF_U);
  u16* gsbuf = (u16*)(ws + OFF_GS);
  u16* ys5a = (u16*)(ws + OFF_YS5A);
  u16* qmbuf = (u16*)(ws + OFF_QM);
  u16* gmbuf = (u16*)(ws + OFF_GM);
  u16* merged = (u16*)(ws + OFF_MERGED);
  u16* WinT = (u16*)(ws + OFF_WINT);
  u16* WglT = (u16*)(ws + OFF_WGLT);
  u16* WkvT = (u16*)(ws + OFF_WKVT);
  u16* WoutT = (u16*)(ws + OFF_WOUTT);
  u16* WpfT = (u16*)(ws + OFF_WPFT);
  u16* WpsT = (u16*)(ws + OFF_WPST);
  u16* WpmT = (u16*)(ws + OFF_WPMT);
  u16* WgluT = (u16*)(ws + OFF_WGLUT);
  u16* memn = (u16*)(ws + OFF_MEMN);
  u16* mkbuf = (u16*)(ws + OFF_MK);
  u16* mvT = (u16*)(ws + OFF_MVT);
  float* logf = (float*)(ws + OFF_LOGF);
  float* Fbuf = (float*)(ws + OFF_F);
  float2* abar = (float2*)(ws + OFF_S5AB);
  float* bbar = (float*)(ws + OFF_S5BB);
  float2* Sst = (float2*)(ws + OFF_S5S);
  float* part = (float*)(ws + OFF_PART);
  unsigned* ctl = (unsigned*)(ws + OFF_CTL);
  u16* kbuf = (u16*)p.out;
  u16* vT = (u16*)((char*)p.out + 48 * MiB);

  {
    if (PH(0)) {
      TIDVARS
      if (bid == 0 && tid < 128) ctl[tid] = 0u;
      float* tile = (float*)smem;
      for (int ti = bid; ti < 3344; ti += nblk) {
        const float* src; int ld, col0, K; u16* dst; int tt;
        if (ti < 576) { src = p.w_in; ld = 8716; col0 = 0; K = 1024; dst = WinT; tt = ti; }
        else if (ti < 1408) { src = p.w_in; ld = 8716; col0 = 2316; K = 1024; dst = WinT + (size_t)2304 * KLD; tt = ti - 576; }
        else if (ti < 2176) { src = p.w_in; ld = 8716; col0 = 5644; K = 1024; dst = WglT; tt = ti - 1408; }
        else if (ti < 2432) { src = p.w_mem_kv; ld = 1024; col0 = 0; K = 1024; dst = WkvT; tt = ti - 2176; }
        else if (ti < 2688) { src = p.w_out; ld = 1024; col0 = 0; K = 1024; dst = WoutT; tt = ti - 2432; }
        else if (ti < 2880) { src = p.w_pf; ld = 1024; col0 = 0; K = 768; dst = WpfT; tt = ti - 2688; }
        else if (ti < 3072) { src = p.w_ps; ld = 1024; col0 = 0; K = 768; dst = WpsT; tt = ti - 2880; }
        else if (ti < 3200) { src = p.w_pm; ld = 1024; col0 = 0; K = 512; dst = WpmT; tt = ti - 3072; }
        else { src = p.w_glu; ld = 768; col0 = 0; K = 768; dst = WgluT; tt = ti - 3200; }
        const int nkt = K >> 6;
        const int dld = (K == 1024) ? KLD : K;
        const int k0 = (tt % nkt) * 64, n0 = (tt / nkt) * 64;
#pragma unroll 4
        for (int i = 0; i < 16; ++i) {
          int k = i * 4 + w, n = lane;
          tile[k * 65 + n] = src[(size_t)(k0 + k) * ld + col0 + n0 + n];
        }
        __syncthreads();
#pragma unroll 4
        for (int i = 0; i < 16; ++i) {
          int n = i * 4 + w, k = lane;
          dst[(size_t)(n0 + n) * dld + k0 + k] = f2bf(tile[k * 65 + n]);
        }
        __syncthreads();
      }
      float* wfl = (float*)smem;
      for (int idx = tid; idx < 12288; idx += 256) {
        int k = idx / 12, j = idx - k * 12;
        wfl[j * 1024 + k] = p.w_in[(size_t)k * 8716 + 2304 + j];
      }
      __syncthreads();
      for (int row = bid * 4 + w; row < T_ + 1024; row += nblk * 4) {
        const bool isx = row < T_;
        const float* src = isx ? p.x + (size_t)row * 1024 : p.mem + (size_t)(row - T_) * 1024;
        const float* gsrc = isx ? p.g_norm : p.g_mem_norm;
        u16* dst = isx ? hbuf + (size_t)row * KLD : memn + (size_t)(row - T_) * KLD;
        float4 xv[4];
        float ss = 0.f;
#pragma unroll
        for (int i = 0; i < 4; ++i) {
          xv[i] = *(const float4*)(src + i * 256 + lane * 4);
          ss += xv[i].x * xv[i].x + xv[i].y * xv[i].y + xv[i].z * xv[i].z + xv[i].w * xv[i].w;
        }
        ss = wave_sum(ss);
        const float rstd = rsqrtf(ss * (1.f / 1024.f) + 1e-6f);
#pragma unroll
        for (int i = 0; i < 4; ++i) {
          float4 gv = *(const float4*)(gsrc + i * 256 + lane * 4);
          xv[i].x *= rstd * gv.x; xv[i].y *= rstd * gv.y; xv[i].z *= rstd * gv.z; xv[i].w *= rstd * gv.w;
          u32x2 o = {pack2(xv[i].x, xv[i].y), pack2(xv[i].z, xv[i].w)};
          *(u32x2*)(dst + i * 256 + lane * 4) = o;
        }
        if (isx) {
          float myfl = 0.f;
#pragma unroll
          for (int j = 0; j < 12; ++j) {
            float a = 0.f;
#pragma unroll
            for (int i = 0; i < 4; ++i) {
              float4 wv = *(const float4*)(wfl + j * 1024 + i * 256 + lane * 4);
              a += xv[i].x * wv.x + xv[i].y * wv.y + xv[i].z * wv.z + xv[i].w * wv.w;
            }
            a = wave_sum(a);
            if (lane == j) myfl = a;
          }
          if (lane < 12) {
            float xx = myfl + p.b_forget[lane];
            float lf = fminf(xx, 0.f) - log1pf(__expf(-fabsf(xx)));
            const int b = row >> 13, t = row & (L_ - 1);
            logf[(size_t)(b * 12 + lane) * L_ + t] = lf;
          }
        }
      }
      {
        const int gid = bid * 256 + tid;
        if (gid < 3072) {
          const int g = gid >> 6;
          const float step = expf(p.log_step[g]);
          const float lr = p.lam_re[gid], li = p.lam_im[gid];
          const float mag = expf(lr * step);
          const float ar = mag * cosf(li * step), ai = mag * sinf(li * step);
          const float den = lr * lr + li * li;
          const float nr = ar - 1.f, ni = ai;
          const float fr = (nr * lr + ni * li) / den, fi = (ni * lr - nr * li) / den;
          abar[gid] = make_float2(ar, ai);
#pragma unroll
          for (int h = 0; h < 16; ++h) {
            const float br = p.b_re[(size_t)gid * 16 + h], bi = p.b_im[(size_t)gid * 16 + h];
            bbar[(size_t)gid * 32 + h] = fr * br - fi * bi;
            bbar[(size_t)gid * 32 + 16 + h] = fr * bi + fi * br;
          }
        }
      }
      __syncthreads();
    }
    SYNC_BEFORE(1);
    if (PH(1)) {
      TIDVARS
      float* sm = (float*)smem;
      for (int seq = bid; seq < 48; seq += nblk) {
        const float* src = logf + (size_t)seq * L_ + tid * 32;
        float* dst = Fbuf + (size_t)seq * L_ + tid * 32;
        float v[32];
#pragma unroll
        for (int i = 0; i < 8; ++i) {
          float4 t = *(const float4*)(src + i * 4);
          v[4 * i] = t.x; v[4 * i + 1] = t.y; v[4 * i + 2] = t.z; v[4 * i + 3] = t.w;
        }
        float run = 0.f;
#pragma unroll
        for (int i = 0; i < 32; ++i) { run += v[i]; v[i] = run; }
        float incl = run;
#pragma unroll
        for (int o = 1; o < 64; o <<= 1) {
          float t = __shfl_up(incl, o);
          if (lane >= o) incl += t;
        }
        if (lane == 63) sm[w] = incl;
        __syncthreads();
        float base = incl - run;
        for (int w2 = 0; w2 < w; ++w2) base += sm[w2];
#pragma unroll
        for (int i = 0; i < 8; ++i) {
          float4 t = make_float4((v[4 * i] + base) * LOG2E, (v[4 * i + 1] + base) * LOG2E, (v[4 * i + 2] + base) * LOG2E, (v[4 * i + 3] + base) * LOG2E);
          *(float4*)(dst + i * 4) = t;
        }
        __syncthreads();
      }
#define P1_V(PN, VOUT)                                                     \
      {                                                                    \
        VOUT = -1;                                                         \
        if (nblk == 512) {                                                 \
          const int i_ = bid >> 3, x_ = bid & 7;                           \
          int j_ = -1;                                                     \
          if ((PN) < 20) j_ = 64 * (PN) + i_;                              \
          else if (i_ < 32 && (PN) < 24) j_ = 1280 + 32 * ((PN) - 20) + i_; \
          else if (i_ < 8 && (PN) == 24) j_ = 1408 + i_;                   \
          if (j_ >= 0) VOUT = j_ * 8 + x_;                                 \
        } else {                                                           \
          const int v_ = bid + (PN) * nblk;                                \
          if (v_ < 11264 + 64) VOUT = v_;                                  \
        }                                                                  \
      }
#define P1_OPS(V, AO, BO_, M0O, N0O, KVO)                                  \
      {                                                                    \
        KVO = (V) >= 11264;                                                \
        if (!KVO) {                                                        \
          int mt_, nt_;                                                    \
          swz((V), 44, 4, mt_, nt_);                                       \
          M0O = mt_ * 128; N0O = nt_ * 128;                                \
          AO = hbuf + (size_t)M0O * KLD; BO_ = WinT + (size_t)N0O * KLD;   \
        } else {                                                           \
          const int kv_ = (V) - 11264;                                     \
          M0O = (kv_ >> 3) * 128; N0O = (kv_ & 7) * 128;                   \
          AO = memn + (size_t)M0O * KLD; BO_ = WkvT + (size_t)N0O * KLD;   \
        }                                                                  \
      }
      for (int pn = 0;; ++pn) {
        int v;
        P1_V(pn, v)
        if (v < 0) break;
        const u16 *A, *Bt;
        int m0, n0;
        bool kvtile;
        P1_OPS(v, A, Bt, m0, n0, kvtile)
        const u16 *An = nullptr, *Btn = nullptr;
        {
          int vn;
          P1_V(pn + 1, vn)
          if (vn >= 0) { int m0n_, n0n_; bool kvn_; P1_OPS(vn, An, Btn, m0n_, n0n_, kvn_) (void)m0n_; (void)n0n_; (void)kvn_; }
        }
        const bool transp = kvtile ? (n0 >= 512) : (n0 >= 1536 && n0 < 2304);
        f32x4 acc[4][4];
        zero_acc(acc);
        if (transp) {
          gemm_core<false, 1, false, true>(acc, A, KLD, Bt, KLD, 1024, smem, pn > 0, An, KLD, Btn, KLD);
          if (kvtile) epi_transposed(acc, mvT, m0, n0 - 512, 4, 7, 8);
          else epi_transposed(acc, vT, m0, n0 - 1536, 12, 6, 13);
        } else {
          gemm_core<true, 1, false, true>(acc, A, KLD, Bt, KLD, 1024, smem, pn > 0, An, KLD, Btn, KLD);
          u16* dst; int ld, c0, mode;
          if (kvtile) { dst = mkbuf; ld = 512; c0 = n0; mode = 0; }
          else if (n0 < 768) { dst = qbuf; ld = 768; c0 = n0; mode = 1; }
          else if (n0 < 1536) { dst = kbuf; ld = 768; c0 = n0 - 768; mode = 0; }
          else if (n0 < 3072) { dst = gfbuf; ld = 768; c0 = n0 - 2304; mode = 2; }
          else if (n0 < 3840) { dst = ubuf; ld = 768; c0 = n0 - 3072; mode = 0; }
          else if (n0 < 4608) { dst = gsbuf; ld = 768; c0 = n0 - 3840; mode = 2; }
          else if (n0 < 5120) { dst = qmbuf; ld = 512; c0 = n0 - 4608; mode = 0; }
          else { dst = gmbuf; ld = 512; c0 = n0 - 5120; mode = 2; }
          epi_rowmajor(acc, dst, ld, m0, c0, mode, smem + 32768);
          if (!kvtile && n0 >= 768 && n0 < 1536) {
            float mxv = 0.f;
#pragma unroll
            for (int i = 0; i < 4; ++i) {
              float ss = 0.f;
#pragma unroll
              for (int j = 0; j < 4; ++j)
#pragma unroll
                for (int r = 0; r < 4; ++r) {
                  const float v = __uint_as_float(((unsigned)f2bf(acc[i][j][r])) << 16);
                  ss += v * v;
                }
              ss += __shfl_xor(ss, 16);
              ss += __shfl_xor(ss, 32);
              mxv = fmaxf(mxv, ss);
            }
#pragma unroll
            for (int o = 1; o < 16; o <<= 1) mxv = fmaxf(mxv, __shfl_xor(mxv, o));
            if (lane == 0) atomicMax(&ctl[(m0 >> 13) * 12 + ((n0 - 768) >> 6) + (w & 1)], __float_as_uint(mxv));
          }
        }
      }
    }
    SYNC_BEFORE(2);
    if (PH(2)) {
      TIDVARS
      int* qslot = (int*)(smem + 73696);
#define NEXT_ITEM(CTR)                                        \
      {                                                       \
        if (tid == 0) *qslot = (int)atomicAdd(&ctl[CTR], 1u); \
        __syncthreads();                                      \
        it = *qslot;                                          \
        __syncthreads();                                      \
      }
      int it;
      for (;;) {
        NEXT_ITEM(64);
        if (it >= 3072) break;
        {
#ifndef NO_FOX
          const int qt = 63 - it / 48, bh = it % 48, b = bh / 12, h = bh % 12;
          const int q0 = qt * 128;
          const size_t qoff = ((size_t)(b * L_ + q0)) * 768 + h * 64;
          attn_item<64, true, true, 2>(qbuf + qoff, 768, kbuf + (size_t)b * L_ * 768 + h * 64, 768,
                              vT + (size_t)(b * 12 + h) * 64 * L_, L_, Fbuf + (size_t)(b * 12 + h) * L_, q0, 2 * qt + 2,
                              gfbuf + qoff, qbuf + qoff, 1.f, sqrtf(__uint_as_float(ctl[b * 12 + h])), smem);
#endif
        }
      }
      for (;;) {
        NEXT_ITEM(65);
        if (it >= 2048) break;
        {
#ifndef NO_MEM
          const int im = it;
          const int hm = im & 3, qt = (im >> 2) & 127, b = im >> 9;
          const int q0 = qt * 64;
          const size_t qoff = ((size_t)(b * L_ + q0)) * 512 + hm * 128;
          attn_item<128, false, false, 1>(qmbuf + qoff, 512, mkbuf + (size_t)b * 256 * 512 + hm * 128, 512,
                                mvT + (size_t)(b * 4 + hm) * 128 * 256, 256, nullptr, q0, 4,
                                gmbuf + qoff, qmbuf + qoff, 0.08838834764831845f * LOG2E, 0.f, smem);
#endif
        }
      }
      for (;;) {
        NEXT_ITEM(66);
        if (it >= 1536) break;
        {
#ifndef NO_S5P1
          const int wi = it * 4 + w;
          const int g = wi % 48, cg = (wi / 48) & 31, b = wi / (48 * 32);
          char* xs = smem + w * 12800;
          const int gp = g * 64 + lane;
          bf16x8 ah[8], al[8];
          s5_load_bfrag(bbar, g, l15, g4, ah, al);
          const float2 ab = abar[gp];
#pragma unroll 1
          for (int ci = 0; ci < 4; ++ci) {
          const int c = cg * 4 + ci;
          const u16* ub0 = ubuf + ((size_t)(b * L_ + c * 64 + l15)) * 768 + g * 16;
          u32x4 uq[4];
#pragma unroll
          for (int sub = 0; sub < 4; ++sub) {
            uq[sub] = u32x4{0u, 0u, 0u, 0u};
            if (g4 < 2) uq[sub] = *(const u32x4*)(ub0 + (size_t)sub * 16 * 768 + g4 * 8);
          }
          float hr = 0.f, hi = 0.f;
#pragma unroll
          for (int sub = 0; sub < 4; ++sub) {
            s5_xsub(uq[sub], ah, al, xs, l15, g4);
            asm volatile("s_waitcnt lgkmcnt(0)" ::: "memory");
#pragma unroll
            for (int tt = 0; tt < 16; ++tt) {
              const float xr = *(const float*)(xs + tt * 528 + lane * 4);
              const float xi = *(const float*)(xs + tt * 528 + 256 + lane * 4);
              const float nhr = ab.x * hr - ab.y * hi + xr;
              const float nhi = ab.x * hi + ab.y * hr + xi;
              hr = nhr; hi = nhi;
            }
            asm volatile("s_waitcnt lgkmcnt(0)" ::: "memory");
          }
          Sst[((size_t)(b * 128 + c) * 48 + g) * 64 + lane] = make_float2(hr, hi);
          }
          __syncthreads();
#endif
        }
      }
    }
    SYNC_BEFORE(3);
    if (PH(3)) {
      TIDVARS
      for (int wi = bid * 4 + w; wi < 192; wi += nblk * 4) {
        const int g = wi % 48, b = wi / 48;
        const float2 ab = abar[g * 64 + lane];
        float a64r = ab.x, a64i = ab.y;
#pragma unroll
        for (int q = 0; q < 6; ++q) {
          const float nr = a64r * a64r - a64i * a64i, ni = 2.f * a64r * a64i;
          a64r = nr; a64i = ni;
        }
        float2* sp = Sst + ((size_t)(b * 128) * 48 + g) * 64 + lane;
        float hr = 0.f, hi = 0.f;
        for (int cc = 0; cc < 128; cc += 16) {
          float2 sv[16];
#pragma unroll
          for (int q = 0; q < 16; ++q) sv[q] = sp[(size_t)(cc + q) * 48 * 64];
#pragma unroll
          for (int q = 0; q < 16; ++q) {
            sp[(size_t)(cc + q) * 48 * 64] = make_float2(hr, hi);
            const float nhr = a64r * hr - a64i * hi + sv[q].x;
            const float nhi = a64r * hi + a64i * hr + sv[q].y;
            hr = nhr; hi = nhi;
          }
        }
      }
    }
    SYNC_BEFORE(4);
    if (PH(4)) {
      TIDVARS
      for (int it = bid; it < 1536; it += nblk) {
        const int wi = it * 4 + w;
        const int g = wi % 48, cg = (wi / 48) & 31, b = wi / (48 * 32);
        char* xs = smem + w * 12800;
        char* stt = xs + 8448;
        const int gp = g * 64 + lane;
        bf16x8 ah[8], al[8];
        s5_load_bfrag(bbar, g, l15, g4, ah, al);
        const float2 ab = abar[gp];
        bf16x8 cf[4];
#pragma unroll
        for (int s = 0; s < 4; ++s) {
          const float* cs = (s < 2 ? p.c_re : p.c_im) + (size_t)(g * 16 + l15) * 64 + (s & 1) * 32 + g4 * 8;
          float4 t0 = *(const float4*)cs, t1 = *(const float4*)(cs + 4);
          const float sg = (s < 2) ? 1.f : -1.f;
          u32x4 t = pack8_mfma(sg * t0.x, sg * t0.y, sg * t0.z, sg * t0.w, sg * t1.x, sg * t1.y, sg * t1.z, sg * t1.w);
          cf[s] = __builtin_bit_cast(bf16x8, t);
        }
        const float4 dsk = *(const float4*)(p.s5_d + g * 16 + g4 * 4);
#pragma unroll 1
        for (int ci = 0; ci < 4; ++ci) {
        const int c = cg * 4 + ci;
        const u16* ub0 = ubuf + ((size_t)(b * L_ + c * 64 + l15)) * 768 + g * 16;
        const float2 hc = Sst[((size_t)(b * 128 + c) * 48 + g) * 64 + lane];
        float hr = hc.x, hi = hc.y;
        u32x4 uq[4];
        u32x2 uvq[4];
#pragma unroll
        for (int sub = 0; sub < 4; ++sub) {
          uq[sub] = u32x4{0u, 0u, 0u, 0u};
          if (g4 < 2) uq[sub] = *(const u32x4*)(ub0 + (size_t)sub * 16 * 768 + g4 * 8);
          uvq[sub] = *(const u32x2*)(ub0 + (size_t)sub * 16 * 768 + g4 * 4);
        }
        asm volatile("s_waitcnt lgkmcnt(0)" ::: "memory");
#pragma unroll
        for (int sub = 0; sub < 4; ++sub) {
          s5_xsub(uq[sub], ah, al, xs, l15, g4);
          asm volatile("s_waitcnt lgkmcnt(0)" ::: "memory");
#pragma unroll
          for (int tt = 0; tt < 16; ++tt) {
            const float xr = *(const float*)(xs + tt * 528 + lane * 4);
            const float xi = *(const float*)(xs + tt * 528 + 256 + lane * 4);
            const float nhr = ab.x * hr - ab.y * hi + xr;
            const float nhi = ab.x * hi + ab.y * hr + xi;
            hr = nhr; hi = nhi;
            *(u16*)(stt + tt * 272 + lane * 2) = f2bf(hr);
            *(u16*)(stt + tt * 272 + 128 + lane * 2) = f2bf(hi);
          }
          asm volatile("s_waitcnt lgkmcnt(0)" ::: "memory");
          f32x4 y = {0, 0, 0, 0};
#pragma unroll
          for (int s = 0; s < 4; ++s) {
            bf16x8 bfr = *(const bf16x8*)(stt + l15 * 272 + s * 64 + g4 * 16);
            y = mfma16(cf[s], bfr, y);
          }
          const int t = sub * 16 + l15;
          const u32x2 uv = uvq[sub];
          float o0 = gelu_tanh(y[0] + dsk.x * bflo(uv[0]));
          float o1 = gelu_tanh(y[1] + dsk.y * bfhi(uv[0]));
          float o2 = gelu_tanh(y[2] + dsk.z * bflo(uv[1]));
          float o3 = gelu_tanh(y[3] + dsk.w * bfhi(uv[1]));
          u32x2 o = {pack2(o0, o1), pack2(o2, o3)};
          *(u32x2*)(ys5a + ((size_t)(b * L_ + c * 64 + t)) * 768 + g * 16 + g4 * 4) = o;
          asm volatile("s_waitcnt lgkmcnt(0)" ::: "memory");
        }
        }
        __syncthreads();
      }
    }
    SYNC_BEFORE(5);
    if (PH(5)) {
      TIDVARS
      for (int v = bid; v < 256 * 6; v += nblk) {
        int mt, nt;
        swz(v, 6, 6, mt, nt);
        const int m0 = mt * 128, n0 = nt * 128;
        f32x4 acc[4][4];
        zero_acc(acc);
        gemm_core<true>(acc, ys5a + (size_t)m0 * 768, 768, WgluT + (size_t)n0 * 768, 768, 768, smem);
        const int wr = w >> 1, wc = w & 1;
#pragma unroll
        for (int i = 0; i < 4; ++i) {
          const size_t row = (size_t)(m0 + wr * 64 + i * 16 + l15);
#pragma unroll
          for (int j = 0; j < 4; ++j) {
            const int n = n0 + wc * 64 + j * 16 + g4 * 4;
            const float4 bg = *(const float4*)(p.b_glu + n);
            const u32x2 av = *(const u32x2*)(ys5a + row * 768 + n);
            const u32x2 sv = *(const u32x2*)(gsbuf + row * 768 + n);
            float o0 = bflo(av[0]) * sigmoidf_(acc[i][j][0] + bg.x) * bflo(sv[0]);
            float o1 = bfhi(av[0]) * sigmoidf_(acc[i][j][1] + bg.y) * bfhi(sv[0]);
            float o2 = bflo(av[1]) * sigmoidf_(acc[i][j][2] + bg.z) * bflo(sv[1]);
            float o3 = bfhi(av[1]) * sigmoidf_(acc[i][j][3] + bg.w) * bfhi(sv[1]);
            u32x2 o = {pack2(o0, o1), pack2(o2, o3)};
            *(u32x2*)(ubuf + row * 768 + n) = o;
          }
        }
      }
    }
    SYNC_BEFORE(6);
    if (PH(6)) {
      TIDVARS
      for (int v = bid; v < 256 * 8; v += nblk) {
        int mt, nt;
        swz(v, 8, 4, mt, nt);
        const int m0 = mt * 128, n0 = nt * 128;
        const int wr = w >> 1, wc = w & 1;
        char* gstash = ws + OFF_GATE + (size_t)bid * 32768;
        f32x4 accm[4][4];
        zero_acc(accm);
        const unsigned toff = (unsigned)tid * 16u;
#pragma unroll 1
        for (int stp = 0; stp < 6; ++stp) {
          const int br = stp >> 1;
          const u16* Ab; const u16* Wb; int Kb; int ldk;
          if (!(stp & 1)) { Ab = hbuf + (size_t)m0 * KLD; Wb = WglT + (size_t)(br * 1024 + n0) * KLD; Kb = 1024; }
          else if (br == 0) { Ab = qbuf + (size_t)m0 * 768; Wb = WpfT + (size_t)n0 * 768; Kb = 768; }
          else if (br == 1) { Ab = ubuf + (size_t)m0 * 768; Wb = WpsT + (size_t)n0 * 768; Kb = 768; }
          else { Ab = qmbuf + (size_t)m0 * 512; Wb = WpmT + (size_t)n0 * 512; Kb = 512; }
          f32x4 acc[4][4];
          zero_acc(acc);
          ldk = (Kb == 1024) ? KLD : Kb;
          gemm_core<true>(acc, Ab, ldk, Wb, ldk, Kb, smem);
          if (!(stp & 1)) {
#pragma unroll
            for (int j = 0; j < 4; ++j) {
              const float4 bm = *(const float4*)(p.b_merge + br * 1024 + n0 + wc * 64 + j * 16 + g4 * 4);
#pragma unroll
              for (int i = 0; i < 4; i += 2) {
                u32x4 gq = {pack2(sigmoidf_(acc[i][j][0] + bm.x), sigmoidf_(acc[i][j][1] + bm.y)),
                            pack2(sigmoidf_(acc[i][j][2] + bm.z), sigmoidf_(acc[i][j][3] + bm.w)),
                            pack2(sigmoidf_(acc[i + 1][j][0] + bm.x), sigmoidf_(acc[i + 1][j][1] + bm.y)),
                            pack2(sigmoidf_(acc[i + 1][j][2] + bm.z), sigmoidf_(acc[i + 1][j][3] + bm.w))};
                *(u32x4*)(gstash + (j * 2 + (i >> 1)) * 4096 + toff) = gq;
              }
            }
          } else {
#pragma unroll
            for (int j = 0; j < 4; ++j)
#pragma unroll
              for (int i = 0; i < 4; i += 2) {
                const u32x4 gq = *(const u32x4*)(gstash + (j * 2 + (i >> 1)) * 4096 + toff);
                acc[i][j][0] *= bflo(gq[0]); acc[i][j][1] *= bfhi(gq[0]);
                acc[i][j][2] *= bflo(gq[1]); acc[i][j][3] *= bfhi(gq[1]);
                acc[i + 1][j][0] *= bflo(gq[2]); acc[i + 1][j][1] *= bfhi(gq[2]);
                acc[i + 1][j][2] *= bflo(gq[3]); acc[i + 1][j][3] *= bfhi(gq[3]);
                accm[i][j] += acc[i][j];
                accm[i + 1][j] += acc[i + 1][j];
                __builtin_amdgcn_sched_barrier(0);
              }
            if (br == 2) epi_rowmajor_direct(accm, merged, KLD, m0, n0, 0);
          }
        }
      }
    }
    SYNC_BEFORE(7);
    if (PH(7)) {
      TIDVARS
      for (int v = bid; v < 256 * 8; v += nblk) {
        int mt, nt;
        swz(v, 8, 4, mt, nt);
        const int m0 = mt * 128, n0 = nt * 128;
        const int wr = w >> 1, wc = w & 1;
        f32x4 acc[4][4];
        zero_acc(acc);
        gemm_core<true>(acc, merged + (size_t)m0 * KLD, KLD, WoutT + (size_t)n0 * KLD, KLD, 1024, smem);
#pragma unroll
        for (int i = 0; i < 4; ++i) {
          const size_t row = (size_t)(m0 + wr * 64 + i * 16 + l15);
          float ss = 0.f;
#pragma unroll
          for (int j = 0; j < 4; ++j) {
            const int n = n0 + wc * 64 + j * 16 + g4 * 4;
            const float4 xv = *(const float4*)(p.x + row * 1024 + n);
            float4 o = make_float4(xv.x + acc[i][j][0], xv.y + acc[i][j][1], xv.z + acc[i][j][2], xv.w + acc[i][j][3]);
            ss += o.x * o.x + o.y * o.y + o.z * o.z + o.w * o.w;
            *(float4*)(p.out + row * 1024 + n) = o;
          }
          ss += __shfl_xor(ss, 16);
          ss += __shfl_xor(ss, 32);
          if (g4 == 0) part[row * 16 + nt * 2 + wc] = ss;
        }
      }
    }
    SYNC_BEFORE(8);
    if (PH(8)) {
      TIDVARS
      for (int row = bid * 4 + w; row < T_; row += nblk * 8) {
        const int row2 = row + nblk * 4;
        const bool has2 = row2 < T_;
        float ssa = (lane < 16) ? part[(size_t)row * 16 + lane] : 0.f;
        float ssb = (has2 && lane < 16) ? part[(size_t)row2 * 16 + lane] : 0.f;
        float* oa = p.out + (size_t)row * 1024;
        float* ob = p.out + (size_t)(has2 ? row2 : row) * 1024;
        float4 va[4], vb[4];
#pragma unroll
        for (int i = 0; i < 4; ++i) {
          va[i] = *(const float4*)(oa + i * 256 + lane * 4);
          vb[i] = *(const float4*)(ob + i * 256 + lane * 4);
        }
        ssa = wave_sum(ssa);
        ssb = wave_sum(ssb);
        const float ra = rsqrtf(ssa * (1.f / 1024.f) + 1e-6f);
        const float rb = rsqrtf(ssb * (1.f / 1024.f) + 1e-6f);
#pragma unroll
        for (int i = 0; i < 4; ++i) {
          const float4 gv = *(const float4*)(p.g_final + i * 256 + lane * 4);
          va[i].x *= ra * gv.x; va[i].y *= ra * gv.y; va[i].z *= ra * gv.z; va[i].w *= ra * gv.w;
          *(float4*)(oa + i * 256 + lane * 4) = va[i];
          if (has2) {
            vb[i].x *= rb * gv.x; vb[i].y *= rb * gv.y; vb[i].z *= rb * gv.z; vb[i].w *= rb * gv.w;
            *(float4*)(ob + i * 256 + lane * 4) = vb[i];
          }
        }
      }
    }
  }
}

extern "C" void kernel_launch(void* const* d_in, const int* in_sizes, int n_in, void* d_out, int out_size, void* d_ws,
                              size_t ws_size, hipStream_t stream) {
  static int grid_blocks = 0;
  if (!grid_blocks) {
    if (ws_size < WS_END || n_in != 23) {
      fprintf(stderr, "kernel_launch: unexpected ws_size %zu (need %zu) or n_in %d\n", ws_size, (size_t)WS_END, n_in);
      grid_blocks = -1;
      return;
    }
    int dev = 0, cus = 0, per_cu = 0;
    (void)hipGetDevice(&dev);
    (void)hipDeviceGetAttribute(&cus, hipDeviceAttributeMultiprocessorCount, dev);
    (void)hipFuncSetAttribute((const void*)mega, hipFuncAttributeMaxDynamicSharedMemorySize, LDS_BYTES);
    (void)hipOccupancyMaxActiveBlocksPerMultiprocessor(&per_cu, (const void*)mega, 256, LDS_BYTES);
    per_cu = (per_cu >= 2) ? 2 : 1;
    grid_blocks = cus * per_cu;
  }
  if (grid_blocks < 0) return;
  Params p{};
  const float** pp = (const float**)&p;
  for (int i = 0; i < 23; ++i) pp[i] = (const float*)d_in[i];
  p.out = (float*)d_out;
  p.ws = (char*)d_ws;
#if COOP
  (void)hipMemsetAsync((char*)d_ws + OFF_CTL + 4096, 0, XCD_BAR_WORDS * 4, stream);
  p.phase_lo = 0;
  p.phase_hi = NPHASE - 1;
  void* args[] = {&p};
  hipError_t e = hipLaunchCooperativeKernel((const void*)mega, dim3(grid_blocks), dim3(256), args, LDS_BYTES, stream);
  if (e != hipSuccess) fprintf(stderr, "cooperative launch failed: %s (grid %d)\n", hipGetErrorString(e), grid_blocks);
#else
  for (int ph = 0; ph < NPHASE; ++ph) {
    p.phase_lo = ph;
    p.phase_hi = ph;
    hipLaunchKernelGGL(mega, dim3(grid_blocks), dim3(256), LDS_BYTES, stream, p);
#ifdef PROBE_DUP
    if (ph == PROBE_DUP) {
      for (int rep = 0; rep < 2; ++rep) {
        if (ph == 2) { p.phase_lo = p.phase_hi = 1; hipLaunchKernelGGL(mega, dim3(grid_blocks), dim3(256), LDS_BYTES, stream, p); p.phase_lo = p.phase_hi = 2; }
        hipLaunchKernelGGL(mega, dim3(grid_blocks), dim3(256), LDS_BYTES, stream, p);
      }
    }
#endif
  }
#endif
}
```

```cpp
#include <hip/hip_runtime.h>
#include <hip/hip_cooperative_groups.h>
#include <stdint.h>
#include <stdio.h>
namespace cg = cooperative_groups;

#ifndef COOP
#define COOP 1
#define XCD_MODE 0
#endif

#define DI __device__ __forceinline__
#ifdef ONLY_PHASE
#define PH(n) ((n) == ONLY_PHASE && p.phase_lo <= (n) && (n) <= p.phase_hi)
#else
#define PH(n) (p.phase_lo <= (n) && (n) <= p.phase_hi)
#endif
#define SYNC_BEFORE(n)                                        \
  if (p.phase_lo < (n) && (n) <= p.phase_hi) {                \
    xcd_barrier(xb);                                          \
  }
typedef unsigned short u16;
using bf16x8 = __attribute__((ext_vector_type(8))) short;
using f32x4 = __attribute__((ext_vector_type(4))) float;
using u32x4 = __attribute__((ext_vector_type(4))) unsigned;
using u32x2 = __attribute__((ext_vector_type(2))) unsigned;

constexpr int T_ = 32768, L_ = 8192;
constexpr int LDS_BYTES = 73728;
constexpr int NPHASE = 9;

constexpr size_t MiB = 1u << 20;
constexpr float LOG2E = 1.4426950408889634f;
constexpr float QSCALE = 0.125f * LOG2E;
constexpr int KLD = 1088;
constexpr size_t OFF_H = 0;
constexpr size_t OFF_Q = 68 * MiB;
constexpr size_t OFF_GF = 116 * MiB;
constexpr size_t OFF_U = 164 * MiB;
constexpr size_t OFF_GS = 212 * MiB;
constexpr size_t OFF_YS5A = 260 * MiB;
constexpr size_t OFF_QM = 308 * MiB;
constexpr size_t OFF_GM = 340 * MiB;
constexpr size_t OFF_MERGED = 372 * MiB;
constexpr size_t OFF_WINT = 440 * MiB;
constexpr size_t OFF_WGLT = 453 * MiB;
constexpr size_t OFF_WKVT = 460 * MiB;
constexpr size_t OFF_WOUTT = 463 * MiB;
constexpr size_t OFF_WPFT = 466 * MiB;
constexpr size_t OFF_WPST = 468 * MiB;
constexpr size_t OFF_WPMT = 470 * MiB;
constexpr size_t OFF_WGLUT = 471 * MiB;
constexpr size_t OFF_MEMN = 473 * MiB;
constexpr size_t OFF_MK = 476 * MiB;
constexpr size_t OFF_MVT = 477 * MiB;
constexpr size_t OFF_LOGF = 478 * MiB;
constexpr size_t OFF_F = 480 * MiB;
constexpr size_t OFF_S5AB = 482 * MiB;
constexpr size_t OFF_S5BB = 483 * MiB;
constexpr size_t OFF_S5S = 484 * MiB;
constexpr size_t OFF_PART = 496 * MiB;
constexpr size_t OFF_GATE = OFF_GS;
constexpr size_t OFF_CTL = 498 * MiB;
constexpr size_t WS_END = 499 * MiB;

struct Params {
  const float *x, *mem, *g_norm, *g_mem_norm, *g_final, *w_in, *b_forget, *b_merge, *w_mem_kv;
  const float *lam_re, *lam_im, *log_step, *b_re, *b_im, *c_re, *c_im, *s5_d, *w_glu, *b_glu;
  const float *w_pf, *w_ps, *w_pm, *w_out;
  float* out;
  char* ws;
  int phase_lo, phase_hi;
};

DI unsigned pack2(float a, float b) {
  unsigned r;
  asm volatile("v_cvt_pk_bf16_f32 %0, %1, %2" : "=v"(r) : "v"(a), "v"(b));
  return r;
}
DI u32x4 pack8_mfma(float a0, float a1, float a2, float a3, float a4, float a5, float a6, float a7) {
  u32x4 r;
  asm volatile("v_cvt_pk_bf16_f32 %0, %4, %5\n\tv_cvt_pk_bf16_f32 %1, %6, %7\n\tv_cvt_pk_bf16_f32 %2, %8, %9\n\tv_cvt_pk_bf16_f32 %3, %10, %11\n\ts_nop 1"
               : "=&v"(r[0]), "=&v"(r[1]), "=&v"(r[2]), "=&v"(r[3])
               : "v"(a0), "v"(a1), "v"(a2), "v"(a3), "v"(a4), "v"(a5), "v"(a6), "v"(a7));
  return r;
}
DI u16 f2bf(float x) { return (u16)(pack2(x, x) & 0xffffu); }
DI float bflo(unsigned v) { return __uint_as_float(v << 16); }
DI float bfhi(unsigned v) { return __uint_as_float(v & 0xffff0000u); }
DI float sigmoidf_(float x) { return 1.f / (1.f + __expf(-x)); }
DI float siluf_(float x) { return x / (1.f + __expf(-x)); }
DI float gelu_tanh(float x) {
  float z = 0.7978845608028654f * (x + 0.044715f * x * x * x);
  float e = __expf(2.f * z);
  float th = 1.f - 2.f / (e + 1.f);
  return 0.5f * x * (1.f + th);
}
DI float wave_sum(float v) {
#pragma unroll
  for (int o = 32; o > 0; o >>= 1) v += __shfl_xor(v, o);
  return v;
}
DI f32x4 mfma16(bf16x8 a, bf16x8 b, f32x4 c) { return __builtin_amdgcn_mfma_f32_16x16x32_bf16(a, b, c, 0, 0, 0); }

template <bool SWAP, int DEPTH = 1, bool LEAN = false, bool NEXTPF = false>
DI void gemm_core(f32x4 (&acc)[4][4], const u16* __restrict__ A, int lda, const u16* __restrict__ Bt, int ldb, int K, char* smem,
                  bool preloaded = false, const u16* An = nullptr, int ldan = 0, const u16* Btn = nullptr, int ldbn = 0) {
  const int tid = threadIdx.x, lane = tid & 63, w = tid >> 6, wr = w >> 1, wc = w & 1, l15 = lane & 15, g = lane >> 4;
  const int lrow = tid >> 3, lch = tid & 7;
  const char* ap = (const char*)A;
  const char* bp = (const char*)Bt;
  const unsigned aoff = (unsigned)(lrow * lda + lch * 8) * 2u;
  const unsigned boff = (unsigned)(lrow * ldb + lch * 8) * 2u;
  u32x4 ra0[4], rb0[4], ra1[4], rb1[4];
  const int nk = K >> 6;
#define G_LOAD(RA, RB, KT)                                                        \
  _Pragma("unroll") for (int c = 0; c < 4; ++c) {                                 \
    RA[c] = *(const u32x4*)(ap + ((size_t)c * 64 * lda + (KT) * 128) + aoff);     \
    RB[c] = *(const u32x4*)(bp + ((size_t)c * 64 * ldb + (KT) * 128) + boff);     \
  }
#define G_STORE(RA, RB, BO)                                                       \
  _Pragma("unroll") for (int c = 0; c < 4; ++c) {                                 \
    *(u32x4*)(wbase + (BO) + c * 32 * 128) = RA[c];                               \
    *(u32x4*)(wbase + (BO) + 16384 + c * 32 * 128) = RB[c];                       \
  }
#define G_COMPUTE_FULL(BO)                                                             \
  {                                                                               \
    bf16x8 af[2][4], bfr[2][4];                                                   \
    _Pragma("unroll") for (int i = 0; i < 4; ++i) af[0][i] = *(const bf16x8*)(ard0 + (BO) + i * 16 * 128);  \
    _Pragma("unroll") for (int j = 0; j < 4; ++j) bfr[0][j] = *(const bf16x8*)(brd0 + (BO) + j * 16 * 128); \
    _Pragma("unroll") for (int i = 0; i < 4; ++i) af[1][i] = *(const bf16x8*)(ard1 + (BO) + i * 16 * 128);  \
    _Pragma("unroll") for (int j = 0; j < 4; ++j) bfr[1][j] = *(const bf16x8*)(brd1 + (BO) + j * 16 * 128); \
    __builtin_amdgcn_sched_barrier(0);                                            \
    __builtin_amdgcn_s_setprio(1);                                                \
    _Pragma("unroll") for (int s = 0; s < 2; ++s)                                 \
      _Pragma("unroll") for (int i = 0; i < 4; ++i)                               \
        _Pragma("unroll") for (int j = 0; j < 4; ++j)                             \
          acc[i][j] = SWAP ? mfma16(bfr[s][j], af[s][i], acc[i][j]) : mfma16(af[s][i], bfr[s][j], acc[i][j]); \
    __builtin_amdgcn_s_setprio(0);                                                \
  }
#define G_COMPUTE_LEAN(BO)                                                        \
  _Pragma("unroll") for (int s = 0; s < 2; ++s) {                                 \
    bf16x8 af[4];                                                                 \
    _Pragma("unroll") for (int i = 0; i < 4; ++i) af[i] = *(const bf16x8*)((s ? ard1 : ard0) + (BO) + i * 16 * 128);  \
    _Pragma("unroll") for (int j = 0; j < 4; ++j) {                               \
      const bf16x8 bfr = *(const bf16x8*)((s ? brd1 : brd0) + (BO) + j * 16 * 128);   \
      _Pragma("unroll") for (int i = 0; i < 4; ++i)                               \
        acc[i][j] = SWAP ? mfma16(bfr, af[i], acc[i][j]) : mfma16(af[i], bfr, acc[i][j]); \
    }                                                                             \
  }
#define G_COMPUTE(BO) if constexpr (LEAN) { G_COMPUTE_LEAN(BO) } else { G_COMPUTE_FULL(BO) }
  char* wbase = smem + lrow * 128 + ((lch ^ ((lrow >> 1) & 7)) << 4);
  const int hsw = l15 >> 1;
  const char* ard0 = smem + (wr * 64 + l15) * 128 + ((g ^ hsw) << 4);
  const char* ard1 = smem + (wr * 64 + l15) * 128 + (((4 + g) ^ hsw) << 4);
  const char* brd0 = smem + 16384 + (wc * 64 + l15) * 128 + ((g ^ hsw) << 4);
  const char* brd1 = smem + 16384 + (wc * 64 + l15) * 128 + (((4 + g) ^ hsw) << 4);
  if constexpr (DEPTH == 2) {
    G_LOAD(ra0, rb0, 0);
    G_LOAD(ra1, rb1, 1);
    G_STORE(ra0, rb0, 0);
    __syncthreads();
    for (int kt = 0; kt < nk; kt += 2) {
      if (kt + 2 < nk) G_LOAD(ra0, rb0, kt + 2);
      __builtin_amdgcn_sched_barrier(0);
      G_COMPUTE(0);
      __builtin_amdgcn_sched_barrier(0);
      G_STORE(ra1, rb1, 32768);
      __syncthreads();
      if (kt + 3 < nk) G_LOAD(ra1, rb1, kt + 3);
      __builtin_amdgcn_sched_barrier(0);
      G_COMPUTE(32768);
      __builtin_amdgcn_sched_barrier(0);
      if (kt + 2 < nk) G_STORE(ra0, rb0, 0);
      __syncthreads();
    }
  } else {
    const int grow = w * 8 + (lane >> 3);
    const int glc = (lane & 7) ^ ((w * 4 + (lane >> 4)) & 7);
    const unsigned gaoff = (unsigned)(grow * lda + glc * 8) * 2u;
    const unsigned gboff = (unsigned)(grow * ldb + glc * 8) * 2u;
    char* gl = smem + w * 1024 + lane * 16;
#define G_GLDS(KT, BO)                                                            \
  _Pragma("unroll") for (int c = 0; c < 4; ++c) {                                 \
    __builtin_amdgcn_global_load_lds((const unsigned*)(ap + ((size_t)c * 64 * lda + (size_t)(KT) * 128) + gaoff),          \
                                     (unsigned*)(gl + (BO) + c * 4096), 16, 0, 0);                                          \
    __builtin_amdgcn_global_load_lds((const unsigned*)(bp + ((size_t)c * 64 * ldb + (size_t)(KT) * 128) + gboff),          \
                                     (unsigned*)(gl + (BO) + 16384 + c * 4096), 16, 0, 0);                                  \
  }
    if (!(NEXTPF && preloaded)) {
      G_GLDS(0, 0)
      __syncthreads();
    }
    for (int kt = 0; kt < nk; kt += 2) {
      G_GLDS(kt + 1, 32768)
      __builtin_amdgcn_sched_barrier(0);
      G_COMPUTE(0);
      __syncthreads();
      if constexpr (!NEXTPF) {
        const int k2 = (kt + 2 < nk) ? kt + 2 : nk - 1;
        G_GLDS(k2, 0)
      } else if (kt + 2 < nk) {
        G_GLDS(kt + 2, 0)
      } else if (An) {
        const char* apn = (const char*)An;
        const char* bpn = (const char*)Btn;
        const unsigned gan = (unsigned)(grow * ldan + glc * 8) * 2u;
        const unsigned gbn = (unsigned)(grow * ldbn + glc * 8) * 2u;
#pragma unroll
        for (int c = 0; c < 4; ++c) {
          __builtin_amdgcn_global_load_lds((const unsigned*)(apn + ((size_t)c * 64 * ldan) + gan), (unsigned*)(gl + c * 4096), 16, 0, 0);
          __builtin_amdgcn_global_load_lds((const unsigned*)(bpn + ((size_t)c * 64 * ldbn) + gbn), (unsigned*)(gl + 16384 + c * 4096), 16, 0, 0);
        }
      }
      __builtin_amdgcn_sched_barrier(0);
      G_COMPUTE(32768);
      __syncthreads();
    }
#undef G_GLDS
  }
#undef G_LOAD
#undef G_STORE
#undef G_COMPUTE
#undef G_COMPUTE_FULL
#undef G_COMPUTE_LEAN
}

DI void zero_acc(f32x4 (&acc)[4][4]) {
#pragma unroll
  for (int i = 0; i < 4; ++i)
#pragma unroll
    for (int j = 0; j < 4; ++j) acc[i][j] = f32x4{0.f, 0.f, 0.f, 0.f};
}

DI void swz(int v, int NT, int GN, int& mt, int& nt) {
#if XCD_MODE == 0
  int xcd = v & 7, j = v >> 3;
#else
  int xcd = (v & 511) >> 6, j = ((v >> 9) << 6) + (v & 63);
#endif
  int per_mg = 8 * NT;
  int mg = j / per_mg, r = j - mg * per_mg;
  int ng = r / (8 * GN), wv = r - ng * (8 * GN);
  mt = xcd * 32 + mg * 8 + (wv & 7);
  nt = ng * GN + (wv >> 3);
}

DI void epi_rowmajor(const f32x4 (&acc)[4][4], u16* dst, int ld, int m0, int c0, int mode, char* smem) {
  const int tid = threadIdx.x, lane = tid & 63, w = tid >> 6, wr = w >> 1, wc = w & 1, l15 = lane & 15, g = lane >> 4;
#pragma unroll
  for (int i = 0; i < 4; ++i) {
    const int row = wr * 64 + i * 16 + l15;
#pragma unroll
    for (int j = 0; j < 4; ++j) {
      f32x4 v = acc[i][j];
      if (mode == 1) { v[0] *= QSCALE; v[1] *= QSCALE; v[2] *= QSCALE; v[3] *= QSCALE; }
      else if (mode == 2) { v[0] = siluf_(v[0]); v[1] = siluf_(v[1]); v[2] = siluf_(v[2]); v[3] = siluf_(v[3]); }
      u32x2 o = {pack2(v[0], v[1]), pack2(v[2], v[3])};
      *(u32x2*)(smem + row * 272 + (wc * 64 + j * 16 + g * 4) * 2) = o;
    }
  }
  __syncthreads();
#pragma unroll
  for (int c = 0; c < 8; ++c) {
    const int id = c * 256 + tid, row = id >> 4, ch = id & 15;
    const u32x4 v = *(const u32x4*)(smem + row * 272 + ch * 16);
    *(u32x4*)(dst + (size_t)(m0 + row) * ld + c0 + ch * 8) = v;
  }
  __syncthreads();
}
DI void epi_rowmajor_direct(const f32x4 (&acc)[4][4], u16* dst, int ld, int m0, int c0, int mode) {
  const int tid = threadIdx.x, lane = tid & 63, w = tid >> 6, wr = w >> 1, wc = w & 1, l15 = lane & 15, g = lane >> 4;
#pragma unroll
  for (int i = 0; i < 4; ++i) {
    const size_t row = (size_t)(m0 + wr * 64 + i * 16 + l15);
#pragma unroll
    for (int j = 0; j < 4; ++j) {
      f32x4 v = acc[i][j];
      if (mode == 1) { v[0] *= QSCALE; v[1] *= QSCALE; v[2] *= QSCALE; v[3] *= QSCALE; }
      else if (mode == 2) { v[0] = siluf_(v[0]); v[1] = siluf_(v[1]); v[2] = siluf_(v[2]); v[3] = siluf_(v[3]); }
      u32x2 o = {pack2(v[0], v[1]), pack2(v[2], v[3])};
      *(u32x2*)(dst + row * ld + c0 + wc * 64 + j * 16 + g * 4) = o;
    }
  }
}
DI void epi_transposed(const f32x4 (&acc)[4][4], u16* dst, int m0, int c0, int H, int lgDh, int lgLk) {
  const int tid = threadIdx.x, lane = tid & 63, w = tid >> 6, wr = w >> 1, wc = w & 1, l15 = lane & 15, g = lane >> 4;
#pragma unroll
  for (int i = 0; i < 4; ++i) {
    const int token = m0 + wr * 64 + i * 16 + g * 4;
    const int bidx = token >> lgLk, tl = token & ((1 << lgLk) - 1);
#pragma unroll
    for (int j = 0; j < 4; ++j) {
      const int col = c0 + wc * 64 + j * 16 + l15;
      const int head = col >> lgDh, d = col & ((1 << lgDh) - 1);
      f32x4 v = acc[i][j];
      u32x2 o = {pack2(v[0], v[1]), pack2(v[2], v[3])};
      *(u32x2*)(dst + ((((((size_t)bidx * H + head) << lgDh) + d) << lgLk) + tl)) = o;
    }
  }
}

template <int D, bool FOX, bool PF, int NQ>
DI void attn_item(const u16* __restrict__ qbase, int ldq, const u16* __restrict__ kbase, int ldk,
                  const u16* __restrict__ vtbase, int ldv, const float* __restrict__ Fseq, int q0, int nkv,
                  const u16* __restrict__ gate, u16* outp, float scale, float kmaxv, char* smem) {
  const int tid = threadIdx.x, lane = tid & 63, w = tid >> 6, l15 = lane & 15, g = lane >> 4;
  constexpr int KROW = D * 2 + 16;
  constexpr int KBYTES = 64 * KROW;
  constexpr int VBYTES = D * 144;
  constexpr int BUF = KBYTES + VBYTES + 256;
  constexpr int NL = D / 32;
  constexpr int KCH = D / 8;
  static_assert(2 * BUF <= LDS_BYTES, "attn lds");

  bf16x8 qf[NQ][D / 32];
#pragma unroll
  for (int qi = 0; qi < NQ; ++qi)
#pragma unroll
    for (int s = 0; s < D / 32; ++s)
      qf[qi][s] = *(const bf16x8*)(qbase + (size_t)(w * (16 * NQ) + qi * 16 + l15) * ldq + s * 32 + g * 8);
  float fq[NQ];
#pragma unroll
  for (int qi = 0; qi < NQ; ++qi) fq[qi] = FOX ? Fseq[q0 + w * (16 * NQ) + qi * 16 + l15] : 0.f;
  f32x4 ot[D / 16][NQ];
#pragma unroll
  for (int dt = 0; dt < D / 16; ++dt)
#pragma unroll
    for (int qi = 0; qi < NQ; ++qi) ot[dt][qi] = f32x4{0, 0, 0, 0};
  float mrun[NQ], lsum[NQ];
#pragma unroll
  for (int qi = 0; qi < NQ; ++qi) { mrun[qi] = -1e30f; lsum[qi] = 0.f; }
  float qk[NQ];
#pragma unroll
  for (int qi = 0; qi < NQ; ++qi) {
    float ss = 0.f;
    if (FOX) {
#pragma unroll
      for (int s = 0; s < D / 32; ++s)
#pragma unroll
        for (int e = 0; e < 8; ++e) {
          const float v = __uint_as_float(((unsigned)(unsigned short)qf[qi][s][e]) << 16);
          ss += v * v;
        }
      ss += __shfl_xor(ss, 16);
      ss += __shfl_xor(ss, 32);
    }
    qk[qi] = sqrtf(ss) * kmaxv * 1.002f + 1e-3f;
  }
  int* flags = (int*)(smem + 73664);

  u32x4 kr[NL], vr[NL];
  f32x4 fr = {0, 0, 0, 0};
#define krow(c) (((c) * 256 + tid) / KCH)
#define kch(c) (((c) * 256 + tid) % KCH)
#define vrow(c) (((c) * 256 + tid) >> 3)
#define vch(c) (tid & 7)
#define ATT_LOAD(J)                                                                                   \
  {                                                                                                   \
    const int s0_ = (J) * 64;                                                                         \
    _Pragma("unroll") for (int c = 0; c < NL; ++c) {                                                  \
      kr[c] = *(const u32x4*)(kbase + (size_t)(s0_ + krow(c)) * ldk + kch(c) * 8);                    \
      vr[c] = *(const u32x4*)(vtbase + (size_t)vrow(c) * ldv + s0_ + vch(c) * 8);                     \
    }                                                                                                 \
    if (FOX && tid < 16) fr = *(const f32x4*)(Fseq + s0_ + tid * 4);                                  \
  }
#define ATT_STORE(BO)                                                                                 \
  {                                                                                                   \
    char* b_ = smem + (BO);                                                                           \
    _Pragma("unroll") for (int c = 0; c < NL; ++c) {                                                  \
      *(u32x4*)(b_ + krow(c) * KROW + kch(c) * 16) = kr[c];                                           \
      *(u32x4*)(b_ + KBYTES + vrow(c) * 144 + vch(c) * 16) = vr[c];                                   \
    }                                                                                                 \
    if (FOX && tid < 16) *(f32x4*)(b_ + KBYTES + VBYTES + tid * 16) = fr;                             \
  }
  ATT_LOAD(nkv - 1);
  ATT_STORE(0);
  __syncthreads();
  const int qlo = q0 + w * (16 * NQ);
  for (int j = nkv - 1, itn = 0; j >= 0; --j, ++itn) {
    const int cur = (itn & 1) * BUF;
    if (j > 0) {
      ATT_LOAD(j - 1);
      if (!PF) ATT_STORE(cur ^ BUF);
    }
    __builtin_amdgcn_sched_barrier(0);
    bool ok = false;
    const int s0 = j * 64;
    const bool active = !FOX || (s0 <= qlo + 16 * NQ - 1);
    if (active) {
      const char* Ks = smem + cur;
      const char* Vs = smem + cur + KBYTES;
      const char* Fs = smem + cur + KBYTES + VBYTES;
      f32x4 st[4][NQ];
#pragma unroll
      for (int kt = 0; kt < 4; ++kt)
#pragma unroll
        for (int qi = 0; qi < NQ; ++qi) st[kt][qi] = f32x4{0, 0, 0, 0};
#pragma unroll
      for (int s = 0; s < D / 32; ++s) {
        bf16x8 kf[4];
#pragma unroll
        for (int kt = 0; kt < 4; ++kt) kf[kt] = *(const bf16x8*)(Ks + (kt * 16 + l15) * KROW + s * 64 + g * 16);
#pragma unroll
        for (int kt = 0; kt < 4; ++kt)
#pragma unroll
          for (int qi = 0; qi < NQ; ++qi) st[kt][qi] = mfma16(kf[kt], qf[qi][s], st[kt][qi]);
      }
      if (FOX) {
        const bool need_mask = (s0 + 63 > qlo);
#pragma unroll
        for (int kt = 0; kt < 4; ++kt) {
          f32x4 fk = *(const f32x4*)(Fs + (kt * 16 + g * 4) * 4);
#pragma unroll
          for (int qi = 0; qi < NQ; ++qi) {
            const int qpos = qlo + qi * 16 + l15;
#pragma unroll
            for (int r = 0; r < 4; ++r) {
              float v = st[kt][qi][r] - fk[r];
              if (need_mask && (s0 + kt * 16 + g * 4 + r > qpos)) v = -1e30f;
              st[kt][qi][r] = v;
            }
          }
        }
      } else {
#pragma unroll
        for (int kt = 0; kt < 4; ++kt)
#pragma unroll
          for (int qi = 0; qi < NQ; ++qi)
#pragma unroll
            for (int r = 0; r < 4; ++r) st[kt][qi][r] *= scale;
      }
      float mxl[NQ];
      bool upd = false;
#pragma unroll
      for (int qi = 0; qi < NQ; ++qi) {
        float mx = st[0][qi][0];
#pragma unroll
        for (int kt = 0; kt < 4; ++kt)
#pragma unroll
          for (int r = 0; r < 4; ++r) mx = fmaxf(mx, st[kt][qi][r]);
        mxl[qi] = mx;
        upd = upd || (mx > mrun[qi]);
      }
      const bool resc = __any(upd);
      if (resc) {
#pragma unroll
        for (int qi = 0; qi < NQ; ++qi) {
          float mx = mxl[qi];
          mx = fmaxf(mx, __shfl_xor(mx, 16));
          mx = fmaxf(mx, __shfl_xor(mx, 32));
          const float mnew = fmaxf(mrun[qi], mx);
          const float al = __builtin_amdgcn_exp2f(mrun[qi] - mnew);
          mrun[qi] = mnew;
          lsum[qi] *= al;
#pragma unroll
          for (int dt = 0; dt < D / 16; ++dt)
#pragma unroll
            for (int r = 0; r < 4; ++r) ot[dt][qi][r] *= al;
        }
      }
#pragma unroll
      for (int qi = 0; qi < NQ; ++qi) {
        const float mref = mrun[qi];
        float ps = 0.f;
#pragma unroll
        for (int kt = 0; kt < 4; ++kt)
#pragma unroll
          for (int r = 0; r < 4; ++r) {
            float p = __builtin_amdgcn_exp2f(st[kt][qi][r] - mref);
            st[kt][qi][r] = p;
            ps += p;
          }
        lsum[qi] += ps;
      }
      bf16x8 pb[2][NQ];
#pragma unroll
      for (int kp = 0; kp < 2; ++kp)
#pragma unroll
        for (int qi = 0; qi < NQ; ++qi) {
          u32x4 t = pack8_mfma(st[2 * kp][qi][0], st[2 * kp][qi][1], st[2 * kp][qi][2], st[2 * kp][qi][3],
                               st[2 * kp + 1][qi][0], st[2 * kp + 1][qi][1], st[2 * kp + 1][qi][2], st[2 * kp + 1][qi][3]);
          pb[kp][qi] = __builtin_bit_cast(bf16x8, t);
        }
#pragma unroll
      for (int dt = 0; dt < D / 16; ++dt) {
#pragma unroll
        for (int kp = 0; kp < 2; ++kp) {
          u32x2 lo = *(const u32x2*)(Vs + (dt * 16 + l15) * 144 + (kp * 32 + g * 4) * 2);
          u32x2 hi = *(const u32x2*)(Vs + (dt * 16 + l15) * 144 + (kp * 32 + 16 + g * 4) * 2);
          u32x4 t = {lo[0], lo[1], hi[0], hi[1]};
          bf16x8 vf = __builtin_bit_cast(bf16x8, t);
#pragma unroll
          for (int qi = 0; qi < NQ; ++qi) ot[dt][qi] = mfma16(vf, pb[kp][qi], ot[dt][qi]);
        }
      }
      if (FOX) {
        const float f0 = *(const float*)Fs;
        ok = true;
#pragma unroll
        for (int qi = 0; qi < NQ; ++qi) ok = ok && (qk[qi] - f0 - mrun[qi] <= -30.f * LOG2E);
      }
    }
    __builtin_amdgcn_sched_barrier(0);
    if (PF && j > 0) ATT_STORE(cur ^ BUF);
    if (FOX) {
      const bool wave_ok = (__ballot(ok) == ~0ull);
      if (lane == 0) flags[(itn & 1) * 4 + w] = wave_ok ? 1 : 0;
      __syncthreads();
      const int* fl = flags + (itn & 1) * 4;
      if (fl[0] & fl[1] & fl[2] & fl[3]) break;
    } else {
      __syncthreads();
    }
  }
#undef ATT_LOAD
#undef ATT_STORE
#undef krow
#undef kch
#undef vrow
#undef vch
#pragma unroll
  for (int qi = 0; qi < NQ; ++qi) {
    float l = lsum[qi];
    l += __shfl_xor(l, 16);
    l += __shfl_xor(l, 32);
    const float inv = 1.f / l;
    const size_t rowoff = (size_t)(w * (16 * NQ) + qi * 16 + l15) * ldq;
#pragma unroll
    for (int dt = 0; dt < D / 16; ++dt) {
      const int col = dt * 16 + g * 4;
      u32x2 gv = *(const u32x2*)(gate + rowoff + col);
      u32x2 o = {pack2(ot[dt][qi][0] * inv * bflo(gv[0]), ot[dt][qi][1] * inv * bfhi(gv[0])),
                 pack2(ot[dt][qi][2] * inv * bflo(gv[1]), ot[dt][qi][3] * inv * bfhi(gv[1]))};
      *(u32x2*)(outp + rowoff + col) = o;
    }
  }
}

typedef float v2f __attribute__((ext_vector_type(2)));
DI void s5_load_u(const u16* ubuf, int b, int c, int g, char* ut, int lane) {
  const u16* src = ubuf + ((size_t)(b * L_ + c * 64 + lane)) * 768 + g * 16;
  u32x4 a = *(const u32x4*)src, bb = *(const u32x4*)(src + 8);
  f32x4 o0 = {bflo(a[0]), bfhi(a[0]), bflo(a[1]), bfhi(a[1])};
  f32x4 o1 = {bflo(a[2]), bfhi(a[2]), bflo(a[3]), bfhi(a[3])};
  f32x4 o2 = {bflo(bb[0]), bfhi(bb[0]), bflo(bb[1]), bfhi(bb[1])};
  f32x4 o3 = {bflo(bb[2]), bfhi(bb[2]), bflo(bb[3]), bfhi(bb[3])};
  *(f32x4*)(ut + lane * 64) = o0;
  *(f32x4*)(ut + lane * 64 + 16) = o1;
  *(f32x4*)(ut + lane * 64 + 32) = o2;
  *(f32x4*)(ut + lane * 64 + 48) = o3;
}
DI void s5_load_b(const float* bbar, int gp, v2f (&b2)[16]) {
#pragma unroll
  for (int q = 0; q < 4; ++q) {
    float4 t0 = *(const float4*)(bbar + (size_t)gp * 32 + q * 4);
    float4 t1 = *(const float4*)(bbar + (size_t)gp * 32 + 16 + q * 4);
    b2[4 * q] = v2f{t0.x, t1.x}; b2[4 * q + 1] = v2f{t0.y, t1.y};
    b2[4 * q + 2] = v2f{t0.z, t1.z}; b2[4 * q + 3] = v2f{t0.w, t1.w};
  }
}
DI v2f s5_x(const char* ut, int t, const v2f (&b2)[16]) {
  v2f xa = {0.f, 0.f}, xb = {0.f, 0.f};
#pragma unroll
  for (int q = 0; q < 4; ++q) {
    const f32x4 u = *(const f32x4*)(ut + t * 64 + q * 16);
    xa += b2[4 * q] * u[0];
    xb += b2[4 * q + 1] * u[1];
    xa += b2[4 * q + 2] * u[2];
    xb += b2[4 * q + 3] * u[3];
  }
  return xa + xb;
}

DI void s5_load_bfrag(const float* bbar, int g, int l15, int g4, bf16x8 (&ah)[8], bf16x8 (&al)[8]) {
#pragma unroll
  for (int kt = 0; kt < 8; ++kt) {
    u32x4 h = {0u, 0u, 0u, 0u}, l = {0u, 0u, 0u, 0u};
    if (g4 < 2) {
      const float* src = bbar + (size_t)(g * 64 + (kt & 3) * 16 + l15) * 32 + (kt >> 2) * 16 + g4 * 8;
      const float4 t0 = *(const float4*)src, t1 = *(const float4*)(src + 4);
      const float v[8] = {t0.x, t0.y, t0.z, t0.w, t1.x, t1.y, t1.z, t1.w};
#pragma unroll
      for (int q = 0; q < 4; ++q) {
        const unsigned h0 = f2bf(v[2 * q]), h1 = f2bf(v[2 * q + 1]);
        h[q] = h0 | (h1 << 16);
        l[q] = pack2(v[2 * q] - __uint_as_float(h0 << 16), v[2 * q + 1] - __uint_as_float(h1 << 16));
      }
    }
    ah[kt] = __builtin_bit_cast(bf16x8, h);
    al[kt] = __builtin_bit_cast(bf16x8, l);
  }
}
DI void s5_xsub(const u32x4 uraw, const bf16x8 (&ah)[8], const bf16x8 (&al)[8], char* xs, int l15, int g4) {
  const bf16x8 ub = __builtin_bit_cast(bf16x8, uraw);
#pragma unroll
  for (int kt = 0; kt < 8; ++kt) {
    f32x4 x = {0.f, 0.f, 0.f, 0.f};
    x = mfma16(ah[kt], ub, x);
    x = mfma16(al[kt], ub, x);
    *(f32x4*)(xs + l15 * 528 + (kt * 16 + g4 * 4) * 4) = x;
  }
}

#define XB_TMO      128
#define XB_XCNT(j)  (256  + 64 * (j))
#define XB_XSUB(j)  (1280 + 64 * (j))
#define XB_XGEN(j)  (2304 + 64 * (j))
#define XB_TOP      3328
#define XB_TOPGEN   3392
#define XCD_BAR_WORDS 3456
#define XB_SPIN_CAP (1u << 18)
DI unsigned xb_ld(unsigned* p) { return __hip_atomic_load(p, __ATOMIC_RELAXED, __HIP_MEMORY_SCOPE_AGENT); }
DI unsigned xb_add(unsigned* p, unsigned v) { return __hip_atomic_fetch_add(p, v, __ATOMIC_RELAXED, __HIP_MEMORY_SCOPE_AGENT); }
DI unsigned xb_xcc_id() { return (unsigned)__builtin_amdgcn_s_getreg((3 << 11) | 20) & 0xFu; }
#define XB_SPIN(cond, bar) do { unsigned _sp = 0; while (cond) { __builtin_amdgcn_s_sleep(1); \
    if ((++_sp & 255u) == 0u) { if (xb_ld(&(bar)[XB_TMO])) break; if (_sp > XB_SPIN_CAP) { atomicAdd(&(bar)[XB_TMO], 1u); break; } } } } while (0)
struct XcdBarrier { unsigned* bar; unsigned x; volatile unsigned* st; };
DI XcdBarrier xcd_barrier_post(unsigned* bar, volatile unsigned* st) {
  XcdBarrier b; b.bar = bar; b.x = xb_xcc_id(); b.st = st;
  if (threadIdx.x == 0) (void)xb_add(&bar[XB_XCNT(b.x)], 1u);
  return b;
}
DI void xcd_barrier_complete(unsigned* bar, unsigned x, unsigned& nloc, unsigned& nx) {
  const unsigned G = gridDim.x * gridDim.y * gridDim.z;
  unsigned sum, cnt, mine, sp = 0u;
  for (;;) {
    sum = 0u; cnt = 0u; mine = 0u;
#pragma unroll
    for (unsigned j = 0; j < 16; ++j) { const unsigned c = xb_ld(&bar[XB_XCNT(j)]); sum += c; cnt += (c > 0u) ? 1u : 0u; mine = (j == x) ? c : mine; }
    if (sum == G) break;
    __builtin_amdgcn_s_sleep(1);
    if ((++sp & 255u) == 0u) { if (xb_ld(&bar[XB_TMO])) break; if (sp > XB_SPIN_CAP) { atomicAdd(&bar[XB_TMO], 1u); break; } }
  }
  nloc = mine > 0u ? mine : 1u; nx = cnt > 0u ? cnt : 1u;
}
DI void xcd_barrier(const XcdBarrier& b) {
  asm volatile("s_waitcnt vmcnt(0)" ::: "memory");
  __syncthreads();
  if (threadIdx.x == 0) {
    unsigned* bar = b.bar;
    __builtin_amdgcn_s_waitcnt(0);
    unsigned nloc = b.st[0], nx = b.st[1];
    if (nloc == 0u) { xcd_barrier_complete(bar, b.x, nloc, nx); b.st[0] = nloc; b.st[1] = nx; }
    const unsigned old = xb_add(&bar[XB_XSUB(b.x)], 1u);
    const unsigned gen = old / nloc;
    if (old + 1u == (gen + 1u) * nloc) {
      __builtin_amdgcn_fence(__ATOMIC_RELEASE, "agent");
      asm volatile("s_waitcnt vmcnt(0)" ::: "memory");
      const unsigned og = xb_add(&bar[XB_TOP], 1u);
      const unsigned tg = og / nx;
      if (og + 1u == (tg + 1u) * nx) xb_add(&bar[XB_TOPGEN], 1u);
      else XB_SPIN(xb_ld(&bar[XB_TOPGEN]) == tg, bar);
      __builtin_amdgcn_fence(__ATOMIC_ACQUIRE, "agent");
      xb_add(&bar[XB_XGEN(b.x)], 1u);
      asm volatile("s_waitcnt vmcnt(0)" ::: "memory");
    } else {
      XB_SPIN(xb_ld(&bar[XB_XGEN(b.x)]) == gen, bar);
      __builtin_amdgcn_fence(__ATOMIC_ACQUIRE, "agent");
      asm volatile("s_waitcnt vmcnt(0)" ::: "memory");
    }
  }
  __syncthreads();
}

extern "C" __global__ void __launch_bounds__(256, 2) mega(Params p) {
  extern __shared__ __attribute__((aligned(16))) char smem[];
  cg::grid_group grid = cg::this_grid();
#define TIDVARS                                                                  \
  int tid = threadIdx.x;                                                         \
  asm volatile("" : "+v"(tid));                                                  \
  const int lane = tid & 63, w = tid >> 6, l15 = lane & 15, g4 = lane >> 4;      \
  (void)lane; (void)w; (void)l15; (void)g4;
  const int nblk = gridDim.x, bid = blockIdx.x;
  char* ws = p.ws;
  XcdBarrier xb;
  xb.bar = (unsigned*)(ws + OFF_CTL + 4096); xb.x = 0; xb.st = (volatile unsigned*)(smem + 73712);
  if (p.phase_lo < p.phase_hi) {
    if (threadIdx.x < 2) xb.st[threadIdx.x] = 0u;
    __syncthreads();
    xb = xcd_barrier_post((unsigned*)(ws + OFF_CTL + 4096), (volatile unsigned*)(smem + 73712));
    grid.sync();
  }
  u16* hbuf = (u16*)(ws + OFF_H);
  u16* qbuf = (u16*)(ws + OFF_Q);
  u16* gfbuf = (u16*)(ws + OFF_GF);
  u16* ubuf = (u16*)(ws + OFF_U);
  u16* gsbuf = (u16*)(ws + OFF_GS);
  u16* ys5a = (u16*)(ws + OFF_YS5A);
  u16* qmbuf = (u16*)(ws + OFF_QM);
  u16* gmbuf = (u16*)(ws + OFF_GM);
  u16* merged = (u16*)(ws + OFF_MERGED);
  u16* WinT = (u16*)(ws + OFF_WINT);
  u16* WglT = (u16*)(ws + OFF_WGLT);
  u16* WkvT = (u16*)(ws + OFF_WKVT);
  u16* WoutT = (u16*)(ws + OFF_WOUTT);
  u16* WpfT = (u16*)(ws + OFF_WPFT);
  u16* WpsT = (u16*)(ws + OFF_WPST);
  u16* WpmT = (u16*)(ws + OFF_WPMT);
  u16* WgluT = (u16*)(ws + OFF_WGLUT);
  u16* memn = (u16*)(ws + OFF_MEMN);
  u16* mkbuf = (u16*)(ws + OFF_MK);
  u16* mvT = (u16*)(ws + OFF_MVT);
  float* logf = (float*)(ws + OFF_LOGF);
  float* Fbuf = (float*)(ws + OFF_F);
  float2* abar = (float2*)(ws + OFF_S5AB);
  float* bbar = (float*)(ws + OFF_S5BB);
  float2* Sst = (float2*)(ws + OFF_S5S);
  float* part = (float*)(ws + OFF_PART);
  unsigned* ctl = (unsigned*)(ws + OFF_CTL);
  u16* kbuf = (u16*)p.out;
  u16* vT = (u16*)((char*)p.out + 48 * MiB);

  {
    if (PH(0)) {
      TIDVARS
      if (bid == 0 && tid < 128) ctl[tid] = 0u;
      float* tile = (float*)smem;
      for (int ti = bid; ti < 3344; ti += nblk) {
        const float* src; int ld, col0, K; u16* dst; int tt;
        if (ti < 576) { src = p.w_in; ld = 8716; col0 = 0; K = 1024; dst = WinT; tt = ti; }
        else if (ti < 1408) { src = p.w_in; ld = 8716; col0 = 2316; K = 1024; dst = WinT + (size_t)2304 * KLD; tt = ti - 576; }
        else if (ti < 2176) { src = p.w_in; ld = 8716; col0 = 5644; K = 1024; dst = WglT; tt = ti - 1408; }
        else if (ti < 2432) { src = p.w_mem_kv; ld = 1024; col0 = 0; K = 1024; dst = WkvT; tt = ti - 2176; }
        else if (ti < 2688) { src = p.w_out; ld = 1024; col0 = 0; K = 1024; dst = WoutT; tt = ti - 2432; }
        else if (ti < 2880) { src = p.w_pf; ld = 1024; col0 = 0; K = 768; dst = WpfT; tt = ti - 2688; }
        else if (ti < 3072) { src = p.w_ps; ld = 1024; col0 = 0; K = 768; dst = WpsT; tt = ti - 2880; }
        else if (ti < 3200) { src = p.w_pm; ld = 1024; col0 = 0; K = 512; dst = WpmT; tt = ti - 3072; }
        else { src = p.w_glu; ld = 768; col0 = 0; K = 768; dst = WgluT; tt = ti - 3200; }
        const int nkt = K >> 6;
        const int dld = (K == 1024) ? KLD : K;
        const int k0 = (tt % nkt) * 64, n0 = (tt / nkt) * 64;
#pragma unroll 4
        for (int i = 0; i < 16; ++i) {
          int k = i * 4 + w, n = lane;
          tile[k * 65 + n] = src[(size_t)(k0 + k) * ld + col0 + n0 + n];
        }
        __syncthreads();
#pragma unroll 4
        for (int i = 0; i < 16; ++i) {
          int n = i * 4 + w, k = lane;
          dst[(size_t)(n0 + n) * dld + k0 + k] = f2bf(tile[k * 65 + n]);
        }
        __syncthreads();
      }
      float* wfl = (float*)smem;
      for (int idx = tid; idx < 12288; idx += 256) {
        int k = idx / 12, j = idx - k * 12;
        wfl[j * 1024 + k] = p.w_in[(size_t)k * 8716 + 2304 + j];
      }
      __syncthreads();
      for (int row = bid * 4 + w; row < T_ + 1024; row += nblk * 4) {
        const bool isx = row < T_;
        const float* src = isx ? p.x + (size_t)row * 1024 : p.mem + (size_t)(row - T_) * 1024;
        const float* gsrc = isx ? p.g_norm : p.g_mem_norm;
        u16* dst = isx ? hbuf + (size_t)row * KLD : memn + (size_t)(row - T_) * KLD;
        float4 xv[4], gx[4];
        float v[16];
#pragma unroll
        for (int q = 0; q < 16; ++q) v[q] = 0.f;
#pragma unroll
        for (int i = 0; i < 4; ++i) {
          xv[i] = *(const float4*)(src + i * 256 + lane * 4);
          const float4 gv = *(const float4*)(gsrc + i * 256 + lane * 4);
          gx[i] = make_float4(xv[i].x * gv.x, xv[i].y * gv.y, xv[i].z * gv.z, xv[i].w * gv.w);
          v[12] += xv[i].x * xv[i].x + xv[i].y * xv[i].y + xv[i].z * xv[i].z + xv[i].w * xv[i].w;
        }
        if (isx) {
#pragma unroll
          for (int j = 0; j < 12; ++j) {
#pragma unroll
            for (int i = 0; i < 4; ++i) {
              const float4 wv = *(const float4*)(wfl + j * 1024 + i * 256 + lane * 4);
              v[j] += gx[i].x * wv.x + gx[i].y * wv.y + gx[i].z * wv.z + gx[i].w * wv.w;
            }
          }
        }
        float w8[8], w4[4], w2[2], w1;
        {
          const bool hi = (lane & 32) != 0;
#pragma unroll
          for (int q = 0; q < 8; ++q) {
            const float snd = hi ? v[q] : v[q + 8];
            const float kp = hi ? v[q + 8] : v[q];
            w8[q] = kp + __shfl_xor(snd, 32);
          }
        }
        {
          const bool hi = (lane & 16) != 0;
#pragma unroll
          for (int q = 0; q < 4; ++q) {
            const float snd = hi ? w8[q] : w8[q + 4];
            const float kp = hi ? w8[q + 4] : w8[q];
            w4[q] = kp + __shfl_xor(snd, 16);
          }
        }
        {
          const bool hi = (lane & 8) != 0;
#pragma unroll
          for (int q = 0; q < 2; ++q) {
            const float snd = hi ? w4[q] : w4[q + 2];
            const float kp = hi ? w4[q + 2] : w4[q];
            w2[q] = kp + __shfl_xor(snd, 8);
          }
        }
        {
          const bool hi = (lane & 4) != 0;
          const float snd = hi ? w2[0] : w2[1];
          const float kp = hi ? w2[1] : w2[0];
          w1 = kp + __shfl_xor(snd, 4);
        }
        w1 += __shfl_xor(w1, 2);
        w1 += __shfl_xor(w1, 1);
        const int ridx = ((lane >> 5) & 1) * 8 + ((lane >> 4) & 1) * 4 + ((lane >> 3) & 1) * 2 + ((lane >> 2) & 1);
        const float ss = __shfl(w1, 48);
        const float rstd = rsqrtf(ss * (1.f / 1024.f) + 1e-6f);
#pragma unroll
        for (int i = 0; i < 4; ++i) {
          u32x2 o = {pack2(gx[i].x * rstd, gx[i].y * rstd), pack2(gx[i].z * rstd, gx[i].w * rstd)};
          *(u32x2*)(dst + i * 256 + lane * 4) = o;
        }
        if (isx && ridx < 12 && (lane & 3) == 0) {
          float xx = w1 * rstd + p.b_forget[ridx];
          float lf = fminf(xx, 0.f) - log1pf(__expf(-fabsf(xx)));
          const int b = row >> 13, t = row & (L_ - 1);
          logf[(size_t)(b * 12 + ridx) * L_ + t] = lf;
        }
      }
      {
        const int gid = bid * 256 + tid;
        if (gid < 3072) {
          const int g = gid >> 6;
          const float step = expf(p.log_step[g]);
          const float lr = p.lam_re[gid], li = p.lam_im[gid];
          const float mag = expf(lr * step);
          const float ar = mag * cosf(li * step), ai = mag * sinf(li * step);
          const float den = lr * lr + li * li;
          const float nr = ar - 1.f, ni = ai;
          const float fr = (nr * lr + ni * li) / den, fi = (ni * lr - nr * li) / den;
          abar[gid] = make_float2(ar, ai);
#pragma unroll
          for (int h = 0; h < 16; ++h) {
            const float br = p.b_re[(size_t)gid * 16 + h], bi = p.b_im[(size_t)gid * 16 + h];
            bbar[(size_t)gid * 32 + h] = fr * br - fi * bi;
            bbar[(size_t)gid * 32 + 16 + h] = fr * bi + fi * br;
          }
        }
      }
      __syncthreads();
    }
    SYNC_BEFORE(1);
    if (PH(1)) {
      TIDVARS
      float* sm = (float*)smem;
      for (int seq = bid; seq < 48; seq += nblk) {
        const float* src = logf + (size_t)seq * L_ + tid * 32;
        float* dst = Fbuf + (size_t)seq * L_ + tid * 32;
        float v[32];
#pragma unroll
        for (int i = 0; i < 8; ++i) {
          float4 t = *(const float4*)(src + i * 4);
          v[4 * i] = t.x; v[4 * i + 1] = t.y; v[4 * i + 2] = t.z; v[4 * i + 3] = t.w;
        }
        float run = 0.f;
#pragma unroll
        for (int i = 0; i < 32; ++i) { run += v[i]; v[i] = run; }
        float incl = run;
#pragma unroll
        for (int o = 1; o < 64; o <<= 1) {
          float t = __shfl_up(incl, o);
          if (lane >= o) incl += t;
        }
        if (lane == 63) sm[w] = incl;
        __syncthreads();
        float base = incl - run;
        for (int w2 = 0; w2 < w; ++w2) base += sm[w2];
#pragma unroll
        for (int i = 0; i < 8; ++i) {
          float4 t = make_float4((v[4 * i] + base) * LOG2E, (v[4 * i + 1] + base) * LOG2E, (v[4 * i + 2] + base) * LOG2E, (v[4 * i + 3] + base) * LOG2E);
          *(float4*)(dst + i * 4) = t;
        }
        __syncthreads();
      }
#define P1_V(PN, VOUT)                                                     \
      {                                                                    \
        VOUT = -1;                                                         \
        if (nblk == 512) {                                                 \
          const int i_ = bid >> 3, x_ = bid & 7;                           \
          int j_ = -1;                                                     \
          if ((PN) < 20) j_ = 64 * (PN) + i_;                              \
          else if (i_ < 32 && (PN) < 24) j_ = 1280 + 32 * ((PN) - 20) + i_; \
          else if (i_ < 8 && (PN) == 24) j_ = 1408 + i_;                   \
          if (j_ >= 0) VOUT = j_ * 8 + x_;                                 \
        } else {                                                           \
          const int v_ = bid + (PN) * nblk;                                \
          if (v_ < 11264 + 64) VOUT = v_;                                  \
        }                                                                  \
      }
#define P1_OPS(V, AO, BO_, M0O, N0O, KVO)                                  \
      {                                                                    \
        KVO = (V) >= 11264;                                                \
        if (!KVO) {                                                        \
          int mt_, nt_;                                                    \
          swz((V), 44, 4, mt_, nt_);                                       \
          M0O = mt_ * 128; N0O = nt_ * 128;                                \
          AO = hbuf + (size_t)M0O * KLD; BO_ = WinT + (size_t)N0O * KLD;   \
        } else {                                                           \
          const int kv_ = (V) - 11264;                                     \
          M0O = (kv_ >> 3) * 128; N0O = (kv_ & 7) * 128;                   \
          AO = memn + (size_t)M0O * KLD; BO_ = WkvT + (size_t)N0O * KLD;   \
        }                                                                  \
      }
      for (int pn = 0;; ++pn) {
        int v;
        P1_V(pn, v)
        if (v < 0) break;
        const u16 *A, *Bt;
        int m0, n0;
        bool kvtile;
        P1_OPS(v, A, Bt, m0, n0, kvtile)
        const u16 *An = nullptr, *Btn = nullptr;
        {
          int vn;
          P1_V(pn + 1, vn)
          if (vn >= 0) { int m0n_, n0n_; bool kvn_; P1_OPS(vn, An, Btn, m0n_, n0n_, kvn_) (void)m0n_; (void)n0n_; (void)kvn_; }
        }
        const bool transp = kvtile ? (n0 >= 512) : (n0 >= 1536 && n0 < 2304);
        f32x4 acc[4][4];
        zero_acc(acc);
        if (transp) {
          gemm_core<false, 1, false, true>(acc, A, KLD, Bt, KLD, 1024, smem, pn > 0, An, KLD, Btn, KLD);
          if (kvtile) epi_transposed(acc, mvT, m0, n0 - 512, 4, 7, 8);
          else epi_transposed(acc, vT, m0, n0 - 1536, 12, 6, 13);
        } else {
          gemm_core<true, 1, false, true>(acc, A, KLD, Bt, KLD, 1024, smem, pn > 0, An, KLD, Btn, KLD);
          u16* dst; int ld, c0, mode;
          if (kvtile) { dst = mkbuf; ld = 512; c0 = n0; mode = 0; }
          else if (n0 < 768) { dst = qbuf; ld = 768; c0 = n0; mode = 1; }
          else if (n0 < 1536) { dst = kbuf; ld = 768; c0 = n0 - 768; mode = 0; }
          else if (n0 < 3072) { dst = gfbuf; ld = 768; c0 = n0 - 2304; mode = 2; }
          else if (n0 < 3840) { dst = ubuf; ld = 768; c0 = n0 - 3072; mode = 0; }
          else if (n0 < 4608) { dst = gsbuf; ld = 768; c0 = n0 - 3840; mode = 2; }
          else if (n0 < 5120) { dst = qmbuf; ld = 512; c0 = n0 - 4608; mode = 0; }
          else { dst = gmbuf; ld = 512; c0 = n0 - 5120; mode = 2; }
          epi_rowmajor(acc, dst, ld, m0, c0, mode, smem + 32768);
          if (!kvtile && n0 >= 768 && n0 < 1536) {
            float mxv = 0.f;
#pragma unroll
            for (int i = 0; i < 4; ++i) {
              float ss = 0.f;
#pragma unroll
              for (int j = 0; j < 4; ++j)
#pragma unroll
                for (int r = 0; r < 4; ++r) {
                  const float v = __uint_as_float(((unsigned)f2bf(acc[i][j][r])) << 16);
                  ss += v * v;
                }
              ss += __shfl_xor(ss, 16);
              ss += __shfl_xor(ss, 32);
              mxv = fmaxf(mxv, ss);
            }
#pragma unroll
            for (int o = 1; o < 16; o <<= 1) mxv = fmaxf(mxv, __shfl_xor(mxv, o));
            if (lane == 0) atomicMax(&ctl[(m0 >> 13) * 12 + ((n0 - 768) >> 6) + (w & 1)], __float_as_uint(mxv));
          }
        }
      }
    }
    SYNC_BEFORE(2);
    if (PH(2)) {
      TIDVARS
      int* qslot = (int*)(smem + 73696);
#define NEXT_ITEM(CTR)                                        \
      {                                                       \
        if (tid == 0) *qslot = (int)atomicAdd(&ctl[CTR], 1u); \
        __syncthreads();                                      \
        it = *qslot;                                          \
        __syncthreads();                                      \
      }
      int it;
      for (;;) {
        NEXT_ITEM(64);
        if (it >= 3072) break;
        {
#ifndef NO_FOX
          const int qt = 63 - it / 48, bh = it % 48, b = bh / 12, h = bh % 12;
          const int q0 = qt * 128;
          const size_t qoff = ((size_t)(b * L_ + q0)) * 768 + h * 64;
          attn_item<64, true, true, 2>(qbuf + qoff, 768, kbuf + (size_t)b * L_ * 768 + h * 64, 768,
                              vT + (size_t)(b * 12 + h) * 64 * L_, L_, Fbuf + (size_t)(b * 12 + h) * L_, q0, 2 * qt + 2,
                              gfbuf + qoff, qbuf + qoff, 1.f, sqrtf(__uint_as_float(ctl[b * 12 + h])), smem);
#endif
        }
      }
      for (;;) {
        NEXT_ITEM(65);
        if (it >= 2048) break;
        {
#ifndef NO_MEM
          const int im = it;
          const int hm = im & 3, qt = (im >> 2) & 127, b = im >> 9;
          const int q0 = qt * 64;
          const size_t qoff = ((size_t)(b * L_ + q0)) * 512 + hm * 128;
          attn_item<128, false, false, 1>(qmbuf + qoff, 512, mkbuf + (size_t)b * 256 * 512 + hm * 128, 512,
                                mvT + (size_t)(b * 4 + hm) * 128 * 256, 256, nullptr, q0, 4,
                                gmbuf + qoff, qmbuf + qoff, 0.08838834764831845f * LOG2E, 0.f, smem);
#endif
        }
      }
      for (;;) {
        NEXT_ITEM(66);
        if (it >= 1536) break;
        {
#ifndef NO_S5P1
          const int wi = it * 4 + w;
          const int g = wi % 48, cg = (wi / 48) & 31, b = wi / (48 * 32);
          char* xs = smem + w * 12800;
          const int gp = g * 64 + lane;
          bf16x8 ah[8], al[8];
          s5_load_bfrag(bbar, g, l15, g4, ah, al);
          const float2 ab = abar[gp];
#pragma unroll 1
          for (int ci = 0; ci < 4; ++ci) {
          const int c = cg * 4 + ci;
          const u16* ub0 = ubuf + ((size_t)(b * L_ + c * 64 + l15)) * 768 + g * 16;
          u32x4 uq[4];
#pragma unroll
          for (int sub = 0; sub < 4; ++sub) {
            uq[sub] = u32x4{0u, 0u, 0u, 0u};
            if (g4 < 2) uq[sub] = *(const u32x4*)(ub0 + (size_t)sub * 16 * 768 + g4 * 8);
          }
          float hr = 0.f, hi = 0.f;
#pragma unroll
          for (int sub = 0; sub < 4; ++sub) {
            s5_xsub(uq[sub], ah, al, xs, l15, g4);
            asm volatile("s_waitcnt lgkmcnt(0)" ::: "memory");
#pragma unroll
            for (int tt = 0; tt < 16; ++tt) {
              const float xr = *(const float*)(xs + tt * 528 + lane * 4);
              const float xi = *(const float*)(xs + tt * 528 + 256 + lane * 4);
              const float nhr = ab.x * hr - ab.y * hi + xr;
              const float nhi = ab.x * hi + ab.y * hr + xi;
              hr = nhr; hi = nhi;
            }
            asm volatile("s_waitcnt lgkmcnt(0)" ::: "memory");
          }
          Sst[((size_t)(b * 128 + c) * 48 + g) * 64 + lane] = make_float2(hr, hi);
          }
          __syncthreads();
#endif
        }
      }
    }
    SYNC_BEFORE(3);
    if (PH(3)) {
      TIDVARS
      for (int wi = bid * 4 + w; wi < 192; wi += nblk * 4) {
        const int g = wi % 48, b = wi / 48;
        const float2 ab = abar[g * 64 + lane];
        float a64r = ab.x, a64i = ab.y;
#pragma unroll
        for (int q = 0; q < 6; ++q) {
          const float nr = a64r * a64r - a64i * a64i, ni = 2.f * a64r * a64i;
          a64r = nr; a64i = ni;
        }
        float2* sp = Sst + ((size_t)(b * 128) * 48 + g) * 64 + lane;
        float hr = 0.f, hi = 0.f;
        for (int cc = 0; cc < 128; cc += 16) {
          float2 sv[16];
#pragma unroll
          for (int q = 0; q < 16; ++q) sv[q] = sp[(size_t)(cc + q) * 48 * 64];
#pragma unroll
          for (int q = 0; q < 16; ++q) {
            sp[(size_t)(cc + q) * 48 * 64] = make_float2(hr, hi);
            const float nhr = a64r * hr - a64i * hi + sv[q].x;
            const float nhi = a64r * hi + a64i * hr + sv[q].y;
            hr = nhr; hi = nhi;
          }
        }
      }
    }
    SYNC_BEFORE(4);
    if (PH(4)) {
      TIDVARS
      for (int it = bid; it < 1536; it += nblk) {
        const int wi = it * 4 + w;
        const int g = wi % 48, cg = (wi / 48) & 31, b = wi / (48 * 32);
        char* xs = smem + w * 12800;
        char* stt = xs + 8448;
        const int gp = g * 64 + lane;
        bf16x8 ah[8], al[8];
        s5_load_bfrag(bbar, g, l15, g4, ah, al);
        const float2 ab = abar[gp];
        bf16x8 cf[4];
#pragma unroll
        for (int s = 0; s < 4; ++s) {
          const float* cs = (s < 2 ? p.c_re : p.c_im) + (size_t)(g * 16 + l15) * 64 + (s & 1) * 32 + g4 * 8;
          float4 t0 = *(const float4*)cs, t1 = *(const float4*)(cs + 4);
          const float sg = (s < 2) ? 1.f : -1.f;
          u32x4 t = pack8_mfma(sg * t0.x, sg * t0.y, sg * t0.z, sg * t0.w, sg * t1.x, sg * t1.y, sg * t1.z, sg * t1.w);
          cf[s] = __builtin_bit_cast(bf16x8, t);
        }
        const float4 dsk = *(const float4*)(p.s5_d + g * 16 + g4 * 4);
#pragma unroll 1
        for (int ci = 0; ci < 4; ++ci) {
        const int c = cg * 4 + ci;
        const u16* ub0 = ubuf + ((size_t)(b * L_ + c * 64 + l15)) * 768 + g * 16;
        const float2 hc = Sst[((size_t)(b * 128 + c) * 48 + g) * 64 + lane];
        float hr = hc.x, hi = hc.y;
        u32x4 uq[4];
        u32x2 uvq[4];
#pragma unroll
        for (int sub = 0; sub < 4; ++sub) {
          uq[sub] = u32x4{0u, 0u, 0u, 0u};
          if (g4 < 2) uq[sub] = *(const u32x4*)(ub0 + (size_t)sub * 16 * 768 + g4 * 8);
          uvq[sub] = *(const u32x2*)(ub0 + (size_t)sub * 16 * 768 + g4 * 4);
        }
        asm volatile("s_waitcnt lgkmcnt(0)" ::: "memory");
#pragma unroll
        for (int sub = 0; sub < 4; ++sub) {
          s5_xsub(uq[sub], ah, al, xs, l15, g4);
          asm volatile("s_waitcnt lgkmcnt(0)" ::: "memory");
#pragma unroll
          for (int tt = 0; tt < 16; ++tt) {
            const float xr = *(const float*)(xs + tt * 528 + lane * 4);
            const float xi = *(const float*)(xs + tt * 528 + 256 + lane * 4);
            const float nhr = ab.x * hr - ab.y * hi + xr;
            const float nhi = ab.x * hi + ab.y * hr + xi;
            hr = nhr; hi = nhi;
            *(u16*)(stt + tt * 272 + lane * 2) = f2bf(hr);
            *(u16*)(stt + tt * 272 + 128 + lane * 2) = f2bf(hi);
          }
          asm volatile("s_waitcnt lgkmcnt(0)" ::: "memory");
          f32x4 y = {0, 0, 0, 0};
#pragma unroll
          for (int s = 0; s < 4; ++s) {
            bf16x8 bfr = *(const bf16x8*)(stt + l15 * 272 + s * 64 + g4 * 16);
            y = mfma16(cf[s], bfr, y);
          }
          const int t = sub * 16 + l15;
          const u32x2 uv = uvq[sub];
          float o0 = gelu_tanh(y[0] + dsk.x * bflo(uv[0]));
          float o1 = gelu_tanh(y[1] + dsk.y * bfhi(uv[0]));
          float o2 = gelu_tanh(y[2] + dsk.z * bflo(uv[1]));
          float o3 = gelu_tanh(y[3] + dsk.w * bfhi(uv[1]));
          u32x2 o = {pack2(o0, o1), pack2(o2, o3)};
          *(u32x2*)(ys5a + ((size_t)(b * L_ + c * 64 + t)) * 768 + g * 16 + g4 * 4) = o;
          asm volatile("s_waitcnt lgkmcnt(0)" ::: "memory");
        }
        }
        __syncthreads();
      }
    }
    SYNC_BEFORE(5);
    if (PH(5)) {
      TIDVARS
      for (int v = bid; v < 256 * 6; v += nblk) {
        int mt, nt;
        swz(v, 6, 6, mt, nt);
        const int m0 = mt * 128, n0 = nt * 128;
        f32x4 acc[4][4];
        zero_acc(acc);
        gemm_core<true>(acc, ys5a + (size_t)m0 * 768, 768, WgluT + (size_t)n0 * 768, 768, 768, smem);
        const int wr = w >> 1, wc = w & 1;
#pragma unroll
        for (int i = 0; i < 4; ++i) {
          const size_t row = (size_t)(m0 + wr * 64 + i * 16 + l15);
#pragma unroll
          for (int j = 0; j < 4; ++j) {
            const int n = n0 + wc * 64 + j * 16 + g4 * 4;
            const float4 bg = *(const float4*)(p.b_glu + n);
            const u32x2 av = *(const u32x2*)(ys5a + row * 768 + n);
            const u32x2 sv = *(const u32x2*)(gsbuf + row * 768 + n);
            float o0 = bflo(av[0]) * sigmoidf_(acc[i][j][0] + bg.x) * bflo(sv[0]);
            float o1 = bfhi(av[0]) * sigmoidf_(acc[i][j][1] + bg.y) * bfhi(sv[0]);
            float o2 = bflo(av[1]) * sigmoidf_(acc[i][j][2] + bg.z) * bflo(sv[1]);
            float o3 = bfhi(av[1]) * sigmoidf_(acc[i][j][3] + bg.w) * bfhi(sv[1]);
            u32x2 o = {pack2(o0, o1), pack2(o2, o3)};
            *(u32x2*)(ubuf + row * 768 + n) = o;
          }
        }
      }
    }
    SYNC_BEFORE(6);
    if (PH(6)) {
      TIDVARS
      for (int v = bid; v < 256 * 8; v += nblk) {
        int mt, nt;
        swz(v, 8, 4, mt, nt);
        const int m0 = mt * 128, n0 = nt * 128;
        const int wr = w >> 1, wc = w & 1;
        char* gstash = ws + OFF_GATE + (size_t)bid * 32768;
        f32x4 accm[4][4];
        zero_acc(accm);
        unsigned gt[4][4][2];
#pragma unroll 1
        for (int stp = 0; stp < 6; ++stp) {
          const int br = stp >> 1;
          const u16* Ab; const u16* Wb; int Kb; int ldk;
          if (!(stp & 1)) { Ab = hbuf + (size_t)m0 * KLD; Wb = WglT + (size_t)(br * 1024 + n0) * KLD; Kb = 1024; }
          else if (br == 0) { Ab = qbuf + (size_t)m0 * 768; Wb = WpfT + (size_t)n0 * 768; Kb = 768; }
          else if (br == 1) { Ab = ubuf + (size_t)m0 * 768; Wb = WpsT + (size_t)n0 * 768; Kb = 768; }
          else { Ab = qmbuf + (size_t)m0 * 512; Wb = WpmT + (size_t)n0 * 512; Kb = 512; }
          f32x4 acc[4][4];
          zero_acc(acc);
          ldk = (Kb == 1024) ? KLD : Kb;
          gemm_core<true, 1, true>(acc, Ab, ldk, Wb, ldk, Kb, smem);
          if (!(stp & 1)) {
#pragma unroll
            for (int j = 0; j < 4; ++j) {
              const float4 bm = *(const float4*)(p.b_merge + br * 1024 + n0 + wc * 64 + j * 16 + g4 * 4);
#pragma unroll
              for (int i = 0; i < 4; ++i) {
                gt[i][j][0] = pack2(sigmoidf_(acc[i][j][0] + bm.x), sigmoidf_(acc[i][j][1] + bm.y));
                gt[i][j][1] = pack2(sigmoidf_(acc[i][j][2] + bm.z), sigmoidf_(acc[i][j][3] + bm.w));
              }
            }
          } else {
#pragma unroll
            for (int j = 0; j < 4; ++j)
#pragma unroll
              for (int i = 0; i < 4; ++i) {
                accm[i][j][0] += bflo(gt[i][j][0]) * acc[i][j][0];
                accm[i][j][1] += bfhi(gt[i][j][0]) * acc[i][j][1];
                accm[i][j][2] += bflo(gt[i][j][1]) * acc[i][j][2];
                accm[i][j][3] += bfhi(gt[i][j][1]) * acc[i][j][3];
              }
            if (br == 2) epi_rowmajor_direct(accm, merged, KLD, m0, n0, 0);
          }
        }
      }
    }
    SYNC_BEFORE(7);
    if (PH(7)) {
      TIDVARS
      for (int v = bid; v < 256 * 8; v += nblk) {
        int mt, nt;
        swz(v, 8, 4, mt, nt);
        const int m0 = mt * 128, n0 = nt * 128;
        const int wr = w >> 1, wc = w & 1;
        f32x4 acc[4][4];
        zero_acc(acc);
        gemm_core<true>(acc, merged + (size_t)m0 * KLD, KLD, WoutT + (size_t)n0 * KLD, KLD, 1024, smem);
#pragma unroll
        for (int i = 0; i < 4; ++i) {
          const size_t row = (size_t)(m0 + wr * 64 + i * 16 + l15);
          float ss = 0.f;
#pragma unroll
          for (int j = 0; j < 4; ++j) {
            const int n = n0 + wc * 64 + j * 16 + g4 * 4;
            const float4 xv = *(const float4*)(p.x + row * 1024 + n);
            float4 o = make_float4(xv.x + acc[i][j][0], xv.y + acc[i][j][1], xv.z + acc[i][j][2], xv.w + acc[i][j][3]);
            ss += o.x * o.x + o.y * o.y + o.z * o.z + o.w * o.w;
            *(float4*)(p.out + row * 1024 + n) = o;
          }
          ss += __shfl_xor(ss, 16);
          ss += __shfl_xor(ss, 32);
          if (g4 == 0) part[row * 16 + nt * 2 + wc] = ss;
        }
      }
    }
    SYNC_BEFORE(8);
    if (PH(8)) {
      TIDVARS
      for (int row = bid * 4 + w; row < T_; row += nblk * 8) {
        const int row2 = row + nblk * 4;
        const bool has2 = row2 < T_;
        float ssa = (lane < 16) ? part[(size_t)row * 16 + lane] : 0.f;
        float ssb = (has2 && lane < 16) ? part[(size_t)row2 * 16 + lane] : 0.f;
        float* oa = p.out + (size_t)row * 1024;
        float* ob = p.out + (size_t)(has2 ? row2 : row) * 1024;
        float4 va[4], vb[4];
#pragma unroll
        for (int i = 0; i < 4; ++i) {
          va[i] = *(const float4*)(oa + i * 256 + lane * 4);
          vb[i] = *(const float4*)(ob + i * 256 + lane * 4);
        }
        ssa = wave_sum(ssa);
        ssb = wave_sum(ssb);
        const float ra = rsqrtf(ssa * (1.f / 1024.f) + 1e-6f);
        const float rb = rsqrtf(ssb * (1.f / 1024.f) + 1e-6f);
#pragma unroll
        for (int i = 0; i < 4; ++i) {
          const float4 gv = *(const float4*)(p.g_final + i * 256 + lane * 4);
          va[i].x *= ra * gv.x; va[i].y *= ra * gv.y; va[i].z *= ra * gv.z; va[i].w *= ra * gv.w;
          *(float4*)(oa + i * 256 + lane * 4) = va[i];
          if (has2) {
            vb[i].x *= rb * gv.x; vb[i].y *= rb * gv.y; vb[i].z *= rb * gv.z; vb[i].w *= rb * gv.w;
            *(float4*)(ob + i * 256 + lane * 4) = vb[i];
          }
        }
      }
    }
  }
}

extern "C" void kernel_launch(void* const* d_in, const int* in_sizes, int n_in, void* d_out, int out_size, void* d_ws,
                              size_t ws_size, hipStream_t stream) {
  static int grid_blocks = 0;
  if (!grid_blocks) {
    if (ws_size < WS_END || n_in != 23) {
      fprintf(stderr, "kernel_launch: unexpected ws_size %zu (need %zu) or n_in %d\n", ws_size, (size_t)WS_END, n_in);
      grid_blocks = -1;
      return;
    }
    int dev = 0, cus = 0, per_cu = 0;
    (void)hipGetDevice(&dev);
    (void)hipDeviceGetAttribute(&cus, hipDeviceAttributeMultiprocessorCount, dev);
    (void)hipFuncSetAttribute((const void*)mega, hipFuncAttributeMaxDynamicSharedMemorySize, LDS_BYTES);
    (void)hipOccupancyMaxActiveBlocksPerMultiprocessor(&per_cu, (const void*)mega, 256, LDS_BYTES);
    per_cu = (per_cu >= 2) ? 2 : 1;
    grid_blocks = cus * per_cu;
  }
  if (grid_blocks < 0) return;
  Params p{};
  const float** pp = (const float**)&p;
  for (int i = 0; i < 23; ++i) pp[i] = (const float*)d_in[i];
  p.out = (float*)d_out;
  p.ws = (char*)d_ws;
#if COOP
  (void)hipMemsetAsync((char*)d_ws + OFF_CTL + 4096, 0, XCD_BAR_WORDS * 4, stream);
  p.phase_lo = 0;
  p.phase_hi = NPHASE - 1;
  void* args[] = {&p};
  hipError_t e = hipLaunchCooperativeKernel((const void*)mega, dim3(grid_blocks), dim3(256), args, LDS_BYTES, stream);
  if (e != hipSuccess) fprintf(stderr, "cooperative launch failed: %s (grid %d)\n", hipGetErrorString(e), grid_blocks);
#else
  for (int ph = 0; ph < NPHASE; ++ph) {
    p.phase_lo = ph;
    p.phase_hi = ph;
    hipLaunchKernelGGL(mega, dim3(grid_blocks), dim3(256), LDS_BYTES, stream, p);
#ifdef PROBE_DUP
    if (ph == PROBE_DUP) {
      for (int rep = 0; rep < 2; ++rep) {
        if (ph == 2) { p.phase_lo = p.phase_hi = 1; hipLaunchKernelGGL(mega, dim3(grid_blocks), dim3(256), LDS_BYTES, stream, p); p.phase_lo = p.phase_hi = 2; }
        hipLaunchKernelGGL(mega, dim3(grid_blocks), dim3(256), LDS_BYTES, stream, p);
      }
    }
#endif
  }
#endif
}
```

```cpp
#include <hip/hip_runtime.h>
#include <hip/hip_cooperative_groups.h>
#include <stdint.h>
#include <stdio.h>
namespace cg = cooperative_groups;

#ifndef COOP
#define COOP 1
#define XCD_MODE 0
#endif

#define DI __device__ __forceinline__
#ifdef ONLY_PHASE
#define PH(n) ((n) == ONLY_PHASE && p.phase_lo <= (n) && (n) <= p.phase_hi)
#else
#define PH(n) (p.phase_lo <= (n) && (n) <= p.phase_hi)
#endif
#define SYNC_BEFORE(n)                                        \
  if (p.phase_lo < (n) && (n) <= p.phase_hi) {                \
    xcd_barrier(xb);                                          \
  }
typedef unsigned short u16;
using bf16x8 = __attribute__((ext_vector_type(8))) short;
using f32x4 = __attribute__((ext_vector_type(4))) float;
using u32x4 = __attribute__((ext_vector_type(4))) unsigned;
using u32x2 = __attribute__((ext_vector_type(2))) unsigned;

constexpr int T_ = 32768, L_ = 8192;
constexpr int LDS_BYTES = 73728;
constexpr int NPHASE = 9;

constexpr size_t MiB = 1u << 20;
constexpr float LOG2E = 1.4426950408889634f;
constexpr float QSCALE = 0.125f * LOG2E;
constexpr int KLD = 1088;
constexpr size_t OFF_H = 0;
constexpr size_t OFF_Q = 68 * MiB;
constexpr size_t OFF_GF = 116 * MiB;
constexpr size_t OFF_U = 164 * MiB;
constexpr size_t OFF_GS = 212 * MiB;
constexpr size_t OFF_YS5A = 260 * MiB;
constexpr size_t OFF_QM = 308 * MiB;
constexpr size_t OFF_GM = 340 * MiB;
constexpr size_t OFF_MERGED = 372 * MiB;
constexpr size_t OFF_WINT = 440 * MiB;
constexpr size_t OFF_WGLT = 453 * MiB;
constexpr size_t OFF_WKVT = 460 * MiB;
constexpr size_t OFF_WOUTT = 463 * MiB;
constexpr size_t OFF_WPFT = 466 * MiB;
constexpr size_t OFF_WPST = 468 * MiB;
constexpr size_t OFF_WPMT = 470 * MiB;
constexpr size_t OFF_WGLUT = 471 * MiB;
constexpr size_t OFF_MEMN = 473 * MiB;
constexpr size_t OFF_MK = 476 * MiB;
constexpr size_t OFF_MVT = 477 * MiB;
constexpr size_t OFF_LOGF = 478 * MiB;
constexpr size_t OFF_F = 480 * MiB;
constexpr size_t OFF_S5AB = 482 * MiB;
constexpr size_t OFF_S5BB = 483 * MiB;
constexpr size_t OFF_S5S = 484 * MiB;
constexpr size_t OFF_PART = 496 * MiB;
constexpr size_t OFF_GATE = OFF_GS;
constexpr size_t OFF_CTL = 498 * MiB;
constexpr size_t WS_END = 499 * MiB;

struct Params {
  const float *x, *mem, *g_norm, *g_mem_norm, *g_final, *w_in, *b_forget, *b_merge, *w_mem_kv;
  const float *lam_re, *lam_im, *log_step, *b_re, *b_im, *c_re, *c_im, *s5_d, *w_glu, *b_glu;
  const float *w_pf, *w_ps, *w_pm, *w_out;
  float* out;
  char* ws;
  int phase_lo, phase_hi;
};

DI unsigned pack2(float a, float b) {
  unsigned r;
  asm volatile("v_cvt_pk_bf16_f32 %0, %1, %2" : "=v"(r) : "v"(a), "v"(b));
  return r;
}
DI u32x4 pack8_mfma(float a0, float a1, float a2, float a3, float a4, float a5, float a6, float a7) {
  u32x4 r;
  asm volatile("v_cvt_pk_bf16_f32 %0, %4, %5\n\tv_cvt_pk_bf16_f32 %1, %6, %7\n\tv_cvt_pk_bf16_f32 %2, %8, %9\n\tv_cvt_pk_bf16_f32 %3, %10, %11\n\ts_nop 1"
               : "=&v"(r[0]), "=&v"(r[1]), "=&v"(r[2]), "=&v"(r[3])
               : "v"(a0), "v"(a1), "v"(a2), "v"(a3), "v"(a4), "v"(a5), "v"(a6), "v"(a7));
  return r;
}
DI u16 f2bf(float x) { return (u16)(pack2(x, x) & 0xffffu); }
DI float bflo(unsigned v) { return __uint_as_float(v << 16); }
DI float bfhi(unsigned v) { return __uint_as_float(v & 0xffff0000u); }
DI float sigmoidf_(float x) { return 1.f / (1.f + __expf(-x)); }
DI float siluf_(float x) { return x / (1.f + __expf(-x)); }
DI float gelu_tanh(float x) {
  float z = 0.7978845608028654f * (x + 0.044715f * x * x * x);
  float e = __expf(2.f * z);
  float th = 1.f - 2.f / (e + 1.f);
  return 0.5f * x * (1.f + th);
}
DI float wave_sum(float v) {
#pragma unroll
  for (int o = 32; o > 0; o >>= 1) v += __shfl_xor(v, o);
  return v;
}
DI f32x4 mfma16(bf16x8 a, bf16x8 b, f32x4 c) { return __builtin_amdgcn_mfma_f32_16x16x32_bf16(a, b, c, 0, 0, 0); }

template <bool SWAP, int DEPTH = 1, bool LEAN = false, bool NEXTPF = false>
DI void gemm_core(f32x4 (&acc)[4][4], const u16* __restrict__ A, int lda, const u16* __restrict__ Bt, int ldb, int K, char* smem,
                  bool preloaded = false, const u16* An = nullptr, int ldan = 0, const u16* Btn = nullptr, int ldbn = 0) {
  const int tid = threadIdx.x, lane = tid & 63, w = tid >> 6, wr = w >> 1, wc = w & 1, l15 = lane & 15, g = lane >> 4;
  const int lrow = tid >> 3, lch = tid & 7;
  const char* ap = (const char*)A;
  const char* bp = (const char*)Bt;
  const unsigned aoff = (unsigned)(lrow * lda + lch * 8) * 2u;
  const unsigned boff = (unsigned)(lrow * ldb + lch * 8) * 2u;
  u32x4 ra0[4], rb0[4], ra1[4], rb1[4];
  const int nk = K >> 6;
#define G_LOAD(RA, RB, KT)                                                        \
  _Pragma("unroll") for (int c = 0; c < 4; ++c) {                                 \
    RA[c] = *(const u32x4*)(ap + ((size_t)c * 64 * lda + (KT) * 128) + aoff);     \
    RB[c] = *(const u32x4*)(bp + ((size_t)c * 64 * ldb + (KT) * 128) + boff);     \
  }
#define G_STORE(RA, RB, BO)                                                       \
  _Pragma("unroll") for (int c = 0; c < 4; ++c) {                                 \
    *(u32x4*)(wbase + (BO) + c * 32 * 128) = RA[c];                               \
    *(u32x4*)(wbase + (BO) + 16384 + c * 32 * 128) = RB[c];                       \
  }
#define G_COMPUTE_FULL(BO)                                                             \
  {                                                                               \
    bf16x8 af[2][4], bfr[2][4];                                                   \
    _Pragma("unroll") for (int i = 0; i < 4; ++i) af[0][i] = *(const bf16x8*)(ard0 + (BO) + i * 16 * 128);  \
    _Pragma("unroll") for (int j = 0; j < 4; ++j) bfr[0][j] = *(const bf16x8*)(brd0 + (BO) + j * 16 * 128); \
    _Pragma("unroll") for (int i = 0; i < 4; ++i) af[1][i] = *(const bf16x8*)(ard1 + (BO) + i * 16 * 128);  \
    _Pragma("unroll") for (int j = 0; j < 4; ++j) bfr[1][j] = *(const bf16x8*)(brd1 + (BO) + j * 16 * 128); \
    __builtin_amdgcn_sched_barrier(0);                                            \
    __builtin_amdgcn_s_setprio(1);                                                \
    _Pragma("unroll") for (int s = 0; s < 2; ++s)                                 \
      _Pragma("unroll") for (int i = 0; i < 4; ++i)                               \
        _Pragma("unroll") for (int j = 0; j < 4; ++j)                             \
          acc[i][j] = SWAP ? mfma16(bfr[s][j], af[s][i], acc[i][j]) : mfma16(af[s][i], bfr[s][j], acc[i][j]); \
    __builtin_amdgcn_s_setprio(0);                                                \
  }
#define G_COMPUTE_LEAN(BO)                                                        \
  _Pragma("unroll") for (int s = 0; s < 2; ++s) {                                 \
    bf16x8 af[4];                                                                 \
    _Pragma("unroll") for (int i = 0; i < 4; ++i) af[i] = *(const bf16x8*)((s ? ard1 : ard0) + (BO) + i * 16 * 128);  \
    _Pragma("unroll") for (int j = 0; j < 4; ++j) {                               \
      const bf16x8 bfr = *(const bf16x8*)((s ? brd1 : brd0) + (BO) + j * 16 * 128);   \
      _Pragma("unroll") for (int i = 0; i < 4; ++i)                               \
        acc[i][j] = SWAP ? mfma16(bfr, af[i], acc[i][j]) : mfma16(af[i], bfr, acc[i][j]); \
    }                                                                             \
  }
#define G_COMPUTE(BO) if constexpr (LEAN) { G_COMPUTE_LEAN(BO) } else { G_COMPUTE_FULL(BO) }
  char* wbase = smem + lrow * 128 + ((lch ^ ((lrow >> 1) & 7)) << 4);
  const int hsw = l15 >> 1;
  const char* ard0 = smem + (wr * 64 + l15) * 128 + ((g ^ hsw) << 4);
  const char* ard1 = smem + (wr * 64 + l15) * 128 + (((4 + g) ^ hsw) << 4);
  const char* brd0 = smem + 16384 + (wc * 64 + l15) * 128 + ((g ^ hsw) << 4);
  const char* brd1 = smem + 16384 + (wc * 64 + l15) * 128 + (((4 + g) ^ hsw) << 4);
  if constexpr (DEPTH == 2) {
    G_LOAD(ra0, rb0, 0);
    G_LOAD(ra1, rb1, 1);
    G_STORE(ra0, rb0, 0);
    __syncthreads();
    for (int kt = 0; kt < nk; kt += 2) {
      if (kt + 2 < nk) G_LOAD(ra0, rb0, kt + 2);
      __builtin_amdgcn_sched_barrier(0);
      G_COMPUTE(0);
      __builtin_amdgcn_sched_barrier(0);
      G_STORE(ra1, rb1, 32768);
      __syncthreads();
      if (kt + 3 < nk) G_LOAD(ra1, rb1, kt + 3);
      __builtin_amdgcn_sched_barrier(0);
      G_COMPUTE(32768);
      __builtin_amdgcn_sched_barrier(0);
      if (kt + 2 < nk) G_STORE(ra0, rb0, 0);
      __syncthreads();
    }
  } else {
    const int grow = w * 8 + (lane >> 3);
    const int glc = (lane & 7) ^ ((w * 4 + (lane >> 4)) & 7);
    const unsigned gaoff = (unsigned)(grow * lda + glc * 8) * 2u;
    const unsigned gboff = (unsigned)(grow * ldb + glc * 8) * 2u;
    char* gl = smem + w * 1024 + lane * 16;
#define G_GLDS(KT, BO)                                                            \
  _Pragma("unroll") for (int c = 0; c < 4; ++c) {                                 \
    __builtin_amdgcn_global_load_lds((const unsigned*)(ap + ((size_t)c * 64 * lda + (size_t)(KT) * 128) + gaoff),          \
                                     (unsigned*)(gl + (BO) + c * 4096), 16, 0, 0);                                          \
    __builtin_amdgcn_global_load_lds((const unsigned*)(bp + ((size_t)c * 64 * ldb + (size_t)(KT) * 128) + gboff),          \
                                     (unsigned*)(gl + (BO) + 16384 + c * 4096), 16, 0, 0);                                  \
  }
    if (!(NEXTPF && preloaded)) {
      G_GLDS(0, 0)
      __syncthreads();
    }
    for (int kt = 0; kt < nk; kt += 2) {
      G_GLDS(kt + 1, 32768)
      __builtin_amdgcn_sched_barrier(0);
      G_COMPUTE(0);
      __syncthreads();
      if constexpr (!NEXTPF) {
        const int k2 = (kt + 2 < nk) ? kt + 2 : nk - 1;
        G_GLDS(k2, 0)
      } else if (kt + 2 < nk) {
        G_GLDS(kt + 2, 0)
      } else if (An) {
        const char* apn = (const char*)An;
        const char* bpn = (const char*)Btn;
        const unsigned gan = (unsigned)(grow * ldan + glc * 8) * 2u;
        const unsigned gbn = (unsigned)(grow * ldbn + glc * 8) * 2u;
#pragma unroll
        for (int c = 0; c < 4; ++c) {
          __builtin_amdgcn_global_load_lds((const unsigned*)(apn + ((size_t)c * 64 * ldan) + gan), (unsigned*)(gl + c * 4096), 16, 0, 0);
          __builtin_amdgcn_global_load_lds((const unsigned*)(bpn + ((size_t)c * 64 * ldbn) + gbn), (unsigned*)(gl + 16384 + c * 4096), 16, 0, 0);
        }
      }
      __builtin_amdgcn_sched_barrier(0);
      G_COMPUTE(32768);
      __syncthreads();
    }
#undef G_GLDS
  }
#undef G_LOAD
#undef G_STORE
#undef G_COMPUTE
#undef G_COMPUTE_FULL
#undef G_COMPUTE_LEAN
}

DI void zero_acc(f32x4 (&acc)[4][4]) {
#pragma unroll
  for (int i = 0; i < 4; ++i)
#pragma unroll
    for (int j = 0; j < 4; ++j) acc[i][j] = f32x4{0.f, 0.f, 0.f, 0.f};
}

DI void swz(int v, int NT, int GN, int& mt, int& nt) {
#if XCD_MODE == 0
  int xcd = v & 7, j = v >> 3;
#else
  int xcd = (v & 511) >> 6, j = ((v >> 9) << 6) + (v & 63);
#endif
  int per_mg = 8 * NT;
  int mg = j / per_mg, r = j - mg * per_mg;
  int ng = r / (8 * GN), wv = r - ng * (8 * GN);
  mt = xcd * 32 + mg * 8 + (wv & 7);
  nt = ng * GN + (wv >> 3);
}

DI void epi_rowmajor(const f32x4 (&acc)[4][4], u16* dst, int ld, int m0, int c0, int mode, char* smem) {
  const int tid = threadIdx.x, lane = tid & 63, w = tid >> 6, wr = w >> 1, wc = w & 1, l15 = lane & 15, g = lane >> 4;
#pragma unroll
  for (int i = 0; i < 4; ++i) {
    const int row = wr * 64 + i * 16 + l15;
#pragma unroll
    for (int j = 0; j < 4; ++j) {
      f32x4 v = acc[i][j];
      if (mode == 1) { v[0] *= QSCALE; v[1] *= QSCALE; v[2] *= QSCALE; v[3] *= QSCALE; }
      else if (mode == 2) { v[0] = siluf_(v[0]); v[1] = siluf_(v[1]); v[2] = siluf_(v[2]); v[3] = siluf_(v[3]); }
      u32x2 o = {pack2(v[0], v[1]), pack2(v[2], v[3])};
      *(u32x2*)(smem + row * 272 + (wc * 64 + j * 16 + g * 4) * 2) = o;
    }
  }
  __syncthreads();
#pragma unroll
  for (int c = 0; c < 8; ++c) {
    const int id = c * 256 + tid, row = id >> 4, ch = id & 15;
    const u32x4 v = *(const u32x4*)(smem + row * 272 + ch * 16);
    *(u32x4*)(dst + (size_t)(m0 + row) * ld + c0 + ch * 8) = v;
  }
  __syncthreads();
}
DI void epi_rowmajor_direct(const f32x4 (&acc)[4][4], u16* dst, int ld, int m0, int c0, int mode) {
  const int tid = threadIdx.x, lane = tid & 63, w = tid >> 6, wr = w >> 1, wc = w & 1, l15 = lane & 15, g = lane >> 4;
#pragma unroll
  for (int i = 0; i < 4; ++i) {
    const size_t row = (size_t)(m0 + wr * 64 + i * 16 + l15);
#pragma unroll
    for (int j = 0; j < 4; ++j) {
      f32x4 v = acc[i][j];
      if (mode == 1) { v[0] *= QSCALE; v[1] *= QSCALE; v[2] *= QSCALE; v[3] *= QSCALE; }
      else if (mode == 2) { v[0] = siluf_(v[0]); v[1] = siluf_(v[1]); v[2] = siluf_(v[2]); v[3] = siluf_(v[3]); }
      u32x2 o = {pack2(v[0], v[1]), pack2(v[2], v[3])};
      *(u32x2*)(dst + row * ld + c0 + wc * 64 + j * 16 + g * 4) = o;
    }
  }
}
DI void epi_transposed(const f32x4 (&acc)[4][4], u16* dst, int m0, int c0, int H, int lgDh, int lgLk) {
  const int tid = threadIdx.x, lane = tid & 63, w = tid >> 6, wr = w >> 1, wc = w & 1, l15 = lane & 15, g = lane >> 4;
#pragma unroll
  for (int i = 0; i < 4; ++i) {
    const int token = m0 + wr * 64 + i * 16 + g * 4;
    const int bidx = token >> lgLk, tl = token & ((1 << lgLk) - 1);
#pragma unroll
    for (int j = 0; j < 4; ++j) {
      const int col = c0 + wc * 64 + j * 16 + l15;
      const int head = col >> lgDh, d = col & ((1 << lgDh) - 1);
      f32x4 v = acc[i][j];
      u32x2 o = {pack2(v[0], v[1]), pack2(v[2], v[3])};
      *(u32x2*)(dst + ((((((size_t)bidx * H + head) << lgDh) + d) << lgLk) + tl)) = o;
    }
  }
}

template <int D, bool FOX, bool PF, int NQ>
DI void attn_item(const u16* __restrict__ qbase, int ldq, const u16* __restrict__ kbase, int ldk,
                  const u16* __restrict__ vtbase, int ldv, const float* __restrict__ Fseq, int q0, int nkv,
                  const u16* __restrict__ gate, u16* outp, float scale, float kmaxv, char* smem) {
  const int tid = threadIdx.x, lane = tid & 63, w = tid >> 6, l15 = lane & 15, g = lane >> 4;
  constexpr int KROW = D * 2 + 16;
  constexpr int KBYTES = 64 * KROW;
  constexpr int VBYTES = D * 144;
  constexpr int BUF = KBYTES + VBYTES + 256;
  constexpr int NL = D / 32;
  constexpr int KCH = D / 8;
  static_assert(2 * BUF <= LDS_BYTES, "attn lds");

  bf16x8 qf[NQ][D / 32];
#pragma unroll
  for (int qi = 0; qi < NQ; ++qi)
#pragma unroll
    for (int s = 0; s < D / 32; ++s)
      qf[qi][s] = *(const bf16x8*)(qbase + (size_t)(w * (16 * NQ) + qi * 16 + l15) * ldq + s * 32 + g * 8);
  float fq[NQ];
#pragma unroll
  for (int qi = 0; qi < NQ; ++qi) fq[qi] = FOX ? Fseq[q0 + w * (16 * NQ) + qi * 16 + l15] : 0.f;
  f32x4 ot[D / 16][NQ];
#pragma unroll
  for (int dt = 0; dt < D / 16; ++dt)
#pragma unroll
    for (int qi = 0; qi < NQ; ++qi) ot[dt][qi] = f32x4{0, 0, 0, 0};
  float mrun[NQ], lsum[NQ];
#pragma unroll
  for (int qi = 0; qi < NQ; ++qi) { mrun[qi] = -1e30f; lsum[qi] = 0.f; }
  float qk[NQ];
#pragma unroll
  for (int qi = 0; qi < NQ; ++qi) {
    float ss = 0.f;
    if (FOX) {
#pragma unroll
      for (int s = 0; s < D / 32; ++s)
#pragma unroll
        for (int e = 0; e < 8; ++e) {
          const float v = __uint_as_float(((unsigned)(unsigned short)qf[qi][s][e]) << 16);
          ss += v * v;
        }
      ss += __shfl_xor(ss, 16);
      ss += __shfl_xor(ss, 32);
    }
    qk[qi] = sqrtf(ss) * kmaxv * 1.002f + 1e-3f;
  }
  int* flags = (int*)(smem + 73664);

  u32x4 kr[NL], vr[NL];
  f32x4 fr = {0, 0, 0, 0};
#define krow(c) (((c) * 256 + tid) / KCH)
#define kch(c) (((c) * 256 + tid) % KCH)
#define vrow(c) (((c) * 256 + tid) >> 3)
#define vch(c) (tid & 7)
#define ATT_LOAD(J)                                                                                   \
  {                                                                                                   \
    const int s0_ = (J) * 64;                                                                         \
    _Pragma("unroll") for (int c = 0; c < NL; ++c) {                                                  \
      kr[c] = *(const u32x4*)(kbase + (size_t)(s0_ + krow(c)) * ldk + kch(c) * 8);                    \
      vr[c] = *(const u32x4*)(vtbase + (size_t)vrow(c) * ldv + s0_ + vch(c) * 8);                     \
    }                                                                                                 \
    if (FOX && tid < 16) fr = *(const f32x4*)(Fseq + s0_ + tid * 4);                                  \
  }
#define ATT_STORE(BO)                                                                                 \
  {                                                                                                   \
    char* b_ = smem + (BO);                                                                           \
    _Pragma("unroll") for (int c = 0; c < NL; ++c) {                                                  \
      *(u32x4*)(b_ + krow(c) * KROW + kch(c) * 16) = kr[c];                                           \
      *(u32x4*)(b_ + KBYTES + vrow(c) * 144 + vch(c) * 16) = vr[c];                                   \
    }                                                                                                 \
    if (FOX && tid < 16) *(f32x4*)(b_ + KBYTES + VBYTES + tid * 16) = fr;                             \
  }
  ATT_LOAD(nkv - 1);
  ATT_STORE(0);
  __syncthreads();
  const int qlo = q0 + w * (16 * NQ);
  for (int j = nkv - 1, itn = 0; j >= 0; --j, ++itn) {
    const int cur = (itn & 1) * BUF;
    if (j > 0) {
      ATT_LOAD(j - 1);
      if (!PF) ATT_STORE(cur ^ BUF);
    }
    __builtin_amdgcn_sched_barrier(0);
    bool ok = false;
    const int s0 = j * 64;
    const bool active = !FOX || (s0 <= qlo + 16 * NQ - 1);
    if (active) {
      const char* Ks = smem + cur;
      const char* Vs = smem + cur + KBYTES;
      const char* Fs = smem + cur + KBYTES + VBYTES;
      f32x4 st[4][NQ];
#pragma unroll
      for (int kt = 0; kt < 4; ++kt)
#pragma unroll
        for (int qi = 0; qi < NQ; ++qi) st[kt][qi] = f32x4{0, 0, 0, 0};
#pragma unroll
      for (int s = 0; s < D / 32; ++s) {
        bf16x8 kf[4];
#pragma unroll
        for (int kt = 0; kt < 4; ++kt) kf[kt] = *(const bf16x8*)(Ks + (kt * 16 + l15) * KROW + s * 64 + g * 16);
#pragma unroll
        for (int kt = 0; kt < 4; ++kt)
#pragma unroll
          for (int qi = 0; qi < NQ; ++qi) st[kt][qi] = mfma16(kf[kt], qf[qi][s], st[kt][qi]);
      }
      if (FOX) {
        const bool need_mask = (s0 + 63 > qlo);
#pragma unroll
        for (int kt = 0; kt < 4; ++kt) {
          f32x4 fk = *(const f32x4*)(Fs + (kt * 16 + g * 4) * 4);
#pragma unroll
          for (int qi = 0; qi < NQ; ++qi) {
            const int qpos = qlo + qi * 16 + l15;
#pragma unroll
            for (int r = 0; r < 4; ++r) {
              float v = st[kt][qi][r] - fk[r];
              if (need_mask && (s0 + kt * 16 + g * 4 + r > qpos)) v = -1e30f;
              st[kt][qi][r] = v;
            }
          }
        }
      } else {
#pragma unroll
        for (int kt = 0; kt < 4; ++kt)
#pragma unroll
          for (int qi = 0; qi < NQ; ++qi)
#pragma unroll
            for (int r = 0; r < 4; ++r) st[kt][qi][r] *= scale;
      }
      float mxl[NQ];
      bool upd = false;
#pragma unroll
      for (int qi = 0; qi < NQ; ++qi) {
        float mx = st[0][qi][0];
#pragma unroll
        for (int kt = 0; kt < 4; ++kt)
#pragma unroll
          for (int r = 0; r < 4; ++r) mx = fmaxf(mx, st[kt][qi][r]);
        mxl[qi] = mx;
        upd = upd || (mx > mrun[qi]);
      }
      const bool resc = __any(upd);
      if (resc) {
#pragma unroll
        for (int qi = 0; qi < NQ; ++qi) {
          float mx = mxl[qi];
          mx = fmaxf(mx, __shfl_xor(mx, 16));
          mx = fmaxf(mx, __shfl_xor(mx, 32));
          const float mnew = fmaxf(mrun[qi], mx);
          const float al = __builtin_amdgcn_exp2f(mrun[qi] - mnew);
          mrun[qi] = mnew;
          lsum[qi] *= al;
#pragma unroll
          for (int dt = 0; dt < D / 16; ++dt)
#pragma unroll
            for (int r = 0; r < 4; ++r) ot[dt][qi][r] *= al;
        }
      }
#pragma unroll
      for (int qi = 0; qi < NQ; ++qi) {
        const float mref = mrun[qi];
        float ps = 0.f;
#pragma unroll
        for (int kt = 0; kt < 4; ++kt)
#pragma unroll
          for (int r = 0; r < 4; ++r) {
            float p = __builtin_amdgcn_exp2f(st[kt][qi][r] - mref);
            st[kt][qi][r] = p;
            ps += p;
          }
        lsum[qi] += ps;
      }
      bf16x8 pb[2][NQ];
#pragma unroll
      for (int kp = 0; kp < 2; ++kp)
#pragma unroll
        for (int qi = 0; qi < NQ; ++qi) {
          u32x4 t = pack8_mfma(st[2 * kp][qi][0], st[2 * kp][qi][1], st[2 * kp][qi][2], st[2 * kp][qi][3],
                               st[2 * kp + 1][qi][0], st[2 * kp + 1][qi][1], st[2 * kp + 1][qi][2], st[2 * kp + 1][qi][3]);
          pb[kp][qi] = __builtin_bit_cast(bf16x8, t);
        }
#pragma unroll
      for (int dt = 0; dt < D / 16; ++dt) {
#pragma unroll
        for (int kp = 0; kp < 2; ++kp) {
          u32x2 lo = *(const u32x2*)(Vs + (dt * 16 + l15) * 144 + (kp * 32 + g * 4) * 2);
          u32x2 hi = *(const u32x2*)(Vs + (dt * 16 + l15) * 144 + (kp * 32 + 16 + g * 4) * 2);
          u32x4 t = {lo[0], lo[1], hi[0], hi[1]};
          bf16x8 vf = __builtin_bit_cast(bf16x8, t);
#pragma unroll
          for (int qi = 0; qi < NQ; ++qi) ot[dt][qi] = mfma16(vf, pb[kp][qi], ot[dt][qi]);
        }
      }
      if (FOX) {
        const float f0 = *(const float*)Fs;
        ok = true;
#pragma unroll
        for (int qi = 0; qi < NQ; ++qi) ok = ok && (qk[qi] - f0 - mrun[qi] <= -30.f * LOG2E);
      }
    }
    __builtin_amdgcn_sched_barrier(0);
    if (PF && j > 0) ATT_STORE(cur ^ BUF);
    if (FOX) {
      const bool wave_ok = (__ballot(ok) == ~0ull);
      if (lane == 0) flags[(itn & 1) * 4 + w] = wave_ok ? 1 : 0;
      __syncthreads();
      const int* fl = flags + (itn & 1) * 4;
      if (fl[0] & fl[1] & fl[2] & fl[3]) break;
    } else {
      __syncthreads();
    }
  }
#undef ATT_LOAD
#undef ATT_STORE
#undef krow
#undef kch
#undef vrow
#undef vch
#pragma unroll
  for (int qi = 0; qi < NQ; ++qi) {
    float l = lsum[qi];
    l += __shfl_xor(l, 16);
    l += __shfl_xor(l, 32);
    const float inv = 1.f / l;
    const size_t rowoff = (size_t)(w * (16 * NQ) + qi * 16 + l15) * ldq;
#pragma unroll
    for (int dt = 0; dt < D / 16; ++dt) {
      const int col = dt * 16 + g * 4;
      u32x2 gv = *(const u32x2*)(gate + rowoff + col);
      u32x2 o = {pack2(ot[dt][qi][0] * inv * bflo(gv[0]), ot[dt][qi][1] * inv * bfhi(gv[0])),
                 pack2(ot[dt][qi][2] * inv * bflo(gv[1]), ot[dt][qi][3] * inv * bfhi(gv[1]))};
      *(u32x2*)(outp + rowoff + col) = o;
    }
  }
}

typedef float v2f __attribute__((ext_vector_type(2)));
DI void s5_load_u(const u16* ubuf, int b, int c, int g, char* ut, int lane) {
  const u16* src = ubuf + ((size_t)(b * L_ + c * 64 + lane)) * 768 + g * 16;
  u32x4 a = *(const u32x4*)src, bb = *(const u32x4*)(src + 8);
  f32x4 o0 = {bflo(a[0]), bfhi(a[0]), bflo(a[1]), bfhi(a[1])};
  f32x4 o1 = {bflo(a[2]), bfhi(a[2]), bflo(a[3]), bfhi(a[3])};
  f32x4 o2 = {bflo(bb[0]), bfhi(bb[0]), bflo(bb[1]), bfhi(bb[1])};
  f32x4 o3 = {bflo(bb[2]), bfhi(bb[2]), bflo(bb[3]), bfhi(bb[3])};
  *(f32x4*)(ut + lane * 64) = o0;
  *(f32x4*)(ut + lane * 64 + 16) = o1;
  *(f32x4*)(ut + lane * 64 + 32) = o2;
  *(f32x4*)(ut + lane * 64 + 48) = o3;
}
DI void s5_load_b(const float* bbar, int gp, v2f (&b2)[16]) {
#pragma unroll
  for (int q = 0; q < 4; ++q) {
    float4 t0 = *(const float4*)(bbar + (size_t)gp * 32 + q * 4);
    float4 t1 = *(const float4*)(bbar + (size_t)gp * 32 + 16 + q * 4);
    b2[4 * q] = v2f{t0.x, t1.x}; b2[4 * q + 1] = v2f{t0.y, t1.y};
    b2[4 * q + 2] = v2f{t0.z, t1.z}; b2[4 * q + 3] = v2f{t0.w, t1.w};
  }
}
DI v2f s5_x(const char* ut, int t, const v2f (&b2)[16]) {
  v2f xa = {0.f, 0.f}, xb = {0.f, 0.f};
#pragma unroll
  for (int q = 0; q < 4; ++q) {
    const f32x4 u = *(const f32x4*)(ut + t * 64 + q * 16);
    xa += b2[4 * q] * u[0];
    xb += b2[4 * q + 1] * u[1];
    xa += b2[4 * q + 2] * u[2];
    xb += b2[4 * q + 3] * u[3];
  }
  return xa + xb;
}

DI void s5_load_bfrag(const float* bbar, int g, int l15, int g4, bf16x8 (&ah)[8], bf16x8 (&al)[8]) {
#pragma unroll
  for (int kt = 0; kt < 8; ++kt) {
    u32x4 h = {0u, 0u, 0u, 0u}, l = {0u, 0u, 0u, 0u};
    if (g4 < 2) {
      const float* src = bbar + (size_t)(g * 64 + (kt & 3) * 16 + l15) * 32 + (kt >> 2) * 16 + g4 * 8;
      const float4 t0 = *(const float4*)src, t1 = *(const float4*)(src + 4);
      const float v[8] = {t0.x, t0.y, t0.z, t0.w, t1.x, t1.y, t1.z, t1.w};
#pragma unroll
      for (int q = 0; q < 4; ++q) {
        const unsigned h0 = f2bf(v[2 * q]), h1 = f2bf(v[2 * q + 1]);
        h[q] = h0 | (h1 << 16);
        l[q] = pack2(v[2 * q] - __uint_as_float(h0 << 16), v[2 * q + 1] - __uint_as_float(h1 << 16));
      }
    }
    ah[kt] = __builtin_bit_cast(bf16x8, h);
    al[kt] = __builtin_bit_cast(bf16x8, l);
  }
}
DI void s5_xsub(const u32x4 uraw, const bf16x8 (&ah)[8], const bf16x8 (&al)[8], char* xs, int l15, int g4) {
  const bf16x8 ub = __builtin_bit_cast(bf16x8, uraw);
#pragma unroll
  for (int kt = 0; kt < 8; ++kt) {
    f32x4 x = {0.f, 0.f, 0.f, 0.f};
    x = mfma16(ah[kt], ub, x);
    x = mfma16(al[kt], ub, x);
    *(f32x4*)(xs + l15 * 528 + (kt * 16 + g4 * 4) * 4) = x;
  }
}

#define XB_TMO      128
#define XB_XCNT(j)  (256  + 64 * (j))
#define XB_XSUB(j)  (1280 + 64 * (j))
#define XB_XGEN(j)  (2304 + 64 * (j))
#define XB_TOP      3328
#define XB_TOPGEN   3392
#define XCD_BAR_WORDS 3456
#define XB_SPIN_CAP (1u << 18)
DI unsigned xb_ld(unsigned* p) { return __hip_atomic_load(p, __ATOMIC_RELAXED, __HIP_MEMORY_SCOPE_AGENT); }
DI unsigned xb_add(unsigned* p, unsigned v) { return __hip_atomic_fetch_add(p, v, __ATOMIC_RELAXED, __HIP_MEMORY_SCOPE_AGENT); }
DI unsigned xb_xcc_id() { return (unsigned)__builtin_amdgcn_s_getreg((3 << 11) | 20) & 0xFu; }
#define XB_SPIN(cond, bar) do { unsigned _sp = 0; while (cond) { __builtin_amdgcn_s_sleep(1); \
    if ((++_sp & 255u) == 0u) { if (xb_ld(&(bar)[XB_TMO])) break; if (_sp > XB_SPIN_CAP) { atomicAdd(&(bar)[XB_TMO], 1u); break; } } } } while (0)
struct XcdBarrier { unsigned* bar; unsigned x; volatile unsigned* st; };
DI XcdBarrier xcd_barrier_post(unsigned* bar, volatile unsigned* st) {
  XcdBarrier b; b.bar = bar; b.x = xb_xcc_id(); b.st = st;
  if (threadIdx.x == 0) (void)xb_add(&bar[XB_XCNT(b.x)], 1u);
  return b;
}
DI void xcd_barrier_complete(unsigned* bar, unsigned x, unsigned& nloc, unsigned& nx) {
  const unsigned G = gridDim.x * gridDim.y * gridDim.z;
  unsigned sum, cnt, mine, sp = 0u;
  for (;;) {
    sum = 0u; cnt = 0u; mine = 0u;
#pragma unroll
    for (unsigned j = 0; j < 16; ++j) { const unsigned c = xb_ld(&bar[XB_XCNT(j)]); sum += c; cnt += (c > 0u) ? 1u : 0u; mine = (j == x) ? c : mine; }
    if (sum == G) break;
    __builtin_amdgcn_s_sleep(1);
    if ((++sp & 255u) == 0u) { if (xb_ld(&bar[XB_TMO])) break; if (sp > XB_SPIN_CAP) { atomicAdd(&bar[XB_TMO], 1u); break; } }
  }
  nloc = mine > 0u ? mine : 1u; nx = cnt > 0u ? cnt : 1u;
}
DI void xcd_barrier(const XcdBarrier& b) {
  asm volatile("s_waitcnt vmcnt(0)" ::: "memory");
  __syncthreads();
  if (threadIdx.x == 0) {
    unsigned* bar = b.bar;
    __builtin_amdgcn_s_waitcnt(0);
    unsigned nloc = b.st[0], nx = b.st[1];
    if (nloc == 0u) { xcd_barrier_complete(bar, b.x, nloc, nx); b.st[0] = nloc; b.st[1] = nx; }
    const unsigned old = xb_add(&bar[XB_XSUB(b.x)], 1u);
    const unsigned gen = old / nloc;
    if (old + 1u == (gen + 1u) * nloc) {
      __builtin_amdgcn_fence(__ATOMIC_RELEASE, "agent");
      asm volatile("s_waitcnt vmcnt(0)" ::: "memory");
      const unsigned og = xb_add(&bar[XB_TOP], 1u);
      const unsigned tg = og / nx;
      if (og + 1u == (tg + 1u) * nx) xb_add(&bar[XB_TOPGEN], 1u);
      else XB_SPIN(xb_ld(&bar[XB_TOPGEN]) == tg, bar);
      __builtin_amdgcn_fence(__ATOMIC_ACQUIRE, "agent");
      xb_add(&bar[XB_XGEN(b.x)], 1u);
      asm volatile("s_waitcnt vmcnt(0)" ::: "memory");
    } else {
      XB_SPIN(xb_ld(&bar[XB_XGEN(b.x)]) == gen, bar);
      __builtin_amdgcn_fence(__ATOMIC_ACQUIRE, "agent");
      asm volatile("s_waitcnt vmcnt(0)" ::: "memory");
    }
  }
  __syncthreads();
}

extern "C" __global__ void __launch_bounds__(256, 2) mega(Params p) {
  extern __shared__ __attribute__((aligned(16))) char smem[];
  cg::grid_group grid = cg::this_grid();
#define TIDVARS                                                                  \
  int tid = threadIdx.x;                                                         \
  asm volatile("" : "+v"(tid));                                                  \
  const int lane = tid & 63, w = tid >> 6, l15 = lane & 15, g4 = lane >> 4;      \
  (void)lane; (void)w; (void)l15; (void)g4;
  const int nblk = gridDim.x, bid = blockIdx.x;
  char* ws = p.ws;
  XcdBarrier xb;
  xb.bar = (unsigned*)(ws + OFF_CTL + 4096); xb.x = 0; xb.st = (volatile unsigned*)(smem + 73712);
  if (p.phase_lo < p.phase_hi) {
    if (threadIdx.x < 2) xb.st[threadIdx.x] = 0u;
    __syncthreads();
    xb = xcd_barrier_post((unsigned*)(ws + OFF_CTL + 4096), (volatile unsigned*)(smem + 73712));
    grid.sync();
  }
  u16* hbuf = (u16*)(ws + OFF_H);
  u16* qbuf = (u16*)(ws + OFF_Q);
  u16* gfbuf = (u16*)(ws + OFF_GF);
  u16* ubuf = (u16*)(ws + OFF_U);
  u16* gsbuf = (u16*)(ws + OFF_GS);
  u16* ys5a = (u16*)(ws + OFF_YS5A);
  u16* qmbuf = (u16*)(ws + OFF_QM);
  u16* gmbuf = (u16*)(ws + OFF_GM);
  u16* merged = (u16*)(ws + OFF_MERGED);
  u16* WinT = (u16*)(ws + OFF_WINT);
  u16* WglT = (u16*)(ws + OFF_WGLT);
  u16* WkvT = (u16*)(ws + OFF_WKVT);
  u16* WoutT = (u16*)(ws + OFF_WOUTT);
  u16* WpfT = (u16*)(ws + OFF_WPFT);
  u16* WpsT = (u16*)(ws + OFF_WPST);
  u16* WpmT = (u16*)(ws + OFF_WPMT);
  u16* WgluT = (u16*)(ws + OFF_WGLUT);
  u16* memn = (u16*)(ws + OFF_MEMN);
  u16* mkbuf = (u16*)(ws + OFF_MK);
  u16* mvT = (u16*)(ws + OFF_MVT);
  float* logf = (float*)(ws + OFF_LOGF);
  float* Fbuf = (float*)(ws + OFF_F);
  float2* abar = (float2*)(ws + OFF_S5AB);
  float* bbar = (float*)(ws + OFF_S5BB);
  float2* Sst = (float2*)(ws + OFF_S5S);
  float* part = (float*)(ws + OFF_PART);
  unsigned* ctl = (unsigned*)(ws + OFF_CTL);
  u16* kbuf = (u16*)p.out;
  u16* vT = (u16*)((char*)p.out + 48 * MiB);

  {
    if (PH(0)) {
      TIDVARS
      if (bid == 0 && tid < 128) ctl[tid] = 0u;
      float* tile = (float*)smem;
      for (int ti = bid; ti < 3344; ti += nblk) {
        const float* src; int ld, col0, K; u16* dst; int tt;
        if (ti < 576) { src = p.w_in; ld = 8716; col0 = 0; K = 1024; dst = WinT; tt = ti; }
        else if (ti < 1408) { src = p.w_in; ld = 8716; col0 = 2316; K = 1024; dst = WinT + (size_t)2304 * KLD; tt = ti - 576; }
        else if (ti < 2176) { src = p.w_in; ld = 8716; col0 = 5644; K = 1024; dst = WglT; tt = ti - 1408; }
        else if (ti < 2432) { src = p.w_mem_kv; ld = 1024; col0 = 0; K = 1024; dst = WkvT; tt = ti - 2176; }
        else if (ti < 2688) { src = p.w_out; ld = 1024; col0 = 0; K = 1024; dst = WoutT; tt = ti - 2432; }
        else if (ti < 2880) { src = p.w_pf; ld = 1024; col0 = 0; K = 768; dst = WpfT; tt = ti - 2688; }
        else if (ti < 3072) { src = p.w_ps; ld = 1024; col0 = 0; K = 768; dst = WpsT; tt = ti - 2880; }
        else if (ti < 3200) { src = p.w_pm; ld = 1024; col0 = 0; K = 512; dst = WpmT; tt = ti - 3072; }
        else { src = p.w_glu; ld = 768; col0 = 0; K = 768; dst = WgluT; tt = ti - 3200; }
        const int nkt = K >> 6;
        const int dld = (K == 1024) ? KLD : K;
        const int k0 = (tt % nkt) * 64, n0 = (tt / nkt) * 64;
#pragma unroll 4
        for (int i = 0; i < 16; ++i) {
          int k = i * 4 + w, n = lane;
          tile[k * 65 + n] = src[(size_t)(k0 + k) * ld + col0 + n0 + n];
        }
        __syncthreads();
#pragma unroll 4
        for (int i = 0; i < 16; ++i) {
          int n = i * 4 + w, k = lane;
          dst[(size_t)(n0 + n) * dld + k0 + k] = f2bf(tile[k * 65 + n]);
        }
        __syncthreads();
      }
      float* wfl = (float*)smem;
      for (int idx = tid; idx < 12288; idx += 256) {
        int k = idx / 12, j = idx - k * 12;
        wfl[j * 1024 + k] = p.w_in[(size_t)k * 8716 + 2304 + j];
      }
      __syncthreads();
      for (int row = bid * 4 + w; row < T_ + 1024; row += nblk * 4) {
        const bool isx = row < T_;
        const float* src = isx ? p.x + (size_t)row * 1024 : p.mem + (size_t)(row - T_) * 1024;
        const float* gsrc = isx ? p.g_norm : p.g_mem_norm;
        u16* dst = isx ? hbuf + (size_t)row * KLD : memn + (size_t)(row - T_) * KLD;
        float4 xv[4], gx[4];
        float v[16];
#pragma unroll
        for (int q = 0; q < 16; ++q) v[q] = 0.f;
#pragma unroll
        for (int i = 0; i < 4; ++i) {
          xv[i] = *(const float4*)(src + i * 256 + lane * 4);
          const float4 gv = *(const float4*)(gsrc + i * 256 + lane * 4);
          gx[i] = make_float4(xv[i].x * gv.x, xv[i].y * gv.y, xv[i].z * gv.z, xv[i].w * gv.w);
          v[12] += xv[i].x * xv[i].x + xv[i].y * xv[i].y + xv[i].z * xv[i].z + xv[i].w * xv[i].w;
        }
        if (isx) {
#pragma unroll
          for (int j = 0; j < 12; ++j) {
#pragma unroll
            for (int i = 0; i < 4; ++i) {
              const float4 wv = *(const float4*)(wfl + j * 1024 + i * 256 + lane * 4);
              v[j] += gx[i].x * wv.x + gx[i].y * wv.y + gx[i].z * wv.z + gx[i].w * wv.w;
            }
          }
        }
        float w8[8], w4[4], w2[2], w1;
        {
          const bool hi = (lane & 32) != 0;
#pragma unroll
          for (int q = 0; q < 8; ++q) {
            const float snd = hi ? v[q] : v[q + 8];
            const float kp = hi ? v[q + 8] : v[q];
            w8[q] = kp + __shfl_xor(snd, 32);
          }
        }
        {
          const bool hi = (lane & 16) != 0;
#pragma unroll
          for (int q = 0; q < 4; ++q) {
            const float snd = hi ? w8[q] : w8[q + 4];
            const float kp = hi ? w8[q + 4] : w8[q];
            w4[q] = kp + __shfl_xor(snd, 16);
          }
        }
        {
          const bool hi = (lane & 8) != 0;
#pragma unroll
          for (int q = 0; q < 2; ++q) {
            const float snd = hi ? w4[q] : w4[q + 2];
            const float kp = hi ? w4[q + 2] : w4[q];
            w2[q] = kp + __shfl_xor(snd, 8);
          }
        }
        {
          const bool hi = (lane & 4) != 0;
          const float snd = hi ? w2[0] : w2[1];
          const float kp = hi ? w2[1] : w2[0];
          w1 = kp + __shfl_xor(snd, 4);
        }
        w1 += __shfl_xor(w1, 2);
        w1 += __shfl_xor(w1, 1);
        const int ridx = ((lane >> 5) & 1) * 8 + ((lane >> 4) & 1) * 4 + ((lane >> 3) & 1) * 2 + ((lane >> 2) & 1);
        const float ss = __shfl(w1, 48);
        const float rstd = rsqrtf(ss * (1.f / 1024.f) + 1e-6f);
#pragma unroll
        for (int i = 0; i < 4; ++i) {
          u32x2 o = {pack2(gx[i].x * rstd, gx[i].y * rstd), pack2(gx[i].z * rstd, gx[i].w * rstd)};
          *(u32x2*)(dst + i * 256 + lane * 4) = o;
        }
        if (isx && ridx < 12 && (lane & 3) == 0) {
          float xx = w1 * rstd + p.b_forget[ridx];
          float lf = fminf(xx, 0.f) - log1pf(__expf(-fabsf(xx)));
          const int b = row >> 13, t = row & (L_ - 1);
          logf[(size_t)(b * 12 + ridx) * L_ + t] = lf;
        }
      }
      {
        const int gid = bid * 256 + tid;
        if (gid < 3072) {
          const int g = gid >> 6;
          const float step = expf(p.log_step[g]);
          const float lr = p.lam_re[gid], li = p.lam_im[gid];
          const float mag = expf(lr * step);
          const float ar = mag * cosf(li * step), ai = mag * sinf(li * step);
          const float den = lr * lr + li * li;
          const float nr = ar - 1.f, ni = ai;
          const float fr = (nr * lr + ni * li) / den, fi = (ni * lr - nr * li) / den;
          abar[gid] = make_float2(ar, ai);
#pragma unroll
          for (int h = 0; h < 16; ++h) {
            const float br = p.b_re[(size_t)gid * 16 + h], bi = p.b_im[(size_t)gid * 16 + h];
            bbar[(size_t)gid * 32 + h] = fr * br - fi * bi;
            bbar[(size_t)gid * 32 + 16 + h] = fr * bi + fi * br;
          }
        }
      }
      __syncthreads();
    }
    SYNC_BEFORE(1);
    if (PH(1)) {
      TIDVARS
      float* sm = (float*)smem;
      for (int seq = bid; seq < 48; seq += nblk) {
        const float* src = logf + (size_t)seq * L_ + tid * 32;
        float* dst = Fbuf + (size_t)seq * L_ + tid * 32;
        float v[32];
#pragma unroll
        for (int i = 0; i < 8; ++i) {
          float4 t = *(const float4*)(src + i * 4);
          v[4 * i] = t.x; v[4 * i + 1] = t.y; v[4 * i + 2] = t.z; v[4 * i + 3] = t.w;
        }
        float run = 0.f;
#pragma unroll
        for (int i = 0; i < 32; ++i) { run += v[i]; v[i] = run; }
        float incl = run;
#pragma unroll
        for (int o = 1; o < 64; o <<= 1) {
          float t = __shfl_up(incl, o);
          if (lane >= o) incl += t;
        }
        if (lane == 63) sm[w] = incl;
        __syncthreads();
        float base = incl - run;
        for (int w2 = 0; w2 < w; ++w2) base += sm[w2];
#pragma unroll
        for (int i = 0; i < 8; ++i) {
          float4 t = make_float4((v[4 * i] + base) * LOG2E, (v[4 * i + 1] + base) * LOG2E, (v[4 * i + 2] + base) * LOG2E, (v[4 * i + 3] + base) * LOG2E);
          *(float4*)(dst + i * 4) = t;
        }
        __syncthreads();
      }
#define P1_V(PN, VOUT)                                                     \
      {                                                                    \
        VOUT = -1;                                                         \
        if (nblk == 512) {                                                 \
          const int i_ = bid >> 3, x_ = bid & 7;                           \
          int j_ = -1;                                                     \
          if ((PN) < 20) j_ = 64 * (PN) + i_;                              \
          else if (i_ < 32 && (PN) < 24) j_ = 1280 + 32 * ((PN) - 20) + i_; \
          else if (i_ < 8 && (PN) == 24) j_ = 1408 + i_;                   \
          if (j_ >= 0) VOUT = j_ * 8 + x_;                                 \
        } else {                                                           \
          const int v_ = bid + (PN) * nblk;                                \
          if (v_ < 11264 + 64) VOUT = v_;                                  \
        }                                                                  \
      }
#define P1_OPS(V, AO, BO_, M0O, N0O, KVO)                                  \
      {                                                                    \
        KVO = (V) >= 11264;                                                \
        if (!KVO) {                                                        \
          int mt_, nt_;                                                    \
          swz((V), 44, 4, mt_, nt_);                                       \
          M0O = mt_ * 128; N0O = nt_ * 128;                                \
          AO = hbuf + (size_t)M0O * KLD; BO_ = WinT + (size_t)N0O * KLD;   \
        } else {                                                           \
          const int kv_ = (V) - 11264;                                     \
          M0O = (kv_ >> 3) * 128; N0O = (kv_ & 7) * 128;                   \
          AO = memn + (size_t)M0O * KLD; BO_ = WkvT + (size_t)N0O * KLD;   \
        }                                                                  \
      }
      for (int pn = 0;; ++pn) {
        int v;
        P1_V(pn, v)
        if (v < 0) break;
        const u16 *A, *Bt;
        int m0, n0;
        bool kvtile;
        P1_OPS(v, A, Bt, m0, n0, kvtile)
        const u16 *An = nullptr, *Btn = nullptr;
        {
          int vn;
          P1_V(pn + 1, vn)
          if (vn >= 0) { int m0n_, n0n_; bool kvn_; P1_OPS(vn, An, Btn, m0n_, n0n_, kvn_) (void)m0n_; (void)n0n_; (void)kvn_; }
        }
        const bool transp = kvtile ? (n0 >= 512) : (n0 >= 1536 && n0 < 2304);
        f32x4 acc[4][4];
        zero_acc(acc);
        if (transp) {
          gemm_core<false, 1, false, true>(acc, A, KLD, Bt, KLD, 1024, smem, pn > 0, An, KLD, Btn, KLD);
          if (kvtile) epi_transposed(acc, mvT, m0, n0 - 512, 4, 7, 8);
          else epi_transposed(acc, vT, m0, n0 - 1536, 12, 6, 13);
        } else {
          gemm_core<true, 1, false, true>(acc, A, KLD, Bt, KLD, 1024, smem, pn > 0, An, KLD, Btn, KLD);
          u16* dst; int ld, c0, mode;
          if (kvtile) { dst = mkbuf; ld = 512; c0 = n0; mode = 0; }
          else if (n0 < 768) { dst = qbuf; ld = 768; c0 = n0; mode = 1; }
          else if (n0 < 1536) { dst = kbuf; ld = 768; c0 = n0 - 768; mode = 0; }
          else if (n0 < 3072) { dst = gfbuf; ld = 768; c0 = n0 - 2304; mode = 2; }
          else if (n0 < 3840) { dst = ubuf; ld = 768; c0 = n0 - 3072; mode = 0; }
          else if (n0 < 4608) { dst = gsbuf; ld = 768; c0 = n0 - 3840; mode = 2; }
          else if (n0 < 5120) { dst = qmbuf; ld = 512; c0 = n0 - 4608; mode = 0; }
          else { dst = gmbuf; ld = 512; c0 = n0 - 5120; mode = 2; }
          epi_rowmajor(acc, dst, ld, m0, c0, mode, smem + 32768);
          if (!kvtile && n0 >= 768 && n0 < 1536) {
            float mxv = 0.f;
#pragma unroll
            for (int i = 0; i < 4; ++i) {
              float ss = 0.f;
#pragma unroll
              for (int j = 0; j < 4; ++j)
#pragma unroll
                for (int r = 0; r < 4; ++r) {
                  const float v = __uint_as_float(((unsigned)f2bf(acc[i][j][r])) << 16);
                  ss += v * v;
                }
              ss += __shfl_xor(ss, 16);
              ss += __shfl_xor(ss, 32);
              mxv = fmaxf(mxv, ss);
            }
#pragma unroll
            for (int o = 1; o < 16; o <<= 1) mxv = fmaxf(mxv, __shfl_xor(mxv, o));
            if (lane == 0) atomicMax(&ctl[(m0 >> 13) * 12 + ((n0 - 768) >> 6) + (w & 1)], __float_as_uint(mxv));
          }
        }
      }
    }
    SYNC_BEFORE(2);
    if (PH(2)) {
      TIDVARS
      int* qslot = (int*)(smem + 73696);
#define NEXT_ITEM(CTR)                                        \
      {                                                       \
        if (tid == 0) *qslot = (int)atomicAdd(&ctl[CTR], 1u); \
        __syncthreads();                                      \
        it = *qslot;                                          \
        __syncthreads();                                      \
      }
      int it;
      for (;;) {
        NEXT_ITEM(64);
        if (it >= 3072) break;
        {
#ifndef NO_FOX
          const int qt = 63 - it / 48, bh = it % 48, b = bh / 12, h = bh % 12;
          const int q0 = qt * 128;
          const size_t qoff = ((size_t)(b * L_ + q0)) * 768 + h * 64;
          attn_item<64, true, true, 2>(qbuf + qoff, 768, kbuf + (size_t)b * L_ * 768 + h * 64, 768,
                              vT + (size_t)(b * 12 + h) * 64 * L_, L_, Fbuf + (size_t)(b * 12 + h) * L_, q0, 2 * qt + 2,
                              gfbuf + qoff, qbuf + qoff, 1.f, sqrtf(__uint_as_float(ctl[b * 12 + h])), smem);
#endif
        }
      }
      for (;;) {
        NEXT_ITEM(65);
        if (it >= 2048) break;
        {
#ifndef NO_MEM
          const int im = it;
          const int hm = im & 3, qt = (im >> 2) & 127, b = im >> 9;
          const int q0 = qt * 64;
          const size_t qoff = ((size_t)(b * L_ + q0)) * 512 + hm * 128;
          attn_item<128, false, false, 1>(qmbuf + qoff, 512, mkbuf + (size_t)b * 256 * 512 + hm * 128, 512,
                                mvT + (size_t)(b * 4 + hm) * 128 * 256, 256, nullptr, q0, 4,
                                gmbuf + qoff, qmbuf + qoff, 0.08838834764831845f * LOG2E, 0.f, smem);
#endif
        }
      }
      for (;;) {
        NEXT_ITEM(66);
        if (it >= 1536) break;
        {
#ifndef NO_S5P1
          const int wi = it * 4 + w;
          const int g = wi % 48, cg = (wi / 48) & 31, b = wi / (48 * 32);
          char* xs = smem + w * 12800;
          const int gp = g * 64 + lane;
          bf16x8 ah[8], al[8];
          s5_load_bfrag(bbar, g, l15, g4, ah, al);
          const float2 ab = abar[gp];
#pragma unroll 1
          for (int ci = 0; ci < 4; ++ci) {
          const int c = cg * 4 + ci;
          const u16* ub0 = ubuf + ((size_t)(b * L_ + c * 64 + l15)) * 768 + g * 16;
          u32x4 uq[4];
#pragma unroll
          for (int sub = 0; sub < 4; ++sub) {
            uq[sub] = u32x4{0u, 0u, 0u, 0u};
            if (g4 < 2) uq[sub] = *(const u32x4*)(ub0 + (size_t)sub * 16 * 768 + g4 * 8);
          }
          float hr = 0.f, hi = 0.f;
#pragma unroll
          for (int sub = 0; sub < 4; ++sub) {
            s5_xsub(uq[sub], ah, al, xs, l15, g4);
            asm volatile("s_waitcnt lgkmcnt(0)" ::: "memory");
#pragma unroll
            for (int tt = 0; tt < 16; ++tt) {
              const float xr = *(const float*)(xs + tt * 528 + lane * 4);
              const float xi = *(const float*)(xs + tt * 528 + 256 + lane * 4);
              const float nhr = ab.x * hr - ab.y * hi + xr;
              const float nhi = ab.x * hi + ab.y * hr + xi;
              hr = nhr; hi = nhi;
            }
            asm volatile("s_waitcnt lgkmcnt(0)" ::: "memory");
          }
          Sst[((size_t)(b * 128 + c) * 48 + g) * 64 + lane] = make_float2(hr, hi);
          }
          __syncthreads();
#endif
        }
      }
    }
    SYNC_BEFORE(3);
    if (PH(3)) {
      TIDVARS
      for (int wi = bid * 4 + w; wi < 192; wi += nblk * 4) {
        const int g = wi % 48, b = wi / 48;
        const float2 ab = abar[g * 64 + lane];
        float a64r = ab.x, a64i = ab.y;
#pragma unroll
        for (int q = 0; q < 6; ++q) {
          const float nr = a64r * a64r - a64i * a64i, ni = 2.f * a64r * a64i;
          a64r = nr; a64i = ni;
        }
        float2* sp = Sst + ((size_t)(b * 128) * 48 + g) * 64 + lane;
        float hr = 0.f, hi = 0.f;
        for (int cc = 0; cc < 128; cc += 16) {
          float2 sv[16];
#pragma unroll
          for (int q = 0; q < 16; ++q) sv[q] = sp[(size_t)(cc + q) * 48 * 64];
#pragma unroll
          for (int q = 0; q < 16; ++q) {
            sp[(size_t)(cc + q) * 48 * 64] = make_float2(hr, hi);
            const float nhr = a64r * hr - a64i * hi + sv[q].x;
            const float nhi = a64r * hi + a64i * hr + sv[q].y;
            hr = nhr; hi = nhi;
          }
        }
      }
    }
    SYNC_BEFORE(4);
    if (PH(4)) {
      TIDVARS
      for (int it = bid; it < 1536; it += nblk) {
        const int wi = it * 4 + w;
        const int g = wi % 48, cg = (wi / 48) & 31, b = wi / (48 * 32);
        char* xs = smem + w * 12800;
        char* stt = xs + 8448;
        const int gp = g * 64 + lane;
        bf16x8 ah[8], al[8];
        s5_load_bfrag(bbar, g, l15, g4, ah, al);
        const float2 ab = abar[gp];
        bf16x8 cf[4];
#pragma unroll
        for (int s = 0; s < 4; ++s) {
          const float* cs = (s < 2 ? p.c_re : p.c_im) + (size_t)(g * 16 + l15) * 64 + (s & 1) * 32 + g4 * 8;
          float4 t0 = *(const float4*)cs, t1 = *(const float4*)(cs + 4);
          const float sg = (s < 2) ? 1.f : -1.f;
          u32x4 t = pack8_mfma(sg * t0.x, sg * t0.y, sg * t0.z, sg * t0.w, sg * t1.x, sg * t1.y, sg * t1.z, sg * t1.w);
          cf[s] = __builtin_bit_cast(bf16x8, t);
        }
        const float4 dsk = *(const float4*)(p.s5_d + g * 16 + g4 * 4);
#pragma unroll 1
        for (int ci = 0; ci < 4; ++ci) {
        const int c = cg * 4 + ci;
        const u16* ub0 = ubuf + ((size_t)(b * L_ + c * 64 + l15)) * 768 + g * 16;
        const float2 hc = Sst[((size_t)(b * 128 + c) * 48 + g) * 64 + lane];
        float hr = hc.x, hi = hc.y;
        u32x4 uq[4];
        u32x2 uvq[4];
#pragma unroll
        for (int sub = 0; sub < 4; ++sub) {
          uq[sub] = u32x4{0u, 0u, 0u, 0u};
          if (g4 < 2) uq[sub] = *(const u32x4*)(ub0 + (size_t)sub * 16 * 768 + g4 * 8);
          uvq[sub] = *(const u32x2*)(ub0 + (size_t)sub * 16 * 768 + g4 * 4);
        }
        asm volatile("s_waitcnt lgkmcnt(0)" ::: "memory");
#pragma unroll
        for (int sub = 0; sub < 4; ++sub) {
          s5_xsub(uq[sub], ah, al, xs, l15, g4);
          asm volatile("s_waitcnt lgkmcnt(0)" ::: "memory");
#pragma unroll
          for (int tt = 0; tt < 16; ++tt) {
            const float xr = *(const float*)(xs + tt * 528 + lane * 4);
            const float xi = *(const float*)(xs + tt * 528 + 256 + lane * 4);
            const float nhr = ab.x * hr - ab.y * hi + xr;
            const float nhi = ab.x * hi + ab.y * hr + xi;
            hr = nhr; hi = nhi;
            *(u16*)(stt + tt * 272 + lane * 2) = f2bf(hr);
            *(u16*)(stt + tt * 272 + 128 + lane * 2) = f2bf(hi);
          }
          asm volatile("s_waitcnt lgkmcnt(0)" ::: "memory");
          f32x4 y = {0, 0, 0, 0};
#pragma unroll
          for (int s = 0; s < 4; ++s) {
            bf16x8 bfr = *(const bf16x8*)(stt + l15 * 272 + s * 64 + g4 * 16);
            y = mfma16(cf[s], bfr, y);
          }
          const int t = sub * 16 + l15;
          const u32x2 uv = uvq[sub];
          float o0 = gelu_tanh(y[0] + dsk.x * bflo(uv[0]));
          float o1 = gelu_tanh(y[1] + dsk.y * bfhi(uv[0]));
          float o2 = gelu_tanh(y[2] + dsk.z * bflo(uv[1]));
          float o3 = gelu_tanh(y[3] + dsk.w * bfhi(uv[1]));
          u32x2 o = {pack2(o0, o1), pack2(o2, o3)};
          *(u32x2*)(ys5a + ((size_t)(b * L_ + c * 64 + t)) * 768 + g * 16 + g4 * 4) = o;
          asm volatile("s_waitcnt lgkmcnt(0)" ::: "memory");
        }
        }
        __syncthreads();
      }
    }
    SYNC_BEFORE(5);
    if (PH(5)) {
      TIDVARS
      for (int v = bid; v < 256 * 6; v += nblk) {
        int mt, nt;
        swz(v, 6, 6, mt, nt);
        const int m0 = mt * 128, n0 = nt * 128;
        f32x4 acc[4][4];
        zero_acc(acc);
        const u16 *An5 = nullptr, *Bn5 = nullptr;
        if (v + nblk < 256 * 6) { int mtn, ntn; swz(v + nblk, 6, 6, mtn, ntn); An5 = ys5a + (size_t)(mtn * 128) * 768; Bn5 = WgluT + (size_t)(ntn * 128) * 768; }
        gemm_core<true, 1, false, true>(acc, ys5a + (size_t)m0 * 768, 768, WgluT + (size_t)n0 * 768, 768, 768, smem, v != bid, An5, 768, Bn5, 768);
        const int wr = w >> 1, wc = w & 1;
#pragma unroll
        for (int i = 0; i < 4; ++i) {
          const size_t row = (size_t)(m0 + wr * 64 + i * 16 + l15);
#pragma unroll
          for (int j = 0; j < 4; ++j) {
            const int n = n0 + wc * 64 + j * 16 + g4 * 4;
            const float4 bg = *(const float4*)(p.b_glu + n);
            const u32x2 av = *(const u32x2*)(ys5a + row * 768 + n);
            const u32x2 sv = *(const u32x2*)(gsbuf + row * 768 + n);
            float o0 = bflo(av[0]) * sigmoidf_(acc[i][j][0] + bg.x) * bflo(sv[0]);
            float o1 = bfhi(av[0]) * sigmoidf_(acc[i][j][1] + bg.y) * bfhi(sv[0]);
            float o2 = bflo(av[1]) * sigmoidf_(acc[i][j][2] + bg.z) * bflo(sv[1]);
            float o3 = bfhi(av[1]) * sigmoidf_(acc[i][j][3] + bg.w) * bfhi(sv[1]);
            u32x2 o = {pack2(o0, o1), pack2(o2, o3)};
            *(u32x2*)(ubuf + row * 768 + n) = o;
          }
        }
      }
    }
    SYNC_BEFORE(6);
    if (PH(6)) {
      TIDVARS
      for (int v = bid; v < 256 * 8; v += nblk) {
        int mt, nt;
        swz(v, 8, 4, mt, nt);
        const int m0 = mt * 128, n0 = nt * 128;
        const int wr = w >> 1, wc = w & 1;
        char* gstash = ws + OFF_GATE + (size_t)bid * 32768;
        f32x4 accm[4][4];
        zero_acc(accm);
        unsigned gt[4][4][2];
#pragma unroll 1
        for (int stp = 0; stp < 6; ++stp) {
          const int br = stp >> 1;
          const u16* Ab; const u16* Wb; int Kb; int ldk;
          if (!(stp & 1)) { Ab = hbuf + (size_t)m0 * KLD; Wb = WglT + (size_t)(br * 1024 + n0) * KLD; Kb = 1024; }
          else if (br == 0) { Ab = qbuf + (size_t)m0 * 768; Wb = WpfT + (size_t)n0 * 768; Kb = 768; }
          else if (br == 1) { Ab = ubuf + (size_t)m0 * 768; Wb = WpsT + (size_t)n0 * 768; Kb = 768; }
          else { Ab = qmbuf + (size_t)m0 * 512; Wb = WpmT + (size_t)n0 * 512; Kb = 512; }
          f32x4 acc[4][4];
          zero_acc(acc);
          ldk = (Kb == 1024) ? KLD : Kb;
          gemm_core<true, 1, true>(acc, Ab, ldk, Wb, ldk, Kb, smem);
          if (!(stp & 1)) {
#pragma unroll
            for (int j = 0; j < 4; ++j) {
              const float4 bm = *(const float4*)(p.b_merge + br * 1024 + n0 + wc * 64 + j * 16 + g4 * 4);
#pragma unroll
              for (int i = 0; i < 4; ++i) {
                gt[i][j][0] = pack2(sigmoidf_(acc[i][j][0] + bm.x), sigmoidf_(acc[i][j][1] + bm.y));
                gt[i][j][1] = pack2(sigmoidf_(acc[i][j][2] + bm.z), sigmoidf_(acc[i][j][3] + bm.w));
              }
            }
          } else {
#pragma unroll
            for (int j = 0; j < 4; ++j)
#pragma unroll
              for (int i = 0; i < 4; ++i) {
                accm[i][j][0] += bflo(gt[i][j][0]) * acc[i][j][0];
                accm[i][j][1] += bfhi(gt[i][j][0]) * acc[i][j][1];
                accm[i][j][2] += bflo(gt[i][j][1]) * acc[i][j][2];
                accm[i][j][3] += bfhi(gt[i][j][1]) * acc[i][j][3];
              }
            if (br == 2) epi_rowmajor_direct(accm, merged, KLD, m0, n0, 0);
          }
        }
      }
    }
    SYNC_BEFORE(7);
    if (PH(7)) {
      TIDVARS
      for (int v = bid; v < 256 * 8; v += nblk) {
        int mt, nt;
        swz(v, 8, 4, mt, nt);
        const int m0 = mt * 128, n0 = nt * 128;
        const int wr = w >> 1, wc = w & 1;
        f32x4 acc[4][4];
        zero_acc(acc);
        const u16 *An7 = nullptr, *Bn7 = nullptr;
        if (v + nblk < 256 * 8) { int mtn, ntn; swz(v + nblk, 8, 4, mtn, ntn); An7 = merged + (size_t)(mtn * 128) * KLD; Bn7 = WoutT + (size_t)(ntn * 128) * KLD; }
        gemm_core<true, 1, false, true>(acc, merged + (size_t)m0 * KLD, KLD, WoutT + (size_t)n0 * KLD, KLD, 1024, smem, v != bid, An7, KLD, Bn7, KLD);
#pragma unroll
        for (int i = 0; i < 4; ++i) {
          const size_t row = (size_t)(m0 + wr * 64 + i * 16 + l15);
          float ss = 0.f;
#pragma unroll
          for (int j = 0; j < 4; ++j) {
            const int n = n0 + wc * 64 + j * 16 + g4 * 4;
            const float4 xv = *(const float4*)(p.x + row * 1024 + n);
            float4 o = make_float4(xv.x + acc[i][j][0], xv.y + acc[i][j][1], xv.z + acc[i][j][2], xv.w + acc[i][j][3]);
            ss += o.x * o.x + o.y * o.y + o.z * o.z + o.w * o.w;
            *(float4*)(p.out + row * 1024 + n) = o;
          }
          ss += __shfl_xor(ss, 16);
          ss += __shfl_xor(ss, 32);
          if (g4 == 0) part[row * 16 + nt * 2 + wc] = ss;
        }
      }
    }
    SYNC_BEFORE(8);
    if (PH(8)) {
      TIDVARS
      for (int row = bid * 4 + w; row < T_; row += nblk * 8) {
        const int row2 = row + nblk * 4;
        const bool has2 = row2 < T_;
        float ssa = (lane < 16) ? part[(size_t)row * 16 + lane] : 0.f;
        float ssb = (has2 && lane < 16) ? part[(size_t)row2 * 16 + lane] : 0.f;
        float* oa = p.out + (size_t)row * 1024;
        float* ob = p.out + (size_t)(has2 ? row2 : row) * 1024;
        float4 va[4], vb[4];
#pragma unroll
        for (int i = 0; i < 4; ++i) {
          va[i] = *(const float4*)(oa + i * 256 + lane * 4);
          vb[i] = *(const float4*)(ob + i * 256 + lane * 4);
        }
        ssa = wave_sum(ssa);
        ssb = wave_sum(ssb);
        const float ra = rsqrtf(ssa * (1.f / 1024.f) + 1e-6f);
        const float rb = rsqrtf(ssb * (1.f / 1024.f) + 1e-6f);
#pragma unroll
        for (int i = 0; i < 4; ++i) {
          const float4 gv = *(const float4*)(p.g_final + i * 256 + lane * 4);
          va[i].x *= ra * gv.x; va[i].y *= ra * gv.y; va[i].z *= ra * gv.z; va[i].w *= ra * gv.w;
          *(float4*)(oa + i * 256 + lane * 4) = va[i];
          if (has2) {
            vb[i].x *= rb * gv.x; vb[i].y *= rb * gv.y; vb[i].z *= rb * gv.z; vb[i].w *= rb * gv.w;
            *(float4*)(ob + i * 256 + lane * 4) = vb[i];
          }
        }
      }
    }
  }
}

extern "C" void kernel_launch(void* const* d_in, const int* in_sizes, int n_in, void* d_out, int out_size, void* d_ws,
                              size_t ws_size, hipStream_t stream) {
  static int grid_blocks = 0;
  if (!grid_blocks) {
    if (ws_size < WS_END || n_in != 23) {
      fprintf(stderr, "kernel_launch: unexpected ws_size %zu (need %zu) or n_in %d\n", ws_size, (size_t)WS_END, n_in);
      grid_blocks = -1;
      return;
    }
    int dev = 0, cus = 0, per_cu = 0;
    (void)hipGetDevice(&dev);
    (void)hipDeviceGetAttribute(&cus, hipDeviceAttributeMultiprocessorCount, dev);
    (void)hipFuncSetAttribute((const void*)mega, hipFuncAttributeMaxDynamicSharedMemorySize, LDS_BYTES);
    (void)hipOccupancyMaxActiveBlocksPerMultiprocessor(&per_cu, (const void*)mega, 256, LDS_BYTES);
    per_cu = (per_cu >= 2) ? 2 : 1;
    grid_blocks = cus * per_cu;
  }
  if (grid_blocks < 0) return;
  Params p{};
  const float** pp = (const float**)&p;
  for (int i = 0; i < 23; ++i) pp[i] = (const float*)d_in[i];
  p.out = (float*)d_out;
  p.ws = (char*)d_ws;
#if COOP
  (void)hipMemsetAsync((char*)d_ws + OFF_CTL + 4096, 0, XCD_BAR_WORDS * 4, stream);
  p.phase_lo = 0;
  p.phase_hi = NPHASE - 1;
  void* args[] = {&p};
  hipError_t e = hipLaunchCooperativeKernel((const void*)mega, dim3(grid_blocks), dim3(256), args, LDS_BYTES, stream);
  if (e != hipSuccess) fprintf(stderr, "cooperative launch failed: %s (grid %d)\n", hipGetErrorString(e), grid_blocks);
#else
  for (int ph = 0; ph < NPHASE; ++ph) {
    p.phase_lo = ph;
    p.phase_hi = ph;
    hipLaunchKernelGGL(mega, dim3(grid_blocks), dim3(256), LDS_BYTES, stream, p);
#ifdef PROBE_DUP
    if (ph == PROBE_DUP) {
      for (int rep = 0; rep < 2; ++rep) {
        if (ph == 2) { p.phase_lo = p.phase_hi = 1; hipLaunchKernelGGL(mega, dim3(grid_blocks), dim3(256), LDS_BYTES, stream, p); p.phase_lo = p.phase_hi = 2; }
        hipLaunchKernelGGL(mega, dim3(grid_blocks), dim3(256), LDS_BYTES, stream, p);
      }
    }
#endif
  }
#endif
}
```

```cpp
#include <hip/hip_runtime.h>
#include <hip/hip_cooperative_groups.h>
#include <stdint.h>
#include <stdio.h>
namespace cg = cooperative_groups;

#ifndef COOP
#define COOP 1
#define XCD_MODE 0
#endif

#define DI __device__ __forceinline__
#ifdef ONLY_PHASE
#define PH(n) ((n) == ONLY_PHASE && p.phase_lo <= (n) && (n) <= p.phase_hi)
#else
#define PH(n) (p.phase_lo <= (n) && (n) <= p.phase_hi)
#endif
#define SYNC_BEFORE(n)                                        \
  if (p.phase_lo < (n) && (n) <= p.phase_hi) {                \
    xcd_barrier(xb);                                          \
  }
typedef unsigned short u16;
using bf16x8 = __attribute__((ext_vector_type(8))) short;
using f32x4 = __attribute__((ext_vector_type(4))) float;
using u32x4 = __attribute__((ext_vector_type(4))) unsigned;
using u32x2 = __attribute__((ext_vector_type(2))) unsigned;

constexpr int T_ = 32768, L_ = 8192;
constexpr int LDS_BYTES = 73728;
constexpr int NPHASE = 9;

constexpr size_t MiB = 1u << 20;
constexpr float LOG2E = 1.4426950408889634f;
constexpr float QSCALE = 0.125f * LOG2E;
constexpr int KLD = 1088;
constexpr size_t OFF_H = 0;
constexpr size_t OFF_Q = 68 * MiB;
constexpr size_t OFF_GF = 116 * MiB;
constexpr size_t OFF_U = 164 * MiB;
constexpr size_t OFF_GS = 212 * MiB;
constexpr size_t OFF_YS5A = 260 * MiB;
constexpr size_t OFF_QM = 308 * MiB;
constexpr size_t OFF_GM = 340 * MiB;
constexpr size_t OFF_MERGED = 372 * MiB;
constexpr size_t OFF_WINT = 440 * MiB;
constexpr size_t OFF_WGLT = 453 * MiB;
constexpr size_t OFF_WKVT = 460 * MiB;
constexpr size_t OFF_WOUTT = 463 * MiB;
constexpr size_t OFF_WPFT = 466 * MiB;
constexpr size_t OFF_WPST = 468 * MiB;
constexpr size_t OFF_WPMT = 470 * MiB;
constexpr size_t OFF_WGLUT = 471 * MiB;
constexpr size_t OFF_MEMN = 473 * MiB;
constexpr size_t OFF_MK = 476 * MiB;
constexpr size_t OFF_MVT = 477 * MiB;
constexpr size_t OFF_LOGF = 478 * MiB;
constexpr size_t OFF_F = 480 * MiB;
constexpr size_t OFF_S5AB = 482 * MiB;
constexpr size_t OFF_S5BB = 483 * MiB;
constexpr size_t OFF_S5S = 484 * MiB;
constexpr size_t OFF_PART = 496 * MiB;
constexpr size_t OFF_GATE = OFF_GS;
constexpr size_t OFF_CTL = 498 * MiB;
constexpr size_t WS_END = 499 * MiB;

struct Params {
  const float *x, *mem, *g_norm, *g_mem_norm, *g_final, *w_in, *b_forget, *b_merge, *w_mem_kv;
  const float *lam_re, *lam_im, *log_step, *b_re, *b_im, *c_re, *c_im, *s5_d, *w_glu, *b_glu;
  const float *w_pf, *w_ps, *w_pm, *w_out;
  float* out;
  char* ws;
  int phase_lo, phase_hi;
};

DI unsigned pack2(float a, float b) {
  unsigned r;
  asm volatile("v_cvt_pk_bf16_f32 %0, %1, %2" : "=v"(r) : "v"(a), "v"(b));
  return r;
}
DI u32x4 pack8_mfma(float a0, float a1, float a2, float a3, float a4, float a5, float a6, float a7) {
  u32x4 r;
  asm volatile("v_cvt_pk_bf16_f32 %0, %4, %5\n\tv_cvt_pk_bf16_f32 %1, %6, %7\n\tv_cvt_pk_bf16_f32 %2, %8, %9\n\tv_cvt_pk_bf16_f32 %3, %10, %11\n\ts_nop 1"
               : "=&v"(r[0]), "=&v"(r[1]), "=&v"(r[2]), "=&v"(r[3])
               : "v"(a0), "v"(a1), "v"(a2), "v"(a3), "v"(a4), "v"(a5), "v"(a6), "v"(a7));
  return r;
}
DI u16 f2bf(float x) { return (u16)(pack2(x, x) & 0xffffu); }
DI float bflo(unsigned v) { return __uint_as_float(v << 16); }
DI float bfhi(unsigned v) { return __uint_as_float(v & 0xffff0000u); }
DI float sigmoidf_(float x) { return 1.f / (1.f + __expf(-x)); }
DI float siluf_(float x) { return x / (1.f + __expf(-x)); }
DI float gelu_tanh(float x) {
  float z = 0.7978845608028654f * (x + 0.044715f * x * x * x);
  float e = __expf(2.f * z);
  float th = 1.f - 2.f / (e + 1.f);
  return 0.5f * x * (1.f + th);
}
DI float wave_sum(float v) {
#pragma unroll
  for (int o = 32; o > 0; o >>= 1) v += __shfl_xor(v, o);
  return v;
}
DI f32x4 mfma16(bf16x8 a, bf16x8 b, f32x4 c) { return __builtin_amdgcn_mfma_f32_16x16x32_bf16(a, b, c, 0, 0, 0); }

template <bool SWAP, int DEPTH = 1, bool LEAN = false, bool NEXTPF = false>
DI void gemm_core(f32x4 (&acc)[4][4], const u16* __restrict__ A, int lda, const u16* __restrict__ Bt, int ldb, int K, char* smem,
                  bool preloaded = false, const u16* An = nullptr, int ldan = 0, const u16* Btn = nullptr, int ldbn = 0) {
  const int tid = threadIdx.x, lane = tid & 63, w = tid >> 6, wr = w >> 1, wc = w & 1, l15 = lane & 15, g = lane >> 4;
  const int lrow = tid >> 3, lch = tid & 7;
  const char* ap = (const char*)A;
  const char* bp = (const char*)Bt;
  const unsigned aoff = (unsigned)(lrow * lda + lch * 8) * 2u;
  const unsigned boff = (unsigned)(lrow * ldb + lch * 8) * 2u;
  u32x4 ra0[4], rb0[4], ra1[4], rb1[4];
  const int nk = K >> 6;
#define G_LOAD(RA, RB, KT)                                                        \
  _Pragma("unroll") for (int c = 0; c < 4; ++c) {                                 \
    RA[c] = *(const u32x4*)(ap + ((size_t)c * 64 * lda + (KT) * 128) + aoff);     \
    RB[c] = *(const u32x4*)(bp + ((size_t)c * 64 * ldb + (KT) * 128) + boff);     \
  }
#define G_STORE(RA, RB, BO)                                                       \
  _Pragma("unroll") for (int c = 0; c < 4; ++c) {                                 \
    *(u32x4*)(wbase + (BO) + c * 32 * 128) = RA[c];                               \
    *(u32x4*)(wbase + (BO) + 16384 + c * 32 * 128) = RB[c];                       \
  }
#define G_COMPUTE_FULL(BO)                                                             \
  {                                                                               \
    bf16x8 af[2][4], bfr[2][4];                                                   \
    _Pragma("unroll") for (int i = 0; i < 4; ++i) af[0][i] = *(const bf16x8*)(ard0 + (BO) + i * 16 * 128);  \
    _Pragma("unroll") for (int j = 0; j < 4; ++j) bfr[0][j] = *(const bf16x8*)(brd0 + (BO) + j * 16 * 128); \
    _Pragma("unroll") for (int i = 0; i < 4; ++i) af[1][i] = *(const bf16x8*)(ard1 + (BO) + i * 16 * 128);  \
    _Pragma("unroll") for (int j = 0; j < 4; ++j) bfr[1][j] = *(const bf16x8*)(brd1 + (BO) + j * 16 * 128); \
    __builtin_amdgcn_sched_barrier(0);                                            \
    __builtin_amdgcn_s_setprio(1);                                                \
    _Pragma("unroll") for (int s = 0; s < 2; ++s)                                 \
      _Pragma("unroll") for (int i = 0; i < 4; ++i)                               \
        _Pragma("unroll") for (int j = 0; j < 4; ++j)                             \
          acc[i][j] = SWAP ? mfma16(bfr[s][j], af[s][i], acc[i][j]) : mfma16(af[s][i], bfr[s][j], acc[i][j]); \
    __builtin_amdgcn_s_setprio(0);                                                \
  }
#define G_COMPUTE_LEAN(BO)                                                        \
  _Pragma("unroll") for (int s = 0; s < 2; ++s) {                                 \
    bf16x8 af[4];                                                                 \
    _Pragma("unroll") for (int i = 0; i < 4; ++i) af[i] = *(const bf16x8*)((s ? ard1 : ard0) + (BO) + i * 16 * 128);  \
    _Pragma("unroll") for (int j = 0; j < 4; ++j) {                               \
      const bf16x8 bfr = *(const bf16x8*)((s ? brd1 : brd0) + (BO) + j * 16 * 128);   \
      _Pragma("unroll") for (int i = 0; i < 4; ++i)                               \
        acc[i][j] = SWAP ? mfma16(bfr, af[i], acc[i][j]) : mfma16(af[i], bfr, acc[i][j]); \
    }                                                                             \
  }
#define G_COMPUTE(BO) if constexpr (LEAN) { G_COMPUTE_LEAN(BO) } else { G_COMPUTE_FULL(BO) }
  char* wbase = smem + lrow * 128 + ((lch ^ ((lrow >> 1) & 7)) << 4);
  const int hsw = l15 >> 1;
  const char* ard0 = smem + (wr * 64 + l15) * 128 + ((g ^ hsw) << 4);
  const char* ard1 = smem + (wr * 64 + l15) * 128 + (((4 + g) ^ hsw) << 4);
  const char* brd0 = smem + 16384 + (wc * 64 + l15) * 128 + ((g ^ hsw) << 4);
  const char* brd1 = smem + 16384 + (wc * 64 + l15) * 128 + (((4 + g) ^ hsw) << 4);
  if constexpr (DEPTH == 2) {
    G_LOAD(ra0, rb0, 0);
    G_LOAD(ra1, rb1, 1);
    G_STORE(ra0, rb0, 0);
    __syncthreads();
    for (int kt = 0; kt < nk; kt += 2) {
      if (kt + 2 < nk) G_LOAD(ra0, rb0, kt + 2);
      __builtin_amdgcn_sched_barrier(0);
      G_COMPUTE(0);
      __builtin_amdgcn_sched_barrier(0);
      G_STORE(ra1, rb1, 32768);
      __syncthreads();
      if (kt + 3 < nk) G_LOAD(ra1, rb1, kt + 3);
      __builtin_amdgcn_sched_barrier(0);
      G_COMPUTE(32768);
      __builtin_amdgcn_sched_barrier(0);
      if (kt + 2 < nk) G_STORE(ra0, rb0, 0);
      __syncthreads();
    }
  } else {
    const int grow = w * 8 + (lane >> 3);
    const int glc = (lane & 7) ^ ((w * 4 + (lane >> 4)) & 7);
    const unsigned gaoff = (unsigned)(grow * lda + glc * 8) * 2u;
    const unsigned gboff = (unsigned)(grow * ldb + glc * 8) * 2u;
    char* gl = smem + w * 1024 + lane * 16;
#define G_GLDS(KT, BO)                                                            \
  _Pragma("unroll") for (int c = 0; c < 4; ++c) {                                 \
    __builtin_amdgcn_global_load_lds((const unsigned*)(ap + ((size_t)c * 64 * lda + (size_t)(KT) * 128) + gaoff),          \
                                     (unsigned*)(gl + (BO) + c * 4096), 16, 0, 0);                                          \
    __builtin_amdgcn_global_load_lds((const unsigned*)(bp + ((size_t)c * 64 * ldb + (size_t)(KT) * 128) + gboff),          \
                                     (unsigned*)(gl + (BO) + 16384 + c * 4096), 16, 0, 0);                                  \
  }
    if (!(NEXTPF && preloaded)) {
      G_GLDS(0, 0)
      __syncthreads();
    }
    for (int kt = 0; kt < nk; kt += 2) {
      G_GLDS(kt + 1, 32768)
      __builtin_amdgcn_sched_barrier(0);
      G_COMPUTE(0);
      __syncthreads();
      if constexpr (!NEXTPF) {
        const int k2 = (kt + 2 < nk) ? kt + 2 : nk - 1;
        G_GLDS(k2, 0)
      } else if (kt + 2 < nk) {
        G_GLDS(kt + 2, 0)
      } else if (An) {
        const char* apn = (const char*)An;
        const char* bpn = (const char*)Btn;
        const unsigned gan = (unsigned)(grow * ldan + glc * 8) * 2u;
        const unsigned gbn = (unsigned)(grow * ldbn + glc * 8) * 2u;
#pragma unroll
        for (int c = 0; c < 4; ++c) {
          __builtin_amdgcn_global_load_lds((const unsigned*)(apn + ((size_t)c * 64 * ldan) + gan), (unsigned*)(gl + c * 4096), 16, 0, 0);
          __builtin_amdgcn_global_load_lds((const unsigned*)(bpn + ((size_t)c * 64 * ldbn) + gbn), (unsigned*)(gl + 16384 + c * 4096), 16, 0, 0);
        }
      }
      __builtin_amdgcn_sched_barrier(0);
      G_COMPUTE(32768);
      __syncthreads();
    }
#undef G_GLDS
  }
#undef G_LOAD
#undef G_STORE
#undef G_COMPUTE
#undef G_COMPUTE_FULL
#undef G_COMPUTE_LEAN
}

DI void zero_acc(f32x4 (&acc)[4][4]) {
#pragma unroll
  for (int i = 0; i < 4; ++i)
#pragma unroll
    for (int j = 0; j < 4; ++j) acc[i][j] = f32x4{0.f, 0.f, 0.f, 0.f};
}

DI void swz(int v, int NT, int GN, int& mt, int& nt) {
#if XCD_MODE == 0
  int xcd = v & 7, j = v >> 3;
#else
  int xcd = (v & 511) >> 6, j = ((v >> 9) << 6) + (v & 63);
#endif
  int per_mg = 8 * NT;
  int mg = j / per_mg, r = j - mg * per_mg;
  int ng = r / (8 * GN), wv = r - ng * (8 * GN);
  mt = xcd * 32 + mg * 8 + (wv & 7);
  nt = ng * GN + (wv >> 3);
}

DI void epi_rowmajor(const f32x4 (&acc)[4][4], u16* dst, int ld, int m0, int c0, int mode, char* smem) {
  const int tid = threadIdx.x, lane = tid & 63, w = tid >> 6, wr = w >> 1, wc = w & 1, l15 = lane & 15, g = lane >> 4;
#pragma unroll
  for (int i = 0; i < 4; ++i) {
    const int row = wr * 64 + i * 16 + l15;
#pragma unroll
    for (int j = 0; j < 4; ++j) {
      f32x4 v = acc[i][j];
      if (mode == 1) { v[0] *= QSCALE; v[1] *= QSCALE; v[2] *= QSCALE; v[3] *= QSCALE; }
      else if (mode == 2) { v[0] = siluf_(v[0]); v[1] = siluf_(v[1]); v[2] = siluf_(v[2]); v[3] = siluf_(v[3]); }
      u32x2 o = {pack2(v[0], v[1]), pack2(v[2], v[3])};
      *(u32x2*)(smem + row * 272 + (wc * 64 + j * 16 + g * 4) * 2) = o;
    }
  }
  __syncthreads();
#pragma unroll
  for (int c = 0; c < 8; ++c) {
    const int id = c * 256 + tid, row = id >> 4, ch = id & 15;
    const u32x4 v = *(const u32x4*)(smem + row * 272 + ch * 16);
    *(u32x4*)(dst + (size_t)(m0 + row) * ld + c0 + ch * 8) = v;
  }
  __syncthreads();
}
DI void epi_rowmajor_direct(const f32x4 (&acc)[4][4], u16* dst, int ld, int m0, int c0, int mode) {
  const int tid = threadIdx.x, lane = tid & 63, w = tid >> 6, wr = w >> 1, wc = w & 1, l15 = lane & 15, g = lane >> 4;
#pragma unroll
  for (int i = 0; i < 4; ++i) {
    const size_t row = (size_t)(m0 + wr * 64 + i * 16 + l15);
#pragma unroll
    for (int j = 0; j < 4; ++j) {
      f32x4 v = acc[i][j];
      if (mode == 1) { v[0] *= QSCALE; v[1] *= QSCALE; v[2] *= QSCALE; v[3] *= QSCALE; }
      else if (mode == 2) { v[0] = siluf_(v[0]); v[1] = siluf_(v[1]); v[2] = siluf_(v[2]); v[3] = siluf_(v[3]); }
      u32x2 o = {pack2(v[0], v[1]), pack2(v[2], v[3])};
      *(u32x2*)(dst + row * ld + c0 + wc * 64 + j * 16 + g * 4) = o;
    }
  }
}
DI void epi_transposed(const f32x4 (&acc)[4][4], u16* dst, int m0, int c0, int H, int lgDh, int lgLk) {
  const int tid = threadIdx.x, lane = tid & 63, w = tid >> 6, wr = w >> 1, wc = w & 1, l15 = lane & 15, g = lane >> 4;
#pragma unroll
  for (int i = 0; i < 4; ++i) {
    const int token = m0 + wr * 64 + i * 16 + g * 4;
    const int bidx = token >> lgLk, tl = token & ((1 << lgLk) - 1);
#pragma unroll
    for (int j = 0; j < 4; ++j) {
      const int col = c0 + wc * 64 + j * 16 + l15;
      const int head = col >> lgDh, d = col & ((1 << lgDh) - 1);
      f32x4 v = acc[i][j];
      u32x2 o = {pack2(v[0], v[1]), pack2(v[2], v[3])};
      *(u32x2*)(dst + ((((((size_t)bidx * H + head) << lgDh) + d) << lgLk) + tl)) = o;
    }
  }
}

template <int D, bool FOX, bool PF, int NQ>
DI void attn_item(const u16* __restrict__ qbase, int ldq, const u16* __restrict__ kbase, int ldk,
                  const u16* __restrict__ vtbase, int ldv, const float* __restrict__ Fseq, int q0, int nkv,
                  const u16* __restrict__ gate, u16* outp, float scale, float kmaxv, char* smem) {
  const int tid = threadIdx.x, lane = tid & 63, w = tid >> 6, l15 = lane & 15, g = lane >> 4;
  constexpr int KROW = D * 2 + 16;
  constexpr int KBYTES = 64 * KROW;
  constexpr int VBYTES = D * 144;
  constexpr int BUF = KBYTES + VBYTES + 256;
  constexpr int NL = D / 32;
  constexpr int KCH = D / 8;
  static_assert(2 * BUF <= LDS_BYTES, "attn lds");

  bf16x8 qf[NQ][D / 32];
#pragma unroll
  for (int qi = 0; qi < NQ; ++qi)
#pragma unroll
    for (int s = 0; s < D / 32; ++s)
      qf[qi][s] = *(const bf16x8*)(qbase + (size_t)(w * (16 * NQ) + qi * 16 + l15) * ldq + s * 32 + g * 8);
  float fq[NQ];
#pragma unroll
  for (int qi = 0; qi < NQ; ++qi) fq[qi] = FOX ? Fseq[q0 + w * (16 * NQ) + qi * 16 + l15] : 0.f;
  f32x4 ot[D / 16][NQ];
#pragma unroll
  for (int dt = 0; dt < D / 16; ++dt)
#pragma unroll
    for (int qi = 0; qi < NQ; ++qi) ot[dt][qi] = f32x4{0, 0, 0, 0};
  float mrun[NQ], lsum[NQ];
#pragma unroll
  for (int qi = 0; qi < NQ; ++qi) { mrun[qi] = -1e30f; lsum[qi] = 0.f; }
  float qk[NQ];
#pragma unroll
  for (int qi = 0; qi < NQ; ++qi) {
    float ss = 0.f;
    if (FOX) {
#pragma unroll
      for (int s = 0; s < D / 32; ++s)
#pragma unroll
        for (int e = 0; e < 8; ++e) {
          const float v = __uint_as_float(((unsigned)(unsigned short)qf[qi][s][e]) << 16);
          ss += v * v;
        }
      ss += __shfl_xor(ss, 16);
      ss += __shfl_xor(ss, 32);
    }
    qk[qi] = sqrtf(ss) * kmaxv * 1.002f + 1e-3f;
  }
  int* flags = (int*)(smem + 73664);

  u32x4 kr[NL], vr[NL];
  f32x4 fr = {0, 0, 0, 0};
#define krow(c) (((c) * 256 + tid) / KCH)
#define kch(c) (((c) * 256 + tid) % KCH)
#define vrow(c) (((c) * 256 + tid) >> 3)
#define vch(c) (tid & 7)
#define ATT_LOAD(J)                                                                                   \
  {                                                                                                   \
    const int s0_ = (J) * 64;                                                                         \
    _Pragma("unroll") for (int c = 0; c < NL; ++c) {                                                  \
      kr[c] = *(const u32x4*)(kbase + (size_t)(s0_ + krow(c)) * ldk + kch(c) * 8);                    \
      vr[c] = *(const u32x4*)(vtbase + (size_t)vrow(c) * ldv + s0_ + vch(c) * 8);                     \
    }                                                                                                 \
    if (FOX && tid < 16) fr = *(const f32x4*)(Fseq + s0_ + tid * 4);                                  \
  }
#define ATT_STORE(BO)                                                                                 \
  {                                                                                                   \
    char* b_ = smem + (BO);                                                                           \
    _Pragma("unroll") for (int c = 0; c < NL; ++c) {                                                  \
      *(u32x4*)(b_ + krow(c) * KROW + kch(c) * 16) = kr[c];                                           \
      *(u32x4*)(b_ + KBYTES + vrow(c) * 144 + vch(c) * 16) = vr[c];                                   \
    }                                                                                                 \
    if (FOX && tid < 16) *(f32x4*)(b_ + KBYTES + VBYTES + tid * 16) = fr;                             \
  }
  ATT_LOAD(nkv - 1);
  ATT_STORE(0);
  __syncthreads();
  const int qlo = q0 + w * (16 * NQ);
  for (int j = nkv - 1, itn = 0; j >= 0; --j, ++itn) {
    const int cur = (itn & 1) * BUF;
    if (j > 0) {
      ATT_LOAD(j - 1);
      if (!PF) ATT_STORE(cur ^ BUF);
    }
    __builtin_amdgcn_sched_barrier(0);
    bool ok = false;
    const int s0 = j * 64;
    const bool active = !FOX || (s0 <= qlo + 16 * NQ - 1);
    if (active) {
      const char* Ks = smem + cur;
      const char* Vs = smem + cur + KBYTES;
      const char* Fs = smem + cur + KBYTES + VBYTES;
      f32x4 st[4][NQ];
#pragma unroll
      for (int kt = 0; kt < 4; ++kt)
#pragma unroll
        for (int qi = 0; qi < NQ; ++qi) st[kt][qi] = f32x4{0, 0, 0, 0};
#pragma unroll
      for (int s = 0; s < D / 32; ++s) {
        bf16x8 kf[4];
#pragma unroll
        for (int kt = 0; kt < 4; ++kt) kf[kt] = *(const bf16x8*)(Ks + (kt * 16 + l15) * KROW + s * 64 + g * 16);
#pragma unroll
        for (int kt = 0; kt < 4; ++kt)
#pragma unroll
          for (int qi = 0; qi < NQ; ++qi) st[kt][qi] = mfma16(kf[kt], qf[qi][s], st[kt][qi]);
      }
      if (FOX) {
        const bool need_mask = (s0 + 63 > qlo);
#pragma unroll
        for (int kt = 0; kt < 4; ++kt) {
          f32x4 fk = *(const f32x4*)(Fs + (kt * 16 + g * 4) * 4);
#pragma unroll
          for (int qi = 0; qi < NQ; ++qi) {
            const int qpos = qlo + qi * 16 + l15;
#pragma unroll
            for (int r = 0; r < 4; ++r) {
              float v = st[kt][qi][r] - fk[r];
              if (need_mask && (s0 + kt * 16 + g * 4 + r > qpos)) v = -1e30f;
              st[kt][qi][r] = v;
            }
          }
        }
      } else {
#pragma unroll
        for (int kt = 0; kt < 4; ++kt)
#pragma unroll
          for (int qi = 0; qi < NQ; ++qi)
#pragma unroll
            for (int r = 0; r < 4; ++r) st[kt][qi][r] *= scale;
      }
      float mxl[NQ];
      bool upd = false;
#pragma unroll
      for (int qi = 0; qi < NQ; ++qi) {
        float mx = st[0][qi][0];
#pragma unroll
        for (int kt = 0; kt < 4; ++kt)
#pragma unroll
          for (int r = 0; r < 4; ++r) mx = fmaxf(mx, st[kt][qi][r]);
        mxl[qi] = mx;
        upd = upd || (mx > mrun[qi]);
      }
      const bool resc = __any(upd);
      if (resc) {
#pragma unroll
        for (int qi = 0; qi < NQ; ++qi) {
          float mx = mxl[qi];
          mx = fmaxf(mx, __shfl_xor(mx, 16));
          mx = fmaxf(mx, __shfl_xor(mx, 32));
          const float mnew = fmaxf(mrun[qi], mx);
          const float al = __builtin_amdgcn_exp2f(mrun[qi] - mnew);
          mrun[qi] = mnew;
          lsum[qi] *= al;
#pragma unroll
          for (int dt = 0; dt < D / 16; ++dt)
#pragma unroll
            for (int r = 0; r < 4; ++r) ot[dt][qi][r] *= al;
        }
      }
#pragma unroll
      for (int qi = 0; qi < NQ; ++qi) {
        const float mref = mrun[qi];
        float ps = 0.f;
#pragma unroll
        for (int kt = 0; kt < 4; ++kt)
#pragma unroll
          for (int r = 0; r < 4; ++r) {
            float p = __builtin_amdgcn_exp2f(st[kt][qi][r] - mref);
            st[kt][qi][r] = p;
            ps += p;
          }
        lsum[qi] += ps;
      }
      bf16x8 pb[2][NQ];
#pragma unroll
      for (int kp = 0; kp < 2; ++kp)
#pragma unroll
        for (int qi = 0; qi < NQ; ++qi) {
          u32x4 t = pack8_mfma(st[2 * kp][qi][0], st[2 * kp][qi][1], st[2 * kp][qi][2], st[2 * kp][qi][3],
                               st[2 * kp + 1][qi][0], st[2 * kp + 1][qi][1], st[2 * kp + 1][qi][2], st[2 * kp + 1][qi][3]);
          pb[kp][qi] = __builtin_bit_cast(bf16x8, t);
        }
#pragma unroll
      for (int dt = 0; dt < D / 16; ++dt) {
#pragma unroll
        for (int kp = 0; kp < 2; ++kp) {
          u32x2 lo = *(const u32x2*)(Vs + (dt * 16 + l15) * 144 + (kp * 32 + g * 4) * 2);
          u32x2 hi = *(const u32x2*)(Vs + (dt * 16 + l15) * 144 + (kp * 32 + 16 + g * 4) * 2);
          u32x4 t = {lo[0], lo[1], hi[0], hi[1]};
          bf16x8 vf = __builtin_bit_cast(bf16x8, t);
#pragma unroll
          for (int qi = 0; qi < NQ; ++qi) ot[dt][qi] = mfma16(vf, pb[kp][qi], ot[dt][qi]);
        }
      }
      if (FOX) {
        const float f0 = *(const float*)Fs;
        ok = true;
#pragma unroll
        for (int qi = 0; qi < NQ; ++qi) ok = ok && (qk[qi] - f0 - mrun[qi] <= -30.f * LOG2E);
      }
    }
    __builtin_amdgcn_sched_barrier(0);
    if (PF && j > 0) ATT_STORE(cur ^ BUF);
    if (FOX) {
      const bool wave_ok = (__ballot(ok) == ~0ull);
      if (lane == 0) flags[(itn & 1) * 4 + w] = wave_ok ? 1 : 0;
      __syncthreads();
      const int* fl = flags + (itn & 1) * 4;
      if (fl[0] & fl[1] & fl[2] & fl[3]) break;
    } else {
      __syncthreads();
    }
  }
#undef ATT_LOAD
#undef ATT_STORE
#undef krow
#undef kch
#undef vrow
#undef vch
#pragma unroll
  for (int qi = 0; qi < NQ; ++qi) {
    float l = lsum[qi];
    l += __shfl_xor(l, 16);
    l += __shfl_xor(l, 32);
    const float inv = 1.f / l;
    const size_t rowoff = (size_t)(w * (16 * NQ) + qi * 16 + l15) * ldq;
#pragma unroll
    for (int dt = 0; dt < D / 16; ++dt) {
      const int col = dt * 16 + g * 4;
      u32x2 gv = *(const u32x2*)(gate + rowoff + col);
      u32x2 o = {pack2(ot[dt][qi][0] * inv * bflo(gv[0]), ot[dt][qi][1] * inv * bfhi(gv[0])),
                 pack2(ot[dt][qi][2] * inv * bflo(gv[1]), ot[dt][qi][3] * inv * bfhi(gv[1]))};
      *(u32x2*)(outp + rowoff + col) = o;
    }
  }
}

typedef float v2f __attribute__((ext_vector_type(2)));
DI void s5_load_u(const u16* ubuf, int b, int c, int g, char* ut, int lane) {
  const u16* src = ubuf + ((size_t)(b * L_ + c * 64 + lane)) * 768 + g * 16;
  u32x4 a = *(const u32x4*)src, bb = *(const u32x4*)(src + 8);
  f32x4 o0 = {bflo(a[0]), bfhi(a[0]), bflo(a[1]), bfhi(a[1])};
  f32x4 o1 = {bflo(a[2]), bfhi(a[2]), bflo(a[3]), bfhi(a[3])};
  f32x4 o2 = {bflo(bb[0]), bfhi(bb[0]), bflo(bb[1]), bfhi(bb[1])};
  f32x4 o3 = {bflo(bb[2]), bfhi(bb[2]), bflo(bb[3]), bfhi(bb[3])};
  *(f32x4*)(ut + lane * 64) = o0;
  *(f32x4*)(ut + lane * 64 + 16) = o1;
  *(f32x4*)(ut + lane * 64 + 32) = o2;
  *(f32x4*)(ut + lane * 64 + 48) = o3;
}
DI void s5_load_b(const float* bbar, int gp, v2f (&b2)[16]) {
#pragma unroll
  for (int q = 0; q < 4; ++q) {
    float4 t0 = *(const float4*)(bbar + (size_t)gp * 32 + q * 4);
    float4 t1 = *(const float4*)(bbar + (size_t)gp * 32 + 16 + q * 4);
    b2[4 * q] = v2f{t0.x, t1.x}; b2[4 * q + 1] = v2f{t0.y, t1.y};
    b2[4 * q + 2] = v2f{t0.z, t1.z}; b2[4 * q + 3] = v2f{t0.w, t1.w};
  }
}
DI v2f s5_x(const char* ut, int t, const v2f (&b2)[16]) {
  v2f xa = {0.f, 0.f}, xb = {0.f, 0.f};
#pragma unroll
  for (int q = 0; q < 4; ++q) {
    const f32x4 u = *(const f32x4*)(ut + t * 64 + q * 16);
    xa += b2[4 * q] * u[0];
    xb += b2[4 * q + 1] * u[1];
    xa += b2[4 * q + 2] * u[2];
    xb += b2[4 * q + 3] * u[3];
  }
  return xa + xb;
}

DI void s5_load_bfrag(const float* bbar, int g, int l15, int g4, bf16x8 (&ah)[8], bf16x8 (&al)[8]) {
#pragma unroll
  for (int kt = 0; kt < 8; ++kt) {
    u32x4 h = {0u, 0u, 0u, 0u}, l = {0u, 0u, 0u, 0u};
    if (g4 < 2) {
      const float* src = bbar + (size_t)(g * 64 + (kt & 3) * 16 + l15) * 32 + (kt >> 2) * 16 + g4 * 8;
      const float4 t0 = *(const float4*)src, t1 = *(const float4*)(src + 4);
      const float v[8] = {t0.x, t0.y, t0.z, t0.w, t1.x, t1.y, t1.z, t1.w};
#pragma unroll
      for (int q = 0; q < 4; ++q) {
        const unsigned h0 = f2bf(v[2 * q]), h1 = f2bf(v[2 * q + 1]);
        h[q] = h0 | (h1 << 16);
        l[q] = pack2(v[2 * q] - __uint_as_float(h0 << 16), v[2 * q + 1] - __uint_as_float(h1 << 16));
      }
    }
    ah[kt] = __builtin_bit_cast(bf16x8, h);
    al[kt] = __builtin_bit_cast(bf16x8, l);
  }
}
DI void s5_xsub(const u32x4 uraw, const bf16x8 (&ah)[8], const bf16x8 (&al)[8], char* xs, int l15, int g4) {
  const bf16x8 ub = __builtin_bit_cast(bf16x8, uraw);
#pragma unroll
  for (int kt = 0; kt < 8; ++kt) {
    f32x4 x = {0.f, 0.f, 0.f, 0.f};
    x = mfma16(ah[kt], ub, x);
    x = mfma16(al[kt], ub, x);
    *(f32x4*)(xs + l15 * 528 + (kt * 16 + g4 * 4) * 4) = x;
  }
}

#define XB_TMO      128
#define XB_XCNT(j)  (256  + 64 * (j))
#define XB_XSUB(j)  (1280 + 64 * (j))
#define XB_XGEN(j)  (2304 + 64 * (j))
#define XB_TOP      3328
#define XB_TOPGEN   3392
#define XCD_BAR_WORDS 3456
#define XB_SPIN_CAP (1u << 18)
DI unsigned xb_ld(unsigned* p) { return __hip_atomic_load(p, __ATOMIC_RELAXED, __HIP_MEMORY_SCOPE_AGENT); }
DI unsigned xb_add(unsigned* p, unsigned v) { return __hip_atomic_fetch_add(p, v, __ATOMIC_RELAXED, __HIP_MEMORY_SCOPE_AGENT); }
DI unsigned xb_xcc_id() { return (unsigned)__builtin_amdgcn_s_getreg((3 << 11) | 20) & 0xFu; }
#define XB_SPIN(cond, bar) do { unsigned _sp = 0; while (cond) { __builtin_amdgcn_s_sleep(1); \
    if ((++_sp & 255u) == 0u) { if (xb_ld(&(bar)[XB_TMO])) break; if (_sp > XB_SPIN_CAP) { atomicAdd(&(bar)[XB_TMO], 1u); break; } } } } while (0)
struct XcdBarrier { unsigned* bar; unsigned x; volatile unsigned* st; };
DI XcdBarrier xcd_barrier_post(unsigned* bar, volatile unsigned* st) {
  XcdBarrier b; b.bar = bar; b.x = xb_xcc_id(); b.st = st;
  if (threadIdx.x == 0) (void)xb_add(&bar[XB_XCNT(b.x)], 1u);
  return b;
}
DI void xcd_barrier_complete(unsigned* bar, unsigned x, unsigned& nloc, unsigned& nx) {
  const unsigned G = gridDim.x * gridDim.y * gridDim.z;
  unsigned sum, cnt, mine, sp = 0u;
  for (;;) {
    sum = 0u; cnt = 0u; mine = 0u;
#pragma unroll
    for (unsigned j = 0; j < 16; ++j) { const unsigned c = xb_ld(&bar[XB_XCNT(j)]); sum += c; cnt += (c > 0u) ? 1u : 0u; mine = (j == x) ? c : mine; }
    if (sum == G) break;
    __builtin_amdgcn_s_sleep(1);
    if ((++sp & 255u) == 0u) { if (xb_ld(&bar[XB_TMO])) break; if (sp > XB_SPIN_CAP) { atomicAdd(&bar[XB_TMO], 1u); break; } }
  }
  nloc = mine > 0u ? mine : 1u; nx = cnt > 0u ? cnt : 1u;
}
DI void xcd_barrier(const XcdBarrier& b) {
  asm volatile("s_waitcnt vmcnt(0)" ::: "memory");
  __syncthreads();
  if (threadIdx.x == 0) {
    unsigned* bar = b.bar;
    __builtin_amdgcn_s_waitcnt(0);
    unsigned nloc = b.st[0], nx = b.st[1];
    if (nloc == 0u) { xcd_barrier_complete(bar, b.x, nloc, nx); b.st[0] = nloc; b.st[1] = nx; }
    const unsigned old = xb_add(&bar[XB_XSUB(b.x)], 1u);
    const unsigned gen = old / nloc;
    if (old + 1u == (gen + 1u) * nloc) {
      __builtin_amdgcn_fence(__ATOMIC_RELEASE, "agent");
      asm volatile("s_waitcnt vmcnt(0)" ::: "memory");
      const unsigned og = xb_add(&bar[XB_TOP], 1u);
      const unsigned tg = og / nx;
      if (og + 1u == (tg + 1u) * nx) xb_add(&bar[XB_TOPGEN], 1u);
      else XB_SPIN(xb_ld(&bar[XB_TOPGEN]) == tg, bar);
      __builtin_amdgcn_fence(__ATOMIC_ACQUIRE, "agent");
      xb_add(&bar[XB_XGEN(b.x)], 1u);
      asm volatile("s_waitcnt vmcnt(0)" ::: "memory");
    } else {
      XB_SPIN(xb_ld(&bar[XB_XGEN(b.x)]) == gen, bar);
      __builtin_amdgcn_fence(__ATOMIC_ACQUIRE, "agent");
      asm volatile("s_waitcnt vmcnt(0)" ::: "memory");
    }
  }
  __syncthreads();
}

extern "C" __global__ void __launch_bounds__(256, 2) mega(Params p) {
  extern __shared__ __attribute__((aligned(16))) char smem[];
  cg::grid_group grid = cg::this_grid();
#define TIDVARS                                                                  \
  int tid = threadIdx.x;                                                         \
  asm volatile("" : "+v"(tid));                                                  \
  const int lane = tid & 63, w = tid >> 6, l15 = lane & 15, g4 = lane >> 4;      \
  (void)lane; (void)w; (void)l15; (void)g4;
  const int nblk = gridDim.x, bid = blockIdx.x;
  char* ws = p.ws;
  XcdBarrier xb;
  xb.bar = (unsigned*)(ws + OFF_CTL + 4096); xb.x = 0; xb.st = (volatile unsigned*)(smem + 73712);
  if (p.phase_lo < p.phase_hi) {
    if (threadIdx.x < 2) xb.st[threadIdx.x] = 0u;
    __syncthreads();
    xb = xcd_barrier_post((unsigned*)(ws + OFF_CTL + 4096), (volatile unsigned*)(smem + 73712));
    grid.sync();
  }
  u16* hbuf = (u16*)(ws + OFF_H);
  u16* qbuf = (u16*)(ws + OFF_Q);
  u16* gfbuf = (u16*)(ws + OFF_GF);
  u16* ubuf = (u16*)(ws + OFF_U);
  u16* gsbuf = (u16*)(ws + OFF_GS);
  u16* ys5a = (u16*)(ws + OFF_YS5A);
  u16* qmbuf = (u16*)(ws + OFF_QM);
  u16* gmbuf = (u16*)(ws + OFF_GM);
  u16* merged = (u16*)(ws + OFF_MERGED);
  u16* WinT = (u16*)(ws + OFF_WINT);
  u16* WglT = (u16*)(ws + OFF_WGLT);
  u16* WkvT = (u16*)(ws + OFF_WKVT);
  u16* WoutT = (u16*)(ws + OFF_WOUTT);
  u16* WpfT = (u16*)(ws + OFF_WPFT);
  u16* WpsT = (u16*)(ws + OFF_WPST);
  u16* WpmT = (u16*)(ws + OFF_WPMT);
  u16* WgluT = (u16*)(ws + OFF_WGLUT);
  u16* memn = (u16*)(ws + OFF_MEMN);
  u16* mkbuf = (u16*)(ws + OFF_MK);
  u16* mvT = (u16*)(ws + OFF_MVT);
  float* logf = (float*)(ws + OFF_LOGF);
  float* Fbuf = (float*)(ws + OFF_F);
  float2* abar = (float2*)(ws + OFF_S5AB);
  float* bbar = (float*)(ws + OFF_S5BB);
  float2* Sst = (float2*)(ws + OFF_S5S);
  float* part = (float*)(ws + OFF_PART);
  unsigned* ctl = (unsigned*)(ws + OFF_CTL);
  u16* kbuf = (u16*)p.out;
  u16* vT = (u16*)((char*)p.out + 48 * MiB);

  {
    if (PH(0)) {
      TIDVARS
      if (bid == 0 && tid < 128) ctl[tid] = 0u;
      float* tile = (float*)smem;
      for (int ti = bid; ti < 3344; ti += nblk) {
        const float* src; int ld, col0, K; u16* dst; int tt;
        if (ti < 576) { src = p.w_in; ld = 8716; col0 = 0; K = 1024; dst = WinT; tt = ti; }
        else if (ti < 1408) { src = p.w_in; ld = 8716; col0 = 2316; K = 1024; dst = WinT + (size_t)2304 * KLD; tt = ti - 576; }
        else if (ti < 2176) { src = p.w_in; ld = 8716; col0 = 5644; K = 1024; dst = WglT; tt = ti - 1408; }
        else if (ti < 2432) { src = p.w_mem_kv; ld = 1024; col0 = 0; K = 1024; dst = WkvT; tt = ti - 2176; }
        else if (ti < 2688) { src = p.w_out; ld = 1024; col0 = 0; K = 1024; dst = WoutT; tt = ti - 2432; }
        else if (ti < 2880) { src = p.w_pf; ld = 1024; col0 = 0; K = 768; dst = WpfT; tt = ti - 2688; }
        else if (ti < 3072) { src = p.w_ps; ld = 1024; col0 = 0; K = 768; dst = WpsT; tt = ti - 2880; }
        else if (ti < 3200) { src = p.w_pm; ld = 1024; col0 = 0; K = 512; dst = WpmT; tt = ti - 3072; }
        else { src = p.w_glu; ld = 768; col0 = 0; K = 768; dst = WgluT; tt = ti - 3200; }
        const int nkt = K >> 6;
        const int dld = (K == 1024) ? KLD : K;
        const int k0 = (tt % nkt) * 64, n0 = (tt / nkt) * 64;
#pragma unroll 4
        for (int i = 0; i < 16; ++i) {
          int k = i * 4 + w, n = lane;
          tile[k * 65 + n] = src[(size_t)(k0 + k) * ld + col0 + n0 + n];
        }
        __syncthreads();
#pragma unroll 4
        for (int i = 0; i < 16; ++i) {
          int n = i * 4 + w, k = lane;
          dst[(size_t)(n0 + n) * dld + k0 + k] = f2bf(tile[k * 65 + n]);
        }
        __syncthreads();
      }
      float* wfl = (float*)smem;
      for (int idx = tid; idx < 12288; idx += 256) {
        int k = idx / 12, j = idx - k * 12;
        wfl[j * 1024 + k] = p.w_in[(size_t)k * 8716 + 2304 + j];
      }
      __syncthreads();
      for (int row = bid * 4 + w; row < T_ + 1024; row += nblk * 4) {
        const bool isx = row < T_;
        const float* src = isx ? p.x + (size_t)row * 1024 : p.mem + (size_t)(row - T_) * 1024;
        const float* gsrc = isx ? p.g_norm : p.g_mem_norm;
        u16* dst = isx ? hbuf + (size_t)row * KLD : memn + (size_t)(row - T_) * KLD;
        float4 xv[4], gx[4];
        float v[16];
#pragma unroll
        for (int q = 0; q < 16; ++q) v[q] = 0.f;
#pragma unroll
        for (int i = 0; i < 4; ++i) {
          xv[i] = *(const float4*)(src + i * 256 + lane * 4);
          const float4 gv = *(const float4*)(gsrc + i * 256 + lane * 4);
          gx[i] = make_float4(xv[i].x * gv.x, xv[i].y * gv.y, xv[i].z * gv.z, xv[i].w * gv.w);
          v[12] += xv[i].x * xv[i].x + xv[i].y * xv[i].y + xv[i].z * xv[i].z + xv[i].w * xv[i].w;
        }
        if (isx) {
#pragma unroll
          for (int j = 0; j < 12; ++j) {
#pragma unroll
            for (int i = 0; i < 4; ++i) {
              const float4 wv = *(const float4*)(wfl + j * 1024 + i * 256 + lane * 4);
              v[j] += gx[i].x * wv.x + gx[i].y * wv.y + gx[i].z * wv.z + gx[i].w * wv.w;
            }
          }
        }
        float w8[8], w4[4], w2[2], w1;
        {
          const bool hi = (lane & 32) != 0;
#pragma unroll
          for (int q = 0; q < 8; ++q) {
            const float snd = hi ? v[q] : v[q + 8];
            const float kp = hi ? v[q + 8] : v[q];
            w8[q] = kp + __shfl_xor(snd, 32);
          }
        }
        {
          const bool hi = (lane & 16) != 0;
#pragma unroll
          for (int q = 0; q < 4; ++q) {
            const float snd = hi ? w8[q] : w8[q + 4];
            const float kp = hi ? w8[q + 4] : w8[q];
            w4[q] = kp + __shfl_xor(snd, 16);
          }
        }
        {
          const bool hi = (lane & 8) != 0;
#pragma unroll
          for (int q = 0; q < 2; ++q) {
            const float snd = hi ? w4[q] : w4[q + 2];
            const float kp = hi ? w4[q + 2] : w4[q];
            w2[q] = kp + __shfl_xor(snd, 8);
          }
        }
        {
          const bool hi = (lane & 4) != 0;
          const float snd = hi ? w2[0] : w2[1];
          const float kp = hi ? w2[1] : w2[0];
          w1 = kp + __shfl_xor(snd, 4);
        }
        w1 += __shfl_xor(w1, 2);
        w1 += __shfl_xor(w1, 1);
        const int ridx = ((lane >> 5) & 1) * 8 + ((lane >> 4) & 1) * 4 + ((lane >> 3) & 1) * 2 + ((lane >> 2) & 1);
        const float ss = __shfl(w1, 48);
        const float rstd = rsqrtf(ss * (1.f / 1024.f) + 1e-6f);
#pragma unroll
        for (int i = 0; i < 4; ++i) {
          u32x2 o = {pack2(gx[i].x * rstd, gx[i].y * rstd), pack2(gx[i].z * rstd, gx[i].w * rstd)};
          *(u32x2*)(dst + i * 256 + lane * 4) = o;
        }
        if (isx && ridx < 12 && (lane & 3) == 0) {
          float xx = w1 * rstd + p.b_forget[ridx];
          float lf = fminf(xx, 0.f) - log1pf(__expf(-fabsf(xx)));
          const int b = row >> 13, t = row & (L_ - 1);
          logf[(size_t)(b * 12 + ridx) * L_ + t] = lf;
        }
      }
      {
        const int gid = bid * 256 + tid;
        if (gid < 3072) {
          const int g = gid >> 6;
          const float step = expf(p.log_step[g]);
          const float lr = p.lam_re[gid], li = p.lam_im[gid];
          const float mag = expf(lr * step);
          const float ar = mag * cosf(li * step), ai = mag * sinf(li * step);
          const float den = lr * lr + li * li;
          const float nr = ar - 1.f, ni = ai;
          const float fr = (nr * lr + ni * li) / den, fi = (ni * lr - nr * li) / den;
          abar[gid] = make_float2(ar, ai);
#pragma unroll
          for (int h = 0; h < 16; ++h) {
            const float br = p.b_re[(size_t)gid * 16 + h], bi = p.b_im[(size_t)gid * 16 + h];
            bbar[(size_t)gid * 32 + h] = fr * br - fi * bi;
            bbar[(size_t)gid * 32 + 16 + h] = fr * bi + fi * br;
          }
        }
      }
      __syncthreads();
    }
    SYNC_BEFORE(1);
    if (PH(1)) {
      TIDVARS
      float* sm = (float*)smem;
      for (int seq = bid; seq < 48; seq += nblk) {
        const float* src = logf + (size_t)seq * L_ + tid * 32;
        float* dst = Fbuf + (size_t)seq * L_ + tid * 32;
        float v[32];
#pragma unroll
        for (int i = 0; i < 8; ++i) {
          float4 t = *(const float4*)(src + i * 4);
          v[4 * i] = t.x; v[4 * i + 1] = t.y; v[4 * i + 2] = t.z; v[4 * i + 3] = t.w;
        }
        float run = 0.f;
#pragma unroll
        for (int i = 0; i < 32; ++i) { run += v[i]; v[i] = run; }
        float incl = run;
#pragma unroll
        for (int o = 1; o < 64; o <<= 1) {
          float t = __shfl_up(incl, o);
          if (lane >= o) incl += t;
        }
        if (lane == 63) sm[w] = incl;
        __syncthreads();
        float base = incl - run;
        for (int w2 = 0; w2 < w; ++w2) base += sm[w2];
#pragma unroll
        for (int i = 0; i < 8; ++i) {
          float4 t = make_float4((v[4 * i] + base) * LOG2E, (v[4 * i + 1] + base) * LOG2E, (v[4 * i + 2] + base) * LOG2E, (v[4 * i + 3] + base) * LOG2E);
          *(float4*)(dst + i * 4) = t;
        }
        __syncthreads();
      }
#define P1_V(PN, VOUT)                                                     \
      {                                                                    \
        VOUT = -1;                                                         \
        if (nblk == 512) {                                                 \
          const int i_ = bid >> 3, x_ = bid & 7;                           \
          int j_ = -1;                                                     \
          if ((PN) < 20) j_ = 64 * (PN) + i_;                              \
          else if (i_ < 32 && (PN) < 24) j_ = 1280 + 32 * ((PN) - 20) + i_; \
          else if (i_ < 8 && (PN) == 24) j_ = 1408 + i_;                   \
          if (j_ >= 0) VOUT = j_ * 8 + x_;                                 \
        } else {                                                           \
          const int v_ = bid + (PN) * nblk;                                \
          if (v_ < 11264 + 64) VOUT = v_;                                  \
        }                                                                  \
      }
#define P1_OPS(V, AO, BO_, M0O, N0O, KVO)                                  \
      {                                                                    \
        KVO = (V) >= 11264;                                                \
        if (!KVO) {                                                        \
          int mt_, nt_;                                                    \
          swz((V), 44, 4, mt_, nt_);                                       \
          M0O = mt_ * 128; N0O = nt_ * 128;                                \
          AO = hbuf + (size_t)M0O * KLD; BO_ = WinT + (size_t)N0O * KLD;   \
        } else {                                                           \
          const int kv_ = (V) - 11264;                                     \
          M0O = (kv_ >> 3) * 128; N0O = (kv_ & 7) * 128;                   \
          AO = memn + (size_t)M0O * KLD; BO_ = WkvT + (size_t)N0O * KLD;   \
        }                                                                  \
      }
      for (int pn = 0;; ++pn) {
        int v;
        P1_V(pn, v)
        if (v < 0) break;
        const u16 *A, *Bt;
        int m0, n0;
        bool kvtile;
        P1_OPS(v, A, Bt, m0, n0, kvtile)
        const u16 *An = nullptr, *Btn = nullptr;
        {
          int vn;
          P1_V(pn + 1, vn)
          if (vn >= 0) { int m0n_, n0n_; bool kvn_; P1_OPS(vn, An, Btn, m0n_, n0n_, kvn_) (void)m0n_; (void)n0n_; (void)kvn_; }
        }
        const bool transp = kvtile ? (n0 >= 512) : (n0 >= 1536 && n0 < 2304);
        f32x4 acc[4][4];
        zero_acc(acc);
        if (transp) {
          gemm_core<false, 1, false, true>(acc, A, KLD, Bt, KLD, 1024, smem, pn > 0, An, KLD, Btn, KLD);
          if (kvtile) epi_transposed(acc, mvT, m0, n0 - 512, 4, 7, 8);
          else epi_transposed(acc, vT, m0, n0 - 1536, 12, 6, 13);
        } else {
          gemm_core<true, 1, false, true>(acc, A, KLD, Bt, KLD, 1024, smem, pn > 0, An, KLD, Btn, KLD);
          u16* dst; int ld, c0, mode;
          if (kvtile) { dst = mkbuf; ld = 512; c0 = n0; mode = 0; }
          else if (n0 < 768) { dst = qbuf; ld = 768; c0 = n0; mode = 1; }
          else if (n0 < 1536) { dst = kbuf; ld = 768; c0 = n0 - 768; mode = 0; }
          else if (n0 < 3072) { dst = gfbuf; ld = 768; c0 = n0 - 2304; mode = 2; }
          else if (n0 < 3840) { dst = ubuf; ld = 768; c0 = n0 - 3072; mode = 0; }
          else if (n0 < 4608) { dst = gsbuf; ld = 768; c0 = n0 - 3840; mode = 2; }
          else if (n0 < 5120) { dst = qmbuf; ld = 512; c0 = n0 - 4608; mode = 0; }
          else { dst = gmbuf; ld = 512; c0 = n0 - 5120; mode = 2; }
          epi_rowmajor(acc, dst, ld, m0, c0, mode, smem + 32768);
          if (!kvtile && n0 >= 768 && n0 < 1536) {
            float mxv = 0.f;
#pragma unroll
            for (int i = 0; i < 4; ++i) {
              float ss = 0.f;
#pragma unroll
              for (int j = 0; j < 4; ++j)
#pragma unroll
                for (int r = 0; r < 4; ++r) {
                  const float v = __uint_as_float(((unsigned)f2bf(acc[i][j][r])) << 16);
                  ss += v * v;
                }
              ss += __shfl_xor(ss, 16);
              ss += __shfl_xor(ss, 32);
              mxv = fmaxf(mxv, ss);
            }
#pragma unroll
            for (int o = 1; o < 16; o <<= 1) mxv = fmaxf(mxv, __shfl_xor(mxv, o));
            if (lane == 0) atomicMax(&ctl[(m0 >> 13) * 12 + ((n0 - 768) >> 6) + (w & 1)], __float_as_uint(mxv));
          }
        }
      }
    }
    SYNC_BEFORE(2);
    if (PH(2)) {
      TIDVARS
      int* qslot = (int*)(smem + 73696);
#define NEXT_ITEM(CTR)                                        \
      {                                                       \
        if (tid == 0) *qslot = (int)atomicAdd(&ctl[CTR], 1u); \
        __syncthreads();                                      \
        it = *qslot;                                          \
        __syncthreads();                                      \
      }
      int it;
      for (;;) {
        NEXT_ITEM(64);
        if (it >= 3072) break;
        {
#ifndef NO_FOX
          const int qt = 63 - it / 48, bh = it % 48, b = bh / 12, h = bh % 12;
          const int q0 = qt * 128;
          const size_t qoff = ((size_t)(b * L_ + q0)) * 768 + h * 64;
          attn_item<64, true, true, 2>(qbuf + qoff, 768, kbuf + (size_t)b * L_ * 768 + h * 64, 768,
                              vT + (size_t)(b * 12 + h) * 64 * L_, L_, Fbuf + (size_t)(b * 12 + h) * L_, q0, 2 * qt + 2,
                              gfbuf + qoff, qbuf + qoff, 1.f, sqrtf(__uint_as_float(ctl[b * 12 + h])), smem);
#endif
        }
      }
      for (;;) {
        NEXT_ITEM(65);
        if (it >= 2048) break;
        {
#ifndef NO_MEM
          const int im = it;
          const int hm = im & 3, qt = (im >> 2) & 127, b = im >> 9;
          const int q0 = qt * 64;
          const size_t qoff = ((size_t)(b * L_ + q0)) * 512 + hm * 128;
          attn_item<128, false, false, 1>(qmbuf + qoff, 512, mkbuf + (size_t)b * 256 * 512 + hm * 128, 512,
                                mvT + (size_t)(b * 4 + hm) * 128 * 256, 256, nullptr, q0, 4,
                                gmbuf + qoff, qmbuf + qoff, 0.08838834764831845f * LOG2E, 0.f, smem);
#endif
        }
      }
      for (;;) {
        NEXT_ITEM(66);
        if (it >= 1536) break;
        {
#ifndef NO_S5P1
          const int wi = it * 4 + w;
          const int g = wi % 48, cg = (wi / 48) & 31, b = wi / (48 * 32);
          char* xs = smem + w * 12800;
          const int gp = g * 64 + lane;
          bf16x8 ah[8], al[8];
          s5_load_bfrag(bbar, g, l15, g4, ah, al);
          const float2 ab = abar[gp];
#pragma unroll 1
          for (int ci = 0; ci < 4; ++ci) {
          const int c = cg * 4 + ci;
          const u16* ub0 = ubuf + ((size_t)(b * L_ + c * 64 + l15)) * 768 + g * 16;
          u32x4 uq[4];
#pragma unroll
          for (int sub = 0; sub < 4; ++sub) {
            uq[sub] = u32x4{0u, 0u, 0u, 0u};
            if (g4 < 2) uq[sub] = *(const u32x4*)(ub0 + (size_t)sub * 16 * 768 + g4 * 8);
          }
          float hr = 0.f, hi = 0.f;
#pragma unroll
          for (int sub = 0; sub < 4; ++sub) {
            s5_xsub(uq[sub], ah, al, xs, l15, g4);
            asm volatile("s_waitcnt lgkmcnt(0)" ::: "memory");
#pragma unroll
            for (int tt = 0; tt < 16; ++tt) {
              const float xr = *(const float*)(xs + tt * 528 + lane * 4);
              const float xi = *(const float*)(xs + tt * 528 + 256 + lane * 4);
              const float nhr = ab.x * hr - ab.y * hi + xr;
              const float nhi = ab.x * hi + ab.y * hr + xi;
              hr = nhr; hi = nhi;
            }
            asm volatile("s_waitcnt lgkmcnt(0)" ::: "memory");
          }
          Sst[((size_t)(b * 128 + c) * 48 + g) * 64 + lane] = make_float2(hr, hi);
          }
          __syncthreads();
#endif
        }
      }
    }
    SYNC_BEFORE(3);
    if (PH(3)) {
      TIDVARS
      for (int wi = bid * 4 + w; wi < 192; wi += nblk * 4) {
        const int g = wi % 48, b = wi / 48;
        const float2 ab = abar[g * 64 + lane];
        float a64r = ab.x, a64i = ab.y;
#pragma unroll
        for (int q = 0; q < 6; ++q) {
          const float nr = a64r * a64r - a64i * a64i, ni = 2.f * a64r * a64i;
          a64r = nr; a64i = ni;
        }
        float2* sp = Sst + ((size_t)(b * 128) * 48 + g) * 64 + lane;
        float hr = 0.f, hi = 0.f;
        float2 sv[16], sn[16];
#pragma unroll
        for (int q = 0; q < 16; ++q) sv[q] = sp[(size_t)q * 48 * 64];
#pragma unroll 1
        for (int cc = 0; cc < 128; cc += 16) {
          const int cn = (cc + 16 < 128) ? cc + 16 : cc;
#pragma unroll
          for (int q = 0; q < 16; ++q) sn[q] = sp[(size_t)(cn + q) * 48 * 64];
          __builtin_amdgcn_sched_barrier(0);
#pragma unroll
          for (int q = 0; q < 16; ++q) {
            sp[(size_t)(cc + q) * 48 * 64] = make_float2(hr, hi);
            const float nhr = a64r * hr - a64i * hi + sv[q].x;
            const float nhi = a64r * hi + a64i * hr + sv[q].y;
            hr = nhr; hi = nhi;
          }
#pragma unroll
          for (int q = 0; q < 16; ++q) sv[q] = sn[q];
        }
      }
    }
    SYNC_BEFORE(4);
    if (PH(4)) {
      TIDVARS
      for (int it = bid; it < 1536; it += nblk) {
        const int wi = it * 4 + w;
        const int g = wi % 48, cg = (wi / 48) & 31, b = wi / (48 * 32);
        char* xs = smem + w * 12800;
        char* stt = xs + 8448;
        const int gp = g * 64 + lane;
        bf16x8 ah[8], al[8];
        s5_load_bfrag(bbar, g, l15, g4, ah, al);
        const float2 ab = abar[gp];
        bf16x8 cf[4];
#pragma unroll
        for (int s = 0; s < 4; ++s) {
          const float* cs = (s < 2 ? p.c_re : p.c_im) + (size_t)(g * 16 + l15) * 64 + (s & 1) * 32 + g4 * 8;
          float4 t0 = *(const float4*)cs, t1 = *(const float4*)(cs + 4);
          const float sg = (s < 2) ? 1.f : -1.f;
          u32x4 t = pack8_mfma(sg * t0.x, sg * t0.y, sg * t0.z, sg * t0.w, sg * t1.x, sg * t1.y, sg * t1.z, sg * t1.w);
          cf[s] = __builtin_bit_cast(bf16x8, t);
        }
        const float4 dsk = *(const float4*)(p.s5_d + g * 16 + g4 * 4);
#pragma unroll 1
        for (int ci = 0; ci < 4; ++ci) {
        const int c = cg * 4 + ci;
        const u16* ub0 = ubuf + ((size_t)(b * L_ + c * 64 + l15)) * 768 + g * 16;
        const float2 hc = Sst[((size_t)(b * 128 + c) * 48 + g) * 64 + lane];
        float hr = hc.x, hi = hc.y;
        u32x4 uq[4];
        u32x2 uvq[4];
#pragma unroll
        for (int sub = 0; sub < 4; ++sub) {
          uq[sub] = u32x4{0u, 0u, 0u, 0u};
          if (g4 < 2) uq[sub] = *(const u32x4*)(ub0 + (size_t)sub * 16 * 768 + g4 * 8);
          uvq[sub] = *(const u32x2*)(ub0 + (size_t)sub * 16 * 768 + g4 * 4);
        }
        asm volatile("s_waitcnt lgkmcnt(0)" ::: "memory");
#pragma unroll
        for (int sub = 0; sub < 4; ++sub) {
          s5_xsub(uq[sub], ah, al, xs, l15, g4);
          asm volatile("s_waitcnt lgkmcnt(0)" ::: "memory");
#pragma unroll
          for (int tt = 0; tt < 16; ++tt) {
            const float xr = *(const float*)(xs + tt * 528 + lane * 4);
            const float xi = *(const float*)(xs + tt * 528 + 256 + lane * 4);
            const float nhr = ab.x * hr - ab.y * hi + xr;
            const float nhi = ab.x * hi + ab.y * hr + xi;
            hr = nhr; hi = nhi;
            *(u16*)(stt + tt * 272 + lane * 2) = f2bf(hr);
            *(u16*)(stt + tt * 272 + 128 + lane * 2) = f2bf(hi);
          }
          asm volatile("s_waitcnt lgkmcnt(0)" ::: "memory");
          f32x4 y = {0, 0, 0, 0};
#pragma unroll
          for (int s = 0; s < 4; ++s) {
            bf16x8 bfr = *(const bf16x8*)(stt + l15 * 272 + s * 64 + g4 * 16);
            y = mfma16(cf[s], bfr, y);
          }
          const int t = sub * 16 + l15;
          const u32x2 uv = uvq[sub];
          float o0 = gelu_tanh(y[0] + dsk.x * bflo(uv[0]));
          float o1 = gelu_tanh(y[1] + dsk.y * bfhi(uv[0]));
          float o2 = gelu_tanh(y[2] + dsk.z * bflo(uv[1]));
          float o3 = gelu_tanh(y[3] + dsk.w * bfhi(uv[1]));
          u32x2 o = {pack2(o0, o1), pack2(o2, o3)};
          *(u32x2*)(ys5a + ((size_t)(b * L_ + c * 64 + t)) * 768 + g * 16 + g4 * 4) = o;
          asm volatile("s_waitcnt lgkmcnt(0)" ::: "memory");
        }
        }
        __syncthreads();
      }
    }
    SYNC_BEFORE(5);
    if (PH(5)) {
      TIDVARS
      for (int v = bid; v < 256 * 6; v += nblk) {
        int mt, nt;
        swz(v, 6, 6, mt, nt);
        const int m0 = mt * 128, n0 = nt * 128;
        f32x4 acc[4][4];
        zero_acc(acc);
        const u16 *An5 = nullptr, *Bn5 = nullptr;
        if (v + nblk < 256 * 6) { int mtn, ntn; swz(v + nblk, 6, 6, mtn, ntn); An5 = ys5a + (size_t)(mtn * 128) * 768; Bn5 = WgluT + (size_t)(ntn * 128) * 768; }
        gemm_core<true, 1, false, true>(acc, ys5a + (size_t)m0 * 768, 768, WgluT + (size_t)n0 * 768, 768, 768, smem, v != bid, An5, 768, Bn5, 768);
        const int wr = w >> 1, wc = w & 1;
#pragma unroll
        for (int i = 0; i < 4; ++i) {
          const size_t row = (size_t)(m0 + wr * 64 + i * 16 + l15);
#pragma unroll
          for (int j = 0; j < 4; ++j) {
            const int n = n0 + wc * 64 + j * 16 + g4 * 4;
            const float4 bg = *(const float4*)(p.b_glu + n);
            const u32x2 av = *(const u32x2*)(ys5a + row * 768 + n);
            const u32x2 sv = *(const u32x2*)(gsbuf + row * 768 + n);
            float o0 = bflo(av[0]) * sigmoidf_(acc[i][j][0] + bg.x) * bflo(sv[0]);
            float o1 = bfhi(av[0]) * sigmoidf_(acc[i][j][1] + bg.y) * bfhi(sv[0]);
            float o2 = bflo(av[1]) * sigmoidf_(acc[i][j][2] + bg.z) * bflo(sv[1]);
            float o3 = bfhi(av[1]) * sigmoidf_(acc[i][j][3] + bg.w) * bfhi(sv[1]);
            u32x2 o = {pack2(o0, o1), pack2(o2, o3)};
            *(u32x2*)(ubuf + row * 768 + n) = o;
          }
        }
      }
    }
    SYNC_BEFORE(6);
    if (PH(6)) {
      TIDVARS
      for (int v = bid; v < 256 * 8; v += nblk) {
        int mt, nt;
        swz(v, 8, 4, mt, nt);
        const int m0 = mt * 128, n0 = nt * 128;
        const int wr = w >> 1, wc = w & 1;
        char* gstash = ws + OFF_GATE + (size_t)bid * 32768;
        f32x4 accm[4][4];
        zero_acc(accm);
        unsigned gt[4][4][2];
#pragma unroll 1
        for (int stp = 0; stp < 6; ++stp) {
          const int br = stp >> 1;
          const u16* Ab; const u16* Wb; int Kb; int ldk;
          if (!(stp & 1)) { Ab = hbuf + (size_t)m0 * KLD; Wb = WglT + (size_t)(br * 1024 + n0) * KLD; Kb = 1024; }
          else if (br == 0) { Ab = qbuf + (size_t)m0 * 768; Wb = WpfT + (size_t)n0 * 768; Kb = 768; }
          else if (br == 1) { Ab = ubuf + (size_t)m0 * 768; Wb = WpsT + (size_t)n0 * 768; Kb = 768; }
          else { Ab = qmbuf + (size_t)m0 * 512; Wb = WpmT + (size_t)n0 * 512; Kb = 512; }
          f32x4 acc[4][4];
          zero_acc(acc);
          ldk = (Kb == 1024) ? KLD : Kb;
          gemm_core<true, 1, true>(acc, Ab, ldk, Wb, ldk, Kb, smem);
          if (!(stp & 1)) {
#pragma unroll
            for (int j = 0; j < 4; ++j) {
              const float4 bm = *(const float4*)(p.b_merge + br * 1024 + n0 + wc * 64 + j * 16 + g4 * 4);
#pragma unroll
              for (int i = 0; i < 4; ++i) {
                gt[i][j][0] = pack2(sigmoidf_(acc[i][j][0] + bm.x), sigmoidf_(acc[i][j][1] + bm.y));
                gt[i][j][1] = pack2(sigmoidf_(acc[i][j][2] + bm.z), sigmoidf_(acc[i][j][3] + bm.w));
              }
            }
          } else {
#pragma unroll
            for (int j = 0; j < 4; ++j)
#pragma unroll
              for (int i = 0; i < 4; ++i) {
                accm[i][j][0] += bflo(gt[i][j][0]) * acc[i][j][0];
                accm[i][j][1] += bfhi(gt[i][j][0]) * acc[i][j][1];
                accm[i][j][2] += bflo(gt[i][j][1]) * acc[i][j][2];
                accm[i][j][3] += bfhi(gt[i][j][1]) * acc[i][j][3];
              }
            if (br == 2) epi_rowmajor_direct(accm, merged, KLD, m0, n0, 0);
          }
        }
      }
    }
    SYNC_BEFORE(7);
    if (PH(7)) {
      TIDVARS
      for (int v = bid; v < 256 * 8; v += nblk) {
        int mt, nt;
        swz(v, 8, 4, mt, nt);
        const int m0 = mt * 128, n0 = nt * 128;
        const int wr = w >> 1, wc = w & 1;
        f32x4 acc[4][4];
        zero_acc(acc);
        const u16 *An7 = nullptr, *Bn7 = nullptr;
        if (v + nblk < 256 * 8) { int mtn, ntn; swz(v + nblk, 8, 4, mtn, ntn); An7 = merged + (size_t)(mtn * 128) * KLD; Bn7 = WoutT + (size_t)(ntn * 128) * KLD; }
        gemm_core<true, 1, false, true>(acc, merged + (size_t)m0 * KLD, KLD, WoutT + (size_t)n0 * KLD, KLD, 1024, smem, v != bid, An7, KLD, Bn7, KLD);
#pragma unroll
        for (int i = 0; i < 4; ++i) {
          const size_t row = (size_t)(m0 + wr * 64 + i * 16 + l15);
          float ss = 0.f;
#pragma unroll
          for (int j = 0; j < 4; ++j) {
            const int n = n0 + wc * 64 + j * 16 + g4 * 4;
            const float4 xv = *(const float4*)(p.x + row * 1024 + n);
            float4 o = make_float4(xv.x + acc[i][j][0], xv.y + acc[i][j][1], xv.z + acc[i][j][2], xv.w + acc[i][j][3]);
            ss += o.x * o.x + o.y * o.y + o.z * o.z + o.w * o.w;
            *(float4*)(p.out + row * 1024 + n) = o;
          }
          ss += __shfl_xor(ss, 16);
          ss += __shfl_xor(ss, 32);
          if (g4 == 0) part[row * 16 + nt * 2 + wc] = ss;
        }
      }
    }
    SYNC_BEFORE(8);
    if (PH(8)) {
      TIDVARS
      for (int row = bid * 4 + w; row < T_; row += nblk * 8) {
        const int row2 = row + nblk * 4;
        const bool has2 = row2 < T_;
        float ssa = (lane < 16) ? part[(size_t)row * 16 + lane] : 0.f;
        float ssb = (has2 && lane < 16) ? part[(size_t)row2 * 16 + lane] : 0.f;
        float* oa = p.out + (size_t)row * 1024;
        float* ob = p.out + (size_t)(has2 ? row2 : row) * 1024;
        float4 va[4], vb[4];
#pragma unroll
        for (int i = 0; i < 4; ++i) {
          va[i] = *(const float4*)(oa + i * 256 + lane * 4);
          vb[i] = *(const float4*)(ob + i * 256 + lane * 4);
        }
        ssa = wave_sum(ssa);
        ssb = wave_sum(ssb);
        const float ra = rsqrtf(ssa * (1.f / 1024.f) + 1e-6f);
        const float rb = rsqrtf(ssb * (1.f / 1024.f) + 1e-6f);
#pragma unroll
        for (int i = 0; i < 4; ++i) {
          const float4 gv = *(const float4*)(p.g_final + i * 256 + lane * 4);
          va[i].x *= ra * gv.x; va[i].y *= ra * gv.y; va[i].z *= ra * gv.z; va[i].w *= ra * gv.w;
          *(float4*)(oa + i * 256 + lane * 4) = va[i];
          if (has2) {
            vb[i].x *= rb * gv.x; vb[i].y *= rb * gv.y; vb[i].z *= rb * gv.z; vb[i].w *= rb * gv.w;
            *(float4*)(ob + i * 256 + lane * 4) = vb[i];
          }
        }
      }
    }
  }
}

extern "C" void kernel_launch(void* const* d_in, const int* in_sizes, int n_in, void* d_out, int out_size, void* d_ws,
                              size_t ws_size, hipStream_t stream) {
  static int grid_blocks = 0;
  if (!grid_blocks) {
    if (ws_size < WS_END || n_in != 23) {
      fprintf(stderr, "kernel_launch: unexpected ws_size %zu (need %zu) or n_in %d\n", ws_size, (size_t)WS_END, n_in);
      grid_blocks = -1;
      return;
    }
    int dev = 0, cus = 0, per_cu = 0;
    (void)hipGetDevice(&dev);
    (void)hipDeviceGetAttribute(&cus, hipDeviceAttributeMultiprocessorCount, dev);
    (void)hipFuncSetAttribute((const void*)mega, hipFuncAttributeMaxDynamicSharedMemorySize, LDS_BYTES);
    (void)hipOccupancyMaxActiveBlocksPerMultiprocessor(&per_cu, (const void*)mega, 256, LDS_BYTES);
    per_cu = (per_cu >= 2) ? 2 : 1;
    grid_blocks = cus * per_cu;
  }
  if (grid_blocks < 0) return;
  Params p{};
  const float** pp = (const float**)&p;
  for (int i = 0; i < 23; ++i) pp[i] = (const float*)d_in[i];
  p.out = (float*)d_out;
  p.ws = (char*)d_ws;
#if COOP
  (void)hipMemsetAsync((char*)d_ws + OFF_CTL + 4096, 0, XCD_BAR_WORDS * 4, stream);
  p.phase_lo = 0;
  p.phase_hi = NPHASE - 1;
  void* args[] = {&p};
  hipError_t e = hipLaunchCooperativeKernel((const void*)mega, dim3(grid_blocks), dim3(256), args, LDS_BYTES, stream);
  if (e != hipSuccess) fprintf(stderr, "cooperative launch failed: %s (grid %d)\n", hipGetErrorString(e), grid_blocks);
#else
  for (int ph = 0; ph < NPHASE; ++ph) {
    p.phase_lo = ph;
    p.phase_hi = ph;
    hipLaunchKernelGGL(mega, dim3(grid_blocks), dim3(256), LDS_BYTES, stream, p);
#ifdef PROBE_DUP
    if (ph == PROBE_DUP) {
      for (int rep = 0; rep < 2; ++rep) {
        if (ph == 2) { p.phase_lo = p.phase_hi = 1; hipLaunchKernelGGL(mega, dim3(grid_blocks), dim3(256), LDS_BYTES, stream, p); p.phase_lo = p.phase_hi = 2; }
        hipLaunchKernelGGL(mega, dim3(grid_blocks), dim3(256), LDS_BYTES, stream, p);
      }
    }
#endif
  }
#endif
}
```

```cpp
#include <hip/hip_runtime.h>
#include <hip/hip_cooperative_groups.h>
#include <stdint.h>
#include <stdio.h>
namespace cg = cooperative_groups;

#ifndef COOP
#define COOP 1
#define XCD_MODE 0
#endif

#define DI __device__ __forceinline__
#ifdef ONLY_PHASE
#define PH(n) ((n) == ONLY_PHASE && p.phase_lo <= (n) && (n) <= p.phase_hi)
#else
#define PH(n) (p.phase_lo <= (n) && (n) <= p.phase_hi)
#endif
#define SYNC_BEFORE(n)                                        \
  if (p.phase_lo < (n) && (n) <= p.phase_hi) {                \
    xcd_barrier(xb);                                          \
  }
typedef unsigned short u16;
using bf16x8 = __attribute__((ext_vector_type(8))) short;
using f32x4 = __attribute__((ext_vector_type(4))) float;
using u32x4 = __attribute__((ext_vector_type(4))) unsigned;
using u32x2 = __attribute__((ext_vector_type(2))) unsigned;

constexpr int T_ = 32768, L_ = 8192;
constexpr int LDS_BYTES = 73728;
constexpr int NPHASE = 9;

constexpr size_t MiB = 1u << 20;
constexpr float LOG2E = 1.4426950408889634f;
constexpr float QSCALE = 0.125f * LOG2E;
constexpr int KLD = 1088;
constexpr size_t OFF_H = 0;
constexpr size_t OFF_Q = 68 * MiB;
constexpr size_t OFF_GF = 116 * MiB;
constexpr size_t OFF_U = 164 * MiB;
constexpr size_t OFF_GS = 212 * MiB;
constexpr size_t OFF_YS5A = 260 * MiB;
constexpr size_t OFF_QM = 308 * MiB;
constexpr size_t OFF_GM = 340 * MiB;
constexpr size_t OFF_MERGED = 372 * MiB;
constexpr size_t OFF_WINT = 440 * MiB;
constexpr size_t OFF_WGLT = 453 * MiB;
constexpr size_t OFF_WKVT = 460 * MiB;
constexpr size_t OFF_WOUTT = 463 * MiB;
constexpr size_t OFF_WPFT = 466 * MiB;
constexpr size_t OFF_WPST = 468 * MiB;
constexpr size_t OFF_WPMT = 470 * MiB;
constexpr size_t OFF_WGLUT = 471 * MiB;
constexpr size_t OFF_MEMN = 473 * MiB;
constexpr size_t OFF_MK = 476 * MiB;
constexpr size_t OFF_MVT = 477 * MiB;
constexpr size_t OFF_LOGF = 478 * MiB;
constexpr size_t OFF_F = 480 * MiB;
constexpr size_t OFF_S5AB = 482 * MiB;
constexpr size_t OFF_S5BB = 483 * MiB;
constexpr size_t OFF_S5S = 484 * MiB;
constexpr size_t OFF_PART = 496 * MiB;
constexpr size_t OFF_GATE = OFF_GS;
constexpr size_t OFF_CTL = 498 * MiB;
constexpr size_t WS_END = 499 * MiB;

struct Params {
  const float *x, *mem, *g_norm, *g_mem_norm, *g_final, *w_in, *b_forget, *b_merge, *w_mem_kv;
  const float *lam_re, *lam_im, *log_step, *b_re, *b_im, *c_re, *c_im, *s5_d, *w_glu, *b_glu;
  const float *w_pf, *w_ps, *w_pm, *w_out;
  float* out;
  char* ws;
  int phase_lo, phase_hi;
};

DI unsigned pack2(float a, float b) {
  unsigned r;
  asm volatile("v_cvt_pk_bf16_f32 %0, %1, %2" : "=v"(r) : "v"(a), "v"(b));
  return r;
}
DI u32x4 pack8_mfma(float a0, float a1, float a2, float a3, float a4, float a5, float a6, float a7) {
  u32x4 r;
  asm volatile("v_cvt_pk_bf16_f32 %0, %4, %5\n\tv_cvt_pk_bf16_f32 %1, %6, %7\n\tv_cvt_pk_bf16_f32 %2, %8, %9\n\tv_cvt_pk_bf16_f32 %3, %10, %11\n\ts_nop 1"
               : "=&v"(r[0]), "=&v"(r[1]), "=&v"(r[2]), "=&v"(r[3])
               : "v"(a0), "v"(a1), "v"(a2), "v"(a3), "v"(a4), "v"(a5), "v"(a6), "v"(a7));
  return r;
}
DI u16 f2bf(float x) { return (u16)(pack2(x, x) & 0xffffu); }
DI float bflo(unsigned v) { return __uint_as_float(v << 16); }
DI float bfhi(unsigned v) { return __uint_as_float(v & 0xffff0000u); }
DI float sigmoidf_(float x) { return 1.f / (1.f + __expf(-x)); }
DI float siluf_(float x) { return x / (1.f + __expf(-x)); }
DI float gelu_tanh(float x) {
  float z = 0.7978845608028654f * (x + 0.044715f * x * x * x);
  float e = __expf(2.f * z);
  float th = 1.f - 2.f / (e + 1.f);
  return 0.5f * x * (1.f + th);
}
DI float wave_sum(float v) {
#pragma unroll
  for (int o = 32; o > 0; o >>= 1) v += __shfl_xor(v, o);
  return v;
}
DI f32x4 mfma16(bf16x8 a, bf16x8 b, f32x4 c) { return __builtin_amdgcn_mfma_f32_16x16x32_bf16(a, b, c, 0, 0, 0); }

template <bool SWAP, int DEPTH = 1, bool LEAN = false, bool NEXTPF = false>
DI void gemm_core(f32x4 (&acc)[4][4], const u16* __restrict__ A, int lda, const u16* __restrict__ Bt, int ldb, int K, char* smem,
                  bool preloaded = false, const u16* An = nullptr, int ldan = 0, const u16* Btn = nullptr, int ldbn = 0) {
  const int tid = threadIdx.x, lane = tid & 63, w = tid >> 6, wr = w >> 1, wc = w & 1, l15 = lane & 15, g = lane >> 4;
  const int lrow = tid >> 3, lch = tid & 7;
  const char* ap = (const char*)A;
  const char* bp = (const char*)Bt;
  const unsigned aoff = (unsigned)(lrow * lda + lch * 8) * 2u;
  const unsigned boff = (unsigned)(lrow * ldb + lch * 8) * 2u;
  u32x4 ra0[4], rb0[4], ra1[4], rb1[4];
  const int nk = K >> 6;
#define G_LOAD(RA, RB, KT)                                                        \
  _Pragma("unroll") for (int c = 0; c < 4; ++c) {                                 \
    RA[c] = *(const u32x4*)(ap + ((size_t)c * 64 * lda + (KT) * 128) + aoff);     \
    RB[c] = *(const u32x4*)(bp + ((size_t)c * 64 * ldb + (KT) * 128) + boff);     \
  }
#define G_STORE(RA, RB, BO)                                                       \
  _Pragma("unroll") for (int c = 0; c < 4; ++c) {                                 \
    *(u32x4*)(wbase + (BO) + c * 32 * 128) = RA[c];                               \
    *(u32x4*)(wbase + (BO) + 16384 + c * 32 * 128) = RB[c];                       \
  }
#define G_COMPUTE_FULL(BO)                                                             \
  {                                                                               \
    bf16x8 af[2][4], bfr[2][4];                                                   \
    _Pragma("unroll") for (int i = 0; i < 4; ++i) af[0][i] = *(const bf16x8*)(ard0 + (BO) + i * 16 * 128);  \
    _Pragma("unroll") for (int j = 0; j < 4; ++j) bfr[0][j] = *(const bf16x8*)(brd0 + (BO) + j * 16 * 128); \
    _Pragma("unroll") for (int i = 0; i < 4; ++i) af[1][i] = *(const bf16x8*)(ard1 + (BO) + i * 16 * 128);  \
    _Pragma("unroll") for (int j = 0; j < 4; ++j) bfr[1][j] = *(const bf16x8*)(brd1 + (BO) + j * 16 * 128); \
    __builtin_amdgcn_sched_barrier(0);                                            \
    __builtin_amdgcn_s_setprio(1);                                                \
    _Pragma("unroll") for (int s = 0; s < 2; ++s)                                 \
      _Pragma("unroll") for (int i = 0; i < 4; ++i)                               \
        _Pragma("unroll") for (int j = 0; j < 4; ++j)                             \
          acc[i][j] = SWAP ? mfma16(bfr[s][j], af[s][i], acc[i][j]) : mfma16(af[s][i], bfr[s][j], acc[i][j]); \
    __builtin_amdgcn_s_setprio(0);                                                \
  }
#define G_COMPUTE_LEAN(BO)                                                        \
  _Pragma("unroll") for (int s = 0; s < 2; ++s) {                                 \
    bf16x8 af[4];                                                                 \
    _Pragma("unroll") for (int i = 0; i < 4; ++i) af[i] = *(const bf16x8*)((s ? ard1 : ard0) + (BO) + i * 16 * 128);  \
    _Pragma("unroll") for (int j = 0; j < 4; ++j) {                               \
      const bf16x8 bfr = *(const bf16x8*)((s ? brd1 : brd0) + (BO) + j * 16 * 128);   \
      _Pragma("unroll") for (int i = 0; i < 4; ++i)                               \
        acc[i][j] = SWAP ? mfma16(bfr, af[i], acc[i][j]) : mfma16(af[i], bfr, acc[i][j]); \
    }                                                                             \
  }
#define G_COMPUTE(BO) if constexpr (LEAN) { G_COMPUTE_LEAN(BO) } else { G_COMPUTE_FULL(BO) }
  char* wbase = smem + lrow * 128 + ((lch ^ ((lrow >> 1) & 7)) << 4);
  const int hsw = l15 >> 1;
  const char* ard0 = smem + (wr * 64 + l15) * 128 + ((g ^ hsw) << 4);
  const char* ard1 = smem + (wr * 64 + l15) * 128 + (((4 + g) ^ hsw) << 4);
  const char* brd0 = smem + 16384 + (wc * 64 + l15) * 128 + ((g ^ hsw) << 4);
  const char* brd1 = smem + 16384 + (wc * 64 + l15) * 128 + (((4 + g) ^ hsw) << 4);
  if constexpr (DEPTH == 2) {
    G_LOAD(ra0, rb0, 0);
    G_LOAD(ra1, rb1, 1);
    G_STORE(ra0, rb0, 0);
    __syncthreads();
    for (int kt = 0; kt < nk; kt += 2) {
      if (kt + 2 < nk) G_LOAD(ra0, rb0, kt + 2);
      __builtin_amdgcn_sched_barrier(0);
      G_COMPUTE(0);
      __builtin_amdgcn_sched_barrier(0);
      G_STORE(ra1, rb1, 32768);
      __syncthreads();
      if (kt + 3 < nk) G_LOAD(ra1, rb1, kt + 3);
      __builtin_amdgcn_sched_barrier(0);
      G_COMPUTE(32768);
      __builtin_amdgcn_sched_barrier(0);
      if (kt + 2 < nk) G_STORE(ra0, rb0, 0);
      __syncthreads();
    }
  } else {
    const int grow = w * 8 + (lane >> 3);
    const int glc = (lane & 7) ^ ((w * 4 + (lane >> 4)) & 7);
    const unsigned gaoff = (unsigned)(grow * lda + glc * 8) * 2u;
    const unsigned gboff = (unsigned)(grow * ldb + glc * 8) * 2u;
    char* gl = smem + w * 1024 + lane * 16;
#define G_GLDS(KT, BO)                                                            \
  _Pragma("unroll") for (int c = 0; c < 4; ++c) {                                 \
    __builtin_amdgcn_global_load_lds((const unsigned*)(ap + ((size_t)c * 64 * lda + (size_t)(KT) * 128) + gaoff),          \
                                     (unsigned*)(gl + (BO) + c * 4096), 16, 0, 0);                                          \
    __builtin_amdgcn_global_load_lds((const unsigned*)(bp + ((size_t)c * 64 * ldb + (size_t)(KT) * 128) + gboff),          \
                                     (unsigned*)(gl + (BO) + 16384 + c * 4096), 16, 0, 0);                                  \
  }
    if (!(NEXTPF && preloaded)) {
      G_GLDS(0, 0)
      __syncthreads();
    }
    for (int kt = 0; kt < nk; kt += 2) {
      G_GLDS(kt + 1, 32768)
      __builtin_amdgcn_sched_barrier(0);
      G_COMPUTE(0);
      __syncthreads();
      if constexpr (!NEXTPF) {
        const int k2 = (kt + 2 < nk) ? kt + 2 : nk - 1;
        G_GLDS(k2, 0)
      } else if (kt + 2 < nk) {
        G_GLDS(kt + 2, 0)
      } else if (An) {
        const char* apn = (const char*)An;
        const char* bpn = (const char*)Btn;
        const unsigned gan = (unsigned)(grow * ldan + glc * 8) * 2u;
        const unsigned gbn = (unsigned)(grow * ldbn + glc * 8) * 2u;
#pragma unroll
        for (int c = 0; c < 4; ++c) {
          __builtin_amdgcn_global_load_lds((const unsigned*)(apn + ((size_t)c * 64 * ldan) + gan), (unsigned*)(gl + c * 4096), 16, 0, 0);
          __builtin_amdgcn_global_load_lds((const unsigned*)(bpn + ((size_t)c * 64 * ldbn) + gbn), (unsigned*)(gl + 16384 + c * 4096), 16, 0, 0);
        }
      }
      __builtin_amdgcn_sched_barrier(0);
      G_COMPUTE(32768);
      __syncthreads();
    }
#undef G_GLDS
  }
#undef G_LOAD
#undef G_STORE
#undef G_COMPUTE
#undef G_COMPUTE_FULL
#undef G_COMPUTE_LEAN
}

DI void zero_acc(f32x4 (&acc)[4][4]) {
#pragma unroll
  for (int i = 0; i < 4; ++i)
#pragma unroll
    for (int j = 0; j < 4; ++j) acc[i][j] = f32x4{0.f, 0.f, 0.f, 0.f};
}

DI void swz(int v, int NT, int GN, int& mt, int& nt) {
#if XCD_MODE == 0
  int xcd = v & 7, j = v >> 3;
#else
  int xcd = (v & 511) >> 6, j = ((v >> 9) << 6) + (v & 63);
#endif
  int per_mg = 8 * NT;
  int mg = j / per_mg, r = j - mg * per_mg;
  int ng = r / (8 * GN), wv = r - ng * (8 * GN);
  mt = xcd * 32 + mg * 8 + (wv & 7);
  nt = ng * GN + (wv >> 3);
}

DI void epi_rowmajor(const f32x4 (&acc)[4][4], u16* dst, int ld, int m0, int c0, int mode, char* smem) {
  const int tid = threadIdx.x, lane = tid & 63, w = tid >> 6, wr = w >> 1, wc = w & 1, l15 = lane & 15, g = lane >> 4;
#pragma unroll
  for (int i = 0; i < 4; ++i) {
    const int row = wr * 64 + i * 16 + l15;
#pragma unroll
    for (int j = 0; j < 4; ++j) {
      f32x4 v = acc[i][j];
      if (mode == 1) { v[0] *= QSCALE; v[1] *= QSCALE; v[2] *= QSCALE; v[3] *= QSCALE; }
      else if (mode == 2) { v[0] = siluf_(v[0]); v[1] = siluf_(v[1]); v[2] = siluf_(v[2]); v[3] = siluf_(v[3]); }
      u32x2 o = {pack2(v[0], v[1]), pack2(v[2], v[3])};
      *(u32x2*)(smem + row * 272 + (wc * 64 + j * 16 + g * 4) * 2) = o;
    }
  }
  __syncthreads();
#pragma unroll
  for (int c = 0; c < 8; ++c) {
    const int id = c * 256 + tid, row = id >> 4, ch = id & 15;
    const u32x4 v = *(const u32x4*)(smem + row * 272 + ch * 16);
    *(u32x4*)(dst + (size_t)(m0 + row) * ld + c0 + ch * 8) = v;
  }
  __syncthreads();
}
DI void epi_rowmajor_direct(const f32x4 (&acc)[4][4], u16* dst, int ld, int m0, int c0, int mode) {
  const int tid = threadIdx.x, lane = tid & 63, w = tid >> 6, wr = w >> 1, wc = w & 1, l15 = lane & 15, g = lane >> 4;
#pragma unroll
  for (int i = 0; i < 4; ++i) {
    const size_t row = (size_t)(m0 + wr * 64 + i * 16 + l15);
#pragma unroll
    for (int j = 0; j < 4; ++j) {
      f32x4 v = acc[i][j];
      if (mode == 1) { v[0] *= QSCALE; v[1] *= QSCALE; v[2] *= QSCALE; v[3] *= QSCALE; }
      else if (mode == 2) { v[0] = siluf_(v[0]); v[1] = siluf_(v[1]); v[2] = siluf_(v[2]); v[3] = siluf_(v[3]); }
      u32x2 o = {pack2(v[0], v[1]), pack2(v[2], v[3])};
      *(u32x2*)(dst + row * ld + c0 + wc * 64 + j * 16 + g * 4) = o;
    }
  }
}
DI void epi_transposed(const f32x4 (&acc)[4][4], u16* dst, int m0, int c0, int H, int lgDh, int lgLk) {
  const int tid = threadIdx.x, lane = tid & 63, w = tid >> 6, wr = w >> 1, wc = w & 1, l15 = lane & 15, g = lane >> 4;
#pragma unroll
  for (int i = 0; i < 4; ++i) {
    const int token = m0 + wr * 64 + i * 16 + g * 4;
    const int bidx = token >> lgLk, tl = token & ((1 << lgLk) - 1);
#pragma unroll
    for (int j = 0; j < 4; ++j) {
      const int col = c0 + wc * 64 + j * 16 + l15;
      const int head = col >> lgDh, d = col & ((1 << lgDh) - 1);
      f32x4 v = acc[i][j];
      u32x2 o = {pack2(v[0], v[1]), pack2(v[2], v[3])};
      *(u32x2*)(dst + ((((((size_t)bidx * H + head) << lgDh) + d) << lgLk) + tl)) = o;
    }
  }
}

template <int D, bool FOX, bool PF, int NQ>
DI void attn_item(const u16* __restrict__ qbase, int ldq, const u16* __restrict__ kbase, int ldk,
                  const u16* __restrict__ vtbase, int ldv, const float* __restrict__ Fseq, int q0, int nkv,
                  const u16* __restrict__ gate, u16* outp, float scale, float kmaxv, char* smem) {
  const int tid = threadIdx.x, lane = tid & 63, w = tid >> 6, l15 = lane & 15, g = lane >> 4;
  constexpr int KROW = D * 2 + 16;
  constexpr int KBYTES = 64 * KROW;
  constexpr int VBYTES = D * 144;
  constexpr int BUF = KBYTES + VBYTES + 256;
  constexpr int NL = D / 32;
  constexpr int KCH = D / 8;
  static_assert(2 * BUF <= LDS_BYTES, "attn lds");

  bf16x8 qf[NQ][D / 32];
#pragma unroll
  for (int qi = 0; qi < NQ; ++qi)
#pragma unroll
    for (int s = 0; s < D / 32; ++s)
      qf[qi][s] = *(const bf16x8*)(qbase + (size_t)(w * (16 * NQ) + qi * 16 + l15) * ldq + s * 32 + g * 8);
  float fq[NQ];
#pragma unroll
  for (int qi = 0; qi < NQ; ++qi) fq[qi] = FOX ? Fseq[q0 + w * (16 * NQ) + qi * 16 + l15] : 0.f;
  f32x4 ot[D / 16][NQ];
#pragma unroll
  for (int dt = 0; dt < D / 16; ++dt)
#pragma unroll
    for (int qi = 0; qi < NQ; ++qi) ot[dt][qi] = f32x4{0, 0, 0, 0};
  float mrun[NQ], lsum[NQ];
#pragma unroll
  for (int qi = 0; qi < NQ; ++qi) { mrun[qi] = -1e30f; lsum[qi] = 0.f; }
  float qk[NQ];
#pragma unroll
  for (int qi = 0; qi < NQ; ++qi) {
    float ss = 0.f;
    if (FOX) {
#pragma unroll
      for (int s = 0; s < D / 32; ++s)
#pragma unroll
        for (int e = 0; e < 8; ++e) {
          const float v = __uint_as_float(((unsigned)(unsigned short)qf[qi][s][e]) << 16);
          ss += v * v;
        }
      ss += __shfl_xor(ss, 16);
      ss += __shfl_xor(ss, 32);
    }
    qk[qi] = sqrtf(ss) * kmaxv * 1.002f + 1e-3f;
  }
  int* flags = (int*)(smem + 73664);

  u32x4 kr[NL], vr[NL];
  f32x4 fr = {0, 0, 0, 0};
#define krow(c) (((c) * 256 + tid) / KCH)
#define kch(c) (((c) * 256 + tid) % KCH)
#define vrow(c) (((c) * 256 + tid) >> 3)
#define vch(c) (tid & 7)
#define ATT_LOAD(J)                                                                                   \
  {                                                                                                   \
    const int s0_ = (J) * 64;                                                                         \
    _Pragma("unroll") for (int c = 0; c < NL; ++c) {                                                  \
      kr[c] = *(const u32x4*)(kbase + (size_t)(s0_ + krow(c)) * ldk + kch(c) * 8);                    \
      vr[c] = *(const u32x4*)(vtbase + (size_t)vrow(c) * ldv + s0_ + vch(c) * 8);                     \
    }                                                                                                 \
    if (FOX && tid < 16) fr = *(const f32x4*)(Fseq + s0_ + tid * 4);                                  \
  }
#define ATT_STORE(BO)                                                                                 \
  {                                                                                                   \
    char* b_ = smem + (BO);                                                                           \
    _Pragma("unroll") for (int c = 0; c < NL; ++c) {                                                  \
      *(u32x4*)(b_ + krow(c) * KROW + kch(c) * 16) = kr[c];                                           \
      *(u32x4*)(b_ + KBYTES + vrow(c) * 144 + vch(c) * 16) = vr[c];                                   \
    }                                                                                                 \
    if (FOX && tid < 16) *(f32x4*)(b_ + KBYTES + VBYTES + tid * 16) = fr;                             \
  }
  ATT_LOAD(nkv - 1);
  ATT_STORE(0);
  __syncthreads();
  const int qlo = q0 + w * (16 * NQ);
  for (int j = nkv - 1, itn = 0; j >= 0; --j, ++itn) {
    const int cur = (itn & 1) * BUF;
    if (j > 0) {
      ATT_LOAD(j - 1);
      if (!PF) ATT_STORE(cur ^ BUF);
    }
    __builtin_amdgcn_sched_barrier(0);
    bool ok = false;
    const int s0 = j * 64;
    const bool active = !FOX || (s0 <= qlo + 16 * NQ - 1);
    if (active) {
      const char* Ks = smem + cur;
      const char* Vs = smem + cur + KBYTES;
      const char* Fs = smem + cur + KBYTES + VBYTES;
      f32x4 st[4][NQ];
#pragma unroll
      for (int kt = 0; kt < 4; ++kt)
#pragma unroll
        for (int qi = 0; qi < NQ; ++qi) st[kt][qi] = f32x4{0, 0, 0, 0};
#pragma unroll
      for (int s = 0; s < D / 32; ++s) {
        bf16x8 kf[4];
#pragma unroll
        for (int kt = 0; kt < 4; ++kt) kf[kt] = *(const bf16x8*)(Ks + (kt * 16 + l15) * KROW + s * 64 + g * 16);
#pragma unroll
        for (int kt = 0; kt < 4; ++kt)
#pragma unroll
          for (int qi = 0; qi < NQ; ++qi) st[kt][qi] = mfma16(kf[kt], qf[qi][s], st[kt][qi]);
      }
      if (FOX) {
        const bool need_mask = (s0 + 63 > qlo);
#pragma unroll
        for (int kt = 0; kt < 4; ++kt) {
          f32x4 fk = *(const f32x4*)(Fs + (kt * 16 + g * 4) * 4);
#pragma unroll
          for (int qi = 0; qi < NQ; ++qi) {
            const int qpos = qlo + qi * 16 + l15;
#pragma unroll
            for (int r = 0; r < 4; ++r) {
              float v = st[kt][qi][r] - fk[r];
              if (need_mask && (s0 + kt * 16 + g * 4 + r > qpos)) v = -1e30f;
              st[kt][qi][r] = v;
            }
          }
        }
      } else {
#pragma unroll
        for (int kt = 0; kt < 4; ++kt)
#pragma unroll
          for (int qi = 0; qi < NQ; ++qi)
#pragma unroll
            for (int r = 0; r < 4; ++r) st[kt][qi][r] *= scale;
      }
      float mxl[NQ];
      bool upd = false;
#pragma unroll
      for (int qi = 0; qi < NQ; ++qi) {
        float mx = st[0][qi][0];
#pragma unroll
        for (int kt = 0; kt < 4; ++kt)
#pragma unroll
          for (int r = 0; r < 4; ++r) mx = fmaxf(mx, st[kt][qi][r]);
        mxl[qi] = mx;
        upd = upd || (mx > mrun[qi]);
      }
      const bool resc = __any(upd);
      if (resc) {
#pragma unroll
        for (int qi = 0; qi < NQ; ++qi) {
          float mx = mxl[qi];
          mx = fmaxf(mx, __shfl_xor(mx, 16));
          mx = fmaxf(mx, __shfl_xor(mx, 32));
          const float mnew = fmaxf(mrun[qi], mx);
          const float al = __builtin_amdgcn_exp2f(mrun[qi] - mnew);
          mrun[qi] = mnew;
          lsum[qi] *= al;
#pragma unroll
          for (int dt = 0; dt < D / 16; ++dt)
#pragma unroll
            for (int r = 0; r < 4; ++r) ot[dt][qi][r] *= al;
        }
      }
#pragma unroll
      for (int qi = 0; qi < NQ; ++qi) {
        const float mref = mrun[qi];
        float ps = 0.f;
#pragma unroll
        for (int kt = 0; kt < 4; ++kt)
#pragma unroll
          for (int r = 0; r < 4; ++r) {
            float p = __builtin_amdgcn_exp2f(st[kt][qi][r] - mref);
            st[kt][qi][r] = p;
            ps += p;
          }
        lsum[qi] += ps;
      }
      bf16x8 pb[2][NQ];
#pragma unroll
      for (int kp = 0; kp < 2; ++kp)
#pragma unroll
        for (int qi = 0; qi < NQ; ++qi) {
          u32x4 t = pack8_mfma(st[2 * kp][qi][0], st[2 * kp][qi][1], st[2 * kp][qi][2], st[2 * kp][qi][3],
                               st[2 * kp + 1][qi][0], st[2 * kp + 1][qi][1], st[2 * kp + 1][qi][2], st[2 * kp + 1][qi][3]);
          pb[kp][qi] = __builtin_bit_cast(bf16x8, t);
        }
#pragma unroll
      for (int dt = 0; dt < D / 16; ++dt) {
#pragma unroll
        for (int kp = 0; kp < 2; ++kp) {
          u32x2 lo = *(const u32x2*)(Vs + (dt * 16 + l15) * 144 + (kp * 32 + g * 4) * 2);
          u32x2 hi = *(const u32x2*)(Vs + (dt * 16 + l15) * 144 + (kp * 32 + 16 + g * 4) * 2);
          u32x4 t = {lo[0], lo[1], hi[0], hi[1]};
          bf16x8 vf = __builtin_bit_cast(bf16x8, t);
#pragma unroll
          for (int qi = 0; qi < NQ; ++qi) ot[dt][qi] = mfma16(vf, pb[kp][qi], ot[dt][qi]);
        }
      }
      if (FOX) {
        const float f0 = *(const float*)Fs;
        ok = true;
#pragma unroll
        for (int qi = 0; qi < NQ; ++qi) ok = ok && (qk[qi] - f0 - mrun[qi] <= -30.f * LOG2E);
      }
    }
    __builtin_amdgcn_sched_barrier(0);
    if (PF && j > 0) ATT_STORE(cur ^ BUF);
    if (FOX) {
      const bool wave_ok = (__ballot(ok) == ~0ull);
      if (lane == 0) flags[(itn & 1) * 4 + w] = wave_ok ? 1 : 0;
      __syncthreads();
      const int* fl = flags + (itn & 1) * 4;
      if (fl[0] & fl[1] & fl[2] & fl[3]) break;
    } else {
      __syncthreads();
    }
  }
#undef ATT_LOAD
#undef ATT_STORE
#undef krow
#undef kch
#undef vrow
#undef vch
#pragma unroll
  for (int qi = 0; qi < NQ; ++qi) {
    float l = lsum[qi];
    l += __shfl_xor(l, 16);
    l += __shfl_xor(l, 32);
    const float inv = 1.f / l;
    const size_t rowoff = (size_t)(w * (16 * NQ) + qi * 16 + l15) * ldq;
#pragma unroll
    for (int dt = 0; dt < D / 16; ++dt) {
      const int col = dt * 16 + g * 4;
      u32x2 gv = *(const u32x2*)(gate + rowoff + col);
      u32x2 o = {pack2(ot[dt][qi][0] * inv * bflo(gv[0]), ot[dt][qi][1] * inv * bfhi(gv[0])),
                 pack2(ot[dt][qi][2] * inv * bflo(gv[1]), ot[dt][qi][3] * inv * bfhi(gv[1]))};
      *(u32x2*)(outp + rowoff + col) = o;
    }
  }
}

typedef float v2f __attribute__((ext_vector_type(2)));
DI void s5_load_u(const u16* ubuf, int b, int c, int g, char* ut, int lane) {
  const u16* src = ubuf + ((size_t)(b * L_ + c * 64 + lane)) * 768 + g * 16;
  u32x4 a = *(const u32x4*)src, bb = *(const u32x4*)(src + 8);
  f32x4 o0 = {bflo(a[0]), bfhi(a[0]), bflo(a[1]), bfhi(a[1])};
  f32x4 o1 = {bflo(a[2]), bfhi(a[2]), bflo(a[3]), bfhi(a[3])};
  f32x4 o2 = {bflo(bb[0]), bfhi(bb[0]), bflo(bb[1]), bfhi(bb[1])};
  f32x4 o3 = {bflo(bb[2]), bfhi(bb[2]), bflo(bb[3]), bfhi(bb[3])};
  *(f32x4*)(ut + lane * 64) = o0;
  *(f32x4*)(ut + lane * 64 + 16) = o1;
  *(f32x4*)(ut + lane * 64 + 32) = o2;
  *(f32x4*)(ut + lane * 64 + 48) = o3;
}
DI void s5_load_b(const float* bbar, int gp, v2f (&b2)[16]) {
#pragma unroll
  for (int q = 0; q < 4; ++q) {
    float4 t0 = *(const float4*)(bbar + (size_t)gp * 32 + q * 4);
    float4 t1 = *(const float4*)(bbar + (size_t)gp * 32 + 16 + q * 4);
    b2[4 * q] = v2f{t0.x, t1.x}; b2[4 * q + 1] = v2f{t0.y, t1.y};
    b2[4 * q + 2] = v2f{t0.z, t1.z}; b2[4 * q + 3] = v2f{t0.w, t1.w};
  }
}
DI v2f s5_x(const char* ut, int t, const v2f (&b2)[16]) {
  v2f xa = {0.f, 0.f}, xb = {0.f, 0.f};
#pragma unroll
  for (int q = 0; q < 4; ++q) {
    const f32x4 u = *(const f32x4*)(ut + t * 64 + q * 16);
    xa += b2[4 * q] * u[0];
    xb += b2[4 * q + 1] * u[1];
    xa += b2[4 * q + 2] * u[2];
    xb += b2[4 * q + 3] * u[3];
  }
  return xa + xb;
}

DI void s5_load_bfrag(const float* bbar, int g, int l15, int g4, bf16x8 (&ah)[8], bf16x8 (&al)[8]) {
#pragma unroll
  for (int kt = 0; kt < 8; ++kt) {
    u32x4 h = {0u, 0u, 0u, 0u}, l = {0u, 0u, 0u, 0u};
    if (g4 < 2) {
      const float* src = bbar + (size_t)(g * 64 + (kt & 3) * 16 + l15) * 32 + (kt >> 2) * 16 + g4 * 8;
      const float4 t0 = *(const float4*)src, t1 = *(const float4*)(src + 4);
      const float v[8] = {t0.x, t0.y, t0.z, t0.w, t1.x, t1.y, t1.z, t1.w};
#pragma unroll
      for (int q = 0; q < 4; ++q) {
        const unsigned h0 = f2bf(v[2 * q]), h1 = f2bf(v[2 * q + 1]);
        h[q] = h0 | (h1 << 16);
        l[q] = pack2(v[2 * q] - __uint_as_float(h0 << 16), v[2 * q + 1] - __uint_as_float(h1 << 16));
      }
    }
    ah[kt] = __builtin_bit_cast(bf16x8, h);
    al[kt] = __builtin_bit_cast(bf16x8, l);
  }
}
DI void s5_xsub(const u32x4 uraw, const bf16x8 (&ah)[8], const bf16x8 (&al)[8], char* xs, int l15, int g4) {
  const bf16x8 ub = __builtin_bit_cast(bf16x8, uraw);
#pragma unroll
  for (int kt = 0; kt < 8; ++kt) {
    f32x4 x = {0.f, 0.f, 0.f, 0.f};
    x = mfma16(ah[kt], ub, x);
    x = mfma16(al[kt], ub, x);
    *(f32x4*)(xs + l15 * 528 + (kt * 16 + g4 * 4) * 4) = x;
  }
}

#define XB_TMO      128
#define XB_XCNT(j)  (256  + 64 * (j))
#define XB_XSUB(j)  (1280 + 64 * (j))
#define XB_XGEN(j)  (2304 + 64 * (j))
#define XB_TOP      3328
#define XB_TOPGEN   3392
#define XCD_BAR_WORDS 3456
#define XB_SPIN_CAP (1u << 18)
DI unsigned xb_ld(unsigned* p) { return __hip_atomic_load(p, __ATOMIC_RELAXED, __HIP_MEMORY_SCOPE_AGENT); }
DI unsigned xb_add(unsigned* p, unsigned v) { return __hip_atomic_fetch_add(p, v, __ATOMIC_RELAXED, __HIP_MEMORY_SCOPE_AGENT); }
DI unsigned xb_xcc_id() { return (unsigned)__builtin_amdgcn_s_getreg((3 << 11) | 20) & 0xFu; }
#define XB_SPIN(cond, bar) do { unsigned _sp = 0; while (cond) { __builtin_amdgcn_s_sleep(1); \
    if ((++_sp & 255u) == 0u) { if (xb_ld(&(bar)[XB_TMO])) break; if (_sp > XB_SPIN_CAP) { atomicAdd(&(bar)[XB_TMO], 1u); break; } } } } while (0)
struct XcdBarrier { unsigned* bar; unsigned x; volatile unsigned* st; };
DI XcdBarrier xcd_barrier_post(unsigned* bar, volatile unsigned* st) {
  XcdBarrier b; b.bar = bar; b.x = xb_xcc_id(); b.st = st;
  if (threadIdx.x == 0) (void)xb_add(&bar[XB_XCNT(b.x)], 1u);
  return b;
}
DI void xcd_barrier_complete(unsigned* bar, unsigned x, unsigned& nloc, unsigned& nx) {
  const unsigned G = gridDim.x * gridDim.y * gridDim.z;
  unsigned sum, cnt, mine, sp = 0u;
  for (;;) {
    sum = 0u; cnt = 0u; mine = 0u;
#pragma unroll
    for (unsigned j = 0; j < 16; ++j) { const unsigned c = xb_ld(&bar[XB_XCNT(j)]); sum += c; cnt += (c > 0u) ? 1u : 0u; mine = (j == x) ? c : mine; }
    if (sum == G) break;
    __builtin_amdgcn_s_sleep(1);
    if ((++sp & 255u) == 0u) { if (xb_ld(&bar[XB_TMO])) break; if (sp > XB_SPIN_CAP) { atomicAdd(&bar[XB_TMO], 1u); break; } }
  }
  nloc = mine > 0u ? mine : 1u; nx = cnt > 0u ? cnt : 1u;
}
DI void xcd_barrier(const XcdBarrier& b) {
  asm volatile("s_waitcnt vmcnt(0)" ::: "memory");
  __syncthreads();
  if (threadIdx.x == 0) {
    unsigned* bar = b.bar;
    __builtin_amdgcn_s_waitcnt(0);
    unsigned nloc = b.st[0], nx = b.st[1];
    if (nloc == 0u) { xcd_barrier_complete(bar, b.x, nloc, nx); b.st[0] = nloc; b.st[1] = nx; }
    const unsigned old = xb_add(&bar[XB_XSUB(b.x)], 1u);
    const unsigned gen = old / nloc;
    if (old + 1u == (gen + 1u) * nloc) {
      __builtin_amdgcn_fence(__ATOMIC_RELEASE, "agent");
      asm volatile("s_waitcnt vmcnt(0)" ::: "memory");
      const unsigned og = xb_add(&bar[XB_TOP], 1u);
      const unsigned tg = og / nx;
      if (og + 1u == (tg + 1u) * nx) xb_add(&bar[XB_TOPGEN], 1u);
      else XB_SPIN(xb_ld(&bar[XB_TOPGEN]) == tg, bar);
      __builtin_amdgcn_fence(__ATOMIC_ACQUIRE, "agent");
      xb_add(&bar[XB_XGEN(b.x)], 1u);
      asm volatile("s_waitcnt vmcnt(0)" ::: "memory");
    } else {
      XB_SPIN(xb_ld(&bar[XB_XGEN(b.x)]) == gen, bar);
      __builtin_amdgcn_fence(__ATOMIC_ACQUIRE, "agent");
      asm volatile("s_waitcnt vmcnt(0)" ::: "memory");
    }
  }
  __syncthreads();
}

extern "C" __global__ void __launch_bounds__(256, 2) mega(Params p) {
  extern __shared__ __attribute__((aligned(16))) char smem[];
  cg::grid_group grid = cg::this_grid();
#define TIDVARS                                                                  \
  int tid = threadIdx.x;                                                         \
  asm volatile("" : "+v"(tid));                                                  \
  const int lane = tid & 63, w = tid >> 6, l15 = lane & 15, g4 = lane >> 4;      \
  (void)lane; (void)w; (void)l15; (void)g4;
  const int nblk = gridDim.x, bid = blockIdx.x;
  char* ws = p.ws;
  XcdBarrier xb;
  xb.bar = (unsigned*)(ws + OFF_CTL + 4096); xb.x = 0; xb.st = (volatile unsigned*)(smem + 73712);
  if (p.phase_lo < p.phase_hi) {
    if (threadIdx.x < 2) xb.st[threadIdx.x] = 0u;
    __syncthreads();
    xb = xcd_barrier_post((unsigned*)(ws + OFF_CTL + 4096), (volatile unsigned*)(smem + 73712));
    grid.sync();
  }
  u16* hbuf = (u16*)(ws + OFF_H);
  u16* qbuf = (u16*)(ws + OFF_Q);
  u16* gfbuf = (u16*)(ws + OFF_GF);
  u16* ubuf = (u16*)(ws + OFF_U);
  u16* gsbuf = (u16*)(ws + OFF_GS);
  u16* ys5a = (u16*)(ws + OFF_YS5A);
  u16* qmbuf = (u16*)(ws + OFF_QM);
  u16* gmbuf = (u16*)(ws + OFF_GM);
  u16* merged = (u16*)(ws + OFF_MERGED);
  u16* WinT = (u16*)(ws + OFF_WINT);
  u16* WglT = (u16*)(ws + OFF_WGLT);
  u16* WkvT = (u16*)(ws + OFF_WKVT);
  u16* WoutT = (u16*)(ws + OFF_WOUTT);
  u16* WpfT = (u16*)(ws + OFF_WPFT);
  u16* WpsT = (u16*)(ws + OFF_WPST);
  u16* WpmT = (u16*)(ws + OFF_WPMT);
  u16* WgluT = (u16*)(ws + OFF_WGLUT);
  u16* memn = (u16*)(ws + OFF_MEMN);
  u16* mkbuf = (u16*)(ws + OFF_MK);
  u16* mvT = (u16*)(ws + OFF_MVT);
  float* logf = (float*)(ws + OFF_LOGF);
  float* Fbuf = (float*)(ws + OFF_F);
  float2* abar = (float2*)(ws + OFF_S5AB);
  float* bbar = (float*)(ws + OFF_S5BB);
  float2* Sst = (float2*)(ws + OFF_S5S);
  float* part = (float*)(ws + OFF_PART);
  unsigned* ctl = (unsigned*)(ws + OFF_CTL);
  u16* kbuf = (u16*)p.out;
  u16* vT = (u16*)((char*)p.out + 48 * MiB);

  {
    if (PH(0)) {
      TIDVARS
      if (bid == 0 && tid < 128) ctl[tid] = 0u;
      float* tile = (float*)smem;
      for (int ti = bid; ti < 3344; ti += nblk) {
        const float* src; int ld, col0, K; u16* dst; int tt;
        if (ti < 576) { src = p.w_in; ld = 8716; col0 = 0; K = 1024; dst = WinT; tt = ti; }
        else if (ti < 1408) { src = p.w_in; ld = 8716; col0 = 2316; K = 1024; dst = WinT + (size_t)2304 * KLD; tt = ti - 576; }
        else if (ti < 2176) { src = p.w_in; ld = 8716; col0 = 5644; K = 1024; dst = WglT; tt = ti - 1408; }
        else if (ti < 2432) { src = p.w_mem_kv; ld = 1024; col0 = 0; K = 1024; dst = WkvT; tt = ti - 2176; }
        else if (ti < 2688) { src = p.w_out; ld = 1024; col0 = 0; K = 1024; dst = WoutT; tt = ti - 2432; }
        else if (ti < 2880) { src = p.w_pf; ld = 1024; col0 = 0; K = 768; dst = WpfT; tt = ti - 2688; }
        else if (ti < 3072) { src = p.w_ps; ld = 1024; col0 = 0; K = 768; dst = WpsT; tt = ti - 2880; }
        else if (ti < 3200) { src = p.w_pm; ld = 1024; col0 = 0; K = 512; dst = WpmT; tt = ti - 3072; }
        else { src = p.w_glu; ld = 768; col0 = 0; K = 768; dst = WgluT; tt = ti - 3200; }
        const int nkt = K >> 6;
        const int dld = (K == 1024) ? KLD : K;
        const int k0 = (tt % nkt) * 64, n0 = (tt / nkt) * 64;
#pragma unroll 4
        for (int i = 0; i < 16; ++i) {
          int k = i * 4 + w, n = lane;
          tile[k * 65 + n] = src[(size_t)(k0 + k) * ld + col0 + n0 + n];
        }
        __syncthreads();
#pragma unroll 4
        for (int i = 0; i < 16; ++i) {
          int n = i * 4 + w, k = lane;
          dst[(size_t)(n0 + n) * dld + k0 + k] = f2bf(tile[k * 65 + n]);
        }
        __syncthreads();
      }
      float* wfl = (float*)smem;
      for (int idx = tid; idx < 12288; idx += 256) {
        int k = idx / 12, j = idx - k * 12;
        wfl[j * 1024 + k] = p.w_in[(size_t)k * 8716 + 2304 + j];
      }
      __syncthreads();
      for (int row = bid * 4 + w; row < T_ + 1024; row += nblk * 4) {
        const bool isx = row < T_;
        const float* src = isx ? p.x + (size_t)row * 1024 : p.mem + (size_t)(row - T_) * 1024;
        const float* gsrc = isx ? p.g_norm : p.g_mem_norm;
        u16* dst = isx ? hbuf + (size_t)row * KLD : memn + (size_t)(row - T_) * KLD;
        float4 xv[4], gx[4];
        float v[16];
#pragma unroll
        for (int q = 0; q < 16; ++q) v[q] = 0.f;
#pragma unroll
        for (int i = 0; i < 4; ++i) {
          xv[i] = *(const float4*)(src + i * 256 + lane * 4);
          const float4 gv = *(const float4*)(gsrc + i * 256 + lane * 4);
          gx[i] = make_float4(xv[i].x * gv.x, xv[i].y * gv.y, xv[i].z * gv.z, xv[i].w * gv.w);
          v[12] += xv[i].x * xv[i].x + xv[i].y * xv[i].y + xv[i].z * xv[i].z + xv[i].w * xv[i].w;
        }
        if (isx) {
#pragma unroll
          for (int j = 0; j < 12; ++j) {
#pragma unroll
            for (int i = 0; i < 4; ++i) {
              const float4 wv = *(const float4*)(wfl + j * 1024 + i * 256 + lane * 4);
              v[j] += gx[i].x * wv.x + gx[i].y * wv.y + gx[i].z * wv.z + gx[i].w * wv.w;
            }
          }
        }
        float w8[8], w4[4], w2[2], w1;
        {
          const bool hi = (lane & 32) != 0;
#pragma unroll
          for (int q = 0; q < 8; ++q) {
            const float snd = hi ? v[q] : v[q + 8];
            const float kp = hi ? v[q + 8] : v[q];
            w8[q] = kp + __shfl_xor(snd, 32);
          }
        }
        {
          const bool hi = (lane & 16) != 0;
#pragma unroll
          for (int q = 0; q < 4; ++q) {
            const float snd = hi ? w8[q] : w8[q + 4];
            const float kp = hi ? w8[q + 4] : w8[q];
            w4[q] = kp + __shfl_xor(snd, 16);
          }
        }
        {
          const bool hi = (lane & 8) != 0;
#pragma unroll
          for (int q = 0; q < 2; ++q) {
            const float snd = hi ? w4[q] : w4[q + 2];
            const float kp = hi ? w4[q + 2] : w4[q];
            w2[q] = kp + __shfl_xor(snd, 8);
          }
        }
        {
          const bool hi = (lane & 4) != 0;
          const float snd = hi ? w2[0] : w2[1];
          const float kp = hi ? w2[1] : w2[0];
          w1 = kp + __shfl_xor(snd, 4);
        }
        w1 += __shfl_xor(w1, 2);
        w1 += __shfl_xor(w1, 1);
        const int ridx = ((lane >> 5) & 1) * 8 + ((lane >> 4) & 1) * 4 + ((lane >> 3) & 1) * 2 + ((lane >> 2) & 1);
        const float ss = __shfl(w1, 48);
        const float rstd = rsqrtf(ss * (1.f / 1024.f) + 1e-6f);
#pragma unroll
        for (int i = 0; i < 4; ++i) {
          u32x2 o = {pack2(gx[i].x * rstd, gx[i].y * rstd), pack2(gx[i].z * rstd, gx[i].w * rstd)};
          *(u32x2*)(dst + i * 256 + lane * 4) = o;
        }
        if (isx && ridx < 12 && (lane & 3) == 0) {
          float xx = w1 * rstd + p.b_forget[ridx];
          float lf = fminf(xx, 0.f) - log1pf(__expf(-fabsf(xx)));
          const int b = row >> 13, t = row & (L_ - 1);
          logf[(size_t)(b * 12 + ridx) * L_ + t] = lf;
        }
      }
      {
        const int gid = bid * 256 + tid;
        if (gid < 3072) {
          const int g = gid >> 6;
          const float step = expf(p.log_step[g]);
          const float lr = p.lam_re[gid], li = p.lam_im[gid];
          const float mag = expf(lr * step);
          const float ar = mag * cosf(li * step), ai = mag * sinf(li * step);
          const float den = lr * lr + li * li;
          const float nr = ar - 1.f, ni = ai;
          const float fr = (nr * lr + ni * li) / den, fi = (ni * lr - nr * li) / den;
          abar[gid] = make_float2(ar, ai);
#pragma unroll
          for (int h = 0; h < 16; ++h) {
            const float br = p.b_re[(size_t)gid * 16 + h], bi = p.b_im[(size_t)gid * 16 + h];
            bbar[(size_t)gid * 32 + h] = fr * br - fi * bi;
            bbar[(size_t)gid * 32 + 16 + h] = fr * bi + fi * br;
          }
        }
      }
      __syncthreads();
    }
    SYNC_BEFORE(1);
    if (PH(1)) {
      TIDVARS
      float* sm = (float*)smem;
      for (int seq = bid; seq < 48; seq += nblk) {
        const float* src = logf + (size_t)seq * L_ + tid * 32;
        float* dst = Fbuf + (size_t)seq * L_ + tid * 32;
        float v[32];
#pragma unroll
        for (int i = 0; i < 8; ++i) {
          float4 t = *(const float4*)(src + i * 4);
          v[4 * i] = t.x; v[4 * i + 1] = t.y; v[4 * i + 2] = t.z; v[4 * i + 3] = t.w;
        }
        float run = 0.f;
#pragma unroll
        for (int i = 0; i < 32; ++i) { run += v[i]; v[i] = run; }
        float incl = run;
#pragma unroll
        for (int o = 1; o < 64; o <<= 1) {
          float t = __shfl_up(incl, o);
          if (lane >= o) incl += t;
        }
        if (lane == 63) sm[w] = incl;
        __syncthreads();
        float base = incl - run;
        for (int w2 = 0; w2 < w; ++w2) base += sm[w2];
#pragma unroll
        for (int i = 0; i < 8; ++i) {
          float4 t = make_float4((v[4 * i] + base) * LOG2E, (v[4 * i + 1] + base) * LOG2E, (v[4 * i + 2] + base) * LOG2E, (v[4 * i + 3] + base) * LOG2E);
          *(float4*)(dst + i * 4) = t;
        }
        __syncthreads();
      }
#define P1_V(PN, VOUT)                                                     \
      {                                                                    \
        VOUT = -1;                                                         \
        if (nblk == 512) {                                                 \
          const int i_ = bid >> 3, x_ = bid & 7;                           \
          int j_ = -1;                                                     \
          if ((PN) < 20) j_ = 64 * (PN) + i_;                              \
          else if (i_ < 32 && (PN) < 24) j_ = 1280 + 32 * ((PN) - 20) + i_; \
          else if (i_ < 8 && (PN) == 24) j_ = 1408 + i_;                   \
          if (j_ >= 0) VOUT = j_ * 8 + x_;                                 \
        } else {                                                           \
          const int v_ = bid + (PN) * nblk;                                \
          if (v_ < 11264 + 64) VOUT = v_;                                  \
        }                                                                  \
      }
#define P1_OPS(V, AO, BO_, M0O, N0O, KVO)                                  \
      {                                                                    \
        KVO = (V) >= 11264;                                                \
        if (!KVO) {                                                        \
          int mt_, nt_;                                                    \
          swz((V), 44, 4, mt_, nt_);                                       \
          M0O = mt_ * 128; N0O = nt_ * 128;                                \
          AO = hbuf + (size_t)M0O * KLD; BO_ = WinT + (size_t)N0O * KLD;   \
        } else {                                                           \
          const int kv_ = (V) - 11264;                                     \
          M0O = (kv_ >> 3) * 128; N0O = (kv_ & 7) * 128;                   \
          AO = memn + (size_t)M0O * KLD; BO_ = WkvT + (size_t)N0O * KLD;   \
        }                                                                  \
      }
      for (int pn = 0;; ++pn) {
        int v;
        P1_V(pn, v)
        if (v < 0) break;
        const u16 *A, *Bt;
        int m0, n0;
        bool kvtile;
        P1_OPS(v, A, Bt, m0, n0, kvtile)
        const u16 *An = nullptr, *Btn = nullptr;
        {
          int vn;
          P1_V(pn + 1, vn)
          if (vn >= 0) { int m0n_, n0n_; bool kvn_; P1_OPS(vn, An, Btn, m0n_, n0n_, kvn_) (void)m0n_; (void)n0n_; (void)kvn_; }
        }
        const bool transp = kvtile ? (n0 >= 512) : (n0 >= 1536 && n0 < 2304);
        f32x4 acc[4][4];
        zero_acc(acc);
        if (transp) {
          gemm_core<false, 1, false, true>(acc, A, KLD, Bt, KLD, 1024, smem, pn > 0, An, KLD, Btn, KLD);
          if (kvtile) epi_transposed(acc, mvT, m0, n0 - 512, 4, 7, 8);
          else epi_transposed(acc, vT, m0, n0 - 1536, 12, 6, 13);
        } else {
          gemm_core<true, 1, false, true>(acc, A, KLD, Bt, KLD, 1024, smem, pn > 0, An, KLD, Btn, KLD);
          u16* dst; int ld, c0, mode;
          if (kvtile) { dst = mkbuf; ld = 512; c0 = n0; mode = 0; }
          else if (n0 < 768) { dst = qbuf; ld = 768; c0 = n0; mode = 1; }
          else if (n0 < 1536) { dst = kbuf; ld = 768; c0 = n0 - 768; mode = 0; }
          else if (n0 < 3072) { dst = gfbuf; ld = 768; c0 = n0 - 2304; mode = 2; }
          else if (n0 < 3840) { dst = ubuf; ld = 768; c0 = n0 - 3072; mode = 0; }
          else if (n0 < 4608) { dst = gsbuf; ld = 768; c0 = n0 - 3840; mode = 2; }
          else if (n0 < 5120) { dst = qmbuf; ld = 512; c0 = n0 - 4608; mode = 0; }
          else { dst = gmbuf; ld = 512; c0 = n0 - 5120; mode = 2; }
          epi_rowmajor(acc, dst, ld, m0, c0, mode, smem + 32768);
          if (!kvtile && n0 >= 768 && n0 < 1536) {
            float mxv = 0.f;
#pragma unroll
            for (int i = 0; i < 4; ++i) {
              float ss = 0.f;
#pragma unroll
              for (int j = 0; j < 4; ++j)
#pragma unroll
                for (int r = 0; r < 4; ++r) {
                  const float v = __uint_as_float(((unsigned)f2bf(acc[i][j][r])) << 16);
                  ss += v * v;
                }
              ss += __shfl_xor(ss, 16);
              ss += __shfl_xor(ss, 32);
              mxv = fmaxf(mxv, ss);
            }
#pragma unroll
            for (int o = 1; o < 16; o <<= 1) mxv = fmaxf(mxv, __shfl_xor(mxv, o));
            if (lane == 0) atomicMax(&ctl[(m0 >> 13) * 12 + ((n0 - 768) >> 6) + (w & 1)], __float_as_uint(mxv));
          }
        }
      }
    }
    SYNC_BEFORE(2);
    if (PH(2)) {
      TIDVARS
      int* qslot = (int*)(smem + 73696);
#define NEXT_ITEM(CTR)                                        \
      {                                                       \
        if (tid == 0) *qslot = (int)atomicAdd(&ctl[CTR], 1u); \
        __syncthreads();                                      \
        it = *qslot;                                          \
        __syncthreads();                                      \
      }
      int it;
      for (;;) {
        NEXT_ITEM(64);
        if (it >= 3072) break;
        {
#ifndef NO_FOX
          const int qt = 63 - it / 48, bh = it % 48, b = bh / 12, h = bh % 12;
          const int q0 = qt * 128;
          const size_t qoff = ((size_t)(b * L_ + q0)) * 768 + h * 64;
          attn_item<64, true, true, 2>(qbuf + qoff, 768, kbuf + (size_t)b * L_ * 768 + h * 64, 768,
                              vT + (size_t)(b * 12 + h) * 64 * L_, L_, Fbuf + (size_t)(b * 12 + h) * L_, q0, 2 * qt + 2,
                              gfbuf + qoff, qbuf + qoff, 1.f, sqrtf(__uint_as_float(ctl[b * 12 + h])), smem);
#endif
        }
      }
      for (;;) {
        NEXT_ITEM(65);
        if (it >= 2048) break;
        {
#ifndef NO_MEM
          const int im = it;
          const int hm = im & 3, qt = (im >> 2) & 127, b = im >> 9;
          const int q0 = qt * 64;
          const size_t qoff = ((size_t)(b * L_ + q0)) * 512 + hm * 128;
          attn_item<128, false, false, 1>(qmbuf + qoff, 512, mkbuf + (size_t)b * 256 * 512 + hm * 128, 512,
                                mvT + (size_t)(b * 4 + hm) * 128 * 256, 256, nullptr, q0, 4,
                                gmbuf + qoff, qmbuf + qoff, 0.08838834764831845f * LOG2E, 0.f, smem);
#endif
        }
      }
      for (;;) {
        NEXT_ITEM(66);
        if (it >= 1536) break;
        {
#ifndef NO_S5P1
          const int wi = it * 4 + w;
          const int g = wi % 48, cg = (wi / 48) & 31, b = wi / (48 * 32);
          char* xs = smem + w * 12800;
          const int gp = g * 64 + lane;
          bf16x8 ah[8], al[8];
          s5_load_bfrag(bbar, g, l15, g4, ah, al);
          const float2 ab = abar[gp];
#pragma unroll 1
          for (int ci = 0; ci < 4; ++ci) {
          const int c = cg * 4 + ci;
          const u16* ub0 = ubuf + ((size_t)(b * L_ + c * 64 + l15)) * 768 + g * 16;
          u32x4 uq[4];
#pragma unroll
          for (int sub = 0; sub < 4; ++sub) {
            uq[sub] = u32x4{0u, 0u, 0u, 0u};
            if (g4 < 2) uq[sub] = *(const u32x4*)(ub0 + (size_t)sub * 16 * 768 + g4 * 8);
          }
          float hr = 0.f, hi = 0.f;
#pragma unroll
          for (int sub = 0; sub < 4; ++sub) {
            s5_xsub(uq[sub], ah, al, xs, l15, g4);
            asm volatile("s_waitcnt lgkmcnt(0)" ::: "memory");
#pragma unroll
            for (int tt = 0; tt < 16; ++tt) {
              const float xr = *(const float*)(xs + tt * 528 + lane * 4);
              const float xi = *(const float*)(xs + tt * 528 + 256 + lane * 4);
              const float nhr = ab.x * hr - ab.y * hi + xr;
              const float nhi = ab.x * hi + ab.y * hr + xi;
              hr = nhr; hi = nhi;
            }
            asm volatile("s_waitcnt lgkmcnt(0)" ::: "memory");
          }
          Sst[((size_t)(b * 128 + c) * 48 + g) * 64 + lane] = make_float2(hr, hi);
          }
          __syncthreads();
#endif
        }
      }
    }
    SYNC_BEFORE(3);
    if (PH(3)) {
      TIDVARS
      for (int wi = bid * 4 + w; wi < 192; wi += nblk * 4) {
        const int g = wi % 48, b = wi / 48;
        const float2 ab = abar[g * 64 + lane];
        float a64r = ab.x, a64i = ab.y;
#pragma unroll
        for (int q = 0; q < 6; ++q) {
          const float nr = a64r * a64r - a64i * a64i, ni = 2.f * a64r * a64i;
          a64r = nr; a64i = ni;
        }
        float2* sp = Sst + ((size_t)(b * 128) * 48 + g) * 64 + lane;
        float hr = 0.f, hi = 0.f;
        float2 sv[16], sn[16];
#pragma unroll
        for (int q = 0; q < 16; ++q) sv[q] = sp[(size_t)q * 48 * 64];
#pragma unroll 1
        for (int cc = 0; cc < 128; cc += 16) {
          const int cn = (cc + 16 < 128) ? cc + 16 : cc;
#pragma unroll
          for (int q = 0; q < 16; ++q) sn[q] = sp[(size_t)(cn + q) * 48 * 64];
          __builtin_amdgcn_sched_barrier(0);
#pragma unroll
          for (int q = 0; q < 16; ++q) {
            sp[(size_t)(cc + q) * 48 * 64] = make_float2(hr, hi);
            const float nhr = a64r * hr - a64i * hi + sv[q].x;
            const float nhi = a64r * hi + a64i * hr + sv[q].y;
            hr = nhr; hi = nhi;
          }
#pragma unroll
          for (int q = 0; q < 16; ++q) sv[q] = sn[q];
        }
      }
    }
    SYNC_BEFORE(4);
    if (PH(4)) {
      TIDVARS
      for (int it = bid; it < 1536; it += nblk) {
        const int wi = it * 4 + w;
        const int g = wi % 48, cg = (wi / 48) & 31, b = wi / (48 * 32);
        char* xs = smem + w * 12800;
        char* stt = xs + 8448;
        const int gp = g * 64 + lane;
        bf16x8 ah[8], al[8];
        s5_load_bfrag(bbar, g, l15, g4, ah, al);
        const float2 ab = abar[gp];
        bf16x8 cf[4];
#pragma unroll
        for (int s = 0; s < 4; ++s) {
          const float* cs = (s < 2 ? p.c_re : p.c_im) + (size_t)(g * 16 + l15) * 64 + (s & 1) * 32 + g4 * 8;
          float4 t0 = *(const float4*)cs, t1 = *(const float4*)(cs + 4);
          const float sg = (s < 2) ? 1.f : -1.f;
          u32x4 t = pack8_mfma(sg * t0.x, sg * t0.y, sg * t0.z, sg * t0.w, sg * t1.x, sg * t1.y, sg * t1.z, sg * t1.w);
          cf[s] = __builtin_bit_cast(bf16x8, t);
        }
        const float4 dsk = *(const float4*)(p.s5_d + g * 16 + g4 * 4);
#pragma unroll 1
        for (int ci = 0; ci < 4; ++ci) {
        const int c = cg * 4 + ci;
        const u16* ub0 = ubuf + ((size_t)(b * L_ + c * 64 + l15)) * 768 + g * 16;
        const float2 hc = Sst[((size_t)(b * 128 + c) * 48 + g) * 64 + lane];
        float hr = hc.x, hi = hc.y;
        u32x4 uq[4];
        u32x2 uvq[4];
#pragma unroll
        for (int sub = 0; sub < 4; ++sub) {
          uq[sub] = u32x4{0u, 0u, 0u, 0u};
          if (g4 < 2) uq[sub] = *(const u32x4*)(ub0 + (size_t)sub * 16 * 768 + g4 * 8);
          uvq[sub] = *(const u32x2*)(ub0 + (size_t)sub * 16 * 768 + g4 * 4);
        }
        asm volatile("s_waitcnt lgkmcnt(0)" ::: "memory");
#pragma unroll
        for (int sub = 0; sub < 4; ++sub) {
          s5_xsub(uq[sub], ah, al, xs, l15, g4);
          asm volatile("s_waitcnt lgkmcnt(0)" ::: "memory");
#pragma unroll
          for (int tt = 0; tt < 16; ++tt) {
            const float xr = *(const float*)(xs + tt * 528 + lane * 4);
            const float xi = *(const float*)(xs + tt * 528 + 256 + lane * 4);
            const float nhr = ab.x * hr - ab.y * hi + xr;
            const float nhi = ab.x * hi + ab.y * hr + xi;
            hr = nhr; hi = nhi;
            *(u16*)(stt + tt * 272 + lane * 2) = f2bf(hr);
            *(u16*)(stt + tt * 272 + 128 + lane * 2) = f2bf(hi);
          }
          asm volatile("s_waitcnt lgkmcnt(0)" ::: "memory");
          f32x4 y = {0, 0, 0, 0};
#pragma unroll
          for (int s = 0; s < 4; ++s) {
            bf16x8 bfr = *(const bf16x8*)(stt + l15 * 272 + s * 64 + g4 * 16);
            y = mfma16(cf[s], bfr, y);
          }
          const int t = sub * 16 + l15;
          const u32x2 uv = uvq[sub];
          float o0 = gelu_tanh(y[0] + dsk.x * bflo(uv[0]));
          float o1 = gelu_tanh(y[1] + dsk.y * bfhi(uv[0]));
          float o2 = gelu_tanh(y[2] + dsk.z * bflo(uv[1]));
          float o3 = gelu_tanh(y[3] + dsk.w * bfhi(uv[1]));
          u32x2 o = {pack2(o0, o1), pack2(o2, o3)};
          *(u32x2*)(ys5a + ((size_t)(b * L_ + c * 64 + t)) * 768 + g * 16 + g4 * 4) = o;
          asm volatile("s_waitcnt lgkmcnt(0)" ::: "memory");
        }
        }
      }
    }
    SYNC_BEFORE(5);
    if (PH(5)) {
      TIDVARS
      for (int v = bid; v < 256 * 6; v += nblk) {
        int mt, nt;
        swz(v, 6, 6, mt, nt);
        const int m0 = mt * 128, n0 = nt * 128;
        f32x4 acc[4][4];
        zero_acc(acc);
        const u16 *An5 = nullptr, *Bn5 = nullptr;
        if (v + nblk < 256 * 6) { int mtn, ntn; swz(v + nblk, 6, 6, mtn, ntn); An5 = ys5a + (size_t)(mtn * 128) * 768; Bn5 = WgluT + (size_t)(ntn * 128) * 768; }
        gemm_core<true, 1, false, true>(acc, ys5a + (size_t)m0 * 768, 768, WgluT + (size_t)n0 * 768, 768, 768, smem, v != bid, An5, 768, Bn5, 768);
        const int wr = w >> 1, wc = w & 1;
#pragma unroll
        for (int i = 0; i < 4; ++i) {
          const size_t row = (size_t)(m0 + wr * 64 + i * 16 + l15);
#pragma unroll
          for (int j = 0; j < 4; ++j) {
            const int n = n0 + wc * 64 + j * 16 + g4 * 4;
            const float4 bg = *(const float4*)(p.b_glu + n);
            const u32x2 av = *(const u32x2*)(ys5a + row * 768 + n);
            const u32x2 sv = *(const u32x2*)(gsbuf + row * 768 + n);
            float o0 = bflo(av[0]) * sigmoidf_(acc[i][j][0] + bg.x) * bflo(sv[0]);
            float o1 = bfhi(av[0]) * sigmoidf_(acc[i][j][1] + bg.y) * bfhi(sv[0]);
            float o2 = bflo(av[1]) * sigmoidf_(acc[i][j][2] + bg.z) * bflo(sv[1]);
            float o3 = bfhi(av[1]) * sigmoidf_(acc[i][j][3] + bg.w) * bfhi(sv[1]);
            u32x2 o = {pack2(o0, o1), pack2(o2, o3)};
            *(u32x2*)(ubuf + row * 768 + n) = o;
          }
        }
      }
    }
    SYNC_BEFORE(6);
    if (PH(6)) {
      TIDVARS
      for (int v = bid; v < 256 * 8; v += nblk) {
        int mt, nt;
        swz(v, 8, 4, mt, nt);
        const int m0 = mt * 128, n0 = nt * 128;
        const int wr = w >> 1, wc = w & 1;
        char* gstash = ws + OFF_GATE + (size_t)bid * 32768;
        f32x4 accm[4][4];
        zero_acc(accm);
        unsigned gt[4][4][2];
#pragma unroll 1
        for (int stp = 0; stp < 6; ++stp) {
          const int br = stp >> 1;
          const u16* Ab; const u16* Wb; int Kb; int ldk;
          if (!(stp & 1)) { Ab = hbuf + (size_t)m0 * KLD; Wb = WglT + (size_t)(br * 1024 + n0) * KLD; Kb = 1024; }
          else if (br == 0) { Ab = qbuf + (size_t)m0 * 768; Wb = WpfT + (size_t)n0 * 768; Kb = 768; }
          else if (br == 1) { Ab = ubuf + (size_t)m0 * 768; Wb = WpsT + (size_t)n0 * 768; Kb = 768; }
          else { Ab = qmbuf + (size_t)m0 * 512; Wb = WpmT + (size_t)n0 * 512; Kb = 512; }
          f32x4 acc[4][4];
          zero_acc(acc);
          ldk = (Kb == 1024) ? KLD : Kb;
          gemm_core<true, 1, true>(acc, Ab, ldk, Wb, ldk, Kb, smem);
          if (!(stp & 1)) {
#pragma unroll
            for (int j = 0; j < 4; ++j) {
              const float4 bm = *(const float4*)(p.b_merge + br * 1024 + n0 + wc * 64 + j * 16 + g4 * 4);
#pragma unroll
              for (int i = 0; i < 4; ++i) {
                gt[i][j][0] = pack2(sigmoidf_(acc[i][j][0] + bm.x), sigmoidf_(acc[i][j][1] + bm.y));
                gt[i][j][1] = pack2(sigmoidf_(acc[i][j][2] + bm.z), sigmoidf_(acc[i][j][3] + bm.w));
              }
            }
          } else {
#pragma unroll
            for (int j = 0; j < 4; ++j)
#pragma unroll
              for (int i = 0; i < 4; ++i) {
                accm[i][j][0] += bflo(gt[i][j][0]) * acc[i][j][0];
                accm[i][j][1] += bfhi(gt[i][j][0]) * acc[i][j][1];
                accm[i][j][2] += bflo(gt[i][j][1]) * acc[i][j][2];
                accm[i][j][3] += bfhi(gt[i][j][1]) * acc[i][j][3];
              }
            if (br == 2) epi_rowmajor_direct(accm, merged, KLD, m0, n0, 0);
          }
        }
      }
    }
    SYNC_BEFORE(7);
    if (PH(7)) {
      TIDVARS
      for (int v = bid; v < 256 * 8; v += nblk) {
        int mt, nt;
        swz(v, 8, 4, mt, nt);
        const int m0 = mt * 128, n0 = nt * 128;
        const int wr = w >> 1, wc = w & 1;
        f32x4 acc[4][4];
        zero_acc(acc);
        const u16 *An7 = nullptr, *Bn7 = nullptr;
        if (v + nblk < 256 * 8) { int mtn, ntn; swz(v + nblk, 8, 4, mtn, ntn); An7 = merged + (size_t)(mtn * 128) * KLD; Bn7 = WoutT + (size_t)(ntn * 128) * KLD; }
        gemm_core<true, 1, false, true>(acc, merged + (size_t)m0 * KLD, KLD, WoutT + (size_t)n0 * KLD, KLD, 1024, smem, v != bid, An7, KLD, Bn7, KLD);
#pragma unroll
        for (int i = 0; i < 4; ++i) {
          const size_t row = (size_t)(m0 + wr * 64 + i * 16 + l15);
          float ss = 0.f;
#pragma unroll
          for (int j = 0; j < 4; ++j) {
            const int n = n0 + wc * 64 + j * 16 + g4 * 4;
            const float4 xv = *(const float4*)(p.x + row * 1024 + n);
            float4 o = make_float4(xv.x + acc[i][j][0], xv.y + acc[i][j][1], xv.z + acc[i][j][2], xv.w + acc[i][j][3]);
            ss += o.x * o.x + o.y * o.y + o.z * o.z + o.w * o.w;
            *(float4*)(p.out + row * 1024 + n) = o;
          }
          ss += __shfl_xor(ss, 16);
          ss += __shfl_xor(ss, 32);
          if (g4 == 0) part[row * 16 + nt * 2 + wc] = ss;
        }
      }
    }
    SYNC_BEFORE(8);
    if (PH(8)) {
      TIDVARS
      for (int row = bid * 4 + w; row < T_; row += nblk * 8) {
        const int row2 = row + nblk * 4;
        const bool has2 = row2 < T_;
        float ssa = (lane < 16) ? part[(size_t)row * 16 + lane] : 0.f;
        float ssb = (has2 && lane < 16) ? part[(size_t)row2 * 16 + lane] : 0.f;
        float* oa = p.out + (size_t)row * 1024;
        float* ob = p.out + (size_t)(has2 ? row2 : row) * 1024;
        float4 va[4], vb[4];
#pragma unroll
        for (int i = 0; i < 4; ++i) {
          va[i] = *(const float4*)(oa + i * 256 + lane * 4);
          vb[i] = *(const float4*)(ob + i * 256 + lane * 4);
        }
        ssa = wave_sum(ssa);
        ssb = wave_sum(ssb);
        const float ra = rsqrtf(ssa * (1.f / 1024.f) + 1e-6f);
        const float rb = rsqrtf(ssb * (1.f / 1024.f) + 1e-6f);
#pragma unroll
        for (int i = 0; i < 4; ++i) {
          const float4 gv = *(const float4*)(p.g_final + i * 256 + lane * 4);
          va[i].x *= ra * gv.x; va[i].y *= ra * gv.y; va[i].z *= ra * gv.z; va[i].w *= ra * gv.w;
          *(float4*)(oa + i * 256 + lane * 4) = va[i];
          if (has2) {
            vb[i].x *= rb * gv.x; vb[i].y *= rb * gv.y; vb[i].z *= rb * gv.z; vb[i].w *= rb * gv.w;
            *(float4*)(ob + i * 256 + lane * 4) = vb[i];
          }
        }
      }
    }
  }
}

extern "C" void kernel_launch(void* const* d_in, const int* in_sizes, int n_in, void* d_out, int out_size, void* d_ws,
                              size_t ws_size, hipStream_t stream) {
  static int grid_blocks = 0;
  if (!grid_blocks) {
    if (ws_size < WS_END || n_in != 23) {
      fprintf(stderr, "kernel_launch: unexpected ws_size %zu (need %zu) or n_in %d\n", ws_size, (size_t)WS_END, n_in);
      grid_blocks = -1;
      return;
    }
    int dev = 0, cus = 0, per_cu = 0;
    (void)hipGetDevice(&dev);
    (void)hipDeviceGetAttribute(&cus, hipDeviceAttributeMultiprocessorCount, dev);
    (void)hipFuncSetAttribute((const void*)mega, hipFuncAttributeMaxDynamicSharedMemorySize, LDS_BYTES);
    (void)hipOccupancyMaxActiveBlocksPerMultiprocessor(&per_cu, (const void*)mega, 256, LDS_BYTES);
    per_cu = (per_cu >= 2) ? 2 : 1;
    grid_blocks = cus * per_cu;
  }
  if (grid_blocks < 0) return;
  Params p{};
  const float** pp = (const float**)&p;
  for (int i = 0; i < 23; ++i) pp[i] = (const float*)d_in[i];
  p.out = (float*)d_out;
  p.ws = (char*)d_ws;
#if COOP
  (void)hipMemsetAsync((char*)d_ws + OFF_CTL + 4096, 0, XCD_BAR_WORDS * 4, stream);
  p.phase_lo = 0;
  p.phase_hi = NPHASE - 1;
  void* args[] = {&p};
  hipError_t e = hipLaunchCooperativeKernel((const void*)mega, dim3(grid_blocks), dim3(256), args, LDS_BYTES, stream);
  if (e != hipSuccess) fprintf(stderr, "cooperative launch failed: %s (grid %d)\n", hipGetErrorString(e), grid_blocks);
#else
  for (int ph = 0; ph < NPHASE; ++ph) {
    p.phase_lo = ph;
    p.phase_hi = ph;
    hipLaunchKernelGGL(mega, dim3(grid_blocks), dim3(256), LDS_BYTES, stream, p);
#ifdef PROBE_DUP
    if (ph == PROBE_DUP) {
      for (int rep = 0; rep < 2; ++rep) {
        if (ph == 2) { p.phase_lo = p.phase_hi = 1; hipLaunchKernelGGL(mega, dim3(grid_blocks), dim3(256), LDS_BYTES, stream, p); p.phase_lo = p.phase_hi = 2; }
        hipLaunchKernelGGL(mega, dim3(grid_blocks), dim3(256), LDS_BYTES, stream, p);
      }
    }
#endif
  }
#endif
}
```
